# Optimizing an MI355X kernel written in HIP

```python
import jax, jax.numpy as jnp
from jax import lax
import numpy as np

D_MODEL = 1024
BATCH = 2
SEQ = 8192
DEPTH = 1

D_POOL = D_MODEL // 2
POOL_WINDOWS = (2, 4, 8, 16)
N_POOL_GROUPS = len(POOL_WINDOWS)
POOL_GROUP_DIM = D_POOL // N_POOL_GROUPS
V_HEAD_DIM = 64
N_HEADS = (D_MODEL // 2) // V_HEAD_DIM
D_ATTN = N_HEADS * V_HEAD_DIM
D_MIX = D_POOL + D_ATTN
QK_NOPE_DIM = 64
QK_ROPE_DIM = 32
QK_DIM = QK_NOPE_DIM + QK_ROPE_DIM
Q_LORA_RANK = D_MODEL // 4
KV_LORA_RANK = D_MODEL // 8
ROPE_THETA = 10000.0
Q_BLOCK = 128
D_IN_PROJ = D_POOL + Q_LORA_RANK + KV_LORA_RANK + QK_ROPE_DIM
N_EXPERTS = 32
TOP_K = 4
D_EXPERT = D_MODEL
SWIGLU_ALPHA = 1.702
SWIGLU_LIMIT = 7.0
MOE_BLOCK = 128
RMS_EPS = 1e-6

kernel_name = 'hymba_pool_mla_moe_block'


def rmsnorm(x, g):
    xf = x.astype(jnp.float32)
    y = xf * lax.rsqrt(jnp.mean(xf * xf, axis=-1, keepdims=True) + RMS_EPS)
    return (y * g.astype(jnp.float32)).astype(x.dtype)


def rope_tables(positions):
    half = QK_ROPE_DIM // 2
    inv = ROPE_THETA ** (-jnp.arange(half, dtype=jnp.float32) / half)
    ang = positions.astype(jnp.float32)[..., None] * inv
    return jnp.cos(ang), jnp.sin(ang)


def apply_rope(x, cos, sin):
    half = QK_ROPE_DIM // 2
    xf = x.astype(jnp.float32)
    x1, x2 = xf[..., :half], xf[..., half:]
    out = jnp.concatenate([x1 * cos - x2 * sin, x2 * cos + x1 * sin], axis=-1)
    return out.astype(x.dtype)


def pool_mixer(u, w_pool, b_pool, pool_scale):
    B, S, _ = u.shape
    uf = u.reshape(B, S, N_POOL_GROUPS, POOL_GROUP_DIM).astype(jnp.float32)
    csum = jnp.pad(jnp.cumsum(uf, axis=1), ((0, 0), (1, 0), (0, 0), (0, 0)))
    t = jnp.arange(S)
    pooled = []
    for g, w in enumerate(POOL_WINDOWS):
        c = csum[:, :, g]
        lo = jnp.pad(c[:, :S + 1 - w], ((0, 0), (w - 1, 0), (0, 0)))
        cnt = jnp.minimum(t + 1, w).astype(jnp.float32)[None, :, None]
        pooled.append((c[:, 1:] - lo) / cnt)
    pooled = jnp.stack(pooled, axis=2)
    diff = (pooled - uf).astype(u.dtype)
    mixed = jnp.einsum('bsgc,gcd->bsgd', diff, w_pool) + b_pool
    return mixed.reshape(B, S, D_POOL) * pool_scale


def mla_attention(q_lat, kv_lat, k_rope_raw, cos, sin, g_q_a, w_q_b, g_kv_a, w_kv_b):
    B, S, _ = q_lat.shape
    q = (rmsnorm(q_lat, g_q_a) @ w_q_b).reshape(B, S, N_HEADS, QK_DIM)
    q_nope = q[..., :QK_NOPE_DIM]
    q_rope = apply_rope(q[..., QK_NOPE_DIM:], cos[:, :, None, :], sin[:, :, None, :])
    kv = (rmsnorm(kv_lat, g_kv_a) @ w_kv_b).reshape(B, S, N_HEADS, QK_NOPE_DIM + V_HEAD_DIM)
    k_nope, v = kv[..., :QK_NOPE_DIM], kv[..., QK_NOPE_DIM:]
    k_rope = apply_rope(k_rope_raw, cos, sin)
    scale = QK_DIM ** -0.5
    nb = S // Q_BLOCK
    qn_b = q_nope.reshape(B, nb, Q_BLOCK, N_HEADS, QK_NOPE_DIM).transpose(1, 0, 2, 3, 4)
    qr_b = q_rope.reshape(B, nb, Q_BLOCK, N_HEADS, QK_ROPE_DIM).transpose(1, 0, 2, 3, 4)
    k_idx = jnp.arange(S)

    def attend(args):
        qn, qr, blk = args
        s = (jnp.einsum('bqhd,bkhd->bhqk', qn, k_nope, preferred_element_type=jnp.float32)
             + jnp.einsum('bqhr,bkr->bhqk', qr, k_rope, preferred_element_type=jnp.float32)) * scale
        q_idx = blk * Q_BLOCK + jnp.arange(Q_BLOCK)
        s = jnp.where(k_idx[None, :] <= q_idx[:, None], s, -jnp.inf)
        p = jax.nn.softmax(s, axis=-1).astype(v.dtype)
        return jnp.einsum('bhqk,bkhd->bqhd', p, v)

    out = lax.map(attend, (qn_b, qr_b, jnp.arange(nb)))
    return out.transpose(1, 0, 2, 3, 4).reshape(B, S, D_ATTN)


def moe(h, w_router, b_router, w_gate_up, b_gate_up, w_down, b_down):
    B, S, D = h.shape
    T = B * S
    ht = h.reshape(T, D)
    logits = (ht @ w_router + b_router).astype(jnp.float32)
    top_vals, top_idx = lax.top_k(logits, TOP_K)
    gates = jax.nn.softmax(top_vals, axis=-1)
    n_assign = T * TOP_K
    e_flat = top_idx.reshape(-1).astype(jnp.int32)
    tok_flat = jnp.repeat(jnp.arange(T, dtype=jnp.int32), TOP_K)
    g_flat = gates.reshape(-1)
    order = jnp.argsort(e_flat)
    e_sorted = e_flat[order]
    counts = jnp.zeros((N_EXPERTS,), jnp.int32).at[e_flat].add(1)
    padded = ((counts + MOE_BLOCK - 1) // MOE_BLOCK) * MOE_BLOCK
    start = jnp.cumsum(counts) - counts
    pad_end = jnp.cumsum(padded)
    pad_start = pad_end - padded
    dest = pad_start[e_sorted] + (jnp.arange(n_assign, dtype=jnp.int32) - start[e_sorted])
    n_blocks = n_assign // MOE_BLOCK + N_EXPERTS
    n_rows = n_blocks * MOE_BLOCK
    row_tok = jnp.full((n_rows,), T, jnp.int32).at[dest].set(tok_flat[order])
    row_gate = jnp.zeros((n_rows,), jnp.float32).at[dest].set(g_flat[order])
    block_expert = jnp.minimum(
        jnp.searchsorted(pad_end, jnp.arange(n_blocks, dtype=jnp.int32) * MOE_BLOCK, side='right'),
        N_EXPERTS - 1)
    h_pad = jnp.concatenate([ht, jnp.zeros((1, D), ht.dtype)], axis=0)
    xb = h_pad[row_tok].reshape(n_blocks, MOE_BLOCK, D)

    def expert_block(args):
        xblk, e = args
        gu = xblk @ w_gate_up[e] + b_gate_up[e]
        gate = jnp.minimum(gu[:, :D_EXPERT], SWIGLU_LIMIT)
        up = jnp.clip(gu[:, D_EXPERT:], -SWIGLU_LIMIT, SWIGLU_LIMIT)
        act = gate * jax.nn.sigmoid(SWIGLU_ALPHA * gate) * (up + 1)
        return act @ w_down[e] + b_down[e]

    yb = lax.map(expert_block, (xb, block_expert)).reshape(n_rows, D)
    y = jnp.zeros((T + 1, D), h.dtype).at[row_tok].add(row_gate[:, None].astype(h.dtype) * yb)
    return y[:T].reshape(B, S, D)


def setup_inputs(seed: int = 0) -> dict:
    key = jax.random.key(seed)
    ks = jax.random.split(key, 24)
    L, D, E, F = DEPTH, D_MODEL, N_EXPERTS, D_EXPERT
    nrm = lambda k, shape, fan_in: jax.random.normal(k, shape, jnp.float32) * (fan_in ** -0.5)
    gain = lambda k, shape: 1.0 + 0.05 * jax.random.normal(k, shape, jnp.float32)
    small = lambda k, shape: 0.01 * jax.random.normal(k, shape, jnp.float32)
    x = jax.random.normal(ks[0], (BATCH, SEQ, D), jnp.float32)
    positions = jnp.broadcast_to(jnp.arange(SEQ, dtype=jnp.int32), (BATCH, SEQ))
    return {
        'x': x,
        'positions': positions,
        'g_attn_norm': gain(ks[1], (L, D)),
        'w_in': nrm(ks[2], (L, D, D_IN_PROJ), D),
        'w_pool': nrm(ks[3], (L, N_POOL_GROUPS, POOL_GROUP_DIM, POOL_GROUP_DIM), POOL_GROUP_DIM),
        'b_pool': small(ks[4], (L, N_POOL_GROUPS, POOL_GROUP_DIM)),
        'pool_scale': gain(ks[5], (L, D_POOL)),
        'g_q_a': gain(ks[6], (L, Q_LORA_RANK)),
        'w_q_b': nrm(ks[7], (L, Q_LORA_RANK, N_HEADS * QK_DIM), Q_LORA_RANK),
        'g_kv_a': gain(ks[8], (L, KV_LORA_RANK)),
        'w_kv_b': nrm(ks[9], (L, KV_LORA_RANK, N_HEADS * (QK_NOPE_DIM + V_HEAD_DIM)), KV_LORA_RANK),
        'g_out_pool': gain(ks[10], (L, D_POOL)),
        'g_out_attn': gain(ks[11], (L, D_ATTN)),
        'w_out': nrm(ks[12], (L, D_MIX, D), D_MIX),
        'g_ffn_norm': gain(ks[13], (L, D)),
        'w_router': nrm(ks[14], (L, D, E), D),
        'b_router': small(ks[15], (L, E)),
        'w_gate_up': nrm(ks[16], (L, E, D, 2 * F), D),
        'b_gate_up': small(ks[17], (L, E, 2 * F)),
        'w_down': nrm(ks[18], (L, E, F, D), F),
        'b_down': small(ks[19], (L, E, D)),
        'g_final': gain(ks[20], (D,)),
    }


def reference(x, positions, g_attn_norm, w_in, w_pool, b_pool, pool_scale, g_q_a, w_q_b,
              g_kv_a, w_kv_b, g_out_pool, g_out_attn, w_out, g_ffn_norm, w_router, b_router,
              w_gate_up, b_gate_up, w_down, b_down, g_final):
    cos, sin = rope_tables(positions)
    o1 = D_POOL
    o2 = o1 + Q_LORA_RANK
    o3 = o2 + KV_LORA_RANK
    for l in range(DEPTH):
        h = rmsnorm(x, g_attn_norm[l])
        proj = h @ w_in[l]
        u, q_lat, kv_lat, k_r = proj[..., :o1], proj[..., o1:o2], proj[..., o2:o3], proj[..., o3:]
        y_pool = pool_mixer(u, w_pool[l], b_pool[l], pool_scale[l])
        y_attn = mla_attention(q_lat, kv_lat, k_r, cos, sin, g_q_a[l], w_q_b[l], g_kv_a[l], w_kv_b[l])
        mix = jnp.concatenate([rmsnorm(y_pool, g_out_pool[l]), rmsnorm(y_attn, g_out_attn[l])], axis=-1)
        x = x + mix @ w_out[l]
        h = rmsnorm(x, g_ffn_norm[l])
        x = x + moe(h, w_router[l], b_router[l], w_gate_up[l], b_gate_up[l], w_down[l], b_down[l])
    return rmsnorm(x, g_final)
```

```cpp
#include <hip/hip_runtime.h>
#include <cstdint>
#include <cstdio>

typedef unsigned short bf16_t;
typedef short bf16x8 __attribute__((ext_vector_type(8)));
typedef float f32x4 __attribute__((ext_vector_type(4)));
typedef unsigned u32x4 __attribute__((ext_vector_type(4)));
typedef unsigned u32x2 __attribute__((ext_vector_type(2)));

constexpr int BATCH = 2, SEQ = 8192, T = BATCH * SEQ, D = 1024;
constexpr int DPOOL = 512, NPG = 4, PGD = 128;
constexpr int NH = 8, VD = 64, QKN = 64, QKR = 32, QKD = 96;
constexpr int QLR = 256, KVLR = 128, DINP = 928;
constexpr int NE = 32, TOPK = 4, DE = 1024;
constexpr float RMS_EPS = 1e-6f;
constexpr float QSCALE = 0.10206207261596577f * 1.4426950408889634f;
constexpr int SLOT_ROWS = T * TOPK + NE * 256;

constexpr size_t MiB = 1u << 20;
constexpr size_t WS_CTL = 0;
constexpr size_t CTL_BYTES = 1 * MiB;
constexpr size_t WS_COS = 1 * MiB, WS_SIN = 2 * MiB;
constexpr size_t WS_WIN = 4 * MiB;
constexpr size_t WS_WQB = 6 * MiB;
constexpr size_t WS_WKVB = 7 * MiB;
constexpr size_t WS_WPOOL = 7 * MiB + 512 * 1024;
constexpr size_t WS_WOUT = 8 * MiB;
constexpr size_t WS_WGU = 16 * MiB;
constexpr size_t WS_WD = 144 * MiB;
constexpr size_t WS_XN = 208 * MiB;
constexpr size_t WS_U = 240 * MiB;
constexpr size_t WS_QN = 256 * MiB;
constexpr size_t WS_KVN = 264 * MiB;
constexpr size_t WS_KR = 268 * MiB;
constexpr size_t WS_Q = 272 * MiB;
constexpr size_t WS_K = 296 * MiB;
constexpr size_t WS_V = 320 * MiB;
constexpr size_t WS_MIX = 336 * MiB;
constexpr size_t WS_SSQ = 368 * MiB;
constexpr size_t WS_H = 370 * MiB;
constexpr size_t WS_SLOT = 402 * MiB;
constexpr size_t WS_LIST = 403 * MiB;
constexpr size_t WS_GLIST = 405 * MiB;
constexpr size_t WS_ACT = 408 * MiB;
constexpr size_t WS_Y = 552 * MiB;
constexpr size_t WS_TMP = 700 * MiB;
constexpr size_t WS_END = 828 * MiB;
constexpr int CW_CNT = 64;

__device__ __forceinline__ unsigned f2bf(float f) { unsigned u = __builtin_bit_cast(unsigned, f); return (u + 0x7fffu + ((u >> 16) & 1u)) >> 16; }
__device__ __forceinline__ unsigned pk2(float lo, float hi) { return f2bf(lo) | (f2bf(hi) << 16); }
__device__ __forceinline__ float bf2f(bf16_t b) { return __builtin_bit_cast(float, (unsigned)b << 16); }
__device__ __forceinline__ float wave_sum(float v) {
#pragma unroll
    for (int o = 1; o < 64; o <<= 1) v += __shfl_xor(v, o);
    return v;
}
__device__ __forceinline__ float wave_max(float v) {
#pragma unroll
    for (int o = 1; o < 64; o <<= 1) v = fmaxf(v, __shfl_xor(v, o));
    return v;
}

__device__ __forceinline__ void transpose_item(const float* W, int ldw, int k0, int n0, bf16_t* WT, int ldt, int dn0, int dk0,
                                               const float* ksc, float* scr, int lane) {
#pragma unroll 8
    for (int i = 0; i < 32; ++i) { const int kk = 2 * i + (lane >> 5); float v = W[(size_t)(k0 + kk) * ldw + n0 + (lane & 31)]; if (ksc) v *= ksc[kk]; scr[kk * 33 + (lane & 31)] = v; }
    asm volatile("s_waitcnt lgkmcnt(0)" ::: "memory");
    const int c = lane & 7;
#pragma unroll
    for (int j = 0; j < 4; ++j) { const int n = (lane >> 3) + 8 * j; const float* s = scr + (8 * c) * 33 + n;
        u32x4 o; o.x = pk2(s[0 * 33], s[1 * 33]); o.y = pk2(s[2 * 33], s[3 * 33]); o.z = pk2(s[4 * 33], s[5 * 33]); o.w = pk2(s[6 * 33], s[7 * 33]);
        *(u32x4*)(WT + (size_t)(dn0 + n) * ldt + dk0 + 8 * c) = o; }
    asm volatile("s_waitcnt lgkmcnt(0)" ::: "memory");
}

struct Ptrs {
    const float* x; const int* pos; const float* g_attn; const float* w_in; const float* w_pool; const float* b_pool; const float* pool_scale;
    const float* g_q_a; const float* w_q_b; const float* g_kv_a; const float* w_kv_b; const float* g_out_pool; const float* g_out_attn; const float* w_out;
    const float* g_ffn; const float* w_router; const float* b_router; const float* w_gu; const float* b_gu; const float* w_down; const float* b_down; const float* g_final;
    float* out; unsigned char* ws;
};

constexpr int IT_IN = 16 * 29, IT_QB = 4 * 24, IT_KVB = 2 * 32, IT_POOL = 4 * 2 * 4, IT_OUT = 16 * 32, IT_GU = 32 * 16 * 64, IT_DN = 32 * 16 * 32;
constexpr int IT_TOTAL = IT_IN + IT_QB + IT_KVB + IT_POOL + IT_OUT + IT_GU + IT_DN;

__device__ __forceinline__ void prologue_item(const Ptrs& P, int it, float* scr, int lane) {
    unsigned char* ws = P.ws;
    int r = it;
    if (r < IT_IN) { const int kb = r / 29, nb = r % 29; transpose_item(P.w_in, DINP, 64 * kb, 32 * nb, (bf16_t*)(ws + WS_WIN), 1024, 32 * nb, 64 * kb, nullptr, scr, lane); return; } r -= IT_IN;
    if (r < IT_QB) { const int kb = r / 24, nb = r % 24; transpose_item(P.w_q_b, 768, 64 * kb, 32 * nb, (bf16_t*)(ws + WS_WQB), 256, 32 * nb, 64 * kb, nullptr, scr, lane); return; } r -= IT_QB;
    if (r < IT_KVB) { const int kb = r / 32, nb = r % 32; transpose_item(P.w_kv_b, 1024, 64 * kb, 32 * nb, (bf16_t*)(ws + WS_WKVB), 128, 32 * nb, 64 * kb, nullptr, scr, lane); return; } r -= IT_KVB;
    if (r < IT_POOL) { const int g = r / 8, kb = (r % 8) / 4, nb = r % 4; transpose_item(P.w_pool + (size_t)g * 128 * 128, 128, 64 * kb, 32 * nb, (bf16_t*)(ws + WS_WPOOL) + (size_t)g * 128 * 128, 128, 32 * nb, 64 * kb, nullptr, scr, lane); return; } r -= IT_POOL;
    if (r < IT_OUT) { const int kb = r / 32, nb = r % 32, k0 = 64 * kb; const float* ksc = k0 < 512 ? P.g_out_pool + k0 : P.g_out_attn + (k0 - 512);
        transpose_item(P.w_out, 1024, k0, 32 * nb, (bf16_t*)(ws + WS_WOUT), 1024, 32 * nb, (k0 + 512) & 1023, ksc, scr, lane); return; } r -= IT_OUT;
    if (r < IT_GU) { const int e = r / 1024, q = r % 1024, kb = q / 64, nb = q % 64, n0 = 32 * nb; const int nn = n0 & 1023, p = nn >> 7, dn0 = 256 * p + (n0 >= 1024 ? 128 : 0) + (nn & 127);
        transpose_item(P.w_gu + (size_t)e * 1024 * 2048, 2048, 64 * kb, n0, (bf16_t*)(ws + WS_WGU) + (size_t)e * 2048 * 1024, 1024, dn0, 64 * kb, nullptr, scr, lane); return; } r -= IT_GU;
    { const int e = r / 512, q = r % 512, kb = q / 32, nb = q % 32;
        transpose_item(P.w_down + (size_t)e * 1024 * 1024, 1024, 64 * kb, 32 * nb, (bf16_t*)(ws + WS_WD) + (size_t)e * 1024 * 1024, 1024, 32 * nb, 64 * kb, nullptr, scr, lane); }
}

__device__ __forceinline__ void rms_row_to_bf16(const float* xrow, const float* g, bf16_t* orow, int lane) {
    const f32x4* xr = (const f32x4*)xrow + lane; const f32x4* gr = (const f32x4*)g + lane;
    f32x4 v[4]; float s = 0.f;
#pragma unroll
    for (int j = 0; j < 4; ++j) { v[j] = xr[64 * j]; s += (v[j].x * v[j].x + v[j].y * v[j].y) + (v[j].z * v[j].z + v[j].w * v[j].w); }
    const float rstd = 1.f / sqrtf(wave_sum(s) * (1.f / 1024.f) + RMS_EPS);
    u32x2* o8 = (u32x2*)orow + lane;
#pragma unroll
    for (int j = 0; j < 4; ++j) { const f32x4 gg = gr[64 * j]; u32x2 w; w.x = pk2(v[j].x * rstd * gg.x, v[j].y * rstd * gg.y); w.y = pk2(v[j].z * rstd * gg.z, v[j].w * rstd * gg.w); o8[64 * j] = w; }
}

__global__ __launch_bounds__(256) void k_prologue(Ptrs P) {
    __shared__ float scr_all[4][64 * 33];
    const int tid = threadIdx.x, lane = tid & 63, wave = tid >> 6;
    const int gw = blockIdx.x * 4 + wave, NGW = gridDim.x * 4;
    float* scr = scr_all[wave];
    for (int it = gw; it < IT_TOTAL; it += NGW) prologue_item(P, it, scr, lane);
    { bf16_t* w = (bf16_t*)(P.ws + WS_WIN) + (size_t)DINP * 1024; const int n8 = (1024 - DINP) * 1024 / 8;
      for (int i = blockIdx.x * 256 + tid; i < n8; i += gridDim.x * 256) ((u32x4*)w)[i] = (u32x4){0u, 0u, 0u, 0u}; }
    for (int m = gw; m < T; m += NGW) rms_row_to_bf16(P.x + (size_t)m * D, P.g_attn, (bf16_t*)(P.ws + WS_XN) + (size_t)m * D, lane);
    { float* C = (float*)(P.ws + WS_COS); float* S = (float*)(P.ws + WS_SIN);
      for (int i = blockIdx.x * 256 + tid; i < T * 16; i += gridDim.x * 256) { const int t = i >> 4, j = i & 15;
          const float inv = (float)pow(10000.0, -(double)j / 16.0); const float ang = (float)P.pos[t] * inv;
          C[i] = (float)cos((double)ang); S[i] = (float)sin((double)ang); } }
}

__global__ __launch_bounds__(256) void k_gemm_f32(const bf16_t* A, int lda, const bf16_t* Bt, int ldb, float* C, int ldc, int K) {
    const int tid = threadIdx.x, lane = tid & 63, w = tid >> 6, wr = w >> 1, wc = w & 1;
    const int row0 = blockIdx.y * 64 + wr * 32, col0 = blockIdx.x * 128 + wc * 64;
    const int fr = lane & 15, fq = lane >> 4;
    f32x4 acc[2][4];
#pragma unroll
    for (int i = 0; i < 2; ++i)
#pragma unroll
        for (int j = 0; j < 4; ++j) acc[i][j] = (f32x4){0.f, 0.f, 0.f, 0.f};
    for (int k0 = 0; k0 < K; k0 += 32) {
        bf16x8 a[2], b[4];
#pragma unroll
        for (int i = 0; i < 2; ++i) a[i] = *(const bf16x8*)(A + (size_t)(row0 + i * 16 + fr) * lda + k0 + 8 * fq);
#pragma unroll
        for (int j = 0; j < 4; ++j) b[j] = *(const bf16x8*)(Bt + (size_t)(col0 + j * 16 + fr) * ldb + k0 + 8 * fq);
#pragma unroll
        for (int i = 0; i < 2; ++i)
#pragma unroll
            for (int j = 0; j < 4; ++j) acc[i][j] = __builtin_amdgcn_mfma_f32_16x16x32_bf16(a[i], b[j], acc[i][j], 0, 0, 0);
    }
#pragma unroll
    for (int i = 0; i < 2; ++i)
#pragma unroll
        for (int j = 0; j < 4; ++j)
#pragma unroll
            for (int r = 0; r < 4; ++r) C[(size_t)(row0 + i * 16 + fq * 4 + r) * ldc + col0 + j * 16 + fr] = acc[i][j][r];
}

__global__ __launch_bounds__(256) void k_e1(Ptrs P) {
    const int tid = threadIdx.x, lane = tid & 63; const int gw = blockIdx.x * 4 + (tid >> 6), NGW = gridDim.x * 4;
    const float* PROJ = (const float*)(P.ws + WS_TMP);
    const float* COS = (const float*)(P.ws + WS_COS); const float* SIN = (const float*)(P.ws + WS_SIN);
    for (int t = gw; t < T; t += NGW) {
        const float* pr = PROJ + (size_t)t * 1024;
        bf16_t* u = (bf16_t*)(P.ws + WS_U) + (size_t)t * 512;
        for (int c = lane; c < 512; c += 64) u[c] = (bf16_t)f2bf(pr[c]);
        { float v[4]; float s = 0.f; for (int j = 0; j < 4; ++j) { v[j] = pr[512 + lane + 64 * j]; s += v[j] * v[j]; }
          const float rstd = 1.f / sqrtf(wave_sum(s) * (1.f / 256.f) + RMS_EPS);
          bf16_t* q = (bf16_t*)(P.ws + WS_QN) + (size_t)t * 256;
          for (int j = 0; j < 4; ++j) q[lane + 64 * j] = (bf16_t)f2bf(v[j] * rstd * P.g_q_a[lane + 64 * j]); }
        { float v[2]; float s = 0.f; for (int j = 0; j < 2; ++j) { v[j] = pr[768 + lane + 64 * j]; s += v[j] * v[j]; }
          const float rstd = 1.f / sqrtf(wave_sum(s) * (1.f / 128.f) + RMS_EPS);
          bf16_t* q = (bf16_t*)(P.ws + WS_KVN) + (size_t)t * 128;
          for (int j = 0; j < 2; ++j) q[lane + 64 * j] = (bf16_t)f2bf(v[j] * rstd * P.g_kv_a[lane + 64 * j]); }
        if (lane < 16) { const float x1 = pr[896 + lane], x2 = pr[896 + 16 + lane]; const float c = COS[t * 16 + lane], s = SIN[t * 16 + lane];
          bf16_t* kr = (bf16_t*)(P.ws + WS_KR) + (size_t)t * 32; kr[lane] = (bf16_t)f2bf(x1 * c - x2 * s); kr[16 + lane] = (bf16_t)f2bf(x2 * c + x1 * s); }
    }
}
__global__ __launch_bounds__(256) void k_e2q(Ptrs P) {
    const float* TMP = (const float*)(P.ws + WS_TMP); const float* COS = (const float*)(P.ws + WS_COS); const float* SIN = (const float*)(P.ws + WS_SIN);
    bf16_t* Q = (bf16_t*)(P.ws + WS_Q);
    for (size_t i = (size_t)blockIdx.x * 256 + threadIdx.x; i < (size_t)T * 768; i += (size_t)gridDim.x * 256) {
        const int t = (int)(i / 768), c = (int)(i % 768), h = c / 96, d = c % 96; float v;
        if (d < 64) v = TMP[i];
        else { const int j = (d - 64) & 15; const float x1 = TMP[(size_t)t * 768 + h * 96 + 64 + j], x2 = TMP[(size_t)t * 768 + h * 96 + 80 + j]; const float cc = COS[t * 16 + j], ss = SIN[t * 16 + j];
               v = (d < 80) ? (x1 * cc - x2 * ss) : (x2 * cc + x1 * ss); }
        Q[i] = (bf16_t)f2bf(v * QSCALE);
    }
}
__global__ __launch_bounds__(256) void k_e2kv(Ptrs P) {
    const float* TMP = (const float*)(P.ws + WS_TMP); const bf16_t* KR = (const bf16_t*)(P.ws + WS_KR);
    bf16_t* K = (bf16_t*)(P.ws + WS_K); bf16_t* V = (bf16_t*)(P.ws + WS_V);
    for (size_t i = (size_t)blockIdx.x * 256 + threadIdx.x; i < (size_t)T * 768; i += (size_t)gridDim.x * 256) {
        const int t = (int)(i / 768), c = (int)(i % 768), h = c / 96, d = c % 96;
        K[i] = d < 64 ? (bf16_t)f2bf(TMP[(size_t)t * 1024 + h * 128 + d]) : KR[(size_t)t * 32 + d - 64];
    }
    for (size_t i = (size_t)blockIdx.x * 256 + threadIdx.x; i < (size_t)T * 512; i += (size_t)gridDim.x * 256) {
        const int t = (int)(i / 512), c = (int)(i % 512), h = c / 64, d = c % 64;
        V[i] = (bf16_t)f2bf(TMP[(size_t)t * 1024 + h * 128 + 64 + d]);
    }
}
__global__ __launch_bounds__(256) void k_pooldiff(Ptrs P) {
    const bf16_t* U = (const bf16_t*)(P.ws + WS_U); bf16_t* DIFF = (bf16_t*)(P.ws + WS_H);
    for (size_t i = (size_t)blockIdx.x * 256 + threadIdx.x; i < (size_t)T * 512; i += (size_t)gridDim.x * 256) {
        const int t = (int)(i / 512), c = (int)(i % 512), g = c / 128, s = t % SEQ, w = 2 << g; const int n = s + 1 < w ? s + 1 : w;
        float sum = 0.f; for (int j = 0; j < n; ++j) sum += bf2f(U[(size_t)(t - j) * 512 + c]);
        DIFF[i] = (bf16_t)f2bf(sum / (float)n - bf2f(U[i]));
    }
}
__global__ __launch_bounds__(256) void k_epool(Ptrs P) {
    const int tid = threadIdx.x, lane = tid & 63; const int gw = blockIdx.x * 4 + (tid >> 6), NGW = gridDim.x * 4;
    const float* TMP = (const float*)(P.ws + WS_TMP);
    for (int t = gw; t < T; t += NGW) {
        float v[8]; float s = 0.f;
        for (int j = 0; j < 8; ++j) { const int c = lane + 64 * j; v[j] = (TMP[(size_t)t * 512 + c] + P.b_pool[c]) * P.pool_scale[c]; s += v[j] * v[j]; }
        const float rstd = 1.f / sqrtf(wave_sum(s) * (1.f / 512.f) + RMS_EPS);
        bf16_t* m = (bf16_t*)(P.ws + WS_MIX) + (size_t)t * 1024 + 512;
        for (int j = 0; j < 8; ++j) m[lane + 64 * j] = (bf16_t)f2bf(v[j] * rstd);
    }
}
__global__ __launch_bounds__(256) void k_attn_naive(Ptrs P) {
    __shared__ float qs[4][96];
    const int tid = threadIdx.x, lane = tid & 63, wv = tid >> 6;
    const bf16_t* Q = (const bf16_t*)(P.ws + WS_Q); const bf16_t* K = (const bf16_t*)(P.ws + WS_K); const bf16_t* V = (const bf16_t*)(P.ws + WS_V);
    bf16_t* MIX = (bf16_t*)(P.ws + WS_MIX); float* SSQ = (float*)(P.ws + WS_SSQ);
    const int item = blockIdx.x * 4 + wv;
    const int t = item >> 3, h = item & 7, b = t / SEQ, s = t % SEQ;
    for (int d = lane; d < 96; d += 64) qs[wv][d] = bf2f(Q[(size_t)t * 768 + h * 96 + d]);
    asm volatile("s_waitcnt lgkmcnt(0)" ::: "memory");
    float m = -1e30f, l = 0.f, o = 0.f;
    const int ntile = s / 64 + 1;
    for (int kt = 0; kt < ntile; ++kt) {
        const int key = kt * 64 + lane; const size_t krow = (size_t)(b * SEQ + key);
        float sc = -__builtin_inff();
        if (key <= s) { const bf16_t* kp = K + krow * 768 + h * 96; float a = 0.f;
            for (int d8 = 0; d8 < 12; ++d8) { const bf16x8 kv = *(const bf16x8*)(kp + d8 * 8);
#pragma unroll
                for (int j = 0; j < 8; ++j) a += qs[wv][d8 * 8 + j] * bf2f((bf16_t)kv[j]); }
            sc = a; }
        const float mn = fmaxf(m, wave_max(sc)); const float alpha = exp2f(m - mn); const float p = exp2f(sc - mn);
        const float pb = bf2f((bf16_t)f2bf(p));
        l = l * alpha + wave_sum(pb); o *= alpha; m = mn;
        const int nk = (kt == ntile - 1) ? (s - kt * 64 + 1) : 64;
        for (int j = 0; j < nk; ++j) { const float pj = __shfl(pb, j); o += pj * bf2f(V[(size_t)(b * SEQ + kt * 64 + j) * 512 + h * 64 + lane]); }
    }
    const float ov = o / l;
    MIX[(size_t)t * 1024 + h * 64 + lane] = (bf16_t)f2bf(ov);
    const float ss = wave_sum(ov * ov);
    if (lane == 0) SSQ[t * 8 + h] = ss;
}
__global__ __launch_bounds__(256) void k_e4(Ptrs P) {
    const float* T1 = (const float*)(P.ws + WS_TMP); const float* T2 = T1 + (size_t)T * 1024; const float* SSQ = (const float*)(P.ws + WS_SSQ);
    for (size_t i = (size_t)blockIdx.x * 256 + threadIdx.x; i < (size_t)T * 1024; i += (size_t)gridDim.x * 256) {
        const int t = (int)(i >> 10); float s = 0.f; for (int h = 0; h < 8; ++h) s += SSQ[t * 8 + h];
        const float sa = 1.f / sqrtf(s * (1.f / 512.f) + RMS_EPS);
        P.out[i] = P.x[i] + sa * T1[i] + T2[i];
    }
}
__global__ __launch_bounds__(256) void k_router(Ptrs P) {
    __shared__ float hs[4][1024];
    const int tid = threadIdx.x, lane = tid & 63, wv = tid >> 6; const int gw = blockIdx.x * 4 + wv, NGW = gridDim.x * 4;
    int* cnt = (int*)(P.ws + WS_CTL) + CW_CNT; int* SLOT = (int*)(P.ws + WS_SLOT); int* LIST = (int*)(P.ws + WS_LIST); float* GLIST = (float*)(P.ws + WS_GLIST);
    for (int t = gw; t < T; t += NGW) {
        const f32x4* xr = (const f32x4*)(P.out + (size_t)t * 1024) + lane; const f32x4* gr = (const f32x4*)P.g_ffn + lane;
        f32x4 v[4]; float s = 0.f;
        for (int j = 0; j < 4; ++j) { v[j] = xr[64 * j]; s += (v[j].x * v[j].x + v[j].y * v[j].y) + (v[j].z * v[j].z + v[j].w * v[j].w); }
        const float rstd = 1.f / sqrtf(wave_sum(s) * (1.f / 1024.f) + RMS_EPS);
        u32x2* ho = (u32x2*)((bf16_t*)(P.ws + WS_H) + (size_t)t * 1024) + lane;
        for (int j = 0; j < 4; ++j) { const f32x4 gg = gr[64 * j]; f32x4 hv = {v[j].x * rstd * gg.x, v[j].y * rstd * gg.y, v[j].z * rstd * gg.z, v[j].w * rstd * gg.w};
            ((f32x4*)hs[wv])[lane + 64 * j] = hv; u32x2 w; w.x = pk2(hv.x, hv.y); w.y = pk2(hv.z, hv.w); ho[64 * j] = w; }
        asm volatile("s_waitcnt lgkmcnt(0)" ::: "memory");
        const int e = lane & 31, half = lane >> 5; float a = 0.f;
        for (int c = half * 512; c < half * 512 + 512; ++c) a += hs[wv][c] * P.w_router[c * 32 + e];
        a += __shfl_xor(a, 32); a += P.b_router[e];
        float lv[4]; int li[4]; unsigned long long used = 0ull;
        for (int k = 0; k < 4; ++k) { float best = -__builtin_inff(); int bi = 0;
            for (int j = 0; j < 32; ++j) { const float x = __shfl(a, j); if (!((used >> j) & 1ull) && x > best) { best = x; bi = j; } }
            lv[k] = best; li[k] = bi; used |= 1ull << bi; }
        const float e0 = 1.f, e1 = expf(lv[1] - lv[0]), e2 = expf(lv[2] - lv[0]), e3 = expf(lv[3] - lv[0]); const float inv = 1.f / (e0 + e1 + e2 + e3);
        const float gt[4] = {e0 * inv, e1 * inv, e2 * inv, e3 * inv};
        if (lane < 4) { const int k = lane; const int ex = li[k]; const int pos = atomicAdd(&cnt[ex], 1); SLOT[t * 4 + k] = ex * T + pos; LIST[ex * T + pos] = t; GLIST[ex * T + pos] = gt[k]; }
        asm volatile("s_waitcnt lgkmcnt(0)" ::: "memory");
    }
}
__device__ __forceinline__ int slot_base(const int* cnt, int e) { int s = 0; for (int i = 0; i < e; ++i) s += (cnt[i] + 255) & ~255; return s; }
__global__ __launch_bounds__(256) void k_moe1_naive(Ptrs P) {
    const int* cnt = (const int*)(P.ws + WS_CTL) + CW_CNT; const int e = blockIdx.z, n = cnt[e], m0 = blockIdx.y * 64; if (m0 >= n) return;
    const int tid = threadIdx.x, lane = tid & 63, w = tid >> 6, wr = w >> 1, wc = w & 1, fr = lane & 15, fq = lane >> 4;
    const int* LIST = (const int*)(P.ws + WS_LIST) + (size_t)e * T; const bf16_t* H = (const bf16_t*)(P.ws + WS_H);
    const bf16_t* W = (const bf16_t*)(P.ws + WS_WGU) + (size_t)e * 2048 * 1024;
    const int ca0 = blockIdx.x * 64 + wc * 32;
    const int p = ca0 >> 7, r0 = ca0 & 127;
    int tok[2]; for (int i = 0; i < 2; ++i) { int m = m0 + wr * 32 + i * 16 + fr; if (m >= n) m = 0; tok[i] = LIST[m]; }
    f32x4 ag[2][2], au[2][2];
    for (int i = 0; i < 2; ++i) for (int j = 0; j < 2; ++j) { ag[i][j] = (f32x4){0.f, 0.f, 0.f, 0.f}; au[i][j] = (f32x4){0.f, 0.f, 0.f, 0.f}; }
    for (int k0 = 0; k0 < 1024; k0 += 32) {
        bf16x8 a[2], bg[2], bu[2];
        for (int i = 0; i < 2; ++i) a[i] = *(const bf16x8*)(H + (size_t)tok[i] * 1024 + k0 + 8 * fq);
        for (int j = 0; j < 2; ++j) { bg[j] = *(const bf16x8*)(W + (size_t)(256 * p + r0 + j * 16 + fr) * 1024 + k0 + 8 * fq); bu[j] = *(const bf16x8*)(W + (size_t)(256 * p + 128 + r0 + j * 16 + fr) * 1024 + k0 + 8 * fq); }
        for (int i = 0; i < 2; ++i) for (int j = 0; j < 2; ++j) { ag[i][j] = __builtin_amdgcn_mfma_f32_16x16x32_bf16(a[i], bg[j], ag[i][j], 0, 0, 0); au[i][j] = __builtin_amdgcn_mfma_f32_16x16x32_bf16(a[i], bu[j], au[i][j], 0, 0, 0); }
    }
    const int sb = slot_base(cnt, e); bf16_t* ACT = (bf16_t*)(P.ws + WS_ACT);
    for (int i = 0; i < 2; ++i) for (int j = 0; j < 2; ++j) for (int r = 0; r < 4; ++r) {
        const int m = m0 + wr * 32 + i * 16 + fq * 4 + r, c = ca0 + j * 16 + fr; if (m >= n) continue;
        float g = ag[i][j][r] + P.b_gu[e * 2048 + c], u = au[i][j][r] + P.b_gu[e * 2048 + 1024 + c];
        g = fminf(g, 7.f); u = fminf(fmaxf(u, -7.f), 7.f);
        const float act = g * (1.f / (1.f + expf(-1.702f * g))) * (u + 1.f);
        ACT[(size_t)(sb + m) * 1024 + c] = (bf16_t)f2bf(act);
    }
}
__global__ __launch_bounds__(256) void k_moe2_naive(Ptrs P) {
    const int* cnt = (const int*)(P.ws + WS_CTL) + CW_CNT; const int e = blockIdx.z, n = cnt[e], m0 = blockIdx.y * 64; if (m0 >= n) return;
    const int tid = threadIdx.x, lane = tid & 63, w = tid >> 6, wr = w >> 1, wc = w & 1, fr = lane & 15, fq = lane >> 4;
    const int sb = slot_base(cnt, e); const bf16_t* ACT = (const bf16_t*)(P.ws + WS_ACT) + (size_t)sb * 1024; bf16_t* Y = (bf16_t*)(P.ws + WS_Y) + (size_t)sb * 1024;
    const bf16_t* W = (const bf16_t*)(P.ws + WS_WD) + (size_t)e * 1024 * 1024; const float* GL = (const float*)(P.ws + WS_GLIST) + (size_t)e * T;
    const int col0 = blockIdx.x * 128 + wc * 64, row0 = m0 + wr * 32;
    f32x4 acc[2][4]; for (int i = 0; i < 2; ++i) for (int j = 0; j < 4; ++j) acc[i][j] = (f32x4){0.f, 0.f, 0.f, 0.f};
    for (int k0 = 0; k0 < 1024; k0 += 32) {
        bf16x8 a[2], b[4];
        for (int i = 0; i < 2; ++i) { int m = row0 + i * 16 + fr; if (m >= n) m = 0; a[i] = *(const bf16x8*)(ACT + (size_t)m * 1024 + k0 + 8 * fq); }
        for (int j = 0; j < 4; ++j) b[j] = *(const bf16x8*)(W + (size_t)(col0 + j * 16 + fr) * 1024 + k0 + 8 * fq);
        for (int i = 0; i < 2; ++i) for (int j = 0; j < 4; ++j) acc[i][j] = __builtin_amdgcn_mfma_f32_16x16x32_bf16(a[i], b[j], acc[i][j], 0, 0, 0);
    }
    for (int i = 0; i < 2; ++i) for (int j = 0; j < 4; ++j) for (int r = 0; r < 4; ++r) {
        const int m = row0 + i * 16 + fq * 4 + r, c = col0 + j * 16 + fr; if (m >= n) continue;
        Y[(size_t)m * 1024 + c] = (bf16_t)f2bf((acc[i][j][r] + P.b_down[e * 1024 + c]) * GL[m]);
    }
}
__global__ __launch_bounds__(256) void k_final(Ptrs P) {
    const int tid = threadIdx.x, lane = tid & 63; const int gw = blockIdx.x * 4 + (tid >> 6), NGW = gridDim.x * 4;
    const int* cnt = (const int*)(P.ws + WS_CTL) + CW_CNT; const int* SLOT = (const int*)(P.ws + WS_SLOT); const bf16_t* Y = (const bf16_t*)(P.ws + WS_Y);
    __shared__ int sbase[32];
    if (tid < 32) sbase[tid] = slot_base(cnt, tid);
    __syncthreads();
    for (int t = gw; t < T; t += NGW) {
        f32x4* xr = (f32x4*)(P.out + (size_t)t * 1024) + lane; const f32x4* gr = (const f32x4*)P.g_final + lane;
        f32x4 v[4]; for (int j = 0; j < 4; ++j) v[j] = xr[64 * j];
        for (int k = 0; k < 4; ++k) { const int sl = SLOT[t * 4 + k]; const int e = sl / T, pos = sl % T; const u32x2* yr = (const u32x2*)(Y + (size_t)(sbase[e] + pos) * 1024) + lane;
            for (int j = 0; j < 4; ++j) { const u32x2 w = yr[64 * j]; v[j].x += __builtin_bit_cast(float, w.x << 16); v[j].y += __builtin_bit_cast(float, w.x & 0xffff0000u); v[j].z += __builtin_bit_cast(float, w.y << 16); v[j].w += __builtin_bit_cast(float, w.y & 0xffff0000u); } }
        float s = 0.f; for (int j = 0; j < 4; ++j) s += (v[j].x * v[j].x + v[j].y * v[j].y) + (v[j].z * v[j].z + v[j].w * v[j].w);
        const float rstd = 1.f / sqrtf(wave_sum(s) * (1.f / 1024.f) + RMS_EPS);
        for (int j = 0; j < 4; ++j) { const f32x4 gg = gr[64 * j]; xr[64 * j] = (f32x4){v[j].x * rstd * gg.x, v[j].y * rstd * gg.y, v[j].z * rstd * gg.z, v[j].w * rstd * gg.w}; }
    }
}

extern "C" void kernel_launch(void* const* d_in, const int* in_sizes, int n_in, void* d_out, int out_size, void* d_ws, size_t ws_size, hipStream_t stream) {
    if (n_in != 22 || out_size != T * D || ws_size < WS_END) { fprintf(stderr, "kernel_launch: unexpected shapes (n_in %d out %d ws %zu)\n", n_in, out_size, ws_size); return; }
    Ptrs P{};
    P.x = (const float*)d_in[0]; P.pos = (const int*)d_in[1]; P.g_attn = (const float*)d_in[2]; P.w_in = (const float*)d_in[3]; P.w_pool = (const float*)d_in[4];
    P.b_pool = (const float*)d_in[5]; P.pool_scale = (const float*)d_in[6]; P.g_q_a = (const float*)d_in[7]; P.w_q_b = (const float*)d_in[8]; P.g_kv_a = (const float*)d_in[9];
    P.w_kv_b = (const float*)d_in[10]; P.g_out_pool = (const float*)d_in[11]; P.g_out_attn = (const float*)d_in[12]; P.w_out = (const float*)d_in[13]; P.g_ffn = (const float*)d_in[14];
    P.w_router = (const float*)d_in[15]; P.b_router = (const float*)d_in[16]; P.w_gu = (const float*)d_in[17]; P.b_gu = (const float*)d_in[18]; P.w_down = (const float*)d_in[19];
    P.b_down = (const float*)d_in[20]; P.g_final = (const float*)d_in[21]; P.out = (float*)d_out; P.ws = (unsigned char*)d_ws;
    unsigned char* ws = (unsigned char*)d_ws;
    hipMemsetAsync(ws + WS_CTL, 0, CTL_BYTES, stream);
    k_prologue<<<1024, 256, 0, stream>>>(P);
    float* TMP = (float*)(ws + WS_TMP);
    k_gemm_f32<<<dim3(1024 / 128, T / 64), 256, 0, stream>>>((const bf16_t*)(ws + WS_XN), 1024, (const bf16_t*)(ws + WS_WIN), 1024, TMP, 1024, 1024);
    k_e1<<<1024, 256, 0, stream>>>(P);
    k_gemm_f32<<<dim3(768 / 128, T / 64), 256, 0, stream>>>((const bf16_t*)(ws + WS_QN), 256, (const bf16_t*)(ws + WS_WQB), 256, TMP, 768, 256);
    k_e2q<<<2048, 256, 0, stream>>>(P);
    k_gemm_f32<<<dim3(1024 / 128, T / 64), 256, 0, stream>>>((const bf16_t*)(ws + WS_KVN), 128, (const bf16_t*)(ws + WS_WKVB), 128, TMP, 1024, 128);
    k_e2kv<<<2048, 256, 0, stream>>>(P);
    k_pooldiff<<<2048, 256, 0, stream>>>(P);
    for (int g = 0; g < 4; ++g)
        k_gemm_f32<<<dim3(1, T / 64), 256, 0, stream>>>((const bf16_t*)(ws + WS_H) + g * 128, 512, (const bf16_t*)(ws + WS_WPOOL) + (size_t)g * 128 * 128, 128, TMP + g * 128, 512, 128);
    k_epool<<<1024, 256, 0, stream>>>(P);
    k_attn_naive<<<T * 8 / 4, 256, 0, stream>>>(P);
    k_gemm_f32<<<dim3(1024 / 128, T / 64), 256, 0, stream>>>((const bf16_t*)(ws + WS_MIX), 1024, (const bf16_t*)(ws + WS_WOUT), 1024, TMP, 1024, 512);
    k_gemm_f32<<<dim3(1024 / 128, T / 64), 256, 0, stream>>>((const bf16_t*)(ws + WS_MIX) + 512, 1024, (const bf16_t*)(ws + WS_WOUT) + 512, 1024, TMP + (size_t)T * 1024, 1024, 512);
    k_e4<<<2048, 256, 0, stream>>>(P);
    k_router<<<1024, 256, 0, stream>>>(P);
    k_moe1_naive<<<dim3(16, T / 64, 32), 256, 0, stream>>>(P);
    k_moe2_naive<<<dim3(8, T / 64, 32), 256, 0, stream>>>(P);
    k_final<<<1024, 256, 0, stream>>>(P);
}
```

```cpp
#include <hip/hip_runtime.h>
#include <cstdint>
#include <cstdio>

typedef unsigned short bf16_t;
typedef short bf16x8 __attribute__((ext_vector_type(8)));
typedef float f32x4 __attribute__((ext_vector_type(4)));
typedef unsigned u32x4 __attribute__((ext_vector_type(4)));
typedef unsigned u32x2 __attribute__((ext_vector_type(2)));

constexpr int BATCH = 2, SEQ = 8192, T = BATCH * SEQ, D = 1024;
constexpr int DPOOL = 512, NPG = 4, PGD = 128;
constexpr int NH = 8, VD = 64, QKN = 64, QKR = 32, QKD = 96;
constexpr int QLR = 256, KVLR = 128, DINP = 928;
constexpr int NE = 32, TOPK = 4, DE = 1024;
constexpr float RMS_EPS = 1e-6f;
constexpr float QSCALE = 0.10206207261596577f * 1.4426950408889634f;
constexpr int SLOT_ROWS = T * TOPK + NE * 256;

constexpr size_t MiB = 1u << 20;
constexpr size_t WS_CTL = 0;
constexpr size_t CTL_BYTES = 1 * MiB;
constexpr size_t WS_COS = 1 * MiB, WS_SIN = 2 * MiB;
constexpr size_t WS_WIN = 4 * MiB;
constexpr size_t WS_WQB = 6 * MiB;
constexpr size_t WS_WKVB = 7 * MiB;
constexpr size_t WS_WPOOL = 7 * MiB + 512 * 1024;
constexpr size_t WS_WOUT = 8 * MiB;
constexpr size_t WS_WGU = 16 * MiB;
constexpr size_t WS_WD = 144 * MiB;
constexpr size_t WS_XN = 208 * MiB;
constexpr size_t WS_U = 240 * MiB;
constexpr size_t WS_QN = 256 * MiB;
constexpr size_t WS_KVN = 264 * MiB;
constexpr size_t WS_KR = 268 * MiB;
constexpr size_t WS_Q = 272 * MiB;
constexpr size_t WS_K = 296 * MiB;
constexpr size_t WS_V = 320 * MiB;
constexpr size_t WS_MIX = 336 * MiB;
constexpr size_t WS_SSQ = 368 * MiB;
constexpr size_t WS_H = 370 * MiB;
constexpr size_t WS_SLOT = 402 * MiB;
constexpr size_t WS_LIST = 403 * MiB;
constexpr size_t WS_GLIST = 405 * MiB;
constexpr size_t WS_ACT = 408 * MiB;
constexpr size_t WS_Y = 552 * MiB;
constexpr size_t WS_TMP = 700 * MiB;
constexpr size_t WS_END = 828 * MiB;
constexpr int CW_CNT = 64;

__device__ __forceinline__ unsigned f2bf(float f) { unsigned u = __builtin_bit_cast(unsigned, f); return (u + 0x7fffu + ((u >> 16) & 1u)) >> 16; }
__device__ __forceinline__ unsigned pk2(float lo, float hi) { return f2bf(lo) | (f2bf(hi) << 16); }
__device__ __forceinline__ float bf2f(bf16_t b) { return __builtin_bit_cast(float, (unsigned)b << 16); }
__device__ __forceinline__ float wave_sum(float v) {
#pragma unroll
    for (int o = 1; o < 64; o <<= 1) v += __shfl_xor(v, o);
    return v;
}
__device__ __forceinline__ float wave_max(float v) {
#pragma unroll
    for (int o = 1; o < 64; o <<= 1) v = fmaxf(v, __shfl_xor(v, o));
    return v;
}

__device__ __forceinline__ void transpose_item(const float* W, int ldw, int k0, int n0, bf16_t* WT, int ldt, int dn0, int dk0,
                                               const float* ksc, float* scr, int lane) {
#pragma unroll 8
    for (int i = 0; i < 32; ++i) { const int kk = 2 * i + (lane >> 5); float v = W[(size_t)(k0 + kk) * ldw + n0 + (lane & 31)]; if (ksc) v *= ksc[kk]; scr[kk * 33 + (lane & 31)] = v; }
    asm volatile("s_waitcnt lgkmcnt(0)" ::: "memory");
    const int c = lane & 7;
#pragma unroll
    for (int j = 0; j < 4; ++j) { const int n = (lane >> 3) + 8 * j; const float* s = scr + (8 * c) * 33 + n;
        u32x4 o; o.x = pk2(s[0 * 33], s[1 * 33]); o.y = pk2(s[2 * 33], s[3 * 33]); o.z = pk2(s[4 * 33], s[5 * 33]); o.w = pk2(s[6 * 33], s[7 * 33]);
        *(u32x4*)(WT + (size_t)(dn0 + n) * ldt + dk0 + 8 * c) = o; }
    asm volatile("s_waitcnt lgkmcnt(0)" ::: "memory");
}

struct Ptrs {
    const float* x; const int* pos; const float* g_attn; const float* w_in; const float* w_pool; const float* b_pool; const float* pool_scale;
    const float* g_q_a; const float* w_q_b; const float* g_kv_a; const float* w_kv_b; const float* g_out_pool; const float* g_out_attn; const float* w_out;
    const float* g_ffn; const float* w_router; const float* b_router; const float* w_gu; const float* b_gu; const float* w_down; const float* b_down; const float* g_final;
    float* out; unsigned char* ws;
};

constexpr int IT_IN = 16 * 29, IT_QB = 4 * 24, IT_KVB = 2 * 32, IT_POOL = 4 * 2 * 4, IT_OUT = 16 * 32, IT_GU = 32 * 16 * 64, IT_DN = 32 * 16 * 32;
constexpr int IT_TOTAL = IT_IN + IT_QB + IT_KVB + IT_POOL + IT_OUT + IT_GU + IT_DN;

__device__ __forceinline__ void prologue_item(const Ptrs& P, int it, float* scr, int lane) {
    unsigned char* ws = P.ws;
    int r = it;
    if (r < IT_IN) { const int kb = r / 29, nb = r % 29; transpose_item(P.w_in, DINP, 64 * kb, 32 * nb, (bf16_t*)(ws + WS_WIN), 1024, 32 * nb, 64 * kb, nullptr, scr, lane); return; } r -= IT_IN;
    if (r < IT_QB) { const int kb = r / 24, nb = r % 24; transpose_item(P.w_q_b, 768, 64 * kb, 32 * nb, (bf16_t*)(ws + WS_WQB), 256, 32 * nb, 64 * kb, nullptr, scr, lane); return; } r -= IT_QB;
    if (r < IT_KVB) { const int kb = r / 32, nb = r % 32; transpose_item(P.w_kv_b, 1024, 64 * kb, 32 * nb, (bf16_t*)(ws + WS_WKVB), 128, 32 * nb, 64 * kb, nullptr, scr, lane); return; } r -= IT_KVB;
    if (r < IT_POOL) { const int g = r / 8, kb = (r % 8) / 4, nb = r % 4; transpose_item(P.w_pool + (size_t)g * 128 * 128, 128, 64 * kb, 32 * nb, (bf16_t*)(ws + WS_WPOOL) + (size_t)g * 128 * 128, 128, 32 * nb, 64 * kb, nullptr, scr, lane); return; } r -= IT_POOL;
    if (r < IT_OUT) { const int kb = r / 32, nb = r % 32, k0 = 64 * kb; const float* ksc = k0 < 512 ? P.g_out_pool + k0 : P.g_out_attn + (k0 - 512);
        transpose_item(P.w_out, 1024, k0, 32 * nb, (bf16_t*)(ws + WS_WOUT), 1024, 32 * nb, (k0 + 512) & 1023, ksc, scr, lane); return; } r -= IT_OUT;
    if (r < IT_GU) { const int e = r / 1024, q = r % 1024, kb = q / 64, nb = q % 64, n0 = 32 * nb; const int nn = n0 & 1023, p = nn >> 7, dn0 = 256 * p + (n0 >= 1024 ? 128 : 0) + (nn & 127);
        transpose_item(P.w_gu + (size_t)e * 1024 * 2048, 2048, 64 * kb, n0, (bf16_t*)(ws + WS_WGU) + (size_t)e * 2048 * 1024, 1024, dn0, 64 * kb, nullptr, scr, lane); return; } r -= IT_GU;
    { const int e = r / 512, q = r % 512, kb = q / 32, nb = q % 32;
        transpose_item(P.w_down + (size_t)e * 1024 * 1024, 1024, 64 * kb, 32 * nb, (bf16_t*)(ws + WS_WD) + (size_t)e * 1024 * 1024, 1024, 32 * nb, 64 * kb, nullptr, scr, lane); }
}

__device__ __forceinline__ void rms_row_to_bf16(const float* xrow, const float* g, bf16_t* orow, int lane) {
    const f32x4* xr = (const f32x4*)xrow + lane; const f32x4* gr = (const f32x4*)g + lane;
    f32x4 v[4]; float s = 0.f;
#pragma unroll
    for (int j = 0; j < 4; ++j) { v[j] = xr[64 * j]; s += (v[j].x * v[j].x + v[j].y * v[j].y) + (v[j].z * v[j].z + v[j].w * v[j].w); }
    const float rstd = 1.f / sqrtf(wave_sum(s) * (1.f / 1024.f) + RMS_EPS);
    u32x2* o8 = (u32x2*)orow + lane;
#pragma unroll
    for (int j = 0; j < 4; ++j) { const f32x4 gg = gr[64 * j]; u32x2 w; w.x = pk2(v[j].x * rstd * gg.x, v[j].y * rstd * gg.y); w.y = pk2(v[j].z * rstd * gg.z, v[j].w * rstd * gg.w); o8[64 * j] = w; }
}

#define LAS __attribute__((address_space(3)))
#define XB_TMO      128
#define XB_XCNT(j)  (256  + 64 * (j))
#define XB_XSUB(j)  (1280 + 64 * (j))
#define XB_XGEN(j)  (2304 + 64 * (j))
#define XB_TOP      3328
#define XB_TOPGEN   3392
#define XCD_BAR_WORDS 3456
#define XB_SPIN_CAP (1u << 18)
__device__ __forceinline__ unsigned xb_ld(unsigned* p)              { return __hip_atomic_load(p, __ATOMIC_RELAXED, __HIP_MEMORY_SCOPE_AGENT); }
__device__ __forceinline__ unsigned xb_add(unsigned* p, unsigned v) { return __hip_atomic_fetch_add(p, v, __ATOMIC_RELAXED, __HIP_MEMORY_SCOPE_AGENT); }
__device__ __forceinline__ unsigned xb_xcc_id() { return (unsigned)__builtin_amdgcn_s_getreg((3 << 11) | 20) & 0xFu; }
#define XB_SPIN(cond, bar) do { unsigned _sp = 0; while (cond) { __builtin_amdgcn_s_sleep(1); \
    if ((++_sp & 255u) == 0u) { if (xb_ld(&(bar)[XB_TMO])) break; if (_sp > XB_SPIN_CAP) { atomicAdd(&(bar)[XB_TMO], 1u); break; } } } } while (0)
struct XcdBarrier { unsigned* bar; unsigned x; volatile LAS unsigned* st; };
__device__ __forceinline__ XcdBarrier xcd_barrier_post(unsigned* bar, volatile LAS unsigned* st) {
    XcdBarrier b; b.bar = bar; b.x = xb_xcc_id(); b.st = st;
    if (threadIdx.x == 0) (void)xb_add(&bar[XB_XCNT(b.x)], 1u);
    return b;
}
__device__ __forceinline__ void xcd_barrier_complete(unsigned* bar, unsigned x, unsigned& nloc, unsigned& nx) {
    const unsigned G = gridDim.x * gridDim.y * gridDim.z;
    unsigned sum, cnt, mine, sp = 0u;
    for (;;) {
        sum = 0u; cnt = 0u; mine = 0u;
#pragma unroll
        for (unsigned j = 0; j < 16; ++j) { const unsigned c = xb_ld(&bar[XB_XCNT(j)]); sum += c; cnt += (c > 0u) ? 1u : 0u; mine = (j == x) ? c : mine; }
        if (sum == G) break;
        __builtin_amdgcn_s_sleep(1);
        if ((++sp & 255u) == 0u) { if (xb_ld(&bar[XB_TMO])) break; if (sp > XB_SPIN_CAP) { atomicAdd(&bar[XB_TMO], 1u); break; } }
    }
    nloc = mine > 0u ? mine : 1u; nx = cnt > 0u ? cnt : 1u;
}
__device__ __forceinline__ void xcd_barrier(const XcdBarrier& b) {
    asm volatile("s_waitcnt vmcnt(0)" ::: "memory");
    __syncthreads();
    if (threadIdx.x == 0) {
        unsigned* bar = b.bar;
        __builtin_amdgcn_s_waitcnt(0);
        unsigned nloc = b.st[0], nx = b.st[1];
        if (nloc == 0u) { xcd_barrier_complete(bar, b.x, nloc, nx); b.st[0] = nloc; b.st[1] = nx; }
        const unsigned old = xb_add(&bar[XB_XSUB(b.x)], 1u);
        const unsigned gen = old / nloc;
        if (old + 1u == (gen + 1u) * nloc) {
            __builtin_amdgcn_fence(__ATOMIC_RELEASE, "agent");
            asm volatile("s_waitcnt vmcnt(0)" ::: "memory");
            const unsigned og = xb_add(&bar[XB_TOP], 1u);
            const unsigned tg = og / nx;
            if (og + 1u == (tg + 1u) * nx) xb_add(&bar[XB_TOPGEN], 1u);
            else XB_SPIN(xb_ld(&bar[XB_TOPGEN]) == tg, bar);
            __builtin_amdgcn_fence(__ATOMIC_ACQUIRE, "agent");
            xb_add(&bar[XB_XGEN(b.x)], 1u);
            asm volatile("s_waitcnt vmcnt(0)" ::: "memory");
        } else {
            XB_SPIN(xb_ld(&bar[XB_XGEN(b.x)]) == gen, bar);
            __builtin_amdgcn_fence(__ATOMIC_ACQUIRE, "agent");
            asm volatile("s_waitcnt vmcnt(0)" ::: "memory");
        }
    }
    __syncthreads();
}

constexpr int NWAVES = 8;
constexpr int RING_BYTES = 131072;
constexpr int LDSCTL_OFF = RING_BYTES, MISC_OFF = LDSCTL_OFF + 320;
constexpr int LDS_BYTES = 147456;
constexpr int CW_BAR = 4096;

#define VB_FOR(vb, NVB) for (int vb = blockIdx.x * 2 + (int)(threadIdx.x >> 8); vb < (NVB); vb += gridDim.x * 2)

__device__ __forceinline__ void nv_gemm_f32(const bf16_t* A, int lda, const bf16_t* Bt, int ldb, float* C, int ldc, int K, int nbx, int nby) {
    const int tid = threadIdx.x & 255, lane = tid & 63, w = tid >> 6, wr = w >> 1, wc = w & 1, fr = lane & 15, fq = lane >> 4;
    VB_FOR(vb, nbx * nby) {
        const int bx = vb % nbx, by = vb / nbx;
        const int row0 = by * 64 + wr * 32, col0 = bx * 128 + wc * 64;
        f32x4 acc[2][4];
#pragma unroll
        for (int i = 0; i < 2; ++i)
#pragma unroll
            for (int j = 0; j < 4; ++j) acc[i][j] = (f32x4){0.f, 0.f, 0.f, 0.f};
        for (int k0 = 0; k0 < K; k0 += 32) {
            bf16x8 a[2], b[4];
#pragma unroll
            for (int i = 0; i < 2; ++i) a[i] = *(const bf16x8*)(A + (size_t)(row0 + i * 16 + fr) * lda + k0 + 8 * fq);
#pragma unroll
            for (int j = 0; j < 4; ++j) b[j] = *(const bf16x8*)(Bt + (size_t)(col0 + j * 16 + fr) * ldb + k0 + 8 * fq);
#pragma unroll
            for (int i = 0; i < 2; ++i)
#pragma unroll
                for (int j = 0; j < 4; ++j) acc[i][j] = __builtin_amdgcn_mfma_f32_16x16x32_bf16(a[i], b[j], acc[i][j], 0, 0, 0);
        }
#pragma unroll
        for (int i = 0; i < 2; ++i)
#pragma unroll
            for (int j = 0; j < 4; ++j)
#pragma unroll
                for (int r = 0; r < 4; ++r) C[(size_t)(row0 + i * 16 + fq * 4 + r) * ldc + col0 + j * 16 + fr] = acc[i][j][r];
    }
}

#define GW_SETUP const int tid = threadIdx.x, lane = tid & 63, wave = tid >> 6; const int gw = blockIdx.x * NWAVES + wave, NGW = gridDim.x * NWAVES; (void)lane; (void)gw; (void)NGW;
#define GT_FOR(i, N) for (size_t i = (size_t)blockIdx.x * 512 + threadIdx.x; i < (size_t)(N); i += (size_t)gridDim.x * 512)

__device__ __forceinline__ void ph_prologue(const Ptrs& P, float* ldsf) {
    GW_SETUP
    float* scr = ldsf + wave * (64 * 33);
    for (int it = gw; it < IT_TOTAL; it += NGW) prologue_item(P, it, scr, lane);
    { bf16_t* w = (bf16_t*)(P.ws + WS_WIN) + (size_t)DINP * 1024; const int n8 = (1024 - DINP) * 1024 / 8;
      GT_FOR(i, n8) ((u32x4*)w)[i] = (u32x4){0u, 0u, 0u, 0u}; }
    for (int m = gw; m < T; m += NGW) rms_row_to_bf16(P.x + (size_t)m * D, P.g_attn, (bf16_t*)(P.ws + WS_XN) + (size_t)m * D, lane);
    { float* C = (float*)(P.ws + WS_COS); float* S = (float*)(P.ws + WS_SIN);
      GT_FOR(i, T * 16) { const int t = (int)(i >> 4), j = (int)(i & 15);
          const float inv = (float)pow(10000.0, -(double)j / 16.0); const float ang = (float)P.pos[t] * inv;
          C[i] = (float)cos((double)ang); S[i] = (float)sin((double)ang); } }
}
__device__ __forceinline__ void ph_e1(const Ptrs& P) {
    GW_SETUP
    const float* PROJ = (const float*)(P.ws + WS_TMP);
    const float* COS = (const float*)(P.ws + WS_COS); const float* SIN = (const float*)(P.ws + WS_SIN);
    for (int t = gw; t < T; t += NGW) {
        const float* pr = PROJ + (size_t)t * 1024;
        bf16_t* u = (bf16_t*)(P.ws + WS_U) + (size_t)t * 512;
        for (int c = lane; c < 512; c += 64) u[c] = (bf16_t)f2bf(pr[c]);
        { float v[4]; float s = 0.f; for (int j = 0; j < 4; ++j) { v[j] = pr[512 + lane + 64 * j]; s += v[j] * v[j]; }
          const float rstd = 1.f / sqrtf(wave_sum(s) * (1.f / 256.f) + RMS_EPS);
          bf16_t* q = (bf16_t*)(P.ws + WS_QN) + (size_t)t * 256;
          for (int j = 0; j < 4; ++j) q[lane + 64 * j] = (bf16_t)f2bf(v[j] * rstd * P.g_q_a[lane + 64 * j]); }
        { float v[2]; float s = 0.f; for (int j = 0; j < 2; ++j) { v[j] = pr[768 + lane + 64 * j]; s += v[j] * v[j]; }
          const float rstd = 1.f / sqrtf(wave_sum(s) * (1.f / 128.f) + RMS_EPS);
          bf16_t* q = (bf16_t*)(P.ws + WS_KVN) + (size_t)t * 128;
          for (int j = 0; j < 2; ++j) q[lane + 64 * j] = (bf16_t)f2bf(v[j] * rstd * P.g_kv_a[lane + 64 * j]); }
        if (lane < 16) { const float x1 = pr[896 + lane], x2 = pr[896 + 16 + lane]; const float c = COS[t * 16 + lane], s = SIN[t * 16 + lane];
          bf16_t* kr = (bf16_t*)(P.ws + WS_KR) + (size_t)t * 32; kr[lane] = (bf16_t)f2bf(x1 * c - x2 * s); kr[16 + lane] = (bf16_t)f2bf(x2 * c + x1 * s); }
    }
}
__device__ __forceinline__ void ph_e2q(const Ptrs& P) {
    const float* TMP = (const float*)(P.ws + WS_TMP); const float* COS = (const float*)(P.ws + WS_COS); const float* SIN = (const float*)(P.ws + WS_SIN);
    bf16_t* Q = (bf16_t*)(P.ws + WS_Q);
    GT_FOR(i, (size_t)T * 768) {
        const int t = (int)(i / 768), c = (int)(i % 768), h = c / 96, d = c % 96; float v;
        if (d < 64) v = TMP[i];
        else { const int j = (d - 64) & 15; const float x1 = TMP[(size_t)t * 768 + h * 96 + 64 + j], x2 = TMP[(size_t)t * 768 + h * 96 + 80 + j]; const float cc = COS[t * 16 + j], ss = SIN[t * 16 + j];
               v = (d < 80) ? (x1 * cc - x2 * ss) : (x2 * cc + x1 * ss); }
        Q[i] = (bf16_t)f2bf(v * QSCALE);
    }
}
__device__ __forceinline__ void ph_e2kv(const Ptrs& P) {
    const float* TMP = (const float*)(P.ws + WS_TMP) + (size_t)T * 1024; const bf16_t* KR = (const bf16_t*)(P.ws + WS_KR);
    bf16_t* K = (bf16_t*)(P.ws + WS_K); bf16_t* V = (bf16_t*)(P.ws + WS_V);
    GT_FOR(i, (size_t)T * 768) {
        const int t = (int)(i / 768), c = (int)(i % 768), h = c / 96, d = c % 96;
        K[i] = d < 64 ? (bf16_t)f2bf(TMP[(size_t)t * 1024 + h * 128 + d]) : KR[(size_t)t * 32 + d - 64];
    }
    GT_FOR(i, (size_t)T * 512) {
        const int t = (int)(i / 512), c = (int)(i % 512), h = c / 64, d = c % 64;
        V[i] = (bf16_t)f2bf(TMP[(size_t)t * 1024 + h * 128 + 64 + d]);
    }
}
__device__ __forceinline__ void ph_pooldiff(const Ptrs& P) {
    const bf16_t* U = (const bf16_t*)(P.ws + WS_U); bf16_t* DIFF = (bf16_t*)(P.ws + WS_H);
    GT_FOR(i, (size_t)T * 512) {
        const int t = (int)(i / 512), c = (int)(i % 512), g = c / 128, s = t % SEQ, w = 2 << g; const int n = s + 1 < w ? s + 1 : w;
        float sum = 0.f; for (int j = 0; j < n; ++j) sum += bf2f(U[(size_t)(t - j) * 512 + c]);
        DIFF[i] = (bf16_t)f2bf(sum / (float)n - bf2f(U[i]));
    }
}
__device__ __forceinline__ void ph_epool(const Ptrs& P, const float* TP) {
    GW_SETUP
    for (int t = gw; t < T; t += NGW) {
        float v[8]; float s = 0.f;
        for (int j = 0; j < 8; ++j) { const int c = lane + 64 * j; v[j] = (TP[(size_t)t * 512 + c] + P.b_pool[c]) * P.pool_scale[c]; s += v[j] * v[j]; }
        const float rstd = 1.f / sqrtf(wave_sum(s) * (1.f / 512.f) + RMS_EPS);
        bf16_t* m = (bf16_t*)(P.ws + WS_MIX) + (size_t)t * 1024 + 512;
        for (int j = 0; j < 8; ++j) m[lane + 64 * j] = (bf16_t)f2bf(v[j] * rstd);
    }
}
__device__ __forceinline__ void ph_attn_naive(const Ptrs& P, float* ldsf) {
    GW_SETUP
    float* qs = ldsf + wave * 96;
    const bf16_t* Q = (const bf16_t*)(P.ws + WS_Q); const bf16_t* K = (const bf16_t*)(P.ws + WS_K); const bf16_t* V = (const bf16_t*)(P.ws + WS_V);
    bf16_t* MIX = (bf16_t*)(P.ws + WS_MIX); float* SSQ = (float*)(P.ws + WS_SSQ);
    for (int item = gw; item < T * 8; item += NGW) {
        const int t = item >> 3, h = item & 7, b = t / SEQ, s = t % SEQ;
        for (int d = lane; d < 96; d += 64) qs[d] = bf2f(Q[(size_t)t * 768 + h * 96 + d]);
        asm volatile("s_waitcnt lgkmcnt(0)" ::: "memory");
        float m = -1e30f, l = 0.f, o = 0.f;
        const int ntile = s / 64 + 1;
        for (int kt = 0; kt < ntile; ++kt) {
            const int key = kt * 64 + lane; const size_t krow = (size_t)(b * SEQ + key);
            float sc = -__builtin_inff();
            if (key <= s) { const bf16_t* kp = K + krow * 768 + h * 96; float a = 0.f;
                for (int d8 = 0; d8 < 12; ++d8) { const bf16x8 kv = *(const bf16x8*)(kp + d8 * 8);
#pragma unroll
                    for (int j = 0; j < 8; ++j) a += qs[d8 * 8 + j] * bf2f((bf16_t)kv[j]); }
                sc = a; }
            const float mn = fmaxf(m, wave_max(sc)); const float alpha = exp2f(m - mn); const float p = exp2f(sc - mn);
            const float pb = bf2f((bf16_t)f2bf(p));
            l = l * alpha + wave_sum(pb); o *= alpha; m = mn;
            const int nk = (kt == ntile - 1) ? (s - kt * 64 + 1) : 64;
            for (int j = 0; j < nk; ++j) { const float pj = __shfl(pb, j); o += pj * bf2f(V[(size_t)(b * SEQ + kt * 64 + j) * 512 + h * 64 + lane]); }
        }
        const float ov = o / l;
        MIX[(size_t)t * 1024 + h * 64 + lane] = (bf16_t)f2bf(ov);
        const float ss = wave_sum(ov * ov);
        if (lane == 0) SSQ[t * 8 + h] = ss;
        asm volatile("s_waitcnt lgkmcnt(0)" ::: "memory");
    }
}
__device__ __forceinline__ void ph_e4(const Ptrs& P) {
    const float* T1 = (const float*)(P.ws + WS_TMP); const float* T2 = T1 + (size_t)T * 1024; const float* SSQ = (const float*)(P.ws + WS_SSQ);
    GT_FOR(i, (size_t)T * 1024) {
        const int t = (int)(i >> 10); float s = 0.f; for (int h = 0; h < 8; ++h) s += SSQ[t * 8 + h];
        const float sa = 1.f / sqrtf(s * (1.f / 512.f) + RMS_EPS);
        P.out[i] = P.x[i] + sa * T1[i] + T2[i];
    }
}
__device__ __forceinline__ void ph_router(const Ptrs& P, float* ldsf) {
    GW_SETUP
    float* hs = ldsf + wave * 1024;
    int* cnt = (int*)(P.ws + WS_CTL) + CW_CNT; int* SLOT = (int*)(P.ws + WS_SLOT); int* LIST = (int*)(P.ws + WS_LIST); float* GLIST = (float*)(P.ws + WS_GLIST);
    for (int t = gw; t < T; t += NGW) {
        const f32x4* xr = (const f32x4*)(P.out + (size_t)t * 1024) + lane; const f32x4* gr = (const f32x4*)P.g_ffn + lane;
        f32x4 v[4]; float s = 0.f;
        for (int j = 0; j < 4; ++j) { v[j] = xr[64 * j]; s += (v[j].x * v[j].x + v[j].y * v[j].y) + (v[j].z * v[j].z + v[j].w * v[j].w); }
        const float rstd = 1.f / sqrtf(wave_sum(s) * (1.f / 1024.f) + RMS_EPS);
        u32x2* ho = (u32x2*)((bf16_t*)(P.ws + WS_H) + (size_t)t * 1024) + lane;
        for (int j = 0; j < 4; ++j) { const f32x4 gg = gr[64 * j]; f32x4 hv = {v[j].x * rstd * gg.x, v[j].y * rstd * gg.y, v[j].z * rstd * gg.z, v[j].w * rstd * gg.w};
            ((f32x4*)hs)[lane + 64 * j] = hv; u32x2 w; w.x = pk2(hv.x, hv.y); w.y = pk2(hv.z, hv.w); ho[64 * j] = w; }
        asm volatile("s_waitcnt lgkmcnt(0)" ::: "memory");
        const int e = lane & 31, half = lane >> 5; float a = 0.f;
        for (int c = half * 512; c < half * 512 + 512; ++c) a += hs[c] * P.w_router[c * 32 + e];
        a += __shfl_xor(a, 32); a += P.b_router[e];
        float lv[4]; int li[4]; unsigned used = 0u;
        for (int k = 0; k < 4; ++k) { float best = -__builtin_inff(); int bi = 0;
            for (int j = 0; j < 32; ++j) { const float x = __shfl(a, j); if (!((used >> j) & 1u) && x > best) { best = x; bi = j; } }
            lv[k] = best; li[k] = bi; used |= 1u << bi; }
        const float e1 = expf(lv[1] - lv[0]), e2 = expf(lv[2] - lv[0]), e3 = expf(lv[3] - lv[0]); const float inv = 1.f / (1.f + e1 + e2 + e3);
        if (lane < 4) { const int ex = lane == 0 ? li[0] : lane == 1 ? li[1] : lane == 2 ? li[2] : li[3]; const float gt = (lane == 0 ? 1.f : lane == 1 ? e1 : lane == 2 ? e2 : e3) * inv;
            const int pos = atomicAdd(&cnt[ex], 1); SLOT[t * 4 + lane] = ex * T + pos; LIST[ex * T + pos] = t; GLIST[ex * T + pos] = gt; }
        asm volatile("s_waitcnt lgkmcnt(0)" ::: "memory");
    }
}
__device__ __forceinline__ int slot_base(const int* cnt, int e) { int s = 0; for (int i = 0; i < e; ++i) s += (cnt[i] + 255) & ~255; return s; }
__device__ __forceinline__ void ph_moe1_naive(const Ptrs& P) {
    const int* cnt = (const int*)(P.ws + WS_CTL) + CW_CNT;
    const int tid = threadIdx.x & 255, lane = tid & 63, w = tid >> 6, wr = w >> 1, wc = w & 1, fr = lane & 15, fq = lane >> 4;
    const bf16_t* H = (const bf16_t*)(P.ws + WS_H); bf16_t* ACT = (bf16_t*)(P.ws + WS_ACT);
    VB_FOR(vb, 16 * 256 * 32) {
        const int bx = vb & 15, by = (vb >> 4) & 255, e = vb >> 12; const int n = cnt[e], m0 = by * 64; if (m0 >= n) continue;
        const int* LIST = (const int*)(P.ws + WS_LIST) + (size_t)e * T;
        const bf16_t* W = (const bf16_t*)(P.ws + WS_WGU) + (size_t)e * 2048 * 1024;
        const int ca0 = bx * 64 + wc * 32; const int p = ca0 >> 7, r0 = ca0 & 127;
        int tok[2]; for (int i = 0; i < 2; ++i) { int m = m0 + wr * 32 + i * 16 + fr; if (m >= n) m = 0; tok[i] = LIST[m]; }
        f32x4 ag[2][2], au[2][2];
        for (int i = 0; i < 2; ++i) for (int j = 0; j < 2; ++j) { ag[i][j] = (f32x4){0.f, 0.f, 0.f, 0.f}; au[i][j] = (f32x4){0.f, 0.f, 0.f, 0.f}; }
        for (int k0 = 0; k0 < 1024; k0 += 32) {
            bf16x8 a[2], bg[2], bu[2];
            for (int i = 0; i < 2; ++i) a[i] = *(const bf16x8*)(H + (size_t)tok[i] * 1024 + k0 + 8 * fq);
            for (int j = 0; j < 2; ++j) { bg[j] = *(const bf16x8*)(W + (size_t)(256 * p + r0 + j * 16 + fr) * 1024 + k0 + 8 * fq); bu[j] = *(const bf16x8*)(W + (size_t)(256 * p + 128 + r0 + j * 16 + fr) * 1024 + k0 + 8 * fq); }
            for (int i = 0; i < 2; ++i) for (int j = 0; j < 2; ++j) { ag[i][j] = __builtin_amdgcn_mfma_f32_16x16x32_bf16(a[i], bg[j], ag[i][j], 0, 0, 0); au[i][j] = __builtin_amdgcn_mfma_f32_16x16x32_bf16(a[i], bu[j], au[i][j], 0, 0, 0); }
        }
        const int sb = slot_base(cnt, e);
        for (int i = 0; i < 2; ++i) for (int j = 0; j < 2; ++j) for (int r = 0; r < 4; ++r) {
            const int m = m0 + wr * 32 + i * 16 + fq * 4 + r, c = ca0 + j * 16 + fr; if (m >= n) continue;
            float g = ag[i][j][r] + P.b_gu[e * 2048 + c], u = au[i][j][r] + P.b_gu[e * 2048 + 1024 + c];
            g = fminf(g, 7.f); u = fminf(fmaxf(u, -7.f), 7.f);
            const float act = g * (1.f / (1.f + expf(-1.702f * g))) * (u + 1.f);
            ACT[(size_t)(sb + m) * 1024 + c] = (bf16_t)f2bf(act);
        }
    }
}
__device__ __forceinline__ void ph_moe2_naive(const Ptrs& P) {
    const int* cnt = (const int*)(P.ws + WS_CTL) + CW_CNT;
    const int tid = threadIdx.x & 255, lane = tid & 63, w = tid >> 6, wr = w >> 1, wc = w & 1, fr = lane & 15, fq = lane >> 4;
    VB_FOR(vb, 8 * 256 * 32) {
        const int bx = vb & 7, by = (vb >> 3) & 255, e = vb >> 11; const int n = cnt[e], m0 = by * 64; if (m0 >= n) continue;
        const int sb = slot_base(cnt, e); const bf16_t* ACT = (const bf16_t*)(P.ws + WS_ACT) + (size_t)sb * 1024; bf16_t* Y = (bf16_t*)(P.ws + WS_Y) + (size_t)sb * 1024;
        const bf16_t* W = (const bf16_t*)(P.ws + WS_WD) + (size_t)e * 1024 * 1024; const float* GL = (const float*)(P.ws + WS_GLIST) + (size_t)e * T;
        const int col0 = bx * 128 + wc * 64, row0 = m0 + wr * 32;
        f32x4 acc[2][4]; for (int i = 0; i < 2; ++i) for (int j = 0; j < 4; ++j) acc[i][j] = (f32x4){0.f, 0.f, 0.f, 0.f};
        for (int k0 = 0; k0 < 1024; k0 += 32) {
            bf16x8 a[2], b[4];
            for (int i = 0; i < 2; ++i) { int m = row0 + i * 16 + fr; if (m >= n) m = 0; a[i] = *(const bf16x8*)(ACT + (size_t)m * 1024 + k0 + 8 * fq); }
            for (int j = 0; j < 4; ++j) b[j] = *(const bf16x8*)(W + (size_t)(col0 + j * 16 + fr) * 1024 + k0 + 8 * fq);
            for (int i = 0; i < 2; ++i) for (int j = 0; j < 4; ++j) acc[i][j] = __builtin_amdgcn_mfma_f32_16x16x32_bf16(a[i], b[j], acc[i][j], 0, 0, 0);
        }
        for (int i = 0; i < 2; ++i) for (int j = 0; j < 4; ++j) for (int r = 0; r < 4; ++r) {
            const int m = row0 + i * 16 + fq * 4 + r, c = col0 + j * 16 + fr; if (m >= n) continue;
            Y[(size_t)m * 1024 + c] = (bf16_t)f2bf((acc[i][j][r] + P.b_down[e * 1024 + c]) * GL[m]);
        }
    }
}
__device__ __forceinline__ void ph_final(const Ptrs& P, int* sbase) {
    GW_SETUP
    const int* cnt = (const int*)(P.ws + WS_CTL) + CW_CNT; const int* SLOT = (const int*)(P.ws + WS_SLOT); const bf16_t* Y = (const bf16_t*)(P.ws + WS_Y);
    if (tid < 32) sbase[tid] = slot_base(cnt, tid);
    __syncthreads();
    for (int t = gw; t < T; t += NGW) {
        f32x4* xr = (f32x4*)(P.out + (size_t)t * 1024) + lane; const f32x4* gr = (const f32x4*)P.g_final + lane;
        f32x4 v[4]; for (int j = 0; j < 4; ++j) v[j] = xr[64 * j];
        for (int k = 0; k < 4; ++k) { const int sl = SLOT[t * 4 + k]; const int e = sl / T, pos = sl % T; const u32x2* yr = (const u32x2*)(Y + (size_t)(sbase[e] + pos) * 1024) + lane;
            for (int j = 0; j < 4; ++j) { const u32x2 w = yr[64 * j]; v[j].x += __builtin_bit_cast(float, w.x << 16); v[j].y += __builtin_bit_cast(float, w.x & 0xffff0000u); v[j].z += __builtin_bit_cast(float, w.y << 16); v[j].w += __builtin_bit_cast(float, w.y & 0xffff0000u); } }
        float s = 0.f; for (int j = 0; j < 4; ++j) s += (v[j].x * v[j].x + v[j].y * v[j].y) + (v[j].z * v[j].z + v[j].w * v[j].w);
        const float rstd = 1.f / sqrtf(wave_sum(s) * (1.f / 1024.f) + RMS_EPS);
        for (int j = 0; j < 4; ++j) { const f32x4 gg = gr[64 * j]; xr[64 * j] = (f32x4){v[j].x * rstd * gg.x, v[j].y * rstd * gg.y, v[j].z * rstd * gg.z, v[j].w * rstd * gg.w}; }
    }
}

__global__ void __launch_bounds__(NWAVES * 64, 2) mega_fwd(Ptrs P) {
    extern __shared__ __attribute__((aligned(16))) unsigned char lds[];
    const int tid = threadIdx.x;
    for (int u = tid; u < (LDS_BYTES - LDSCTL_OFF) / 4; u += NWAVES * 64) ((LAS unsigned*)((LAS unsigned char*)lds + LDSCTL_OFF))[u] = 0u;
    __syncthreads();
    unsigned* ctl = (unsigned*)(P.ws + WS_CTL);
    XcdBarrier bar = xcd_barrier_post(ctl + CW_BAR, (volatile LAS unsigned*)((LAS unsigned char*)lds + MISC_OFF) + 8);
    float* ldsf = (float*)lds;
    float* TMP = (float*)(P.ws + WS_TMP);
    unsigned char* ws = P.ws;
#define GRID_BAR() xcd_barrier(bar)
    ph_prologue(P, ldsf); GRID_BAR();
    nv_gemm_f32((const bf16_t*)(ws + WS_XN), 1024, (const bf16_t*)(ws + WS_WIN), 1024, TMP, 1024, 1024, 8, T / 64); GRID_BAR();
    ph_e1(P); GRID_BAR();
    nv_gemm_f32((const bf16_t*)(ws + WS_QN), 256, (const bf16_t*)(ws + WS_WQB), 256, TMP, 768, 256, 6, T / 64);
    nv_gemm_f32((const bf16_t*)(ws + WS_KVN), 128, (const bf16_t*)(ws + WS_WKVB), 128, TMP + (size_t)T * 1024, 1024, 128, 8, T / 64);
    ph_pooldiff(P); GRID_BAR();
    ph_e2q(P); ph_e2kv(P);
    for (int g = 0; g < 4; ++g)
        nv_gemm_f32((const bf16_t*)(ws + WS_H) + g * 128, 512, (const bf16_t*)(ws + WS_WPOOL) + (size_t)g * 128 * 128, 128, (float*)(ws + WS_ACT) + g * 128, 512, 128, 1, T / 64);
    GRID_BAR();
    ph_epool(P, (const float*)(ws + WS_ACT));
    ph_attn_naive(P, ldsf); GRID_BAR();
    nv_gemm_f32((const bf16_t*)(ws + WS_MIX), 1024, (const bf16_t*)(ws + WS_WOUT), 1024, TMP, 1024, 512, 8, T / 64);
    nv_gemm_f32((const bf16_t*)(ws + WS_MIX) + 512, 1024, (const bf16_t*)(ws + WS_WOUT) + 512, 1024, TMP + (size_t)T * 1024, 1024, 512, 8, T / 64);
    GRID_BAR();
    ph_e4(P); GRID_BAR();
    ph_router(P, ldsf); GRID_BAR();
    ph_moe1_naive(P); GRID_BAR();
    ph_moe2_naive(P); GRID_BAR();
    ph_final(P, (int*)lds);
}

extern "C" void kernel_launch(void* const* d_in, const int* in_sizes, int n_in, void* d_out, int out_size, void* d_ws, size_t ws_size, hipStream_t stream) {
    static int grid = 0;
    if (grid == 0) {
        if (n_in != 22 || out_size != T * D || ws_size < WS_END) { fprintf(stderr, "kernel_launch: unexpected shapes (n_in %d out %d ws %zu)\n", n_in, out_size, ws_size); grid = -1; return; }
        int dev = 0, cus = 0, per_cu = 0;
        if (hipGetDevice(&dev) != hipSuccess || hipDeviceGetAttribute(&cus, hipDeviceAttributeMultiprocessorCount, dev) != hipSuccess) { grid = -1; return; }
        if (hipFuncSetAttribute((const void*)mega_fwd, hipFuncAttributeMaxDynamicSharedMemorySize, LDS_BYTES) != hipSuccess) { fprintf(stderr, "kernel_launch: hipFuncSetAttribute failed\n"); grid = -1; return; }
        if (hipOccupancyMaxActiveBlocksPerMultiprocessor(&per_cu, (const void*)mega_fwd, NWAVES * 64, LDS_BYTES) != hipSuccess || per_cu < 1) fprintf(stderr, "kernel_launch: occupancy query reports %d\n", per_cu);
        (void)hipGetLastError();
        grid = cus;
    }
    if (grid < 0) return;
    Ptrs P{};
    P.x = (const float*)d_in[0]; P.pos = (const int*)d_in[1]; P.g_attn = (const float*)d_in[2]; P.w_in = (const float*)d_in[3]; P.w_pool = (const float*)d_in[4];
    P.b_pool = (const float*)d_in[5]; P.pool_scale = (const float*)d_in[6]; P.g_q_a = (const float*)d_in[7]; P.w_q_b = (const float*)d_in[8]; P.g_kv_a = (const float*)d_in[9];
    P.w_kv_b = (const float*)d_in[10]; P.g_out_pool = (const float*)d_in[11]; P.g_out_attn = (const float*)d_in[12]; P.w_out = (const float*)d_in[13]; P.g_ffn = (const float*)d_in[14];
    P.w_router = (const float*)d_in[15]; P.b_router = (const float*)d_in[16]; P.w_gu = (const float*)d_in[17]; P.b_gu = (const float*)d_in[18]; P.w_down = (const float*)d_in[19];
    P.b_down = (const float*)d_in[20]; P.g_final = (const float*)d_in[21]; P.out = (float*)d_out; P.ws = (unsigned char*)d_ws;
    if (hipMemsetAsync((unsigned char*)d_ws + WS_CTL, 0, CTL_BYTES, stream) != hipSuccess) { fprintf(stderr, "kernel_launch: memset failed\n"); return; }
    hipLaunchKernelGGL(mega_fwd, dim3(grid), dim3(NWAVES * 64), LDS_BYTES, stream, P);
}
```

```cpp
#include <hip/hip_runtime.h>
#include <cstdint>
#include <cstdio>

typedef unsigned short bf16_t;
typedef short bf16x8 __attribute__((ext_vector_type(8)));
typedef float f32x4 __attribute__((ext_vector_type(4)));
typedef unsigned u32x4 __attribute__((ext_vector_type(4)));
typedef unsigned u32x2 __attribute__((ext_vector_type(2)));

constexpr int BATCH = 2, SEQ = 8192, T = BATCH * SEQ, D = 1024;
constexpr int DPOOL = 512, NPG = 4, PGD = 128;
constexpr int NH = 8, VD = 64, QKN = 64, QKR = 32, QKD = 96;
constexpr int QLR = 256, KVLR = 128, DINP = 928;
constexpr int NE = 32, TOPK = 4, DE = 1024;
constexpr float RMS_EPS = 1e-6f;
constexpr float QSCALE = 0.10206207261596577f * 1.4426950408889634f;
constexpr int SLOT_ROWS = T * TOPK + NE * 256;

constexpr size_t MiB = 1u << 20;
constexpr size_t WS_CTL = 0;
constexpr size_t CTL_BYTES = 1 * MiB;
constexpr size_t WS_COS = 1 * MiB, WS_SIN = 2 * MiB;
constexpr size_t WS_WIN = 4 * MiB;
constexpr size_t WS_WQB = 6 * MiB;
constexpr size_t WS_WKVB = 7 * MiB;
constexpr size_t WS_WPOOL = 7 * MiB + 512 * 1024;
constexpr size_t WS_WOUT = 8 * MiB;
constexpr size_t WS_WGU = 16 * MiB;
constexpr size_t WS_WD = 144 * MiB;
constexpr size_t WS_XN = 208 * MiB;
constexpr size_t WS_U = 240 * MiB;
constexpr size_t WS_QN = 256 * MiB;
constexpr size_t WS_KVN = 264 * MiB;
constexpr size_t WS_KR = 268 * MiB;
constexpr size_t WS_Q = 272 * MiB;
constexpr size_t WS_K = 296 * MiB;
constexpr size_t WS_V = 320 * MiB;
constexpr size_t WS_MIX = 336 * MiB;
constexpr size_t WS_SSQ = 368 * MiB;
constexpr size_t WS_H = 370 * MiB;
constexpr size_t WS_SLOT = 402 * MiB;
constexpr size_t WS_LIST = 403 * MiB;
constexpr size_t WS_GLIST = 405 * MiB;
constexpr size_t WS_ACT = 408 * MiB;
constexpr size_t WS_Y = 552 * MiB;
constexpr size_t WS_TMP = 700 * MiB;
constexpr size_t WS_END = 828 * MiB;
constexpr int CW_CNT = 64;

__device__ __forceinline__ unsigned f2bf(float f) { unsigned u = __builtin_bit_cast(unsigned, f); return (u + 0x7fffu + ((u >> 16) & 1u)) >> 16; }
__device__ __forceinline__ unsigned pk2(float lo, float hi) { return f2bf(lo) | (f2bf(hi) << 16); }
__device__ __forceinline__ float bf2f(bf16_t b) { return __builtin_bit_cast(float, (unsigned)b << 16); }
__device__ __forceinline__ float wave_sum(float v) {
#pragma unroll
    for (int o = 1; o < 64; o <<= 1) v += __shfl_xor(v, o);
    return v;
}
__device__ __forceinline__ float wave_max(float v) {
#pragma unroll
    for (int o = 1; o < 64; o <<= 1) v = fmaxf(v, __shfl_xor(v, o));
    return v;
}

__device__ __forceinline__ int tid_opaque() { int t = threadIdx.x; asm volatile("" : "+v"(t)); return t; }

__device__ __forceinline__ void transpose_item(const float* W, int ldw, int k0, int n0, bf16_t* WT, int ldt, int dn0, int dk0,
                                               const float* ksc, float* scr, int lane) {
#pragma unroll 8
    for (int i = 0; i < 32; ++i) { const int kk = 2 * i + (lane >> 5); float v = W[(size_t)(k0 + kk) * ldw + n0 + (lane & 31)]; if (ksc) v *= ksc[kk]; scr[kk * 33 + (lane & 31)] = v; }
    asm volatile("s_waitcnt lgkmcnt(0)" ::: "memory");
    const int c = lane & 7;
#pragma unroll
    for (int j = 0; j < 4; ++j) { const int n = (lane >> 3) + 8 * j; const float* s = scr + (8 * c) * 33 + n;
        u32x4 o; o.x = pk2(s[0 * 33], s[1 * 33]); o.y = pk2(s[2 * 33], s[3 * 33]); o.z = pk2(s[4 * 33], s[5 * 33]); o.w = pk2(s[6 * 33], s[7 * 33]);
        *(u32x4*)(WT + (size_t)(dn0 + n) * ldt + dk0 + 8 * c) = o; }
    asm volatile("s_waitcnt lgkmcnt(0)" ::: "memory");
}

struct Ptrs {
    const float* x; const int* pos; const float* g_attn; const float* w_in; const float* w_pool; const float* b_pool; const float* pool_scale;
    const float* g_q_a; const float* w_q_b; const float* g_kv_a; const float* w_kv_b; const float* g_out_pool; const float* g_out_attn; const float* w_out;
    const float* g_ffn; const float* w_router; const float* b_router; const float* w_gu; const float* b_gu; const float* w_down; const float* b_down; const float* g_final;
    float* out; unsigned char* ws;
};

constexpr int IT_IN = 16 * 29, IT_QB = 4 * 24, IT_KVB = 2 * 32, IT_POOL = 4 * 2 * 4, IT_OUT = 16 * 32, IT_GU = 32 * 16 * 64, IT_DN = 32 * 16 * 32;
constexpr int IT_TOTAL = IT_IN + IT_QB + IT_KVB + IT_POOL + IT_OUT + IT_GU + IT_DN;

__device__ __forceinline__ void prologue_item(const Ptrs& P, int it, float* scr, int lane) {
    unsigned char* ws = P.ws;
    int r = it;
    if (r < IT_IN) { const int kb = r / 29, nb = r % 29; transpose_item(P.w_in, DINP, 64 * kb, 32 * nb, (bf16_t*)(ws + WS_WIN), 1024, 32 * nb, 64 * kb, nullptr, scr, lane); return; } r -= IT_IN;
    if (r < IT_QB) { const int kb = r / 24, nb = r % 24; transpose_item(P.w_q_b, 768, 64 * kb, 32 * nb, (bf16_t*)(ws + WS_WQB), 256, 32 * nb, 64 * kb, nullptr, scr, lane); return; } r -= IT_QB;
    if (r < IT_KVB) { const int kb = r / 32, nb = r % 32; transpose_item(P.w_kv_b, 1024, 64 * kb, 32 * nb, (bf16_t*)(ws + WS_WKVB), 128, 32 * nb, 64 * kb, nullptr, scr, lane); return; } r -= IT_KVB;
    if (r < IT_POOL) { const int g = r / 8, kb = (r % 8) / 4, nb = r % 4; transpose_item(P.w_pool + (size_t)g * 128 * 128, 128, 64 * kb, 32 * nb, (bf16_t*)(ws + WS_WPOOL) + (size_t)g * 128 * 128, 128, 32 * nb, 64 * kb, nullptr, scr, lane); return; } r -= IT_POOL;
    if (r < IT_OUT) { const int kb = r / 32, nb = r % 32, k0 = 64 * kb; const float* ksc = k0 < 512 ? P.g_out_pool + k0 : P.g_out_attn + (k0 - 512);
        transpose_item(P.w_out, 1024, k0, 32 * nb, (bf16_t*)(ws + WS_WOUT), 1024, 32 * nb, (k0 + 512) & 1023, ksc, scr, lane); return; } r -= IT_OUT;
    if (r < IT_GU) { const int e = r / 1024, q = r % 1024, kb = q / 64, nb = q % 64, n0 = 32 * nb; const int nn = n0 & 1023, p = nn >> 7, dn0 = 256 * p + (n0 >= 1024 ? 128 : 0) + (nn & 127);
        transpose_item(P.w_gu + (size_t)e * 1024 * 2048, 2048, 64 * kb, n0, (bf16_t*)(ws + WS_WGU) + (size_t)e * 2048 * 1024, 1024, dn0, 64 * kb, nullptr, scr, lane); return; } r -= IT_GU;
    { const int e = r / 512, q = r % 512, kb = q / 32, nb = q % 32;
        transpose_item(P.w_down + (size_t)e * 1024 * 1024, 1024, 64 * kb, 32 * nb, (bf16_t*)(ws + WS_WD) + (size_t)e * 1024 * 1024, 1024, 32 * nb, 64 * kb, nullptr, scr, lane); }
}

__device__ __forceinline__ void rms_row_to_bf16(const float* xrow, const float* g, bf16_t* orow, int lane) {
    const f32x4* xr = (const f32x4*)xrow + lane; const f32x4* gr = (const f32x4*)g + lane;
    f32x4 v[4]; float s = 0.f;
#pragma unroll
    for (int j = 0; j < 4; ++j) { v[j] = xr[64 * j]; s += (v[j].x * v[j].x + v[j].y * v[j].y) + (v[j].z * v[j].z + v[j].w * v[j].w); }
    const float rstd = 1.f / sqrtf(wave_sum(s) * (1.f / 1024.f) + RMS_EPS);
    u32x2* o8 = (u32x2*)orow + lane;
#pragma unroll
    for (int j = 0; j < 4; ++j) { const f32x4 gg = gr[64 * j]; u32x2 w; w.x = pk2(v[j].x * rstd * gg.x, v[j].y * rstd * gg.y); w.y = pk2(v[j].z * rstd * gg.z, v[j].w * rstd * gg.w); o8[64 * j] = w; }
}

#define LAS __attribute__((address_space(3)))
#define XB_TMO      128
#define XB_XCNT(j)  (256  + 64 * (j))
#define XB_XSUB(j)  (1280 + 64 * (j))
#define XB_XGEN(j)  (2304 + 64 * (j))
#define XB_TOP      3328
#define XB_TOPGEN   3392
#define XCD_BAR_WORDS 3456
#define XB_SPIN_CAP (1u << 18)
__device__ __forceinline__ unsigned xb_ld(unsigned* p)              { return __hip_atomic_load(p, __ATOMIC_RELAXED, __HIP_MEMORY_SCOPE_AGENT); }
__device__ __forceinline__ unsigned xb_add(unsigned* p, unsigned v) { return __hip_atomic_fetch_add(p, v, __ATOMIC_RELAXED, __HIP_MEMORY_SCOPE_AGENT); }
__device__ __forceinline__ unsigned xb_xcc_id() { return (unsigned)__builtin_amdgcn_s_getreg((3 << 11) | 20) & 0xFu; }
#define XB_SPIN(cond, bar) do { unsigned _sp = 0; while (cond) { __builtin_amdgcn_s_sleep(1); \
    if ((++_sp & 255u) == 0u) { if (xb_ld(&(bar)[XB_TMO])) break; if (_sp > XB_SPIN_CAP) { atomicAdd(&(bar)[XB_TMO], 1u); break; } } } } while (0)
struct XcdBarrier { unsigned* bar; unsigned x; volatile LAS unsigned* st; };
__device__ __forceinline__ XcdBarrier xcd_barrier_post(unsigned* bar, volatile LAS unsigned* st) {
    XcdBarrier b; b.bar = bar; b.x = xb_xcc_id(); b.st = st;
    if (threadIdx.x == 0) (void)xb_add(&bar[XB_XCNT(b.x)], 1u);
    return b;
}
__device__ __forceinline__ void xcd_barrier_complete(unsigned* bar, unsigned x, unsigned& nloc, unsigned& nx) {
    const unsigned G = gridDim.x * gridDim.y * gridDim.z;
    unsigned sum, cnt, mine, sp = 0u;
    for (;;) {
        sum = 0u; cnt = 0u; mine = 0u;
#pragma unroll
        for (unsigned j = 0; j < 16; ++j) { const unsigned c = xb_ld(&bar[XB_XCNT(j)]); sum += c; cnt += (c > 0u) ? 1u : 0u; mine = (j == x) ? c : mine; }
        if (sum == G) break;
        __builtin_amdgcn_s_sleep(1);
        if ((++sp & 255u) == 0u) { if (xb_ld(&bar[XB_TMO])) break; if (sp > XB_SPIN_CAP) { atomicAdd(&bar[XB_TMO], 1u); break; } }
    }
    nloc = mine > 0u ? mine : 1u; nx = cnt > 0u ? cnt : 1u;
}
__device__ __forceinline__ void xcd_barrier(const XcdBarrier& b) {
    asm volatile("s_waitcnt vmcnt(0)" ::: "memory");
    __syncthreads();
    if (threadIdx.x == 0) {
        unsigned* bar = b.bar;
        __builtin_amdgcn_s_waitcnt(0);
        unsigned nloc = b.st[0], nx = b.st[1];
        if (nloc == 0u) { xcd_barrier_complete(bar, b.x, nloc, nx); b.st[0] = nloc; b.st[1] = nx; }
        const unsigned old = xb_add(&bar[XB_XSUB(b.x)], 1u);
        const unsigned gen = old / nloc;
        if (old + 1u == (gen + 1u) * nloc) {
            __builtin_amdgcn_fence(__ATOMIC_RELEASE, "agent");
            asm volatile("s_waitcnt vmcnt(0)" ::: "memory");
            const unsigned og = xb_add(&bar[XB_TOP], 1u);
            const unsigned tg = og / nx;
            if (og + 1u == (tg + 1u) * nx) xb_add(&bar[XB_TOPGEN], 1u);
            else XB_SPIN(xb_ld(&bar[XB_TOPGEN]) == tg, bar);
            __builtin_amdgcn_fence(__ATOMIC_ACQUIRE, "agent");
            xb_add(&bar[XB_XGEN(b.x)], 1u);
            asm volatile("s_waitcnt vmcnt(0)" ::: "memory");
        } else {
            XB_SPIN(xb_ld(&bar[XB_XGEN(b.x)]) == gen, bar);
            __builtin_amdgcn_fence(__ATOMIC_ACQUIRE, "agent");
            asm volatile("s_waitcnt vmcnt(0)" ::: "memory");
        }
    }
    __syncthreads();
}

constexpr int NWAVES = 8;
constexpr int RING_BYTES = 131072;
constexpr int LDSCTL_OFF = RING_BYTES, MISC_OFF = LDSCTL_OFF + 320;
constexpr int LDS_BYTES = 147456;
constexpr int CW_BAR = 4096;
constexpr int TS_OFF = 131584;
constexpr int SA_OFF = 131840;
constexpr int GT_OFF = 132864;
static_assert(GT_OFF + 9 * 1024 <= LDS_BYTES, "LDS map");
#ifndef FAST_INPROJ
#define FAST_INPROJ 1
#endif
#ifndef FAST_QKV
#define FAST_QKV 1
#endif
#ifndef FAST_WOUT
#define FAST_WOUT 1
#endif
#ifndef FAST_MOE
#define FAST_MOE 1
#endif
#ifndef FAST_ATTN
#define FAST_ATTN 1
#endif

namespace pg8 {
#define PG8_LAS __attribute__((address_space(3)))
constexpr int BM = 256, BK = 64, HALF = 128, HTB = HALF * BK * 2, STAGE_BYTES = 8 * HTB, NXCD = 8, WGM = 8;
__host__ __device__ __forceinline__ int lds_byte(int r, int c) { const int st = (r >> 4) * 2 + (c >> 5), rr = r & 15, cc = c & 31, ob = rr * 64 + cc * 2; return st * 1024 + (ob ^ (((ob >> 9) & 1) << 5)); }
__host__ __device__ __forceinline__ void stage_rc(int b, int& R, int& C) { const int st = b / 1024, sb = b % 1024, swz = sb ^ (((sb >> 9) & 1) << 5); R = (st >> 1) * 16 + swz / 64; C = (st & 1) * 32 + (swz % 64) / 2; }
__host__ __device__ __forceinline__ int perm32(int rho) { const int n = rho >> 4, i = rho & 15; return 8 * (i >> 2) + 4 * n + (i & 3); }
__device__ __forceinline__ unsigned cvt_pk_bf16(float lo, float hi) { unsigned r; asm volatile("v_cvt_pk_bf16_f32 %0, %1, %2" : "=v"(r) : "v"(lo), "v"(hi)); return r; }

struct Unit { const char* a; const char* b; int pm, pn, e, rt; };

struct DenseOrder {
    const char* A; const char* Bt; int nM, nN, nwg, G, c, K;
    __device__ void init(const void* A_, const void* Bt_, int M, int N, int K_, int G_, int c_) { A = (const char*)A_; Bt = (const char*)Bt_; nM = M / BM; nN = N / BM; nwg = nM * nN; G = G_; c = c_; K = K_; }
    __device__ bool next(int i, Unit& u) const {
        const long L = (long)i * G + c; if (L >= nwg) return false;
        int wgid = (int)L; { const int q = nwg / NXCD, r = nwg % NXCD, xcd = wgid % NXCD, off = wgid / NXCD; wgid = (xcd < r ? xcd * (q + 1) : r * (q + 1) + (xcd - r) * q) + off; }
        const int nig = WGM * nN, gid = wgid / nig, fm = gid * WGM, gsz = (nM - fm) < WGM ? (nM - fm) : WGM;
        u.pm = fm + ((wgid % nig) % gsz); u.pn = (wgid % nig) / gsz; u.e = 0; u.rt = 0;
        u.a = A + (size_t)u.pm * BM * K * 2; u.b = Bt + (size_t)u.pn * BM * K * 2; return true;
    }
};

template <class Epi, class Sched, bool ALIGN_EPI, bool GATHER>
__device__ __forceinline__ void gemm_phase(PG8_LAS unsigned char* lds, const int K_, const Sched& S, const Epi& E) {
    int K = K_; asm volatile("" : "+s"(K));
    const int tid = tid_opaque(), wid = __builtin_amdgcn_readfirstlane(tid >> 6), lane = tid & 63, wr = wid >> 2, wc = wid & 3, fr = lane & 15, fq = lane >> 4;
    const int nt = K / BK;
    unsigned voffA0, voffB0; int rowA0;
    { int R, C; stage_rc(tid * 16, R, C); const int Rb = Epi::PERM ? ((R & ~31) + perm32(R & 31)) : R;
      voffA0 = GATHER ? (unsigned)(C * 2) : (unsigned)(R * K + C) * 2u; voffB0 = (unsigned)(Rb * K + C) * 2u; rowA0 = R; }
    const unsigned r64 = (unsigned)(64 * K * 2);
    const size_t kstep = (size_t)(BK * 2);
    const size_t hstep = (size_t)HALF * K * 2;
    const unsigned ldsw = (unsigned)wid * 1024u;
    const int aoff = lds_byte(wr * 64 + fr, fq * 8), boff = lds_byte(wc * 32 + fr, fq * 8);
#define PG8_SA(b, h) (((b) * 2 + (h)) * HTB)
#define PG8_SB(b, h) ((4 + (b) * 2 + (h)) * HTB)
#define PG8_STAGE(bufoff, gbase, voff) do { _Pragma("unroll") for (int _i = 0; _i < 2; ++_i) \
        __builtin_amdgcn_global_load_lds((const unsigned*)((const char*)(gbase) + (size_t)(_i * r64) + (voff)), (PG8_LAS unsigned*)(lds + (bufoff) + ldsw + _i * 8192), 16, 0, 0); } while (0)
#define PG8_STAGE_A(bufoff, abase, rtab, h, koff) do { if constexpr (GATHER) { _Pragma("unroll") for (int _i = 0; _i < 2; ++_i) { \
            const unsigned _ro = *(const PG8_LAS unsigned*)(lds + (rtab) + ((h) * HALF + _i * 64 + rowA0) * 4); \
            __builtin_amdgcn_global_load_lds((const unsigned*)((const char*)(abase) + (koff) + (size_t)(_ro + voffA0)), (PG8_LAS unsigned*)(lds + (bufoff) + ldsw + _i * 8192), 16, 0, 0); } } \
        else { PG8_STAGE(bufoff, (const char*)(abase) + (h) * hstep + (koff), voffA0); } } while (0)
#define PG8_LDA(dst, b, h) do { _Pragma("unroll") for (int m = 0; m < 4; ++m) _Pragma("unroll") for (int k = 0; k < 2; ++k) dst[m][k] = *(const PG8_LAS bf16x8*)(lds + PG8_SA(b, h) + aoff + m * 2048 + k * 1024); } while (0)
#define PG8_LDB(dst, b, h) do { _Pragma("unroll") for (int n = 0; n < 2; ++n) _Pragma("unroll") for (int k = 0; k < 2; ++k) dst[n][k] = *(const PG8_LAS bf16x8*)(lds + PG8_SB(b, h) + boff + n * 2048 + k * 1024); } while (0)
#define PG8_MMA(ai, bj, At, Bt) do { __builtin_amdgcn_s_setprio(1); _Pragma("unroll") for (int m = 0; m < 4; ++m) _Pragma("unroll") for (int n = 0; n < 2; ++n) _Pragma("unroll") for (int k = 0; k < 2; ++k) \
        acc[ai][bj][m][n] = __builtin_amdgcn_mfma_f32_16x16x32_bf16(Bt[n][k], At[m][k], acc[ai][bj][m][n], 0, 0, 0); __builtin_amdgcn_s_setprio(0); } while (0)
#define PG8_WAIT_V(n) asm volatile("s_waitcnt vmcnt(" #n ")" ::: "memory")
#define PG8_WAIT_L(n) asm volatile("s_waitcnt lgkmcnt(" #n ")" ::: "memory")
#define PG8_BAR __builtin_amdgcn_s_barrier()
#define PG8_SCHED __builtin_amdgcn_sched_barrier(0)
    Unit cur, nxt; int ui = 0;
    if (!S.next(0, cur)) return;
    f32x4 acc[2][2][4][2];
#pragma unroll
    for (int a = 0; a < 2; ++a)
#pragma unroll
        for (int b = 0; b < 2; ++b)
#pragma unroll
            for (int m = 0; m < 4; ++m)
#pragma unroll
                for (int n = 0; n < 2; ++n) acc[a][b][m][n] = (f32x4){0.f, 0.f, 0.f, 0.f};
    bf16x8 At[4][2], B0[2][2], B1[2][2];
    const char* cA = cur.a; const char* cB = cur.b; int cR = cur.rt;
    if constexpr (Epi::MID) E.pre(cur, lds, tid);
    PG8_STAGE(PG8_SB(0, 0), cB, voffB0); PG8_STAGE(PG8_SB(0, 1), cB + hstep, voffB0); PG8_STAGE_A(PG8_SA(0, 0), cA, cR, 0, 0); PG8_STAGE_A(PG8_SA(0, 1), cA, cR, 1, 0);
    if (wr == 1) PG8_BAR;
    PG8_WAIT_V(2); PG8_BAR;
    PG8_STAGE(PG8_SB(1, 0), cB + kstep, voffB0); PG8_STAGE_A(PG8_SA(1, 0), cA, cR, 0, kstep); PG8_STAGE(PG8_SB(1, 1), cB + hstep + kstep, voffB0);
    PG8_WAIT_V(6); PG8_BAR;
    for (;;) {
        const bool has_next = S.next(ui + 1, nxt);
        const char* nA = has_next ? nxt.a : cA; const char* nB = has_next ? nxt.b : cB; const int nR = has_next ? nxt.rt : cR;
        for (int t = 0; t < nt; t += 2) {
            const bool last = (t == nt - 2);
            if constexpr (Epi::MID) { if (t == nt / 2) E.mid(acc, wr, fr, lds); }
            const size_t k1 = (size_t)(t + 1) * kstep;
            const char* a2 = last ? nA : cA; const char* b2 = last ? nB : cB + (size_t)(t + 2) * kstep; const int r2 = last ? nR : cR;
            const size_t k2 = last ? 0 : (size_t)(t + 2) * kstep, k3 = k2 + kstep; const char* b3 = b2 + kstep;
            PG8_LDB(B0, 0, 0); PG8_LDB(B1, 0, 1); PG8_SCHED; PG8_LDA(At, 0, 0); PG8_STAGE_A(PG8_SA(1, 1), cA, cR, 1, k1);
            PG8_WAIT_V(8); PG8_WAIT_L(0); PG8_BAR; PG8_MMA(0, 0, At, B0); PG8_MMA(0, 1, At, B1); PG8_BAR; PG8_SCHED;
            PG8_LDA(At, 0, 1); PG8_STAGE(PG8_SB(0, 0), b2, voffB0); PG8_STAGE(PG8_SB(0, 1), b2 + hstep, voffB0); PG8_STAGE_A(PG8_SA(0, 0), a2, r2, 0, k2);
            PG8_WAIT_V(8); PG8_WAIT_L(0); PG8_BAR; PG8_MMA(1, 0, At, B0); PG8_MMA(1, 1, At, B1); PG8_BAR; PG8_SCHED;
            PG8_LDB(B0, 1, 0); PG8_LDB(B1, 1, 1); PG8_SCHED; PG8_LDA(At, 1, 0); PG8_STAGE_A(PG8_SA(0, 1), a2, r2, 1, k2);
            PG8_WAIT_V(8); PG8_WAIT_L(0); PG8_BAR; PG8_MMA(0, 0, At, B0); PG8_MMA(0, 1, At, B1); PG8_BAR; PG8_SCHED;
            PG8_LDA(At, 1, 1); PG8_STAGE(PG8_SB(1, 0), b3, voffB0); PG8_STAGE(PG8_SB(1, 1), b3 + hstep, voffB0); PG8_STAGE_A(PG8_SA(1, 0), a2, r2, 0, k3);
            PG8_WAIT_V(8); PG8_WAIT_L(0); PG8_BAR; PG8_MMA(1, 0, At, B0); PG8_MMA(1, 1, At, B1); PG8_BAR; PG8_SCHED;
        }
        if constexpr (ALIGN_EPI) { if (wr == 0) PG8_BAR; }
        if constexpr (!Epi::AFTER_DRAIN) { E(acc, cur, wr, wc, fr, fq); }
        if (!has_next) break;
#pragma unroll
        for (int a = 0; a < 2; ++a)
#pragma unroll
            for (int b = 0; b < 2; ++b)
#pragma unroll
                for (int m = 0; m < 4; ++m)
#pragma unroll
                    for (int n = 0; n < 2; ++n) acc[a][b][m][n] = (f32x4){0.f, 0.f, 0.f, 0.f};
        cur = nxt; cA = nA; cB = nB; cR = nR; ++ui;
        if constexpr (ALIGN_EPI) { if (wr == 1) PG8_BAR; }
    }
    PG8_WAIT_V(0);
    if constexpr (!ALIGN_EPI) { if (wr == 0) PG8_BAR; }
    PG8_BAR;
    if constexpr (Epi::AFTER_DRAIN) { E.fused(acc, cur, wr, wc, fr, fq, lds, wid, lane); }
#undef PG8_SA
#undef PG8_SB
#undef PG8_STAGE
#undef PG8_STAGE_A
#undef PG8_LDA
#undef PG8_LDB
#undef PG8_MMA
#undef PG8_WAIT_V
#undef PG8_WAIT_L
#undef PG8_BAR
#undef PG8_SCHED
}

struct EpiInProj {
    static constexpr bool PERM = false, AFTER_DRAIN = true, MID = false;
    bf16_t* U; bf16_t* QN; bf16_t* KVN; bf16_t* KR; const float* g_q_a; const float* g_kv_a; const float* COS; const float* SIN;
    __device__ __forceinline__ void fused(f32x4 (&acc)[2][2][4][2], const Unit& u, int wr, int wc, int fr, int fq, PG8_LAS unsigned char* lds, int wid, int lane) const {
        const int row0 = u.pm * BM + wr * 64 + fr;
        if (u.pn < 2) {
#pragma unroll
            for (int ai = 0; ai < 2; ++ai)
#pragma unroll
                for (int m = 0; m < 4; ++m) { bf16_t* rowp = U + (size_t)(row0 + ai * HALF + m * 16) * 512 + u.pn * 256 + wc * 32 + 4 * fq;
#pragma unroll
                    for (int bj = 0; bj < 2; ++bj)
#pragma unroll
                        for (int n = 0; n < 2; ++n) { const f32x4 v = acc[ai][bj][m][n]; u32x2 w; w.x = cvt_pk_bf16(v[0], v[1]); w.y = cvt_pk_bf16(v[2], v[3]); *(u32x2*)(rowp + bj * HALF + n * 16) = w; } }
            return;
        }
        const bool isq = (u.pn == 2);
        PG8_LAS float* Pp = (PG8_LAS float*)lds;
#pragma unroll
        for (int ai = 0; ai < 2; ++ai)
#pragma unroll
            for (int m = 0; m < 4; ++m) { float s = 0.f;
#pragma unroll
                for (int bj = 0; bj < 2; ++bj) { if (bj == 1 && !isq) continue;
#pragma unroll
                    for (int n = 0; n < 2; ++n) { const f32x4 x = acc[ai][bj][m][n]; s += (x[0] * x[0] + x[1] * x[1]) + (x[2] * x[2] + x[3] * x[3]); } }
                s += __shfl_xor(s, 16); s += __shfl_xor(s, 32);
                if (fq == 0) Pp[(ai * HALF + wr * 64 + m * 16 + fr) * 4 + wc] = s; }
        asm volatile("s_waitcnt lgkmcnt(0)" ::: "memory"); __builtin_amdgcn_s_barrier(); asm volatile("" ::: "memory");
        const float invn = isq ? (1.f / 256.f) : (1.f / 128.f);
#pragma unroll
        for (int ai = 0; ai < 2; ++ai)
#pragma unroll
            for (int m = 0; m < 4; ++m) { const int rl = ai * HALF + wr * 64 + m * 16 + fr; const f32x4 p4 = *(const PG8_LAS f32x4*)(Pp + rl * 4);
                const float rstd = 1.f / sqrtf(((p4[0] + p4[1]) + (p4[2] + p4[3])) * invn + RMS_EPS); const size_t row = (size_t)(u.pm * BM + rl);
                if (isq) {
#pragma unroll
                    for (int bj = 0; bj < 2; ++bj)
#pragma unroll
                        for (int n = 0; n < 2; ++n) { const int c = bj * HALF + wc * 32 + n * 16 + 4 * fq; const f32x4 g = *(const f32x4*)(g_q_a + c); const f32x4 v = acc[ai][bj][m][n] * rstd * g;
                            u32x2 w; w.x = cvt_pk_bf16(v[0], v[1]); w.y = cvt_pk_bf16(v[2], v[3]); *(u32x2*)(QN + row * 256 + c) = w; }
                } else {
#pragma unroll
                    for (int n = 0; n < 2; ++n) { const int c = wc * 32 + n * 16 + 4 * fq; const f32x4 g = *(const f32x4*)(g_kv_a + c); const f32x4 v = acc[ai][0][m][n] * rstd * g;
                        u32x2 w; w.x = cvt_pk_bf16(v[0], v[1]); w.y = cvt_pk_bf16(v[2], v[3]); *(u32x2*)(KVN + row * 128 + c) = w; }
                    if (wc == 0) { const f32x4 x1 = acc[ai][1][m][0], x2 = acc[ai][1][m][1]; const f32x4 cs = *(const f32x4*)(COS + row * 16 + 4 * fq), sn = *(const f32x4*)(SIN + row * 16 + 4 * fq);
                        const f32x4 o1 = x1 * cs - x2 * sn, o2 = x2 * cs + x1 * sn; u32x2 w1, w2; w1.x = cvt_pk_bf16(o1[0], o1[1]); w1.y = cvt_pk_bf16(o1[2], o1[3]); w2.x = cvt_pk_bf16(o2[0], o2[1]); w2.y = cvt_pk_bf16(o2[2], o2[3]);
                        *(u32x2*)(KR + row * 32 + 4 * fq) = w1; *(u32x2*)(KR + row * 32 + 16 + 4 * fq) = w2; }
                } }
    }
};
}
namespace pg8 {
struct EpiQ {
    static constexpr bool PERM = false, AFTER_DRAIN = false, MID = false;
    bf16_t* Q; const float* COS; const float* SIN;
    __device__ __forceinline__ void operator()(const f32x4 (&acc)[2][2][4][2], const Unit& u, int wr, int wc, int fr, int fq) const {
        const int row0 = u.pm * BM + wr * 64 + fr; const int G0 = 8 * u.pn + wc, G1 = G0 + 4; const bool r0 = (G0 % 3) == 2, r1 = (G1 % 3) == 2;
#pragma unroll
        for (int ai = 0; ai < 2; ++ai)
#pragma unroll
            for (int m = 0; m < 4; ++m) { const size_t row = (size_t)(row0 + ai * HALF + m * 16);
                f32x4 cs = {1.f, 1.f, 1.f, 1.f}, sn = {0.f, 0.f, 0.f, 0.f};
                if (r0 || r1) { cs = *(const f32x4*)(COS + row * 16 + 4 * fq); sn = *(const f32x4*)(SIN + row * 16 + 4 * fq); }
#pragma unroll
                for (int bj = 0; bj < 2; ++bj) { const bool rope = bj ? r1 : r0; const int cb = 32 * (bj ? G1 : G0) + 4 * fq; f32x4 o1 = acc[ai][bj][m][0], o2 = acc[ai][bj][m][1];
                    if (rope) { const f32x4 x1 = o1, x2 = o2; o1 = x1 * cs - x2 * sn; o2 = x2 * cs + x1 * sn; }
                    o1 = o1 * QSCALE; o2 = o2 * QSCALE; u32x2 w1, w2; w1.x = cvt_pk_bf16(o1[0], o1[1]); w1.y = cvt_pk_bf16(o1[2], o1[3]); w2.x = cvt_pk_bf16(o2[0], o2[1]); w2.y = cvt_pk_bf16(o2[2], o2[3]);
                    *(u32x2*)(Q + row * 768 + cb) = w1; *(u32x2*)(Q + row * 768 + cb + 16) = w2; }
                asm volatile("" ::: "memory"); }
    }
};
struct EpiKV {
    static constexpr bool PERM = true, AFTER_DRAIN = false, MID = false;
    bf16_t* Kn; bf16_t* V;
    __device__ __forceinline__ void operator()(const f32x4 (&acc)[2][2][4][2], const Unit& u, int wr, int wc, int fr, int fq) const {
        const int row0 = u.pm * BM + wr * 64 + fr;
#pragma unroll
        for (int bj = 0; bj < 2; ++bj) { const int head = 2 * u.pn + bj; bf16_t* dst = (wc < 2 ? Kn + head * 64 + wc * 32 : V + head * 64 + (wc - 2) * 32) + 8 * fq;
#pragma unroll
            for (int ai = 0; ai < 2; ++ai)
#pragma unroll
                for (int m = 0; m < 4; ++m) { const size_t row = (size_t)(row0 + ai * HALF + m * 16); const f32x4 v0 = acc[ai][bj][m][0], v1 = acc[ai][bj][m][1];
                    u32x4 w; w.x = cvt_pk_bf16(v0[0], v0[1]); w.y = cvt_pk_bf16(v0[2], v0[3]); w.z = cvt_pk_bf16(v1[0], v1[1]); w.w = cvt_pk_bf16(v1[2], v1[3]); *(u32x4*)(dst + row * 512) = w; } }
    }
};
struct EpiOut {
    static constexpr bool PERM = false, AFTER_DRAIN = false, MID = true;
    const float* x; float* out; const float* SSQ; int aux_off;
    __device__ __forceinline__ void pre(const Unit& u, PG8_LAS unsigned char* lds, int tid) const {
        if (tid < 256) { const f32x4 a = *(const f32x4*)(SSQ + (size_t)(u.pm * BM + tid) * 8), b = *(const f32x4*)(SSQ + (size_t)(u.pm * BM + tid) * 8 + 4);
            const float s = ((a[0] + a[1]) + (a[2] + a[3])) + ((b[0] + b[1]) + (b[2] + b[3])); ((PG8_LAS float*)(lds + aux_off))[tid] = 1.f / sqrtf(s * (1.f / 512.f) + RMS_EPS); }
    }
    __device__ __forceinline__ void mid(f32x4 (&acc)[2][2][4][2], int wr, int fr, PG8_LAS unsigned char* lds) const {
#pragma unroll
        for (int ai = 0; ai < 2; ++ai)
#pragma unroll
            for (int m = 0; m < 4; ++m) { const float sa = ((const PG8_LAS float*)(lds + aux_off))[ai * HALF + wr * 64 + m * 16 + fr];
#pragma unroll
                for (int bj = 0; bj < 2; ++bj)
#pragma unroll
                    for (int n = 0; n < 2; ++n) acc[ai][bj][m][n] = acc[ai][bj][m][n] * sa; }
    }
    __device__ __forceinline__ void operator()(const f32x4 (&acc)[2][2][4][2], const Unit& u, int wr, int wc, int fr, int fq) const {
        const int row0 = u.pm * BM + wr * 64 + fr, col0 = u.pn * BM + wc * 32 + 4 * fq;
#pragma unroll
        for (int ai = 0; ai < 2; ++ai)
#pragma unroll
            for (int m = 0; m < 4; ++m) { const size_t off = (size_t)(row0 + ai * HALF + m * 16) * 1024 + col0;
#pragma unroll
                for (int bj = 0; bj < 2; ++bj)
#pragma unroll
                    for (int n = 0; n < 2; ++n) *(f32x4*)(out + off + bj * HALF + n * 16) = *(const f32x4*)(x + off + bj * HALF + n * 16) + acc[ai][bj][m][n]; }
    }
};
struct EpiSwiglu {
    static constexpr bool PERM = true, AFTER_DRAIN = false, MID = false;
    const float* bgu; bf16_t* ACT;
    __device__ __forceinline__ void operator()(const f32x4 (&acc)[2][2][4][2], const Unit& u, int wr, int wc, int fr, int fq) const {
        const int row0 = u.pm * BM + wr * 64 + fr, col8 = u.pn * HALF + wc * 32 + 8 * fq;
        f32x4 bg[2], bu[2];
#pragma unroll
        for (int n = 0; n < 2; ++n) { bg[n] = *(const f32x4*)(bgu + (size_t)u.e * 2048 + col8 + 4 * n); bu[n] = *(const f32x4*)(bgu + (size_t)u.e * 2048 + 1024 + col8 + 4 * n); }
#pragma unroll
        for (int ai = 0; ai < 2; ++ai)
#pragma unroll
            for (int m = 0; m < 4; ++m) { f32x4 a[2];
#pragma unroll
                for (int n = 0; n < 2; ++n) { const f32x4 g4 = acc[ai][0][m][n] + bg[n], u4 = acc[ai][1][m][n] + bu[n];
#pragma unroll
                    for (int j = 0; j < 4; ++j) { const float g = fminf(g4[j], 7.f), uu = fminf(fmaxf(u4[j], -7.f), 7.f);
                        const float sg = __builtin_amdgcn_rcpf(1.f + __builtin_amdgcn_exp2f(-1.702f * 1.4426950408889634f * g)); a[n][j] = g * sg * (uu + 1.f); } }
                u32x4 w; w.x = cvt_pk_bf16(a[0][0], a[0][1]); w.y = cvt_pk_bf16(a[0][2], a[0][3]); w.z = cvt_pk_bf16(a[1][0], a[1][1]); w.w = cvt_pk_bf16(a[1][2], a[1][3]);
                *(u32x4*)(ACT + (size_t)(row0 + ai * HALF + m * 16) * 1024 + col8) = w; }
    }
};
struct EpiDown {
    static constexpr bool PERM = true, AFTER_DRAIN = false, MID = false;
    const float* bd; const float* GL; bf16_t* Y;
    __device__ __forceinline__ void operator()(const f32x4 (&acc)[2][2][4][2], const Unit& u, int wr, int wc, int fr, int fq) const {
        const int col0 = u.pn * BM + wc * 32 + 8 * fq;
        f32x4 bv[2][2];
#pragma unroll
        for (int bj = 0; bj < 2; ++bj)
#pragma unroll
            for (int n = 0; n < 2; ++n) bv[bj][n] = *(const f32x4*)(bd + (size_t)u.e * 1024 + col0 + bj * HALF + 4 * n);
#pragma unroll
        for (int ai = 0; ai < 2; ++ai)
#pragma unroll
            for (int m = 0; m < 4; ++m) { const int rl = ai * HALF + wr * 64 + m * 16 + fr; const float gt = GL[(size_t)u.e * T + u.rt + rl]; bf16_t* rowp = Y + (size_t)(u.pm * BM + rl) * 1024 + col0;
#pragma unroll
                for (int bj = 0; bj < 2; ++bj) { const f32x4 v0 = (acc[ai][bj][m][0] + bv[bj][0]) * gt, v1 = (acc[ai][bj][m][1] + bv[bj][1]) * gt;
                    u32x4 w; w.x = cvt_pk_bf16(v0[0], v0[1]); w.y = cvt_pk_bf16(v0[2], v0[3]); w.z = cvt_pk_bf16(v1[0], v1[1]); w.w = cvt_pk_bf16(v1[2], v1[3]); *(u32x4*)(rowp + bj * HALF) = w; } }
    }
};
template <bool GATHER>
struct MoeOrder {
    const char* A; const char* W; size_t wstride; int NN, G, c, rt0; const PG8_LAS int* tstart;
    __device__ bool next(int i, Unit& u) const {
        const int nwg = tstart[32] * NN; const long L = (long)i * G + c; if (L >= nwg) return false;
        int wgid = (int)L; { const int q = nwg / NXCD, r = nwg % NXCD, xcd = wgid % NXCD, off = wgid / NXCD; wgid = (xcd < r ? xcd * (q + 1) : r * (q + 1) + (xcd - r) * q) + off; }
        const int mt = wgid / NN, pn = wgid % NN; int e = 0;
        for (int k = 1; k < 32; ++k) e += (tstart[k] <= mt) ? 1 : 0;
        u.pm = mt; u.pn = pn; u.e = e; const int jt = mt - tstart[e];
        u.a = GATHER ? A : A + (size_t)mt * BM * 1024 * 2; u.b = W + (size_t)e * wstride + (size_t)pn * BM * 1024 * 2;
        u.rt = GATHER ? rt0 + i * 1024 : jt * 256;
        return true;
    }
};
}

template <bool GATHER>
__device__ __forceinline__ void moe_setup(const Ptrs& P, LAS unsigned char* lds, const pg8::MoeOrder<GATHER>& S) {
    const int tid = threadIdx.x; const int* cnt = (const int*)(P.ws + WS_CTL) + CW_CNT;
    if (tid < 33) { int s = 0; for (int e = 0; e < tid; ++e) s += (cnt[e] + 255) >> 8; ((LAS int*)(lds + TS_OFF))[tid] = s; }
    __syncthreads();
    if constexpr (GATHER) {
        const int* LIST = (const int*)(P.ws + WS_LIST); pg8::Unit u;
        for (int i = 0; i < 9 && S.next(i, u); ++i) {
            if (tid < 256) { const int jt = u.pm - S.tstart[u.e]; int pos = jt * 256 + tid; const int n = cnt[u.e]; if (pos >= n) pos = n - 1;
                ((LAS unsigned*)(lds + GT_OFF + i * 1024))[tid] = (unsigned)LIST[(size_t)u.e * T + pos] * 2048u; }
        }
        __syncthreads();
    }
}
namespace att {
typedef short s16x4 __attribute__((ext_vector_type(4)));
typedef float f32x16 __attribute__((ext_vector_type(16)));
constexpr int NW = 8, QBLK = 32, KVBLK = 64, QB = NW * QBLK;
constexpr int SHM_V = KVBLK * 64 * 2, SHM_K = KVBLK * 256;
constexpr int OFF_V = 0, OFF_K = 2 * SHM_V, OFF_WS = OFF_K + 2 * SHM_K, OFF_OST = OFF_WS + NW * 64 * 4, ATT_LDS = OFF_OST + NW * 4096;
constexpr float THR2 = 11.5f;
#define KSWZ(row, colB) ((row) * 256 + ((colB) ^ (((row) & 7) << 4)))
#define SBAR() __builtin_amdgcn_sched_barrier(0)
__device__ __forceinline__ int v_st(int k, int c) { const int kk = (k & ~0xC) | ((k & 4) << 1) | ((k & 8) >> 1); return ((kk >> 3) * 2 + (c >> 5)) * 512 + ((kk & 7) * 32 + (c & 31)) * 2; }
__device__ __forceinline__ int v_rd_base(int lane) { return ((lane & 3) << 3) | (((lane >> 2) & 3) << 6) | (((lane >> 4) & 1) << 5) | (((lane >> 5) & 1) << 8); }
__device__ __forceinline__ int crow(int r, int hi) { return (r & 3) + 8 * (r >> 2) + 4 * hi; }
__device__ __forceinline__ unsigned cvtpk(float lo, float hi) { unsigned r; asm volatile("v_cvt_pk_bf16_f32 %0, %1, %2" : "=v"(r) : "v"(lo), "v"(hi)); return r; }
__device__ __forceinline__ void mask_tile(f32x16& p0, f32x16& p1, int dq) {
    const float NEG = -__builtin_inff();
#pragma unroll
    for (int r = 0; r < 16; ++r) { const int c = (r & 3) + 8 * (r >> 2); if (dq - c < 0) p0[r] = NEG; if (dq - c - 32 < 0) p1[r] = NEG; }
}
__device__ __forceinline__ void partialSM(f32x16& p0, f32x16& p1, float& m_reg, float& mn, float& alpha) {
    float pmax = p0[0];
#pragma unroll
    for (int r = 1; r < 16; ++r) pmax = fmaxf(pmax, p0[r]);
#pragma unroll
    for (int r = 0; r < 16; ++r) pmax = fmaxf(pmax, p1[r]);
    { auto rr = __builtin_amdgcn_permlane32_swap(__float_as_uint(pmax), __float_as_uint(pmax), false, false); pmax = fmaxf(__uint_as_float(rr[0]), __uint_as_float(rr[1])); }
    if (__builtin_expect(__all((pmax - m_reg) <= THR2), 1)) { mn = m_reg; alpha = 1.f; }
    else { mn = fmaxf(m_reg, pmax); alpha = __builtin_amdgcn_exp2f(m_reg - mn); m_reg = mn; }
#pragma unroll
    for (int r = 0; r < 16; ++r) p0[r] = p0[r] - mn;
#pragma unroll
    for (int r = 0; r < 16; ++r) p1[r] = p1[r] - mn;
#pragma unroll
    for (int r = 0; r < 16; ++r) p0[r] = __builtin_amdgcn_exp2f(p0[r]);
}
__device__ __forceinline__ void finishSM(f32x16& p0, f32x16& p1, float alpha, float& l_reg, bf16x8& pa0, bf16x8& pa1, bf16x8& pa2, bf16x8& pa3) {
#pragma unroll
    for (int r = 0; r < 16; ++r) p1[r] = __builtin_amdgcn_exp2f(p1[r]);
    float ps = 0;
#pragma unroll
    for (int r = 0; r < 16; ++r) ps += p0[r];
#pragma unroll
    for (int r = 0; r < 16; ++r) ps += p1[r];
    { auto rr = __builtin_amdgcn_permlane32_swap(__float_as_uint(ps), __float_as_uint(ps), false, false); ps = __uint_as_float(rr[0]) + __uint_as_float(rr[1]); }
    l_reg = l_reg * alpha + ps;
#define PK4(P, B_, OUT) do { unsigned a0 = cvtpk(P[B_+0], P[B_+1]), a1 = cvtpk(P[B_+2], P[B_+3]); unsigned b0 = cvtpk(P[B_+4], P[B_+5]), b1 = cvtpk(P[B_+6], P[B_+7]); \
        auto r0 = __builtin_amdgcn_permlane32_swap(a0, b0, false, false); auto r1 = __builtin_amdgcn_permlane32_swap(a1, b1, false, false); \
        u32x4 w = {r0[0], r1[0], r0[1], r1[1]}; OUT = *reinterpret_cast<bf16x8*>(&w); } while (0)
    PK4(p0, 0, pa0); PK4(p0, 8, pa1); PK4(p1, 0, pa2); PK4(p1, 8, pa3);
#undef PK4
}
template <int KB>
__device__ __forceinline__ void qkt(f32x16& p0, f32x16& p1, const char* K_lds, int r32, int hi, const bf16x8* qr) {
    p0 = f32x16{}; p1 = f32x16{};
    const char* kb[4];
#pragma unroll
    for (int dd = 0; dd < 4; ++dd) kb[dd] = K_lds + KB * SHM_K + KSWZ(r32, (dd * 16 + hi * 8) * 2);
#pragma unroll
    for (int d0 = 0; d0 < 6; ++d0) { const char* a = kb[d0 & 3] + (d0 >> 2) * 128;
        bf16x8 b0 = *reinterpret_cast<const bf16x8*>(a);
        bf16x8 b1 = *reinterpret_cast<const bf16x8*>(a + 32 * 256);
        p0 = __builtin_amdgcn_mfma_f32_32x32x16_bf16(b0, qr[d0], p0, 0, 0, 0);
        p1 = __builtin_amdgcn_mfma_f32_32x32x16_bf16(b1, qr[d0], p1, 0, 0, 0); }
}
template <int VB>
__device__ __forceinline__ void pv_tile(f32x16* o, int vb0, bf16x8 pa0, bf16x8 pa1, bf16x8 pa2, bf16x8 pa3) {
#define TRRD(dst, off) asm volatile("ds_read_b64_tr_b16 %0, %1 offset:%2" : "=&v"(dst) : "v"(vb0), "i"(off) : "memory")
#define PV_D0(d0) do { s16x4 l0, l1, l2, l3, h0, h1, h2, h3; constexpr int b_ = OFF_V + VB * SHM_V + (d0) * 512; \
        TRRD(l0, b_); TRRD(h0, b_ + 1024); TRRD(l1, b_ + 2048); TRRD(h1, b_ + 3072); TRRD(l2, b_ + 4096); TRRD(h2, b_ + 5120); TRRD(l3, b_ + 6144); TRRD(h3, b_ + 7168); \
        asm volatile("s_waitcnt lgkmcnt(0)" ::: "memory"); SBAR(); \
        o[d0] = __builtin_amdgcn_mfma_f32_32x32x16_bf16(pa0, (bf16x8){l0[0], l0[1], l0[2], l0[3], h0[0], h0[1], h0[2], h0[3]}, o[d0], 0, 0, 0); \
        o[d0] = __builtin_amdgcn_mfma_f32_32x32x16_bf16(pa1, (bf16x8){l1[0], l1[1], l1[2], l1[3], h1[0], h1[1], h1[2], h1[3]}, o[d0], 0, 0, 0); \
        o[d0] = __builtin_amdgcn_mfma_f32_32x32x16_bf16(pa2, (bf16x8){l2[0], l2[1], l2[2], l2[3], h2[0], h2[1], h2[2], h2[3]}, o[d0], 0, 0, 0); \
        o[d0] = __builtin_amdgcn_mfma_f32_32x32x16_bf16(pa3, (bf16x8){l3[0], l3[1], l3[2], l3[3], h3[0], h3[1], h3[2], h3[3]}, o[d0], 0, 0, 0); } while (0)
    PV_D0(0); PV_D0(1);
#undef PV_D0
#undef TRRD
}
struct BlockRef { const bf16_t* Q; const bf16_t* Kn; const bf16_t* KR; const bf16_t* V; bf16_t* O; float* SSQ; int P0; };
struct Seam { bf16x8 qr[6]; bf16x8 st_v0, st_k0, st_k1; };
#define VMW() asm volatile("s_waitcnt vmcnt(0)" ::: "memory")
#define VMWN(n) asm volatile("s_waitcnt vmcnt(%0)" :: "i"(n) : "memory")
#define KSRC(B, k0, rr) ((ch < 8 ? (B).Kn + (size_t)((k0) + (rr)) * 512 + ch * 8 : (B).KR + (size_t)((k0) + (rr)) * 32 + (ch - 8) * 8))
#define SLOAD_H(B, k0) do { S.st_v0 = *(const bf16x8*)((B).V + (size_t)((k0) + vk) * 512 + vc); \
                            if (ch < 12) { S.st_k0 = *(const bf16x8*)KSRC(B, k0, sr); S.st_k1 = *(const bf16x8*)KSRC(B, k0, 32 + sr); } } while (0)
#define SWRITE_HK(bf) do { if (ch < 12) { *(bf16x8*)(K_lds + (bf) * SHM_K + kws) = S.st_k0; *(bf16x8*)(K_lds + (bf) * SHM_K + kws + 32 * 256) = S.st_k1; } } while (0)
#define SWRITE_HV(bf) do { *(bf16x8*)(V_lds + (bf) * SHM_V + vst0) = S.st_v0; } while (0)
#define SWRITE_H(bf) do { SWRITE_HV(bf); SWRITE_HK(bf); } while (0)
__device__ __forceinline__ void attn_prime(const BlockRef& cur, char* lds, Seam& S) {
    const int tid = tid_opaque(), wid = __builtin_amdgcn_readfirstlane(tid >> 6), lane = tid & 63, r32 = lane & 31, hi = lane >> 5;
    const int sr = tid >> 4, ch = tid & 15, kws = KSWZ(sr, ch * 16), vk = tid >> 3, vc = (tid & 7) * 8; char* K_lds = lds + OFF_K;
#pragma unroll
    for (int d0 = 0; d0 < 6; ++d0) S.qr[d0] = *(const bf16x8*)(cur.Q + (size_t)(wid * QBLK + r32) * 768 + d0 * 16 + hi * 8);
    SLOAD_H(cur, 0); VMW(); SWRITE_HK(0);
    __syncthreads();
}
__device__ __forceinline__ void attn_block(const BlockRef& cur, const BlockRef& nxt, char* lds, Seam& S) {
    const int tid = tid_opaque(), wid = __builtin_amdgcn_readfirstlane(tid >> 6), lane = tid & 63, r32 = lane & 31, hi = lane >> 5;
    const int NT = (cur.P0 + QB) / KVBLK;
    const int qlo = cur.P0 + wid * QBLK, qm = qlo + r32 - 4 * hi;
    char* V_lds = lds + OFF_V; char* K_lds = lds + OFF_K;
    float* ws = (float*)(lds + OFF_WS) + wid * 64; float* li_l = ws, * al_l = ws + 32;
    float m_reg = -1e30f, l_reg = 0; f32x16 o[2] = {};
    const int sr = tid >> 4, ch = tid & 15, kws = KSWZ(sr, ch * 16), vk = tid >> 3, vc = (tid & 7) * 8, vst0 = v_st(vk, vc);
    const int vb0 = (int)(uintptr_t)lds + v_rd_base(lane);
#define RESC(a) do { if (__any((a) < 1.f)) { if (hi == 0) al_l[r32] = (a); asm volatile("s_waitcnt lgkmcnt(0)" ::: "memory"); \
                     _Pragma("unroll") for (int d_ = 0; d_ < 2; ++d_) _Pragma("unroll") for (int r = 0; r < 16; ++r) o[d_][r] *= al_l[crow(r, hi)]; } } while (0)
#define KBASE(t) ((t) * KVBLK)
#define MASKT(P0_, P1_, t) do { const int kb_ = KBASE(t); if (kb_ + KVBLK - 1 > qlo) mask_tile(P0_, P1_, qm - kb_); } while (0)
    constexpr int NQL = 6;
#define SEAM_K0() do { VMWN(NQL); SWRITE_HK(0); SBAR(); } while (0)
    f32x16 pA0, pA1, pB0, pB1; float mnA, mnB, alA, alB; bf16x8 pa0, pa1, pa2, pa3;
    SWRITE_HV(0); SBAR();
    if (NT > 1) SLOAD_H(cur, KBASE(1));
    SBAR(); qkt<0>(pA0, pA1, K_lds, r32, hi, S.qr);
    MASKT(pA0, pA1, 0); partialSM(pA0, pA1, m_reg, mnA, alA);
    if (NT > 1) { VMW(); SWRITE_H(1); }
    __syncthreads();
#define HALF_STEP(PX0, PX1, mnX, alX, PY0, PY1, alY, t, KB, VB, SB) do { \
        SBAR(); qkt<KB>(PX0, PX1, K_lds, r32, hi, S.qr); \
        finishSM(PY0, PY1, alY, l_reg, pa0, pa1, pa2, pa3); SBAR(); \
        if ((t) + 1 < NT) { SLOAD_H(cur, KBASE((t) + 1)); SBAR(); } \
        pv_tile<VB>(o, vb0, pa0, pa1, pa2, pa3); MASKT(PX0, PX1, (t)); partialSM(PX0, PX1, m_reg, mnX, alX); \
        __syncthreads(); \
        if ((t) + 1 < NT) { VMW(); SWRITE_H(SB); } \
        RESC(alX); __syncthreads(); } while (0)
    for (int t = 1; t + 1 < NT; t += 2) {
        HALF_STEP(pB0, pB1, mnB, alB, pA0, pA1, alA, t, 1, 0, 0);
        HALF_STEP(pA0, pA1, mnA, alA, pB0, pB1, alB, t + 1, 0, 1, 1);
    }
    SBAR(); qkt<1>(pB0, pB1, K_lds, r32, hi, S.qr); SBAR();
    SLOAD_H(nxt, 0); SBAR();
#pragma unroll
    for (int d0 = 0; d0 < 6; ++d0) S.qr[d0] = *(const bf16x8*)(nxt.Q + (size_t)(wid * QBLK + r32) * 768 + d0 * 16 + hi * 8);
    SBAR();
    finishSM(pA0, pA1, alA, l_reg, pa0, pa1, pa2, pa3); SBAR();
    pv_tile<0>(o, vb0, pa0, pa1, pa2, pa3);
    MASKT(pB0, pB1, NT - 1); partialSM(pB0, pB1, m_reg, mnB, alB); __syncthreads(); RESC(alB);
    finishSM(pB0, pB1, alB, l_reg, pa0, pa1, pa2, pa3); SBAR(); pv_tile<1>(o, vb0, pa0, pa1, pa2, pa3);
    SBAR(); SEAM_K0();
    if (hi == 0) li_l[r32] = l_reg; asm volatile("s_waitcnt lgkmcnt(0)" ::: "memory");
    float rli[16];
#pragma unroll
    for (int r = 0; r < 16; ++r) rli[r] = __builtin_amdgcn_rcpf(li_l[crow(r, hi)]);
    { bf16_t* stg = (bf16_t*)(lds + OFF_OST) + wid * 2048;
#pragma unroll
      for (int r = 0; r < 16; ++r) { const int orow = crow(r, hi);
#pragma unroll
          for (int d0 = 0; d0 < 2; ++d0) stg[orow * 64 + d0 * 32 + r32] = (bf16_t)f2bf(o[d0][r] * rli[r]); }
      asm volatile("s_waitcnt lgkmcnt(0)" ::: "memory");
#pragma unroll
      for (int i = 0; i < 4; ++i) { const int row = i * 8 + (lane >> 3), c8 = lane & 7; const u32x4 v = *(const u32x4*)(stg + row * 64 + c8 * 8);
          *(u32x4*)(cur.O + (size_t)(wid * QBLK + row) * 1024 + c8 * 8) = v;
          float s = 0.f;
#pragma unroll
          for (int j = 0; j < 4; ++j) { const float a = __builtin_bit_cast(float, v[j] << 16), b = __builtin_bit_cast(float, v[j] & 0xffff0000u); s += a * a + b * b; }
          s += __shfl_xor(s, 1); s += __shfl_xor(s, 2); s += __shfl_xor(s, 4);
          if (c8 == 0) cur.SSQ[(size_t)(wid * QBLK + row) * 8] = s; } }
    __syncthreads();
#undef RESC
#undef KBASE
#undef MASKT
#undef SEAM_K0
#undef HALF_STEP
}
#undef VMW
#undef VMWN
#undef KSRC
#undef SLOAD_H
#undef SWRITE_HK
#undef SWRITE_HV
#undef SWRITE_H
#undef KSWZ
#undef SBAR
__device__ __forceinline__ BlockRef block_ref(const Ptrs& P, int bh, int qb) {
    const int b = bh >> 3, h = bh & 7; const size_t r0 = (size_t)b * SEQ + (size_t)qb * QB; BlockRef r;
    r.Q = (const bf16_t*)(P.ws + WS_Q) + r0 * 768 + h * 96; r.Kn = (const bf16_t*)(P.ws + WS_K) + (size_t)b * SEQ * 512 + h * 64; r.KR = (const bf16_t*)(P.ws + WS_KR) + (size_t)b * SEQ * 32;
    r.V = (const bf16_t*)(P.ws + WS_V) + (size_t)b * SEQ * 512 + h * 64; r.O = (bf16_t*)(P.ws + WS_MIX) + r0 * 1024 + h * 64; r.SSQ = (float*)(P.ws + WS_SSQ) + r0 * 8 + h; r.P0 = qb * QB; return r;
}
__device__ __forceinline__ void attn_phase(const Ptrs& P, char* lds) {
    const int G = gridDim.x, c = blockIdx.x; const int vcu = (G % 8 == 0) ? (c % 8) * (G / 8) + c / 8 : c;
    Seam S;
    for (int it = vcu; it < 256; it += G) {
        const int bh = it >> 4, x = it & 15;
        const BlockRef b0 = block_ref(P, bh, x), b1 = block_ref(P, bh, 31 - x);
        attn_prime(b0, lds, S);
        attn_block(b0, b1, lds, S);
        attn_block(b1, b1, lds, S);
    }
}
}

#define VB_FOR(vb, NVB) for (int vb = blockIdx.x * 2 + (int)(threadIdx.x >> 8); vb < (NVB); vb += gridDim.x * 2)

__device__ __forceinline__ void nv_gemm_f32(const bf16_t* A, int lda, const bf16_t* Bt, int ldb, float* C, int ldc, int K, int nbx, int nby) {
    const int tid = threadIdx.x & 255, lane = tid & 63, w = tid >> 6, wr = w >> 1, wc = w & 1, fr = lane & 15, fq = lane >> 4;
    VB_FOR(vb, nbx * nby) {
        const int bx = vb % nbx, by = vb / nbx;
        const int row0 = by * 64 + wr * 32, col0 = bx * 128 + wc * 64;
        f32x4 acc[2][4];
#pragma unroll
        for (int i = 0; i < 2; ++i)
#pragma unroll
            for (int j = 0; j < 4; ++j) acc[i][j] = (f32x4){0.f, 0.f, 0.f, 0.f};
        for (int k0 = 0; k0 < K; k0 += 32) {
            bf16x8 a[2], b[4];
#pragma unroll
            for (int i = 0; i < 2; ++i) a[i] = *(const bf16x8*)(A + (size_t)(row0 + i * 16 + fr) * lda + k0 + 8 * fq);
#pragma unroll
            for (int j = 0; j < 4; ++j) b[j] = *(const bf16x8*)(Bt + (size_t)(col0 + j * 16 + fr) * ldb + k0 + 8 * fq);
#pragma unroll
            for (int i = 0; i < 2; ++i)
#pragma unroll
                for (int j = 0; j < 4; ++j) acc[i][j] = __builtin_amdgcn_mfma_f32_16x16x32_bf16(a[i], b[j], acc[i][j], 0, 0, 0);
        }
#pragma unroll
        for (int i = 0; i < 2; ++i)
#pragma unroll
            for (int j = 0; j < 4; ++j)
#pragma unroll
                for (int r = 0; r < 4; ++r) C[(size_t)(row0 + i * 16 + fq * 4 + r) * ldc + col0 + j * 16 + fr] = acc[i][j][r];
    }
}

#define GW_SETUP const int tid = tid_opaque(), lane = tid & 63, wave = tid >> 6; const int gw = blockIdx.x * NWAVES + wave, NGW = gridDim.x * NWAVES; (void)lane; (void)gw; (void)NGW;
#define GT_FOR(i, N) for (size_t i = (size_t)blockIdx.x * 512 + threadIdx.x; i < (size_t)(N); i += (size_t)gridDim.x * 512)

__device__ __forceinline__ void ph_prologue(const Ptrs& P, float* ldsf) {
    GW_SETUP
    float* scr = ldsf + wave * (64 * 33);
    for (int it = gw; it < IT_TOTAL; it += NGW) prologue_item(P, it, scr, lane);
    { bf16_t* w = (bf16_t*)(P.ws + WS_WIN) + (size_t)DINP * 1024; const int n8 = (1024 - DINP) * 1024 / 8;
      GT_FOR(i, n8) ((u32x4*)w)[i] = (u32x4){0u, 0u, 0u, 0u}; }
    for (int m = gw; m < T; m += NGW) rms_row_to_bf16(P.x + (size_t)m * D, P.g_attn, (bf16_t*)(P.ws + WS_XN) + (size_t)m * D, lane);
    { float* C = (float*)(P.ws + WS_COS); float* S = (float*)(P.ws + WS_SIN);
      GT_FOR(i, T * 16) { const int t = (int)(i >> 4), j = (int)(i & 15);
          const float inv = (float)pow(10000.0, -(double)j / 16.0); const float ang = (float)P.pos[t] * inv;
          C[i] = (float)cos((double)ang); S[i] = (float)sin((double)ang); } }
}
__device__ __forceinline__ void ph_e1(const Ptrs& P) {
    GW_SETUP
    const float* PROJ = (const float*)(P.ws + WS_TMP);
    const float* COS = (const float*)(P.ws + WS_COS); const float* SIN = (const float*)(P.ws + WS_SIN);
    for (int t = gw; t < T; t += NGW) {
        const float* pr = PROJ + (size_t)t * 1024;
        bf16_t* u = (bf16_t*)(P.ws + WS_U) + (size_t)t * 512;
        for (int c = lane; c < 512; c += 64) u[c] = (bf16_t)f2bf(pr[c]);
        { float v[4]; float s = 0.f; for (int j = 0; j < 4; ++j) { v[j] = pr[512 + lane + 64 * j]; s += v[j] * v[j]; }
          const float rstd = 1.f / sqrtf(wave_sum(s) * (1.f / 256.f) + RMS_EPS);
          bf16_t* q = (bf16_t*)(P.ws + WS_QN) + (size_t)t * 256;
          for (int j = 0; j < 4; ++j) q[lane + 64 * j] = (bf16_t)f2bf(v[j] * rstd * P.g_q_a[lane + 64 * j]); }
        { float v[2]; float s = 0.f; for (int j = 0; j < 2; ++j) { v[j] = pr[768 + lane + 64 * j]; s += v[j] * v[j]; }
          const float rstd = 1.f / sqrtf(wave_sum(s) * (1.f / 128.f) + RMS_EPS);
          bf16_t* q = (bf16_t*)(P.ws + WS_KVN) + (size_t)t * 128;
          for (int j = 0; j < 2; ++j) q[lane + 64 * j] = (bf16_t)f2bf(v[j] * rstd * P.g_kv_a[lane + 64 * j]); }
        if (lane < 16) { const float x1 = pr[896 + lane], x2 = pr[896 + 16 + lane]; const float c = COS[t * 16 + lane], s = SIN[t * 16 + lane];
          bf16_t* kr = (bf16_t*)(P.ws + WS_KR) + (size_t)t * 32; kr[lane] = (bf16_t)f2bf(x1 * c - x2 * s); kr[16 + lane] = (bf16_t)f2bf(x2 * c + x1 * s); }
    }
}
__device__ __forceinline__ void ph_e2q(const Ptrs& P) {
    const float* TMP = (const float*)(P.ws + WS_TMP); const float* COS = (const float*)(P.ws + WS_COS); const float* SIN = (const float*)(P.ws + WS_SIN);
    bf16_t* Q = (bf16_t*)(P.ws + WS_Q);
    GT_FOR(i, (size_t)T * 768) {
        const int t = (int)(i / 768), c = (int)(i % 768), h = c / 96, d = c % 96; float v;
        if (d < 64) v = TMP[i];
        else { const int j = (d - 64) & 15; const float x1 = TMP[(size_t)t * 768 + h * 96 + 64 + j], x2 = TMP[(size_t)t * 768 + h * 96 + 80 + j]; const float cc = COS[t * 16 + j], ss = SIN[t * 16 + j];
               v = (d < 80) ? (x1 * cc - x2 * ss) : (x2 * cc + x1 * ss); }
        Q[i] = (bf16_t)f2bf(v * QSCALE);
    }
}
__device__ __forceinline__ void ph_e2kv(const Ptrs& P) {
    const float* TMP = (const float*)(P.ws + WS_TMP) + (size_t)T * 1024;
    bf16_t* K = (bf16_t*)(P.ws + WS_K); bf16_t* V = (bf16_t*)(P.ws + WS_V);
    GT_FOR(i, (size_t)T * 512) {
        const int t = (int)(i / 512), c = (int)(i % 512), h = c / 64, d = c % 64;
        K[i] = (bf16_t)f2bf(TMP[(size_t)t * 1024 + h * 128 + d]);
        V[i] = (bf16_t)f2bf(TMP[(size_t)t * 1024 + h * 128 + 64 + d]);
    }
}
__device__ __forceinline__ void ph_pooldiff(const Ptrs& P) {
    const bf16_t* U = (const bf16_t*)(P.ws + WS_U); bf16_t* DIFF = (bf16_t*)(P.ws + WS_H);
    GT_FOR(i, (size_t)T * 512) {
        const int t = (int)(i / 512), c = (int)(i % 512), g = c / 128, s = t % SEQ, w = 2 << g; const int n = s + 1 < w ? s + 1 : w;
        float sum = 0.f; for (int j = 0; j < n; ++j) sum += bf2f(U[(size_t)(t - j) * 512 + c]);
        DIFF[i] = (bf16_t)f2bf(sum / (float)n - bf2f(U[i]));
    }
}
__device__ __forceinline__ void ph_epool(const Ptrs& P, const float* TP) {
    GW_SETUP
    for (int t = gw; t < T; t += NGW) {
        float v[8]; float s = 0.f;
        for (int j = 0; j < 8; ++j) { const int c = lane + 64 * j; v[j] = (TP[(size_t)t * 512 + c] + P.b_pool[c]) * P.pool_scale[c]; s += v[j] * v[j]; }
        const float rstd = 1.f / sqrtf(wave_sum(s) * (1.f / 512.f) + RMS_EPS);
        bf16_t* m = (bf16_t*)(P.ws + WS_MIX) + (size_t)t * 1024 + 512;
        for (int j = 0; j < 8; ++j) m[lane + 64 * j] = (bf16_t)f2bf(v[j] * rstd);
    }
}
__device__ __forceinline__ void ph_attn_naive(const Ptrs& P, float* ldsf) {
    GW_SETUP
    float* qs = ldsf + wave * 96;
    const bf16_t* Q = (const bf16_t*)(P.ws + WS_Q); const bf16_t* K = (const bf16_t*)(P.ws + WS_K); const bf16_t* V = (const bf16_t*)(P.ws + WS_V); const bf16_t* KRp = (const bf16_t*)(P.ws + WS_KR);
    bf16_t* MIX = (bf16_t*)(P.ws + WS_MIX); float* SSQ = (float*)(P.ws + WS_SSQ);
    for (int item = gw; item < T * 8; item += NGW) {
        const int t = item >> 3, h = item & 7, b = t / SEQ, s = t % SEQ;
        for (int d = lane; d < 96; d += 64) qs[d] = bf2f(Q[(size_t)t * 768 + h * 96 + d]);
        asm volatile("s_waitcnt lgkmcnt(0)" ::: "memory");
        float m = -1e30f, l = 0.f, o = 0.f;
        const int ntile = s / 64 + 1;
        for (int kt = 0; kt < ntile; ++kt) {
            const int key = kt * 64 + lane; const size_t krow = (size_t)(b * SEQ + key);
            float sc = -__builtin_inff();
            if (key <= s) { float a = 0.f;
                for (int d8 = 0; d8 < 12; ++d8) { const bf16x8 kv = d8 < 8 ? *(const bf16x8*)(K + krow * 512 + h * 64 + d8 * 8) : *(const bf16x8*)(KRp + krow * 32 + (d8 - 8) * 8);
#pragma unroll
                    for (int j = 0; j < 8; ++j) a += qs[d8 * 8 + j] * bf2f((bf16_t)kv[j]); }
                sc = a; }
            const float mn = fmaxf(m, wave_max(sc)); const float alpha = exp2f(m - mn); const float p = exp2f(sc - mn);
            const float pb = bf2f((bf16_t)f2bf(p));
            l = l * alpha + wave_sum(pb); o *= alpha; m = mn;
            const int nk = (kt == ntile - 1) ? (s - kt * 64 + 1) : 64;
            for (int j = 0; j < nk; ++j) { const float pj = __shfl(pb, j); o += pj * bf2f(V[(size_t)(b * SEQ + kt * 64 + j) * 512 + h * 64 + lane]); }
        }
        const float ov = o / l;
        MIX[(size_t)t * 1024 + h * 64 + lane] = (bf16_t)f2bf(ov);
        const float ss = wave_sum(ov * ov);
        if (lane == 0) SSQ[t * 8 + h] = ss;
        asm volatile("s_waitcnt lgkmcnt(0)" ::: "memory");
    }
}
__device__ __forceinline__ void ph_e4(const Ptrs& P) {
    const float* T1 = (const float*)(P.ws + WS_TMP); const float* T2 = T1 + (size_t)T * 1024; const float* SSQ = (const float*)(P.ws + WS_SSQ);
    GT_FOR(i, (size_t)T * 1024) {
        const int t = (int)(i >> 10); float s = 0.f; for (int h = 0; h < 8; ++h) s += SSQ[t * 8 + h];
        const float sa = 1.f / sqrtf(s * (1.f / 512.f) + RMS_EPS);
        P.out[i] = P.x[i] + sa * T1[i] + T2[i];
    }
}
__device__ __forceinline__ void ph_router(const Ptrs& P, float* ldsf) {
    GW_SETUP
    float* hs = ldsf + wave * 1024;
    int* cnt = (int*)(P.ws + WS_CTL) + CW_CNT; int* SLOT = (int*)(P.ws + WS_SLOT); int* LIST = (int*)(P.ws + WS_LIST); float* GLIST = (float*)(P.ws + WS_GLIST);
    for (int t = gw; t < T; t += NGW) {
        const f32x4* xr = (const f32x4*)(P.out + (size_t)t * 1024) + lane; const f32x4* gr = (const f32x4*)P.g_ffn + lane;
        f32x4 v[4]; float s = 0.f;
        for (int j = 0; j < 4; ++j) { v[j] = xr[64 * j]; s += (v[j].x * v[j].x + v[j].y * v[j].y) + (v[j].z * v[j].z + v[j].w * v[j].w); }
        const float rstd = 1.f / sqrtf(wave_sum(s) * (1.f / 1024.f) + RMS_EPS);
        u32x2* ho = (u32x2*)((bf16_t*)(P.ws + WS_H) + (size_t)t * 1024) + lane;
        for (int j = 0; j < 4; ++j) { const f32x4 gg = gr[64 * j]; f32x4 hv = {v[j].x * rstd * gg.x, v[j].y * rstd * gg.y, v[j].z * rstd * gg.z, v[j].w * rstd * gg.w};
            ((f32x4*)hs)[lane + 64 * j] = hv; u32x2 w; w.x = pk2(hv.x, hv.y); w.y = pk2(hv.z, hv.w); ho[64 * j] = w; }
        asm volatile("s_waitcnt lgkmcnt(0)" ::: "memory");
        const int e = lane & 31, half = lane >> 5; float a = 0.f;
        for (int c = half * 512; c < half * 512 + 512; ++c) a += hs[c] * P.w_router[c * 32 + e];
        a += __shfl_xor(a, 32); a += P.b_router[e];
        float lv[4]; int li[4]; unsigned used = 0u;
        for (int k = 0; k < 4; ++k) { float best = -__builtin_inff(); int bi = 0;
            for (int j = 0; j < 32; ++j) { const float x = __shfl(a, j); if (!((used >> j) & 1u) && x > best) { best = x; bi = j; } }
            lv[k] = best; li[k] = bi; used |= 1u << bi; }
        const float e1 = expf(lv[1] - lv[0]), e2 = expf(lv[2] - lv[0]), e3 = expf(lv[3] - lv[0]); const float inv = 1.f / (1.f + e1 + e2 + e3);
        if (lane < 4) { const int ex = lane == 0 ? li[0] : lane == 1 ? li[1] : lane == 2 ? li[2] : li[3]; const float gt = (lane == 0 ? 1.f : lane == 1 ? e1 : lane == 2 ? e2 : e3) * inv;
            const int pos = atomicAdd(&cnt[ex], 1); SLOT[t * 4 + lane] = ex * T + pos; LIST[ex * T + pos] = t; GLIST[ex * T + pos] = gt; }
        asm volatile("s_waitcnt lgkmcnt(0)" ::: "memory");
    }
}
__device__ __forceinline__ int slot_base(const int* cnt, int e) { int s = 0; for (int i = 0; i < e; ++i) s += (cnt[i] + 255) & ~255; return s; }
__device__ __forceinline__ void ph_moe1_naive(const Ptrs& P) {
    const int* cnt = (const int*)(P.ws + WS_CTL) + CW_CNT;
    const int tid = threadIdx.x & 255, lane = tid & 63, w = tid >> 6, wr = w >> 1, wc = w & 1, fr = lane & 15, fq = lane >> 4;
    const bf16_t* H = (const bf16_t*)(P.ws + WS_H); bf16_t* ACT = (bf16_t*)(P.ws + WS_ACT);
    VB_FOR(vb, 16 * 256 * 32) {
        const int bx = vb & 15, by = (vb >> 4) & 255, e = vb >> 12; const int n = cnt[e], m0 = by * 64; if (m0 >= n) continue;
        const int* LIST = (const int*)(P.ws + WS_LIST) + (size_t)e * T;
        const bf16_t* W = (const bf16_t*)(P.ws + WS_WGU) + (size_t)e * 2048 * 1024;
        const int ca0 = bx * 64 + wc * 32; const int p = ca0 >> 7, r0 = ca0 & 127;
        int tok[2]; for (int i = 0; i < 2; ++i) { int m = m0 + wr * 32 + i * 16 + fr; if (m >= n) m = 0; tok[i] = LIST[m]; }
        f32x4 ag[2][2], au[2][2];
        for (int i = 0; i < 2; ++i) for (int j = 0; j < 2; ++j) { ag[i][j] = (f32x4){0.f, 0.f, 0.f, 0.f}; au[i][j] = (f32x4){0.f, 0.f, 0.f, 0.f}; }
        for (int k0 = 0; k0 < 1024; k0 += 32) {
            bf16x8 a[2], bg[2], bu[2];
            for (int i = 0; i < 2; ++i) a[i] = *(const bf16x8*)(H + (size_t)tok[i] * 1024 + k0 + 8 * fq);
            for (int j = 0; j < 2; ++j) { bg[j] = *(const bf16x8*)(W + (size_t)(256 * p + r0 + j * 16 + fr) * 1024 + k0 + 8 * fq); bu[j] = *(const bf16x8*)(W + (size_t)(256 * p + 128 + r0 + j * 16 + fr) * 1024 + k0 + 8 * fq); }
            for (int i = 0; i < 2; ++i) for (int j = 0; j < 2; ++j) { ag[i][j] = __builtin_amdgcn_mfma_f32_16x16x32_bf16(a[i], bg[j], ag[i][j], 0, 0, 0); au[i][j] = __builtin_amdgcn_mfma_f32_16x16x32_bf16(a[i], bu[j], au[i][j], 0, 0, 0); }
        }
        const int sb = slot_base(cnt, e);
        for (int i = 0; i < 2; ++i) for (int j = 0; j < 2; ++j) for (int r = 0; r < 4; ++r) {
            const int m = m0 + wr * 32 + i * 16 + fq * 4 + r, c = ca0 + j * 16 + fr; if (m >= n) continue;
            float g = ag[i][j][r] + P.b_gu[e * 2048 + c], u = au[i][j][r] + P.b_gu[e * 2048 + 1024 + c];
            g = fminf(g, 7.f); u = fminf(fmaxf(u, -7.f), 7.f);
            const float act = g * (1.f / (1.f + expf(-1.702f * g))) * (u + 1.f);
            ACT[(size_t)(sb + m) * 1024 + c] = (bf16_t)f2bf(act);
        }
    }
}
__device__ __forceinline__ void ph_moe2_naive(const Ptrs& P) {
    const int* cnt = (const int*)(P.ws + WS_CTL) + CW_CNT;
    const int tid = threadIdx.x & 255, lane = tid & 63, w = tid >> 6, wr = w >> 1, wc = w & 1, fr = lane & 15, fq = lane >> 4;
    VB_FOR(vb, 8 * 256 * 32) {
        const int bx = vb & 7, by = (vb >> 3) & 255, e = vb >> 11; const int n = cnt[e], m0 = by * 64; if (m0 >= n) continue;
        const int sb = slot_base(cnt, e); const bf16_t* ACT = (const bf16_t*)(P.ws + WS_ACT) + (size_t)sb * 1024; bf16_t* Y = (bf16_t*)(P.ws + WS_Y) + (size_t)sb * 1024;
        const bf16_t* W = (const bf16_t*)(P.ws + WS_WD) + (size_t)e * 1024 * 1024; const float* GL = (const float*)(P.ws + WS_GLIST) + (size_t)e * T;
        const int col0 = bx * 128 + wc * 64, row0 = m0 + wr * 32;
        f32x4 acc[2][4]; for (int i = 0; i < 2; ++i) for (int j = 0; j < 4; ++j) acc[i][j] = (f32x4){0.f, 0.f, 0.f, 0.f};
        for (int k0 = 0; k0 < 1024; k0 += 32) {
            bf16x8 a[2], b[4];
            for (int i = 0; i < 2; ++i) { int m = row0 + i * 16 + fr; if (m >= n) m = 0; a[i] = *(const bf16x8*)(ACT + (size_t)m * 1024 + k0 + 8 * fq); }
            for (int j = 0; j < 4; ++j) b[j] = *(const bf16x8*)(W + (size_t)(col0 + j * 16 + fr) * 1024 + k0 + 8 * fq);
            for (int i = 0; i < 2; ++i) for (int j = 0; j < 4; ++j) acc[i][j] = __builtin_amdgcn_mfma_f32_16x16x32_bf16(a[i], b[j], acc[i][j], 0, 0, 0);
        }
        for (int i = 0; i < 2; ++i) for (int j = 0; j < 4; ++j) for (int r = 0; r < 4; ++r) {
            const int m = row0 + i * 16 + fq * 4 + r, c = col0 + j * 16 + fr; if (m >= n) continue;
            Y[(size_t)m * 1024 + c] = (bf16_t)f2bf((acc[i][j][r] + P.b_down[e * 1024 + c]) * GL[m]);
        }
    }
}
__device__ __forceinline__ void ph_final(const Ptrs& P, int* sbase) {
    GW_SETUP
    const int* cnt = (const int*)(P.ws + WS_CTL) + CW_CNT; const int* SLOT = (const int*)(P.ws + WS_SLOT); const bf16_t* Y = (const bf16_t*)(P.ws + WS_Y);
    if (tid < 32) sbase[tid] = slot_base(cnt, tid);
    __syncthreads();
    for (int t = gw; t < T; t += NGW) {
        f32x4* xr = (f32x4*)(P.out + (size_t)t * 1024) + lane; const f32x4* gr = (const f32x4*)P.g_final + lane;
        f32x4 v[4]; for (int j = 0; j < 4; ++j) v[j] = xr[64 * j];
        for (int k = 0; k < 4; ++k) { const int sl = SLOT[t * 4 + k]; const int e = sl / T, pos = sl % T; const u32x2* yr = (const u32x2*)(Y + (size_t)(sbase[e] + pos) * 1024) + lane;
            for (int j = 0; j < 4; ++j) { const u32x2 w = yr[64 * j]; v[j].x += __builtin_bit_cast(float, w.x << 16); v[j].y += __builtin_bit_cast(float, w.x & 0xffff0000u); v[j].z += __builtin_bit_cast(float, w.y << 16); v[j].w += __builtin_bit_cast(float, w.y & 0xffff0000u); } }
        float s = 0.f; for (int j = 0; j < 4; ++j) s += (v[j].x * v[j].x + v[j].y * v[j].y) + (v[j].z * v[j].z + v[j].w * v[j].w);
        const float rstd = 1.f / sqrtf(wave_sum(s) * (1.f / 1024.f) + RMS_EPS);
        for (int j = 0; j < 4; ++j) { const f32x4 gg = gr[64 * j]; xr[64 * j] = (f32x4){v[j].x * rstd * gg.x, v[j].y * rstd * gg.y, v[j].z * rstd * gg.z, v[j].w * rstd * gg.w}; }
    }
}

__global__ void __launch_bounds__(NWAVES * 64, 2) mega_fwd(Ptrs P) {
    extern __shared__ __attribute__((aligned(16))) unsigned char lds[];
    const int tid = threadIdx.x;
    for (int u = tid; u < (LDS_BYTES - LDSCTL_OFF) / 4; u += NWAVES * 64) ((LAS unsigned*)((LAS unsigned char*)lds + LDSCTL_OFF))[u] = 0u;
    __syncthreads();
    unsigned* ctl = (unsigned*)(P.ws + WS_CTL);
    XcdBarrier bar = xcd_barrier_post(ctl + CW_BAR, (volatile LAS unsigned*)((LAS unsigned char*)lds + MISC_OFF) + 8);
    float* ldsf = (float*)lds;
    float* TMP = (float*)(P.ws + WS_TMP);
    unsigned char* ws = P.ws;
#define GRID_BAR() xcd_barrier(bar)
    ph_prologue(P, ldsf); GRID_BAR();
    LAS unsigned char* L = (LAS unsigned char*)lds; const int G = gridDim.x, c = blockIdx.x;
#if FAST_INPROJ
    { pg8::DenseOrder S; S.init(ws + WS_XN, ws + WS_WIN, T, 1024, 1024, G, c);
      pg8::EpiInProj E{(bf16_t*)(ws + WS_U), (bf16_t*)(ws + WS_QN), (bf16_t*)(ws + WS_KVN), (bf16_t*)(ws + WS_KR), P.g_q_a, P.g_kv_a, (const float*)(ws + WS_COS), (const float*)(ws + WS_SIN)};
      pg8::gemm_phase<pg8::EpiInProj, pg8::DenseOrder, false, false>(L, 1024, S, E); }
    GRID_BAR();
#else
    nv_gemm_f32((const bf16_t*)(ws + WS_XN), 1024, (const bf16_t*)(ws + WS_WIN), 1024, TMP, 1024, 1024, 8, T / 64); GRID_BAR();
    ph_e1(P); GRID_BAR();
#endif
#if FAST_QKV
#ifndef NO_QB
    { pg8::DenseOrder S; S.init(ws + WS_QN, ws + WS_WQB, T, 768, 256, G, c);
      pg8::EpiQ E{(bf16_t*)(ws + WS_Q), (const float*)(ws + WS_COS), (const float*)(ws + WS_SIN)};
      pg8::gemm_phase<pg8::EpiQ, pg8::DenseOrder, true, false>(L, 256, S, E); }
#endif
#ifndef NO_KVB
    { pg8::DenseOrder S; S.init(ws + WS_KVN, ws + WS_WKVB, T, 1024, 128, G, c);
      pg8::EpiKV E{(bf16_t*)(ws + WS_K), (bf16_t*)(ws + WS_V)};
      pg8::gemm_phase<pg8::EpiKV, pg8::DenseOrder, true, false>(L, 128, S, E); }
#endif
    ph_pooldiff(P); GRID_BAR();
#else
    nv_gemm_f32((const bf16_t*)(ws + WS_QN), 256, (const bf16_t*)(ws + WS_WQB), 256, TMP, 768, 256, 6, T / 64);
    nv_gemm_f32((const bf16_t*)(ws + WS_KVN), 128, (const bf16_t*)(ws + WS_WKVB), 128, TMP + (size_t)T * 1024, 1024, 128, 8, T / 64);
    ph_pooldiff(P); GRID_BAR();
    ph_e2q(P); ph_e2kv(P);
#endif
    for (int g = 0; g < 4; ++g)
        nv_gemm_f32((const bf16_t*)(ws + WS_H) + g * 128, 512, (const bf16_t*)(ws + WS_WPOOL) + (size_t)g * 128 * 128, 128, (float*)(ws + WS_ACT) + g * 128, 512, 128, 1, T / 64);
    GRID_BAR();
    ph_epool(P, (const float*)(ws + WS_ACT));
#if FAST_ATTN
    att::attn_phase(P, (char*)lds); GRID_BAR();
#else
    ph_attn_naive(P, ldsf); GRID_BAR();
#endif
#if FAST_WOUT
    { pg8::DenseOrder S; S.init(ws + WS_MIX, ws + WS_WOUT, T, 1024, 1024, G, c);
      pg8::EpiOut E{P.x, P.out, (const float*)(ws + WS_SSQ), SA_OFF};
      pg8::gemm_phase<pg8::EpiOut, pg8::DenseOrder, false, false>(L, 1024, S, E); }
    GRID_BAR();
#else
    nv_gemm_f32((const bf16_t*)(ws + WS_MIX), 1024, (const bf16_t*)(ws + WS_WOUT), 1024, TMP, 1024, 512, 8, T / 64);
    nv_gemm_f32((const bf16_t*)(ws + WS_MIX) + 512, 1024, (const bf16_t*)(ws + WS_WOUT) + 512, 1024, TMP + (size_t)T * 1024, 1024, 512, 8, T / 64);
    GRID_BAR();
    ph_e4(P); GRID_BAR();
#endif
    ph_router(P, ldsf); GRID_BAR();
#if FAST_MOE
    { pg8::MoeOrder<true> S{(const char*)(ws + WS_H), (const char*)(ws + WS_WGU), (size_t)2048 * 1024 * 2, 8, G, c, GT_OFF, (const LAS int*)(L + TS_OFF)};
      moe_setup<true>(P, L, S);
      pg8::EpiSwiglu E{P.b_gu, (bf16_t*)(ws + WS_ACT)};
      pg8::gemm_phase<pg8::EpiSwiglu, pg8::MoeOrder<true>, true, true>(L, 1024, S, E); }
    GRID_BAR();
    { pg8::MoeOrder<false> S{(const char*)(ws + WS_ACT), (const char*)(ws + WS_WD), (size_t)1024 * 1024 * 2, 4, G, c, 0, (const LAS int*)(L + TS_OFF)};
      moe_setup<false>(P, L, S);
      pg8::EpiDown E{P.b_down, (const float*)(ws + WS_GLIST), (bf16_t*)(ws + WS_Y)};
      pg8::gemm_phase<pg8::EpiDown, pg8::MoeOrder<false>, true, false>(L, 1024, S, E); }
    GRID_BAR();
#else
    ph_moe1_naive(P); GRID_BAR();
    ph_moe2_naive(P); GRID_BAR();
#endif
    ph_final(P, (int*)lds);
}

extern "C" void kernel_launch(void* const* d_in, const int* in_sizes, int n_in, void* d_out, int out_size, void* d_ws, size_t ws_size, hipStream_t stream) {
    static int grid = 0;
    if (grid == 0) {
        if (n_in != 22 || out_size != T * D || ws_size < WS_END) { fprintf(stderr, "kernel_launch: unexpected shapes (n_in %d out %d ws %zu)\n", n_in, out_size, ws_size); grid = -1; return; }
        int dev = 0, cus = 0, per_cu = 0;
        if (hipGetDevice(&dev) != hipSuccess || hipDeviceGetAttribute(&cus, hipDeviceAttributeMultiprocessorCount, dev) != hipSuccess) { grid = -1; return; }
        if (hipFuncSetAttribute((const void*)mega_fwd, hipFuncAttributeMaxDynamicSharedMemorySize, LDS_BYTES) != hipSuccess) { fprintf(stderr, "kernel_launch: hipFuncSetAttribute failed\n"); grid = -1; return; }
        if (hipOccupancyMaxActiveBlocksPerMultiprocessor(&per_cu, (const void*)mega_fwd, NWAVES * 64, LDS_BYTES) != hipSuccess || per_cu < 1) fprintf(stderr, "kernel_launch: occupancy query reports %d\n", per_cu);
        (void)hipGetLastError();
        grid = cus;
    }
    if (grid < 0) return;
    Ptrs P{};
    P.x = (const float*)d_in[0]; P.pos = (const int*)d_in[1]; P.g_attn = (const float*)d_in[2]; P.w_in = (const float*)d_in[3]; P.w_pool = (const float*)d_in[4];
    P.b_pool = (const float*)d_in[5]; P.pool_scale = (const float*)d_in[6]; P.g_q_a = (const float*)d_in[7]; P.w_q_b = (const float*)d_in[8]; P.g_kv_a = (const float*)d_in[9];
    P.w_kv_b = (const float*)d_in[10]; P.g_out_pool = (const float*)d_in[11]; P.g_out_attn = (const float*)d_in[12]; P.w_out = (const float*)d_in[13]; P.g_ffn = (const float*)d_in[14];
    P.w_router = (const float*)d_in[15]; P.b_router = (const float*)d_in[16]; P.w_gu = (const float*)d_in[17]; P.b_gu = (const float*)d_in[18]; P.w_down = (const float*)d_in[19];
    P.b_down = (const float*)d_in[20]; P.g_final = (const float*)d_in[21]; P.out = (float*)d_out; P.ws = (unsigned char*)d_ws;
    if (hipMemsetAsync((unsigned char*)d_ws + WS_CTL, 0, CTL_BYTES, stream) != hipSuccess) { fprintf(stderr, "kernel_launch: memset failed\n"); return; }
    hipLaunchKernelGGL(mega_fwd, dim3(grid), dim3(NWAVES * 64), LDS_BYTES, stream, P);
}
```

```cpp
#include <hip/hip_runtime.h>
#include <cstdint>
#include <cstdio>

typedef unsigned short bf16_t;
typedef short bf16x8 __attribute__((ext_vector_type(8)));
typedef float f32x4 __attribute__((ext_vector_type(4)));
typedef unsigned u32x4 __attribute__((ext_vector_type(4)));
typedef unsigned u32x2 __attribute__((ext_vector_type(2)));

constexpr int BATCH = 2, SEQ = 8192, T = BATCH * SEQ, D = 1024;
constexpr int DPOOL = 512, NPG = 4, PGD = 128;
constexpr int NH = 8, VD = 64, QKN = 64, QKR = 32, QKD = 96;
constexpr int QLR = 256, KVLR = 128, DINP = 928;
constexpr int NE = 32, TOPK = 4, DE = 1024;
constexpr float RMS_EPS = 1e-6f;
constexpr float QSCALE = 0.10206207261596577f * 1.4426950408889634f;
constexpr int SLOT_ROWS = T * TOPK + NE * 256;

constexpr size_t MiB = 1u << 20;
constexpr size_t WS_CTL = 0;
constexpr size_t CTL_BYTES = 1 * MiB;
constexpr size_t WS_COS = 1 * MiB, WS_SIN = 2 * MiB;
constexpr size_t WS_WIN = 4 * MiB;
constexpr size_t WS_WQB = 6 * MiB;
constexpr size_t WS_WKVB = 7 * MiB;
constexpr size_t WS_WPOOL = 7 * MiB + 512 * 1024;
constexpr size_t WS_WOUT = 8 * MiB;
constexpr size_t WS_WGU = 16 * MiB;
constexpr size_t WS_WD = 144 * MiB;
constexpr size_t WS_XN = 208 * MiB;
constexpr size_t WS_U = 240 * MiB;
constexpr size_t WS_QN = 256 * MiB;
constexpr size_t WS_KVN = 264 * MiB;
constexpr size_t WS_KR = 268 * MiB;
constexpr size_t WS_Q = 272 * MiB;
constexpr size_t WS_K = 296 * MiB;
constexpr size_t WS_V = 320 * MiB;
constexpr size_t WS_MIX = 336 * MiB;
constexpr size_t WS_SSQ = 368 * MiB;
constexpr size_t WS_H = 370 * MiB;
constexpr size_t WS_SLOT = 402 * MiB;
constexpr size_t WS_LIST = 403 * MiB;
constexpr size_t WS_GLIST = 405 * MiB;
constexpr size_t WS_ACT = 408 * MiB;
constexpr size_t WS_Y = 552 * MiB;
constexpr size_t WS_TMP = 700 * MiB;
constexpr size_t WS_END = 828 * MiB;
constexpr int CW_CNT = 64;

__device__ __forceinline__ unsigned f2bf(float f) { unsigned u = __builtin_bit_cast(unsigned, f); return (u + 0x7fffu + ((u >> 16) & 1u)) >> 16; }
__device__ __forceinline__ unsigned pk2(float lo, float hi) { return f2bf(lo) | (f2bf(hi) << 16); }
__device__ __forceinline__ float bf2f(bf16_t b) { return __builtin_bit_cast(float, (unsigned)b << 16); }
__device__ __forceinline__ float wave_sum(float v) {
#pragma unroll
    for (int o = 1; o < 64; o <<= 1) v += __shfl_xor(v, o);
    return v;
}
__device__ __forceinline__ float wave_max(float v) {
#pragma unroll
    for (int o = 1; o < 64; o <<= 1) v = fmaxf(v, __shfl_xor(v, o));
    return v;
}

typedef int v8i_t __attribute__((ext_vector_type(8)));
constexpr float W8_SCALE = 64.f, W8_INV = 1.f / 64.f;
__device__ __forceinline__ float clamp8(float x) { return fminf(fmaxf(x, -448.f), 448.f); }
__device__ __forceinline__ unsigned pk4_fp8(float a, float b, float c, float d) {
    int p = 0; p = __builtin_amdgcn_cvt_pk_fp8_f32(clamp8(a), clamp8(b), p, false); p = __builtin_amdgcn_cvt_pk_fp8_f32(clamp8(c), clamp8(d), p, true); return (unsigned)p; }
__device__ __forceinline__ int tid_opaque() { int t = threadIdx.x; asm volatile("" : "+v"(t)); return t; }

__device__ __forceinline__ void transpose_item(const float* W, int ldw, int k0, int n0, bf16_t* WT, int ldt, int dn0, int dk0,
                                               const float* ksc, float* scr, int lane) {
    { const int kq = lane >> 3, n4 = (lane & 7) * 4; f32x4 v[8];
#pragma unroll
      for (int i = 0; i < 8; ++i) v[i] = *(const f32x4*)(W + (size_t)(k0 + 8 * i + kq) * ldw + n0 + n4);
#pragma unroll
      for (int i = 0; i < 8; ++i) { const int kk = 8 * i + kq; f32x4 x = v[i]; if (ksc) x = x * ksc[kk];
          scr[kk * 33 + n4 + 0] = x[0]; scr[kk * 33 + n4 + 1] = x[1]; scr[kk * 33 + n4 + 2] = x[2]; scr[kk * 33 + n4 + 3] = x[3]; } }
    asm volatile("s_waitcnt lgkmcnt(0)" ::: "memory");
    const int c = lane & 7;
#pragma unroll
    for (int j = 0; j < 4; ++j) { const int n = (lane >> 3) + 8 * j; const float* s = scr + (8 * c) * 33 + n;
        u32x4 o; o.x = pk2(s[0 * 33], s[1 * 33]); o.y = pk2(s[2 * 33], s[3 * 33]); o.z = pk2(s[4 * 33], s[5 * 33]); o.w = pk2(s[6 * 33], s[7 * 33]);
        *(u32x4*)(WT + (size_t)(dn0 + n) * ldt + dk0 + 8 * c) = o; }
    asm volatile("s_waitcnt lgkmcnt(0)" ::: "memory");
}

__device__ __forceinline__ void transpose_item8(const float* W, int ldw, int k0, int n0, unsigned char* WT, int ldt, int dn0, int dk0, float* scr, int lane) {
    { const int kq = lane >> 3, n4 = (lane & 7) * 4; f32x4 v[8];
#pragma unroll
      for (int i = 0; i < 8; ++i) v[i] = *(const f32x4*)(W + (size_t)(k0 + 8 * i + kq) * ldw + n0 + n4);
#pragma unroll
      for (int i = 0; i < 8; ++i) { const int kk = 8 * i + kq; const f32x4 x = v[i] * W8_SCALE;
          scr[kk * 33 + n4 + 0] = x[0]; scr[kk * 33 + n4 + 1] = x[1]; scr[kk * 33 + n4 + 2] = x[2]; scr[kk * 33 + n4 + 3] = x[3]; } }
    asm volatile("s_waitcnt lgkmcnt(0)" ::: "memory");
    const int c = lane & 7;
#pragma unroll
    for (int j = 0; j < 4; ++j) { const int n = (lane >> 3) + 8 * j; const float* q = scr + (8 * c) * 33 + n;
        u32x2 o; o.x = pk4_fp8(q[0 * 33], q[1 * 33], q[2 * 33], q[3 * 33]); o.y = pk4_fp8(q[4 * 33], q[5 * 33], q[6 * 33], q[7 * 33]);
        *(u32x2*)(WT + (size_t)(dn0 + n) * ldt + dk0 + 8 * c) = o; }
    asm volatile("s_waitcnt lgkmcnt(0)" ::: "memory");
}

struct Ptrs {
    const float* x; const int* pos; const float* g_attn; const float* w_in; const float* w_pool; const float* b_pool; const float* pool_scale;
    const float* g_q_a; const float* w_q_b; const float* g_kv_a; const float* w_kv_b; const float* g_out_pool; const float* g_out_attn; const float* w_out;
    const float* g_ffn; const float* w_router; const float* b_router; const float* w_gu; const float* b_gu; const float* w_down; const float* b_down; const float* g_final;
    float* out; unsigned char* ws;
};

constexpr int IT_IN = 16 * 29, IT_QB = 4 * 24, IT_KVB = 2 * 32, IT_POOL = 4 * 2 * 4, IT_OUT = 16 * 32, IT_GU = 32 * 16 * 64, IT_DN = 32 * 16 * 32;
constexpr int IT_TOTAL = IT_IN + IT_QB + IT_KVB + IT_POOL + IT_OUT + IT_GU + IT_DN;

__device__ __forceinline__ void prologue_item(const Ptrs& P, int it, float* scr, int lane) {
    unsigned char* ws = P.ws;
    int r = it;
    if (r < IT_IN) { const int kb = r / 29, nb = r % 29; transpose_item(P.w_in, DINP, 64 * kb, 32 * nb, (bf16_t*)(ws + WS_WIN), 1024, 32 * nb, 64 * kb, nullptr, scr, lane); return; } r -= IT_IN;
    if (r < IT_QB) { const int kb = r / 24, nb = r % 24; transpose_item(P.w_q_b, 768, 64 * kb, 32 * nb, (bf16_t*)(ws + WS_WQB), 256, 32 * nb, 64 * kb, nullptr, scr, lane); return; } r -= IT_QB;
    if (r < IT_KVB) { const int kb = r / 32, nb = r % 32; transpose_item(P.w_kv_b, 1024, 64 * kb, 32 * nb, (bf16_t*)(ws + WS_WKVB), 128, 32 * nb, 64 * kb, nullptr, scr, lane); return; } r -= IT_KVB;
    if (r < IT_POOL) { const int g = r / 8, kb = (r % 8) / 4, nb = r % 4; transpose_item(P.w_pool + (size_t)g * 128 * 128, 128, 64 * kb, 32 * nb, (bf16_t*)(ws + WS_WPOOL) + (size_t)g * 128 * 128, 128, 32 * nb, 64 * kb, nullptr, scr, lane); return; } r -= IT_POOL;
    if (r < IT_OUT) { const int kb = r / 32, nb = r % 32, k0 = 64 * kb; const float* ksc = k0 < 512 ? P.g_out_pool + k0 : P.g_out_attn + (k0 - 512);
        transpose_item(P.w_out, 1024, k0, 32 * nb, (bf16_t*)(ws + WS_WOUT), 1024, 32 * nb, (k0 + 512) & 1023, ksc, scr, lane); return; } r -= IT_OUT;
    if (r < IT_GU) { const int e = r / 1024, q = r % 1024, kb = q / 64, nb = q % 64, n0 = 32 * nb; const int nn = n0 & 1023, p = nn >> 7, dn0 = 256 * p + (n0 >= 1024 ? 128 : 0) + (nn & 127);
#if FP8_MOE
        transpose_item8(P.w_gu + (size_t)e * 1024 * 2048, 2048, 64 * kb, n0, ws + WS_WGU + (size_t)e * 2048 * 1024, 1024, dn0, 64 * kb, scr, lane); return; } r -= IT_GU;
#else
        transpose_item(P.w_gu + (size_t)e * 1024 * 2048, 2048, 64 * kb, n0, (bf16_t*)(ws + WS_WGU) + (size_t)e * 2048 * 1024, 1024, dn0, 64 * kb, nullptr, scr, lane); return; } r -= IT_GU;
#endif
    { const int e = r / 512, q = r % 512, kb = q / 32, nb = q % 32;
#if FP8_MOE
        transpose_item8(P.w_down + (size_t)e * 1024 * 1024, 1024, 64 * kb, 32 * nb, ws + WS_WD + (size_t)e * 1024 * 1024, 1024, 32 * nb, 64 * kb, scr, lane); }
#else
        transpose_item(P.w_down + (size_t)e * 1024 * 1024, 1024, 64 * kb, 32 * nb, (bf16_t*)(ws + WS_WD) + (size_t)e * 1024 * 1024, 1024, 32 * nb, 64 * kb, nullptr, scr, lane); }
#endif
}

__device__ __forceinline__ void rms_row_to_bf16(const float* xrow, const float* g, bf16_t* orow, int lane) {
    const f32x4* xr = (const f32x4*)xrow + lane; const f32x4* gr = (const f32x4*)g + lane;
    f32x4 v[4]; float s = 0.f;
#pragma unroll
    for (int j = 0; j < 4; ++j) { v[j] = xr[64 * j]; s += (v[j].x * v[j].x + v[j].y * v[j].y) + (v[j].z * v[j].z + v[j].w * v[j].w); }
    const float rstd = 1.f / sqrtf(wave_sum(s) * (1.f / 1024.f) + RMS_EPS);
    u32x2* o8 = (u32x2*)orow + lane;
#pragma unroll
    for (int j = 0; j < 4; ++j) { const f32x4 gg = gr[64 * j]; u32x2 w; w.x = pk2(v[j].x * rstd * gg.x, v[j].y * rstd * gg.y); w.y = pk2(v[j].z * rstd * gg.z, v[j].w * rstd * gg.w); o8[64 * j] = w; }
}

#define LAS __attribute__((address_space(3)))
#define XB_TMO      128
#define XB_XCNT(j)  (256  + 64 * (j))
#define XB_XSUB(j)  (1280 + 64 * (j))
#define XB_XGEN(j)  (2304 + 64 * (j))
#define XB_TOP      3328
#define XB_TOPGEN   3392
#define XCD_BAR_WORDS 3456
#define XB_SPIN_CAP (1u << 18)
__device__ __forceinline__ unsigned xb_ld(unsigned* p)              { return __hip_atomic_load(p, __ATOMIC_RELAXED, __HIP_MEMORY_SCOPE_AGENT); }
__device__ __forceinline__ unsigned xb_add(unsigned* p, unsigned v) { return __hip_atomic_fetch_add(p, v, __ATOMIC_RELAXED, __HIP_MEMORY_SCOPE_AGENT); }
__device__ __forceinline__ unsigned xb_xcc_id() { return (unsigned)__builtin_amdgcn_s_getreg((3 << 11) | 20) & 0xFu; }
#define XB_SPIN(cond, bar) do { unsigned _sp = 0; while (cond) { __builtin_amdgcn_s_sleep(1); \
    if ((++_sp & 255u) == 0u) { if (xb_ld(&(bar)[XB_TMO])) break; if (_sp > XB_SPIN_CAP) { atomicAdd(&(bar)[XB_TMO], 1u); break; } } } } while (0)
struct XcdBarrier { unsigned* bar; unsigned x; volatile LAS unsigned* st; };
__device__ __forceinline__ XcdBarrier xcd_barrier_post(unsigned* bar, volatile LAS unsigned* st) {
    XcdBarrier b; b.bar = bar; b.x = xb_xcc_id(); b.st = st;
    if (threadIdx.x == 0) (void)xb_add(&bar[XB_XCNT(b.x)], 1u);
    return b;
}
__device__ __forceinline__ void xcd_barrier_complete(unsigned* bar, unsigned x, unsigned& nloc, unsigned& nx) {
    const unsigned G = gridDim.x * gridDim.y * gridDim.z;
    unsigned sum, cnt, mine, sp = 0u;
    for (;;) {
        sum = 0u; cnt = 0u; mine = 0u;
#pragma unroll
        for (unsigned j = 0; j < 16; ++j) { const unsigned c = xb_ld(&bar[XB_XCNT(j)]); sum += c; cnt += (c > 0u) ? 1u : 0u; mine = (j == x) ? c : mine; }
        if (sum == G) break;
        __builtin_amdgcn_s_sleep(1);
        if ((++sp & 255u) == 0u) { if (xb_ld(&bar[XB_TMO])) break; if (sp > XB_SPIN_CAP) { atomicAdd(&bar[XB_TMO], 1u); break; } }
    }
    nloc = mine > 0u ? mine : 1u; nx = cnt > 0u ? cnt : 1u;
}
__device__ __forceinline__ void xcd_barrier(const XcdBarrier& b) {
    asm volatile("s_waitcnt vmcnt(0)" ::: "memory");
    __syncthreads();
    if (threadIdx.x == 0) {
        unsigned* bar = b.bar;
        __builtin_amdgcn_s_waitcnt(0);
        unsigned nloc = b.st[0], nx = b.st[1];
        if (nloc == 0u) { xcd_barrier_complete(bar, b.x, nloc, nx); b.st[0] = nloc; b.st[1] = nx; }
        const unsigned old = xb_add(&bar[XB_XSUB(b.x)], 1u);
        const unsigned gen = old / nloc;
        if (old + 1u == (gen + 1u) * nloc) {
            __builtin_amdgcn_fence(__ATOMIC_RELEASE, "agent");
            asm volatile("s_waitcnt vmcnt(0)" ::: "memory");
            const unsigned og = xb_add(&bar[XB_TOP], 1u);
            const unsigned tg = og / nx;
            if (og + 1u == (tg + 1u) * nx) xb_add(&bar[XB_TOPGEN], 1u);
            else XB_SPIN(xb_ld(&bar[XB_TOPGEN]) == tg, bar);
            __builtin_amdgcn_fence(__ATOMIC_ACQUIRE, "agent");
            xb_add(&bar[XB_XGEN(b.x)], 1u);
            asm volatile("s_waitcnt vmcnt(0)" ::: "memory");
        } else {
            XB_SPIN(xb_ld(&bar[XB_XGEN(b.x)]) == gen, bar);
            __builtin_amdgcn_fence(__ATOMIC_ACQUIRE, "agent");
            asm volatile("s_waitcnt vmcnt(0)" ::: "memory");
        }
    }
    __syncthreads();
}

constexpr int NWAVES = 8;
constexpr int RING_BYTES = 131072;
constexpr int LDSCTL_OFF = RING_BYTES, MISC_OFF = LDSCTL_OFF + 320;
constexpr int LDS_BYTES = 147456;
constexpr int CW_BAR = 4096;
constexpr int TS_OFF = 131584;
constexpr int SA_OFF = 131840;
constexpr int GT_OFF = 132864;
static_assert(GT_OFF + 9 * 1024 <= LDS_BYTES, "LDS map");
#ifndef FAST_INPROJ
#define FAST_INPROJ 1
#endif
#ifndef FAST_QKV
#define FAST_QKV 1
#endif
#ifndef FAST_WOUT
#define FAST_WOUT 1
#endif
#ifndef FAST_MOE
#define FAST_MOE 1
#endif
#ifndef FAST_ATTN
#define FAST_ATTN 1
#endif
#ifndef FAST_ROUTER
#define FAST_ROUTER 1
#endif
#ifndef FAST_POOL
#define FAST_POOL 1
#endif
#ifndef FP8_MOE
#define FP8_MOE 0
#endif

namespace pg8 {
typedef int v4i_t __attribute__((ext_vector_type(4)));
#define PG8_LAS __attribute__((address_space(3)))
constexpr int BM = 256, BK = 64, HALF = 128, HTB = HALF * BK * 2, STAGE_BYTES = 8 * HTB, NXCD = 8, WGM = 8;
__host__ __device__ __forceinline__ int lds_byte(int r, int c) { const int st = (r >> 4) * 2 + (c >> 5), rr = r & 15, cc = c & 31, ob = rr * 64 + cc * 2; return st * 1024 + (ob ^ (((ob >> 9) & 1) << 5)); }
__host__ __device__ __forceinline__ void stage_rc(int b, int& R, int& C) { const int st = b / 1024, sb = b % 1024, swz = sb ^ (((sb >> 9) & 1) << 5); R = (st >> 1) * 16 + swz / 64; C = (st & 1) * 32 + (swz % 64) / 2; }
__host__ __device__ __forceinline__ int perm32(int rho) { const int n = rho >> 4, i = rho & 15; return 8 * (i >> 2) + 4 * n + (i & 3); }
__device__ __forceinline__ unsigned cvt_pk_bf16(float lo, float hi) { unsigned r; asm volatile("v_cvt_pk_bf16_f32 %0, %1, %2" : "=v"(r) : "v"(lo), "v"(hi)); return r; }

struct Unit { const char* a; const char* b; int pm, pn, e, rt; };

struct DenseOrder {
    const char* A; const char* Bt; int nM, nN, nwg, G, c, K;
    __device__ void init(const void* A_, const void* Bt_, int M, int N, int K_, int G_, int c_) { A = (const char*)A_; Bt = (const char*)Bt_; nM = M / BM; nN = N / BM; nwg = nM * nN; G = G_; c = c_; K = K_; }
    __device__ bool next(int i, Unit& u) const {
        const long L = (long)i * G + c; if (L >= nwg) return false;
        int wgid = (int)L; { const int q = nwg / NXCD, r = nwg % NXCD, xcd = wgid % NXCD, off = wgid / NXCD; wgid = (xcd < r ? xcd * (q + 1) : r * (q + 1) + (xcd - r) * q) + off; }
        const int nig = WGM * nN, gid = wgid / nig, fm = gid * WGM, gsz = (nM - fm) < WGM ? (nM - fm) : WGM;
        u.pm = fm + ((wgid % nig) % gsz); u.pn = (wgid % nig) / gsz; u.e = 0; u.rt = 0;
        u.a = A + (size_t)u.pm * BM * K * 2; u.b = Bt + (size_t)u.pn * BM * K * 2; return true;
    }
};

template <class Epi, class Sched, bool ALIGN_EPI, bool GATHER, bool FP8 = false>
__device__ __forceinline__ void gemm_phase(PG8_LAS unsigned char* lds, const int K_, const Sched& S, const Epi& E) {
    int K = K_; asm volatile("" : "+s"(K));
    const int tid = tid_opaque(), wid = __builtin_amdgcn_readfirstlane(tid >> 6), lane = tid & 63, wr = wid >> 2, wc = wid & 3, fr = lane & 15, fq = lane >> 4;
    const int nt = K / BK;
    unsigned voffA0, voffB0; int rowA0;
    { int R, C; stage_rc(tid * 16, R, C); const int Rb = Epi::PERM ? ((R & ~31) + perm32(R & 31)) : R;
      voffA0 = GATHER ? (unsigned)(C * 2) : (unsigned)(R * K + C) * 2u; voffB0 = (unsigned)(Rb * K + C) * 2u; rowA0 = R; }
    const unsigned r64 = (unsigned)(64 * K * 2);
    const size_t kstep = (size_t)(BK * 2);
    const size_t hstep = (size_t)HALF * K * 2;
    const unsigned ldsw = (unsigned)wid * 1024u;
    const int aoff = lds_byte(wr * 64 + fr, fq * 8), boff = lds_byte(wc * 32 + fr, fq * 8);
#define PG8_SA(b, h) (((b) * 2 + (h)) * HTB)
#define PG8_SB(b, h) ((4 + (b) * 2 + (h)) * HTB)
#define PG8_STAGE(bufoff, gbase, voff) do { _Pragma("unroll") for (int _i = 0; _i < 2; ++_i) \
        __builtin_amdgcn_global_load_lds((const unsigned*)((const char*)(gbase) + (size_t)(_i * r64) + (voff)), (PG8_LAS unsigned*)(lds + (bufoff) + ldsw + _i * 8192), 16, 0, 0); } while (0)
#define PG8_STAGE_A(bufoff, abase, rtab, h, koff) do { if constexpr (GATHER) { _Pragma("unroll") for (int _i = 0; _i < 2; ++_i) { \
            const unsigned _ro = *(const PG8_LAS unsigned*)(lds + (rtab) + ((h) * HALF + _i * 64 + rowA0) * 4); \
            __builtin_amdgcn_global_load_lds((const unsigned*)((const char*)(abase) + (koff) + (size_t)(_ro + voffA0)), (PG8_LAS unsigned*)(lds + (bufoff) + ldsw + _i * 8192), 16, 0, 0); } } \
        else { PG8_STAGE(bufoff, (const char*)(abase) + (h) * hstep + (koff), voffA0); } } while (0)
#define PG8_LDA(dst, b, h) do { _Pragma("unroll") for (int m = 0; m < 4; ++m) _Pragma("unroll") for (int k = 0; k < 2; ++k) dst[m][k] = *(const PG8_LAS bf16x8*)(lds + PG8_SA(b, h) + aoff + m * 2048 + k * 1024); } while (0)
#define PG8_LDB(dst, b, h) do { _Pragma("unroll") for (int n = 0; n < 2; ++n) _Pragma("unroll") for (int k = 0; k < 2; ++k) dst[n][k] = *(const PG8_LAS bf16x8*)(lds + PG8_SB(b, h) + boff + n * 2048 + k * 1024); } while (0)
#define PG8_CAT(x) __builtin_shufflevector(__builtin_bit_cast(v4i_t, (x)[0]), __builtin_bit_cast(v4i_t, (x)[1]), 0, 1, 2, 3, 4, 5, 6, 7)
#define PG8_MMA(ai, bj, At, Bt) do { __builtin_amdgcn_s_setprio(1); \
        if constexpr (FP8) { _Pragma("unroll") for (int m = 0; m < 4; ++m) _Pragma("unroll") for (int n = 0; n < 2; ++n) \
            asm volatile("v_mfma_scale_f32_16x16x128_f8f6f4 %0, %1, %2, %0, %3, %3 op_sel_hi:[0,0,0]" : "+v"(acc[ai][bj][m][n]) : "v"(PG8_CAT(Bt[n])), "v"(PG8_CAT(At[m])), "v"(sc1)); } \
        else { _Pragma("unroll") for (int m = 0; m < 4; ++m) _Pragma("unroll") for (int n = 0; n < 2; ++n) _Pragma("unroll") for (int k = 0; k < 2; ++k) \
            acc[ai][bj][m][n] = __builtin_amdgcn_mfma_f32_16x16x32_bf16(Bt[n][k], At[m][k], acc[ai][bj][m][n], 0, 0, 0); } \
        __builtin_amdgcn_s_setprio(0); } while (0)
#define PG8_WAIT_V(n) asm volatile("s_waitcnt vmcnt(" #n ")" ::: "memory")
#define PG8_WAIT_L(n) asm volatile("s_waitcnt lgkmcnt(" #n ")" ::: "memory")
#define PG8_BAR __builtin_amdgcn_s_barrier()
#define PG8_SCHED __builtin_amdgcn_sched_barrier(0)
    Unit cur, nxt; int ui = 0;
    if (!S.next(0, cur)) return;
    f32x4 acc[2][2][4][2];
#pragma unroll
    for (int a = 0; a < 2; ++a)
#pragma unroll
        for (int b = 0; b < 2; ++b)
#pragma unroll
            for (int m = 0; m < 4; ++m)
#pragma unroll
                for (int n = 0; n < 2; ++n) acc[a][b][m][n] = (f32x4){0.f, 0.f, 0.f, 0.f};
    bf16x8 At[4][2], B0[2][2], B1[2][2];
    int sc1 = 0x7f7f7f7f; asm volatile("" : "+v"(sc1));
    const char* cA = cur.a; const char* cB = cur.b; int cR = cur.rt;
    if constexpr (Epi::MID) E.pre(cur, lds, tid);
    PG8_STAGE(PG8_SB(0, 0), cB, voffB0); PG8_STAGE(PG8_SB(0, 1), cB + hstep, voffB0); PG8_STAGE_A(PG8_SA(0, 0), cA, cR, 0, 0); PG8_STAGE_A(PG8_SA(0, 1), cA, cR, 1, 0);
    if (wr == 1) PG8_BAR;
    PG8_WAIT_V(2); PG8_BAR;
    PG8_STAGE(PG8_SB(1, 0), cB + kstep, voffB0); PG8_STAGE_A(PG8_SA(1, 0), cA, cR, 0, kstep); PG8_STAGE(PG8_SB(1, 1), cB + hstep + kstep, voffB0);
    PG8_WAIT_V(6); PG8_BAR;
    for (;;) {
        const bool has_next = S.next(ui + 1, nxt);
        const char* nA = has_next ? nxt.a : cA; const char* nB = has_next ? nxt.b : cB; const int nR = has_next ? nxt.rt : cR;
        for (int t = 0; t < nt; t += 2) {
            const bool last = (t == nt - 2);
            if constexpr (Epi::MID) { if (t == nt / 2) E.mid(acc, wr, fr, lds); }
            const size_t k1 = (size_t)(t + 1) * kstep;
            const char* a2 = last ? nA : cA; const char* b2 = last ? nB : cB + (size_t)(t + 2) * kstep; const int r2 = last ? nR : cR;
            const size_t k2 = last ? 0 : (size_t)(t + 2) * kstep, k3 = k2 + kstep; const char* b3 = b2 + kstep;
            PG8_LDB(B0, 0, 0); PG8_LDB(B1, 0, 1); PG8_SCHED; PG8_LDA(At, 0, 0); PG8_STAGE_A(PG8_SA(1, 1), cA, cR, 1, k1);
            PG8_WAIT_V(8); PG8_WAIT_L(0); PG8_BAR; PG8_MMA(0, 0, At, B0); PG8_MMA(0, 1, At, B1); PG8_BAR; PG8_SCHED;
            PG8_LDA(At, 0, 1); PG8_STAGE(PG8_SB(0, 0), b2, voffB0); PG8_STAGE(PG8_SB(0, 1), b2 + hstep, voffB0); PG8_STAGE_A(PG8_SA(0, 0), a2, r2, 0, k2);
            PG8_WAIT_V(8); PG8_WAIT_L(0); PG8_BAR; PG8_MMA(1, 0, At, B0); PG8_MMA(1, 1, At, B1); PG8_BAR; PG8_SCHED;
            PG8_LDB(B0, 1, 0); PG8_LDB(B1, 1, 1); PG8_SCHED; PG8_LDA(At, 1, 0); PG8_STAGE_A(PG8_SA(0, 1), a2, r2, 1, k2);
            PG8_WAIT_V(8); PG8_WAIT_L(0); PG8_BAR; PG8_MMA(0, 0, At, B0); PG8_MMA(0, 1, At, B1); PG8_BAR; PG8_SCHED;
            PG8_LDA(At, 1, 1); PG8_STAGE(PG8_SB(1, 0), b3, voffB0); PG8_STAGE(PG8_SB(1, 1), b3 + hstep, voffB0); PG8_STAGE_A(PG8_SA(1, 0), a2, r2, 0, k3);
            PG8_WAIT_V(8); PG8_WAIT_L(0); PG8_BAR; PG8_MMA(1, 0, At, B0); PG8_MMA(1, 1, At, B1); PG8_BAR; PG8_SCHED;
        }
        if constexpr (ALIGN_EPI) { if (wr == 0) PG8_BAR; }
        if constexpr (FP8) {
            asm volatile("s_nop 15\n\ts_nop 15\n\ts_nop 7" ::: "memory");
            _Pragma("unroll") for (int a = 0; a < 2; ++a) _Pragma("unroll") for (int b = 0; b < 2; ++b) _Pragma("unroll") for (int m = 0; m < 4; ++m) _Pragma("unroll") for (int n = 0; n < 2; ++n)
                asm volatile("" : "+v"(acc[a][b][m][n]));
        }
        if constexpr (!Epi::AFTER_DRAIN) { E(acc, cur, wr, wc, fr, fq); }
        if (!has_next) break;
#pragma unroll
        for (int a = 0; a < 2; ++a)
#pragma unroll
            for (int b = 0; b < 2; ++b)
#pragma unroll
                for (int m = 0; m < 4; ++m)
#pragma unroll
                    for (int n = 0; n < 2; ++n) acc[a][b][m][n] = (f32x4){0.f, 0.f, 0.f, 0.f};
        cur = nxt; cA = nA; cB = nB; cR = nR; ++ui;
        if constexpr (ALIGN_EPI) { if (wr == 1) PG8_BAR; }
    }
    PG8_WAIT_V(0);
    if constexpr (!ALIGN_EPI) { if (wr == 0) PG8_BAR; }
    PG8_BAR;
    if constexpr (Epi::AFTER_DRAIN) { E.fused(acc, cur, wr, wc, fr, fq, lds, wid, lane); }
#undef PG8_SA
#undef PG8_SB
#undef PG8_STAGE
#undef PG8_STAGE_A
#undef PG8_LDA
#undef PG8_LDB
#undef PG8_MMA
#undef PG8_CAT
#undef PG8_WAIT_V
#undef PG8_WAIT_L
#undef PG8_BAR
#undef PG8_SCHED
}

struct EpiInProj {
    static constexpr bool PERM = false, AFTER_DRAIN = true, MID = false;
    bf16_t* U; bf16_t* QN; bf16_t* KVN; bf16_t* KR; const float* g_q_a; const float* g_kv_a; const float* COS; const float* SIN;
    __device__ __forceinline__ void fused(f32x4 (&acc)[2][2][4][2], const Unit& u, int wr, int wc, int fr, int fq, PG8_LAS unsigned char* lds, int wid, int lane) const {
        const int row0 = u.pm * BM + wr * 64 + fr;
        if (u.pn < 2) {
#pragma unroll
            for (int ai = 0; ai < 2; ++ai)
#pragma unroll
                for (int m = 0; m < 4; ++m) { bf16_t* rowp = U + (size_t)(row0 + ai * HALF + m * 16) * 512 + u.pn * 256 + wc * 32 + 4 * fq;
#pragma unroll
                    for (int bj = 0; bj < 2; ++bj)
#pragma unroll
                        for (int n = 0; n < 2; ++n) { const f32x4 v = acc[ai][bj][m][n]; u32x2 w; w.x = cvt_pk_bf16(v[0], v[1]); w.y = cvt_pk_bf16(v[2], v[3]); *(u32x2*)(rowp + bj * HALF + n * 16) = w; } }
            return;
        }
        const bool isq = (u.pn == 2);
        PG8_LAS float* Pp = (PG8_LAS float*)lds;
#pragma unroll
        for (int ai = 0; ai < 2; ++ai)
#pragma unroll
            for (int m = 0; m < 4; ++m) { float s = 0.f;
#pragma unroll
                for (int bj = 0; bj < 2; ++bj) { if (bj == 1 && !isq) continue;
#pragma unroll
                    for (int n = 0; n < 2; ++n) { const f32x4 x = acc[ai][bj][m][n]; s += (x[0] * x[0] + x[1] * x[1]) + (x[2] * x[2] + x[3] * x[3]); } }
                s += __shfl_xor(s, 16); s += __shfl_xor(s, 32);
                if (fq == 0) Pp[(ai * HALF + wr * 64 + m * 16 + fr) * 4 + wc] = s; }
        asm volatile("s_waitcnt lgkmcnt(0)" ::: "memory"); __builtin_amdgcn_s_barrier(); asm volatile("" ::: "memory");
        const float invn = isq ? (1.f / 256.f) : (1.f / 128.f);
#pragma unroll
        for (int ai = 0; ai < 2; ++ai)
#pragma unroll
            for (int m = 0; m < 4; ++m) { const int rl = ai * HALF + wr * 64 + m * 16 + fr; const f32x4 p4 = *(const PG8_LAS f32x4*)(Pp + rl * 4);
                const float rstd = 1.f / sqrtf(((p4[0] + p4[1]) + (p4[2] + p4[3])) * invn + RMS_EPS); const size_t row = (size_t)(u.pm * BM + rl);
                if (isq) {
#pragma unroll
                    for (int bj = 0; bj < 2; ++bj)
#pragma unroll
                        for (int n = 0; n < 2; ++n) { const int c = bj * HALF + wc * 32 + n * 16 + 4 * fq; const f32x4 g = *(const f32x4*)(g_q_a + c); const f32x4 v = acc[ai][bj][m][n] * rstd * g;
                            u32x2 w; w.x = cvt_pk_bf16(v[0], v[1]); w.y = cvt_pk_bf16(v[2], v[3]); *(u32x2*)(QN + row * 256 + c) = w; }
                } else {
#pragma unroll
                    for (int n = 0; n < 2; ++n) { const int c = wc * 32 + n * 16 + 4 * fq; const f32x4 g = *(const f32x4*)(g_kv_a + c); const f32x4 v = acc[ai][0][m][n] * rstd * g;
                        u32x2 w; w.x = cvt_pk_bf16(v[0], v[1]); w.y = cvt_pk_bf16(v[2], v[3]); *(u32x2*)(KVN + row * 128 + c) = w; }
                    if (wc == 0) { const f32x4 x1 = acc[ai][1][m][0], x2 = acc[ai][1][m][1]; const f32x4 cs = *(const f32x4*)(COS + row * 16 + 4 * fq), sn = *(const f32x4*)(SIN + row * 16 + 4 * fq);
                        const f32x4 o1 = x1 * cs - x2 * sn, o2 = x2 * cs + x1 * sn; u32x2 w1, w2; w1.x = cvt_pk_bf16(o1[0], o1[1]); w1.y = cvt_pk_bf16(o1[2], o1[3]); w2.x = cvt_pk_bf16(o2[0], o2[1]); w2.y = cvt_pk_bf16(o2[2], o2[3]);
                        *(u32x2*)(KR + row * 32 + 4 * fq) = w1; *(u32x2*)(KR + row * 32 + 16 + 4 * fq) = w2; }
                } }
    }
};
}
namespace pg8 {
struct EpiQ {
    static constexpr bool PERM = false, AFTER_DRAIN = false, MID = false;
    bf16_t* Q; const float* COS; const float* SIN;
    __device__ __forceinline__ void operator()(const f32x4 (&acc)[2][2][4][2], const Unit& u, int wr, int wc, int fr, int fq) const {
        const int row0 = u.pm * BM + wr * 64 + fr; const int G0 = 8 * u.pn + wc, G1 = G0 + 4; const bool r0 = (G0 % 3) == 2, r1 = (G1 % 3) == 2;
#pragma unroll
        for (int ai = 0; ai < 2; ++ai)
#pragma unroll
            for (int m = 0; m < 4; ++m) { const size_t row = (size_t)(row0 + ai * HALF + m * 16);
                f32x4 cs = {1.f, 1.f, 1.f, 1.f}, sn = {0.f, 0.f, 0.f, 0.f};
                if (r0 || r1) { cs = *(const f32x4*)(COS + row * 16 + 4 * fq); sn = *(const f32x4*)(SIN + row * 16 + 4 * fq); }
#pragma unroll
                for (int bj = 0; bj < 2; ++bj) { const bool rope = bj ? r1 : r0; const int cb = 32 * (bj ? G1 : G0) + 4 * fq; f32x4 o1 = acc[ai][bj][m][0], o2 = acc[ai][bj][m][1];
                    if (rope) { const f32x4 x1 = o1, x2 = o2; o1 = x1 * cs - x2 * sn; o2 = x2 * cs + x1 * sn; }
                    o1 = o1 * QSCALE; o2 = o2 * QSCALE; u32x2 w1, w2; w1.x = cvt_pk_bf16(o1[0], o1[1]); w1.y = cvt_pk_bf16(o1[2], o1[3]); w2.x = cvt_pk_bf16(o2[0], o2[1]); w2.y = cvt_pk_bf16(o2[2], o2[3]);
                    *(u32x2*)(Q + row * 768 + cb) = w1; *(u32x2*)(Q + row * 768 + cb + 16) = w2; }
                asm volatile("" ::: "memory"); }
    }
};
struct EpiKV {
    static constexpr bool PERM = true, AFTER_DRAIN = false, MID = false;
    bf16_t* Kn; bf16_t* V;
    __device__ __forceinline__ void operator()(const f32x4 (&acc)[2][2][4][2], const Unit& u, int wr, int wc, int fr, int fq) const {
        const int row0 = u.pm * BM + wr * 64 + fr;
#pragma unroll
        for (int bj = 0; bj < 2; ++bj) { const int head = 2 * u.pn + bj; bf16_t* dst = (wc < 2 ? Kn + head * 64 + wc * 32 : V + head * 64 + (wc - 2) * 32) + 8 * fq;
#pragma unroll
            for (int ai = 0; ai < 2; ++ai)
#pragma unroll
                for (int m = 0; m < 4; ++m) { const size_t row = (size_t)(row0 + ai * HALF + m * 16); const f32x4 v0 = acc[ai][bj][m][0], v1 = acc[ai][bj][m][1];
                    u32x4 w; w.x = cvt_pk_bf16(v0[0], v0[1]); w.y = cvt_pk_bf16(v0[2], v0[3]); w.z = cvt_pk_bf16(v1[0], v1[1]); w.w = cvt_pk_bf16(v1[2], v1[3]); *(u32x4*)(dst + row * 512) = w; } }
    }
};
struct EpiOut {
    static constexpr bool PERM = false, AFTER_DRAIN = false, MID = true;
    const float* x; float* out; const float* SSQ; int aux_off;
    __device__ __forceinline__ void pre(const Unit& u, PG8_LAS unsigned char* lds, int tid) const {
        if (tid < 256) { const f32x4 a = *(const f32x4*)(SSQ + (size_t)(u.pm * BM + tid) * 8), b = *(const f32x4*)(SSQ + (size_t)(u.pm * BM + tid) * 8 + 4);
            const float s = ((a[0] + a[1]) + (a[2] + a[3])) + ((b[0] + b[1]) + (b[2] + b[3])); ((PG8_LAS float*)(lds + aux_off))[tid] = 1.f / sqrtf(s * (1.f / 512.f) + RMS_EPS); }
    }
    __device__ __forceinline__ void mid(f32x4 (&acc)[2][2][4][2], int wr, int fr, PG8_LAS unsigned char* lds) const {
#pragma unroll
        for (int ai = 0; ai < 2; ++ai)
#pragma unroll
            for (int m = 0; m < 4; ++m) { const float sa = ((const PG8_LAS float*)(lds + aux_off))[ai * HALF + wr * 64 + m * 16 + fr];
#pragma unroll
                for (int bj = 0; bj < 2; ++bj)
#pragma unroll
                    for (int n = 0; n < 2; ++n) acc[ai][bj][m][n] = acc[ai][bj][m][n] * sa; }
    }
    __device__ __forceinline__ void operator()(const f32x4 (&acc)[2][2][4][2], const Unit& u, int wr, int wc, int fr, int fq) const {
        const int row0 = u.pm * BM + wr * 64 + fr, col0 = u.pn * BM + wc * 32 + 4 * fq;
#pragma unroll
        for (int ai = 0; ai < 2; ++ai)
#pragma unroll
            for (int m = 0; m < 4; ++m) { const size_t off = (size_t)(row0 + ai * HALF + m * 16) * 1024 + col0;
#pragma unroll
                for (int bj = 0; bj < 2; ++bj)
#pragma unroll
                    for (int n = 0; n < 2; ++n) *(f32x4*)(out + off + bj * HALF + n * 16) = *(const f32x4*)(x + off + bj * HALF + n * 16) + acc[ai][bj][m][n]; }
    }
};
struct EpiSwiglu {
    static constexpr bool PERM = true, AFTER_DRAIN = false, MID = false;
    const float* bgu; bf16_t* ACT;
    __device__ __forceinline__ void operator()(const f32x4 (&acc)[2][2][4][2], const Unit& u, int wr, int wc, int fr, int fq) const {
        const int row0 = u.pm * BM + wr * 64 + fr, col8 = u.pn * HALF + wc * 32 + 8 * fq;
        f32x4 bg[2], bu[2];
#pragma unroll
        for (int n = 0; n < 2; ++n) { bg[n] = *(const f32x4*)(bgu + (size_t)u.e * 2048 + col8 + 4 * n); bu[n] = *(const f32x4*)(bgu + (size_t)u.e * 2048 + 1024 + col8 + 4 * n); }
#pragma unroll
        for (int ai = 0; ai < 2; ++ai)
#pragma unroll
            for (int m = 0; m < 4; ++m) { f32x4 a[2];
#pragma unroll
                for (int n = 0; n < 2; ++n) { const f32x4 g4 = acc[ai][0][m][n] + bg[n], u4 = acc[ai][1][m][n] + bu[n];
#pragma unroll
                    for (int j = 0; j < 4; ++j) { const float g = fminf(g4[j], 7.f), uu = fminf(fmaxf(u4[j], -7.f), 7.f);
                        const float sg = __builtin_amdgcn_rcpf(1.f + __builtin_amdgcn_exp2f(-1.702f * 1.4426950408889634f * g)); a[n][j] = g * sg * (uu + 1.f); } }
                u32x4 w; w.x = cvt_pk_bf16(a[0][0], a[0][1]); w.y = cvt_pk_bf16(a[0][2], a[0][3]); w.z = cvt_pk_bf16(a[1][0], a[1][1]); w.w = cvt_pk_bf16(a[1][2], a[1][3]);
                *(u32x4*)(ACT + (size_t)(row0 + ai * HALF + m * 16) * 1024 + col8) = w; }
    }
};
struct EpiDown {
    static constexpr bool PERM = true, AFTER_DRAIN = false, MID = false;
    const float* bd; const float* GL; bf16_t* Y;
    __device__ __forceinline__ void operator()(const f32x4 (&acc)[2][2][4][2], const Unit& u, int wr, int wc, int fr, int fq) const {
        const int col0 = u.pn * BM + wc * 32 + 8 * fq;
        f32x4 bv[2][2];
#pragma unroll
        for (int bj = 0; bj < 2; ++bj)
#pragma unroll
            for (int n = 0; n < 2; ++n) bv[bj][n] = *(const f32x4*)(bd + (size_t)u.e * 1024 + col0 + bj * HALF + 4 * n);
#pragma unroll
        for (int ai = 0; ai < 2; ++ai)
#pragma unroll
            for (int m = 0; m < 4; ++m) { const int rl = ai * HALF + wr * 64 + m * 16 + fr; const float gt = GL[(size_t)u.e * T + u.rt + rl]; bf16_t* rowp = Y + (size_t)(u.pm * BM + rl) * 1024 + col0;
#pragma unroll
                for (int bj = 0; bj < 2; ++bj) { const f32x4 v0 = (acc[ai][bj][m][0] + bv[bj][0]) * gt, v1 = (acc[ai][bj][m][1] + bv[bj][1]) * gt;
                    u32x4 w; w.x = cvt_pk_bf16(v0[0], v0[1]); w.y = cvt_pk_bf16(v0[2], v0[3]); w.z = cvt_pk_bf16(v1[0], v1[1]); w.w = cvt_pk_bf16(v1[2], v1[3]); *(u32x4*)(rowp + bj * HALF) = w; } }
    }
};
struct EpiSwiglu8 {
    static constexpr bool PERM = true, AFTER_DRAIN = false, MID = false;
    const float* bgu; unsigned char* ACT;
    __device__ __forceinline__ void operator()(const f32x4 (&acc)[2][2][4][2], const Unit& u, int wr, int wc, int fr, int fq) const {
        const int row0 = u.pm * BM + wr * 64 + fr, col8 = u.pn * HALF + wc * 32 + 8 * fq;
        f32x4 bg[2], bu[2];
#pragma unroll
        for (int n = 0; n < 2; ++n) { bg[n] = *(const f32x4*)(bgu + (size_t)u.e * 2048 + col8 + 4 * n); bu[n] = *(const f32x4*)(bgu + (size_t)u.e * 2048 + 1024 + col8 + 4 * n); }
#pragma unroll
        for (int ai = 0; ai < 2; ++ai)
#pragma unroll
            for (int m = 0; m < 4; ++m) { f32x4 a[2];
#pragma unroll
                for (int n = 0; n < 2; ++n) { const f32x4 g4 = acc[ai][0][m][n] * W8_INV + bg[n], u4 = acc[ai][1][m][n] * W8_INV + bu[n];
#pragma unroll
                    for (int j = 0; j < 4; ++j) { const float g = fminf(g4[j], 7.f), uu = fminf(fmaxf(u4[j], -7.f), 7.f);
                        const float sg = __builtin_amdgcn_rcpf(1.f + __builtin_amdgcn_exp2f(-1.702f * 1.4426950408889634f * g)); a[n][j] = g * sg * (uu + 1.f); } }
                u32x2 w; w.x = pk4_fp8(a[0][0], a[0][1], a[0][2], a[0][3]); w.y = pk4_fp8(a[1][0], a[1][1], a[1][2], a[1][3]);
                *(u32x2*)(ACT + (size_t)(row0 + ai * HALF + m * 16) * 1024 + col8) = w; }
    }
};
struct EpiDown8 {
    static constexpr bool PERM = true, AFTER_DRAIN = false, MID = false;
    const float* bd; const float* GL; bf16_t* Y;
    __device__ __forceinline__ void operator()(const f32x4 (&acc)[2][2][4][2], const Unit& u, int wr, int wc, int fr, int fq) const {
        const int col0 = u.pn * BM + wc * 32 + 8 * fq;
        f32x4 bv[2][2];
#pragma unroll
        for (int bj = 0; bj < 2; ++bj)
#pragma unroll
            for (int n = 0; n < 2; ++n) bv[bj][n] = *(const f32x4*)(bd + (size_t)u.e * 1024 + col0 + bj * HALF + 4 * n);
#pragma unroll
        for (int ai = 0; ai < 2; ++ai)
#pragma unroll
            for (int m = 0; m < 4; ++m) { const int rl = ai * HALF + wr * 64 + m * 16 + fr; const float gt = GL[(size_t)u.e * T + u.rt + rl]; bf16_t* rowp = Y + (size_t)(u.pm * BM + rl) * 1024 + col0;
#pragma unroll
                for (int bj = 0; bj < 2; ++bj) { const f32x4 v0 = (acc[ai][bj][m][0] * W8_INV + bv[bj][0]) * gt, v1 = (acc[ai][bj][m][1] * W8_INV + bv[bj][1]) * gt;
                    u32x4 w; w.x = cvt_pk_bf16(v0[0], v0[1]); w.y = cvt_pk_bf16(v0[2], v0[3]); w.z = cvt_pk_bf16(v1[0], v1[1]); w.w = cvt_pk_bf16(v1[2], v1[3]); *(u32x4*)(rowp + bj * HALF) = w; } }
    }
};
template <bool GATHER>
struct MoeOrder {
    const char* A; const char* W; size_t wstride; int NN, G, c, rt0; const PG8_LAS int* tstart; int rowbytes;
    __device__ bool next(int i, Unit& u) const {
        const int nwg = tstart[32] * NN; const long L = (long)i * G + c; if (L >= nwg) return false;
        int wgid = (int)L; { const int q = nwg / NXCD, r = nwg % NXCD, xcd = wgid % NXCD, off = wgid / NXCD; wgid = (xcd < r ? xcd * (q + 1) : r * (q + 1) + (xcd - r) * q) + off; }
        const int mt = wgid / NN, pn = wgid % NN; int e = 0;
        for (int k = 1; k < 32; ++k) e += (tstart[k] <= mt) ? 1 : 0;
        u.pm = mt; u.pn = pn; u.e = e; const int jt = mt - tstart[e];
        u.a = GATHER ? A : A + (size_t)mt * BM * rowbytes; u.b = W + (size_t)e * wstride + (size_t)pn * BM * rowbytes;
        u.rt = GATHER ? rt0 + i * 1024 : jt * 256;
        return true;
    }
};
}

template <bool GATHER>
__device__ __forceinline__ void moe_setup(const Ptrs& P, LAS unsigned char* lds, const pg8::MoeOrder<GATHER>& S) {
    const int tid = threadIdx.x; const int* cnt = (const int*)(P.ws + WS_CTL) + CW_CNT;
    if (tid < 33) { int s = 0; for (int e = 0; e < tid; ++e) s += (cnt[e] + 255) >> 8; ((LAS int*)(lds + TS_OFF))[tid] = s; }
    __syncthreads();
    if constexpr (GATHER) {
        const int* LIST = (const int*)(P.ws + WS_LIST); pg8::Unit u;
        for (int i = 0; i < 9 && S.next(i, u); ++i) {
            if (tid < 256) { const int jt = u.pm - S.tstart[u.e]; int pos = jt * 256 + tid; const int n = cnt[u.e]; if (pos >= n) pos = n - 1;
                ((LAS unsigned*)(lds + GT_OFF + i * 1024))[tid] = (unsigned)LIST[(size_t)u.e * T + pos] * (unsigned)S.rowbytes; }
        }
        __syncthreads();
    }
}
namespace att {
typedef short s16x4 __attribute__((ext_vector_type(4)));
typedef float f32x16 __attribute__((ext_vector_type(16)));
constexpr int NW = 8, QBLK = 32, KVBLK = 64, QB = NW * QBLK;
constexpr int SHM_V = KVBLK * 64 * 2, SHM_K = KVBLK * 256;
constexpr int OFF_V = 0, OFF_K = 2 * SHM_V, OFF_WS = OFF_K + 2 * SHM_K, OFF_OST = OFF_WS + NW * 64 * 4, ATT_LDS = OFF_OST + NW * 4096;
constexpr float THR2 = 11.5f;
#define KSWZ(row, colB) ((row) * 256 + ((colB) ^ (((row) & 7) << 4)))
#define SBAR() __builtin_amdgcn_sched_barrier(0)
__device__ __forceinline__ int v_st(int k, int c) { const int kk = (k & ~0xC) | ((k & 4) << 1) | ((k & 8) >> 1); return ((kk >> 3) * 2 + (c >> 5)) * 512 + ((kk & 7) * 32 + (c & 31)) * 2; }
__device__ __forceinline__ int v_rd_base(int lane) { return ((lane & 3) << 3) | (((lane >> 2) & 3) << 6) | (((lane >> 4) & 1) << 5) | (((lane >> 5) & 1) << 8); }
__device__ __forceinline__ int crow(int r, int hi) { return (r & 3) + 8 * (r >> 2) + 4 * hi; }
__device__ __forceinline__ unsigned cvtpk(float lo, float hi) { unsigned r; asm volatile("v_cvt_pk_bf16_f32 %0, %1, %2" : "=v"(r) : "v"(lo), "v"(hi)); return r; }
__device__ __forceinline__ void mask_tile(f32x16& p0, f32x16& p1, int dq) {
    const float NEG = -__builtin_inff();
#pragma unroll
    for (int r = 0; r < 16; ++r) { const int c = (r & 3) + 8 * (r >> 2); if (dq - c < 0) p0[r] = NEG; if (dq - c - 32 < 0) p1[r] = NEG; }
}
__device__ __forceinline__ void partialSM(f32x16& p0, f32x16& p1, float& m_reg, float& mn, float& alpha) {
    float pmax = p0[0];
#pragma unroll
    for (int r = 1; r < 16; ++r) pmax = fmaxf(pmax, p0[r]);
#pragma unroll
    for (int r = 0; r < 16; ++r) pmax = fmaxf(pmax, p1[r]);
    { auto rr = __builtin_amdgcn_permlane32_swap(__float_as_uint(pmax), __float_as_uint(pmax), false, false); pmax = fmaxf(__uint_as_float(rr[0]), __uint_as_float(rr[1])); }
    if (__builtin_expect(__all((pmax - m_reg) <= THR2), 1)) { mn = m_reg; alpha = 1.f; }
    else { mn = fmaxf(m_reg, pmax); alpha = __builtin_amdgcn_exp2f(m_reg - mn); m_reg = mn; }
#pragma unroll
    for (int r = 0; r < 16; ++r) p0[r] = p0[r] - mn;
#pragma unroll
    for (int r = 0; r < 16; ++r) p1[r] = p1[r] - mn;
#pragma unroll
    for (int r = 0; r < 16; ++r) p0[r] = __builtin_amdgcn_exp2f(p0[r]);
}
__device__ __forceinline__ void finishSM(f32x16& p0, f32x16& p1, float alpha, float& l_reg, bf16x8& pa0, bf16x8& pa1, bf16x8& pa2, bf16x8& pa3) {
#pragma unroll
    for (int r = 0; r < 16; ++r) p1[r] = __builtin_amdgcn_exp2f(p1[r]);
    float ps = 0;
#pragma unroll
    for (int r = 0; r < 16; ++r) ps += p0[r];
#pragma unroll
    for (int r = 0; r < 16; ++r) ps += p1[r];
    { auto rr = __builtin_amdgcn_permlane32_swap(__float_as_uint(ps), __float_as_uint(ps), false, false); ps = __uint_as_float(rr[0]) + __uint_as_float(rr[1]); }
    l_reg = l_reg * alpha + ps;
#define PK4(P, B_, OUT) do { unsigned a0 = cvtpk(P[B_+0], P[B_+1]), a1 = cvtpk(P[B_+2], P[B_+3]); unsigned b0 = cvtpk(P[B_+4], P[B_+5]), b1 = cvtpk(P[B_+6], P[B_+7]); \
        auto r0 = __builtin_amdgcn_permlane32_swap(a0, b0, false, false); auto r1 = __builtin_amdgcn_permlane32_swap(a1, b1, false, false); \
        u32x4 w = {r0[0], r1[0], r0[1], r1[1]}; OUT = *reinterpret_cast<bf16x8*>(&w); } while (0)
    PK4(p0, 0, pa0); PK4(p0, 8, pa1); PK4(p1, 0, pa2); PK4(p1, 8, pa3);
#undef PK4
}
template <int KB>
__device__ __forceinline__ void qkt(f32x16& p0, f32x16& p1, const char* K_lds, int r32, int hi, const bf16x8* qr) {
    p0 = f32x16{}; p1 = f32x16{};
    const char* kb[4];
#pragma unroll
    for (int dd = 0; dd < 4; ++dd) kb[dd] = K_lds + KB * SHM_K + KSWZ(r32, (dd * 16 + hi * 8) * 2);
#pragma unroll
    for (int d0 = 0; d0 < 6; ++d0) { const char* a = kb[d0 & 3] + (d0 >> 2) * 128;
        bf16x8 b0 = *reinterpret_cast<const bf16x8*>(a);
        bf16x8 b1 = *reinterpret_cast<const bf16x8*>(a + 32 * 256);
        p0 = __builtin_amdgcn_mfma_f32_32x32x16_bf16(b0, qr[d0], p0, 0, 0, 0);
        p1 = __builtin_amdgcn_mfma_f32_32x32x16_bf16(b1, qr[d0], p1, 0, 0, 0); }
}
template <int VB>
__device__ __forceinline__ void pv_tile(f32x16* o, int vb0, bf16x8 pa0, bf16x8 pa1, bf16x8 pa2, bf16x8 pa3) {
#define TRRD(dst, off) asm volatile("ds_read_b64_tr_b16 %0, %1 offset:%2" : "=&v"(dst) : "v"(vb0), "i"(off) : "memory")
#define PV_D0(d0) do { s16x4 l0, l1, l2, l3, h0, h1, h2, h3; constexpr int b_ = OFF_V + VB * SHM_V + (d0) * 512; \
        TRRD(l0, b_); TRRD(h0, b_ + 1024); TRRD(l1, b_ + 2048); TRRD(h1, b_ + 3072); TRRD(l2, b_ + 4096); TRRD(h2, b_ + 5120); TRRD(l3, b_ + 6144); TRRD(h3, b_ + 7168); \
        asm volatile("s_waitcnt lgkmcnt(0)" ::: "memory"); SBAR(); \
        o[d0] = __builtin_amdgcn_mfma_f32_32x32x16_bf16(pa0, (bf16x8){l0[0], l0[1], l0[2], l0[3], h0[0], h0[1], h0[2], h0[3]}, o[d0], 0, 0, 0); \
        o[d0] = __builtin_amdgcn_mfma_f32_32x32x16_bf16(pa1, (bf16x8){l1[0], l1[1], l1[2], l1[3], h1[0], h1[1], h1[2], h1[3]}, o[d0], 0, 0, 0); \
        o[d0] = __builtin_amdgcn_mfma_f32_32x32x16_bf16(pa2, (bf16x8){l2[0], l2[1], l2[2], l2[3], h2[0], h2[1], h2[2], h2[3]}, o[d0], 0, 0, 0); \
        o[d0] = __builtin_amdgcn_mfma_f32_32x32x16_bf16(pa3, (bf16x8){l3[0], l3[1], l3[2], l3[3], h3[0], h3[1], h3[2], h3[3]}, o[d0], 0, 0, 0); } while (0)
    PV_D0(0); PV_D0(1);
#undef PV_D0
#undef TRRD
}
struct BlockRef { const bf16_t* Q; const bf16_t* Kn; const bf16_t* KR; const bf16_t* V; bf16_t* O; float* SSQ; int P0; };
struct Seam { bf16x8 qr[6]; bf16x8 st_v0, st_k0, st_k1; };
#define VMW() asm volatile("s_waitcnt vmcnt(0)" ::: "memory")
#define VMWN(n) asm volatile("s_waitcnt vmcnt(%0)" :: "i"(n) : "memory")
#define KSRC(B, k0, rr) ((ch < 8 ? (B).Kn + (size_t)((k0) + (rr)) * 512 + ch * 8 : (B).KR + (size_t)((k0) + (rr)) * 32 + (ch - 8) * 8))
#define SLOAD_H(B, k0) do { S.st_v0 = *(const bf16x8*)((B).V + (size_t)((k0) + vk) * 512 + vc); \
                            if (ch < 12) { S.st_k0 = *(const bf16x8*)KSRC(B, k0, sr); S.st_k1 = *(const bf16x8*)KSRC(B, k0, 32 + sr); } } while (0)
#define SWRITE_HK(bf) do { if (ch < 12) { *(bf16x8*)(K_lds + (bf) * SHM_K + kws) = S.st_k0; *(bf16x8*)(K_lds + (bf) * SHM_K + kws + 32 * 256) = S.st_k1; } } while (0)
#define SWRITE_HV(bf) do { *(bf16x8*)(V_lds + (bf) * SHM_V + vst0) = S.st_v0; } while (0)
#define SWRITE_H(bf) do { SWRITE_HV(bf); SWRITE_HK(bf); } while (0)
__device__ __forceinline__ void attn_prime(const BlockRef& cur, char* lds, Seam& S) {
    const int tid = tid_opaque(), wid = __builtin_amdgcn_readfirstlane(tid >> 6), lane = tid & 63, r32 = lane & 31, hi = lane >> 5;
    const int sr = tid >> 4, ch = tid & 15, kws = KSWZ(sr, ch * 16), vk = tid >> 3, vc = (tid & 7) * 8; char* K_lds = lds + OFF_K;
#pragma unroll
    for (int d0 = 0; d0 < 6; ++d0) S.qr[d0] = *(const bf16x8*)(cur.Q + (size_t)(wid * QBLK + r32) * 768 + d0 * 16 + hi * 8);
    SLOAD_H(cur, 0); VMW(); SWRITE_HK(0);
    __syncthreads();
}
__device__ __forceinline__ void attn_block(const BlockRef& cur, const BlockRef& nxt, char* lds, Seam& S) {
    const int tid = tid_opaque(), wid = __builtin_amdgcn_readfirstlane(tid >> 6), lane = tid & 63, r32 = lane & 31, hi = lane >> 5;
    const int NT = (cur.P0 + QB) / KVBLK;
    const int qlo = cur.P0 + wid * QBLK, qm = qlo + r32 - 4 * hi;
    char* V_lds = lds + OFF_V; char* K_lds = lds + OFF_K;
    float* ws = (float*)(lds + OFF_WS) + wid * 64; float* li_l = ws, * al_l = ws + 32;
    float m_reg = -1e30f, l_reg = 0; f32x16 o[2] = {};
    const int sr = tid >> 4, ch = tid & 15, kws = KSWZ(sr, ch * 16), vk = tid >> 3, vc = (tid & 7) * 8, vst0 = v_st(vk, vc);
    const int vb0 = (int)(uintptr_t)lds + v_rd_base(lane);
#define RESC(a) do { if (__any((a) < 1.f)) { if (hi == 0) al_l[r32] = (a); asm volatile("s_waitcnt lgkmcnt(0)" ::: "memory"); \
                     _Pragma("unroll") for (int d_ = 0; d_ < 2; ++d_) _Pragma("unroll") for (int r = 0; r < 16; ++r) o[d_][r] *= al_l[crow(r, hi)]; } } while (0)
#define KBASE(t) ((t) * KVBLK)
#define MASKT(P0_, P1_, t) do { const int kb_ = KBASE(t); if (kb_ + KVBLK - 1 > qlo) mask_tile(P0_, P1_, qm - kb_); } while (0)
    constexpr int NQL = 6;
#define SEAM_K0() do { VMWN(NQL); SWRITE_HK(0); SBAR(); } while (0)
    f32x16 pA0, pA1, pB0, pB1; float mnA, mnB, alA, alB; bf16x8 pa0, pa1, pa2, pa3;
    SWRITE_HV(0); SBAR();
    if (NT > 1) SLOAD_H(cur, KBASE(1));
    SBAR(); qkt<0>(pA0, pA1, K_lds, r32, hi, S.qr);
    MASKT(pA0, pA1, 0); partialSM(pA0, pA1, m_reg, mnA, alA);
    if (NT > 1) { VMW(); SWRITE_H(1); }
    __syncthreads();
#define HALF_STEP(PX0, PX1, mnX, alX, PY0, PY1, alY, t, KB, VB, SB) do { \
        SBAR(); qkt<KB>(PX0, PX1, K_lds, r32, hi, S.qr); \
        finishSM(PY0, PY1, alY, l_reg, pa0, pa1, pa2, pa3); SBAR(); \
        if ((t) + 1 < NT) { SLOAD_H(cur, KBASE((t) + 1)); SBAR(); } \
        pv_tile<VB>(o, vb0, pa0, pa1, pa2, pa3); MASKT(PX0, PX1, (t)); partialSM(PX0, PX1, m_reg, mnX, alX); \
        __syncthreads(); \
        if ((t) + 1 < NT) { VMW(); SWRITE_H(SB); } \
        RESC(alX); __syncthreads(); } while (0)
    for (int t = 1; t + 1 < NT; t += 2) {
        HALF_STEP(pB0, pB1, mnB, alB, pA0, pA1, alA, t, 1, 0, 0);
        HALF_STEP(pA0, pA1, mnA, alA, pB0, pB1, alB, t + 1, 0, 1, 1);
    }
    SBAR(); qkt<1>(pB0, pB1, K_lds, r32, hi, S.qr); SBAR();
    SLOAD_H(nxt, 0); SBAR();
#pragma unroll
    for (int d0 = 0; d0 < 6; ++d0) S.qr[d0] = *(const bf16x8*)(nxt.Q + (size_t)(wid * QBLK + r32) * 768 + d0 * 16 + hi * 8);
    SBAR();
    finishSM(pA0, pA1, alA, l_reg, pa0, pa1, pa2, pa3); SBAR();
    pv_tile<0>(o, vb0, pa0, pa1, pa2, pa3);
    MASKT(pB0, pB1, NT - 1); partialSM(pB0, pB1, m_reg, mnB, alB); __syncthreads(); RESC(alB);
    finishSM(pB0, pB1, alB, l_reg, pa0, pa1, pa2, pa3); SBAR(); pv_tile<1>(o, vb0, pa0, pa1, pa2, pa3);
    SBAR(); SEAM_K0();
    if (hi == 0) li_l[r32] = l_reg; asm volatile("s_waitcnt lgkmcnt(0)" ::: "memory");
    float rli[16];
#pragma unroll
    for (int r = 0; r < 16; ++r) rli[r] = __builtin_amdgcn_rcpf(li_l[crow(r, hi)]);
    { bf16_t* stg = (bf16_t*)(lds + OFF_OST) + wid * 2048;
#pragma unroll
      for (int r = 0; r < 16; ++r) { const int orow = crow(r, hi);
#pragma unroll
          for (int d0 = 0; d0 < 2; ++d0) stg[orow * 64 + d0 * 32 + r32] = (bf16_t)f2bf(o[d0][r] * rli[r]); }
      asm volatile("s_waitcnt lgkmcnt(0)" ::: "memory");
#pragma unroll
      for (int i = 0; i < 4; ++i) { const int row = i * 8 + (lane >> 3), c8 = lane & 7; const u32x4 v = *(const u32x4*)(stg + row * 64 + c8 * 8);
          *(u32x4*)(cur.O + (size_t)(wid * QBLK + row) * 1024 + c8 * 8) = v;
          float s = 0.f;
#pragma unroll
          for (int j = 0; j < 4; ++j) { const float a = __builtin_bit_cast(float, v[j] << 16), b = __builtin_bit_cast(float, v[j] & 0xffff0000u); s += a * a + b * b; }
          s += __shfl_xor(s, 1); s += __shfl_xor(s, 2); s += __shfl_xor(s, 4);
          if (c8 == 0) cur.SSQ[(size_t)(wid * QBLK + row) * 8] = s; } }
    __syncthreads();
#undef RESC
#undef KBASE
#undef MASKT
#undef SEAM_K0
#undef HALF_STEP
}
#undef VMW
#undef VMWN
#undef KSRC
#undef SLOAD_H
#undef SWRITE_HK
#undef SWRITE_HV
#undef SWRITE_H
#undef KSWZ
#undef SBAR
__device__ __forceinline__ BlockRef block_ref(const Ptrs& P, int bh, int qb) {
    const int b = bh >> 3, h = bh & 7; const size_t r0 = (size_t)b * SEQ + (size_t)qb * QB; BlockRef r;
    r.Q = (const bf16_t*)(P.ws + WS_Q) + r0 * 768 + h * 96; r.Kn = (const bf16_t*)(P.ws + WS_K) + (size_t)b * SEQ * 512 + h * 64; r.KR = (const bf16_t*)(P.ws + WS_KR) + (size_t)b * SEQ * 32;
    r.V = (const bf16_t*)(P.ws + WS_V) + (size_t)b * SEQ * 512 + h * 64; r.O = (bf16_t*)(P.ws + WS_MIX) + r0 * 1024 + h * 64; r.SSQ = (float*)(P.ws + WS_SSQ) + r0 * 8 + h; r.P0 = qb * QB; return r;
}
__device__ __forceinline__ void attn_phase(const Ptrs& P, char* lds) {
    const int G = gridDim.x, c = blockIdx.x; const int vcu = (G % 8 == 0) ? (c % 8) * (G / 8) + c / 8 : c;
    Seam S;
    for (int it = vcu; it < 256; it += G) {
        const int bh = it >> 4, x = it & 15;
        const BlockRef b0 = block_ref(P, bh, x), b1 = block_ref(P, bh, 31 - x);
        attn_prime(b0, lds, S);
        attn_block(b0, b1, lds, S);
        attn_block(b1, b1, lds, S);
    }
}
}
typedef float f32x16r __attribute__((ext_vector_type(16)));
__device__ __forceinline__ void router_phase(const Ptrs& P, LAS unsigned char* lds) {
    const int tid = tid_opaque(), lane = tid & 63, w = __builtin_amdgcn_readfirstlane(tid >> 6), i32 = lane & 31, kk = lane >> 5;
    LAS float* RED = (LAS float*)lds;
    LAS float* SSQ = (LAS float*)(lds + 8 * 32 * 33 * 4);
    LAS float* LOG = SSQ + 8 * 32;
    LAS float* RSTD = LOG + 32 * 33;
    LAS int* HIST = (LAS int*)(RSTD + 32);
    LAS int* SELE = HIST + 32;
    LAS int* SELR = SELE + 128;
    LAS float* SELG = (LAS float*)(SELR + 128);
    int* cnt = (int*)(P.ws + WS_CTL) + CW_CNT; int* SLOT = (int*)(P.ws + WS_SLOT); int* LIST = (int*)(P.ws + WS_LIST); float* GLIST = (float*)(P.ws + WS_GLIST);
    for (int rb = blockIdx.x; rb < T / 32; rb += gridDim.x) {
        const int t0 = rb * 32;
        const float* xr = P.out + (size_t)(t0 + i32) * 1024 + 128 * w + 64 * kk;
        f32x4 av[16]; float ssq = 0.f;
#pragma unroll
        for (int m = 0; m < 16; ++m) { const f32x4 a = *(const f32x4*)(xr + 4 * m); const f32x4 g = *(const f32x4*)(P.g_ffn + 128 * w + 64 * kk + 4 * m);
            ssq += (a[0] * a[0] + a[1] * a[1]) + (a[2] * a[2] + a[3] * a[3]); av[m] = a * g; }
        f32x16r acc = {};
        const float* wr = P.w_router + (size_t)(128 * w + 64 * kk) * 32 + i32;
#pragma unroll
        for (int m = 0; m < 16; ++m) {
#pragma unroll
            for (int j = 0; j < 4; ++j) acc = __builtin_amdgcn_mfma_f32_32x32x2f32(av[m][j], wr[(4 * m + j) * 32], acc, 0, 0, 0); }
        ssq += __shfl_xor(ssq, 32);
        if (kk == 0) SSQ[w * 32 + i32] = ssq;
#pragma unroll
        for (int r = 0; r < 16; ++r) RED[(w * 32 + (r & 3) + 8 * (r >> 2) + 4 * kk) * 33 + i32] = acc[r];
        if (tid < 32) HIST[tid] = 0;
        __syncthreads();
        if (tid < 32) { float s = 0.f;
#pragma unroll
            for (int q = 0; q < 8; ++q) s += SSQ[q * 32 + tid];
            RSTD[tid] = 1.f / sqrtf(s * (1.f / 1024.f) + RMS_EPS); }
        __syncthreads();
#pragma unroll
        for (int q = 0; q < 2; ++q) { const int idx = tid + 512 * q, row = idx >> 5, e = idx & 31; float s = 0.f;
#pragma unroll
            for (int p = 0; p < 8; ++p) s += RED[(p * 32 + row) * 33 + e];
            LOG[row * 33 + e] = s * RSTD[row] + P.b_router[e]; }
#if FP8_MOE
        { const float rs = RSTD[i32]; unsigned char* hp = P.ws + WS_H + (size_t)(t0 + i32) * 1024 + 128 * w + 64 * kk;
#pragma unroll
          for (int q = 0; q < 4; ++q) { u32x4 o;
              { const f32x4 v = av[4 * q + 0] * rs; o.x = pk4_fp8(v[0], v[1], v[2], v[3]); } { const f32x4 v = av[4 * q + 1] * rs; o.y = pk4_fp8(v[0], v[1], v[2], v[3]); }
              { const f32x4 v = av[4 * q + 2] * rs; o.z = pk4_fp8(v[0], v[1], v[2], v[3]); } { const f32x4 v = av[4 * q + 3] * rs; o.w = pk4_fp8(v[0], v[1], v[2], v[3]); }
              *(u32x4*)(hp + 16 * q) = o; } }
#else
        { const float rs = RSTD[i32]; bf16_t* hp = (bf16_t*)(P.ws + WS_H) + (size_t)(t0 + i32) * 1024 + 128 * w + 64 * kk;
#pragma unroll
          for (int q = 0; q < 8; ++q) { const f32x4 v0 = av[2 * q] * rs, v1 = av[2 * q + 1] * rs; u32x4 o; o.x = pk2(v0[0], v0[1]); o.y = pk2(v0[2], v0[3]); o.z = pk2(v1[0], v1[1]); o.w = pk2(v1[2], v1[3]); *(u32x4*)(hp + 8 * q) = o; } }
#endif
        __syncthreads();
        if (tid < 32) { const int row = tid; float lv[4]; int li[4]; unsigned used = 0u;
            for (int k = 0; k < 4; ++k) { float best = -__builtin_inff(); int bi = 0;
                for (int e = 0; e < 32; ++e) { const float x = LOG[row * 33 + e]; if (!((used >> e) & 1u) && x > best) { best = x; bi = e; } }
                lv[k] = best; li[k] = bi; used |= 1u << bi; }
            const float e1 = expf(lv[1] - lv[0]), e2 = expf(lv[2] - lv[0]), e3 = expf(lv[3] - lv[0]); const float inv = 1.f / (1.f + e1 + e2 + e3);
            const float gt[4] = {inv, e1 * inv, e2 * inv, e3 * inv};
            for (int k = 0; k < 4; ++k) { SELE[row * 4 + k] = li[k]; SELG[row * 4 + k] = gt[k]; SELR[row * 4 + k] = atomicAdd((int*)&HIST[li[k]], 1); } }
        __syncthreads();
        if (tid < 32) { const int n = HIST[tid]; HIST[tid] = n > 0 ? atomicAdd(&cnt[tid], n) : 0; }
        __syncthreads();
        if (tid < 128) { const int row = tid >> 2, k = tid & 3, e = SELE[tid], pos = HIST[e] + SELR[tid]; const int t = t0 + row;
            SLOT[t * 4 + k] = e * T + pos; LIST[e * T + pos] = t; GLIST[e * T + pos] = SELG[tid]; }
        __syncthreads();
    }
}
__device__ __forceinline__ void pool_phase(const Ptrs& P, LAS unsigned char* lds) {
    const int tid = tid_opaque(), lane = tid & 63, w = __builtin_amdgcn_readfirstlane(tid >> 6), fr = lane & 15, fq = lane >> 4;
    constexpr int RS = 1040;
    LAS float* PS = (LAS float*)(lds + 64 * RS);
    const bf16_t* U = (const bf16_t*)(P.ws + WS_U);
    const int g = w >> 1, dh = (w & 1) * 64;
    bf16x8 bfr[4][4];
    { const bf16_t* Wt = (const bf16_t*)(P.ws + WS_WPOOL) + (size_t)g * 128 * 128;
#pragma unroll
      for (int ni = 0; ni < 4; ++ni)
#pragma unroll
          for (int ks = 0; ks < 4; ++ks) bfr[ni][ks] = *(const bf16x8*)(Wt + (size_t)(dh + ni * 16 + fr) * 128 + ks * 32 + 8 * fq); }
    f32x4 bias[4], scl[4];
#pragma unroll
    for (int ni = 0; ni < 4; ++ni) { const int c = g * 128 + dh + ni * 16 + 4 * fq; bias[ni] = *(const f32x4*)(P.b_pool + c); scl[ni] = *(const f32x4*)(P.pool_scale + c); }
    for (int tile = blockIdx.x; tile < T / 64; tile += gridDim.x) {
        const int t0 = tile * 64;
#pragma unroll 2
        for (int q = 0; q < 8; ++q) { const int task = tid + 512 * q, r = task >> 6, cc = task & 63, gg = cc >> 4, win = 2 << gg; const int t = t0 + r, s = t & (SEQ - 1); const int n = s + 1 < win ? s + 1 : win;
            float sum[8];
#pragma unroll
            for (int j = 0; j < 8; ++j) sum[j] = 0.f;
            bf16x8 u0 = {};
            for (int k = 0; k < n; ++k) { const bf16x8 u = *(const bf16x8*)(U + (size_t)(t - k) * 512 + cc * 8); if (k == 0) u0 = u;
#pragma unroll
                for (int j = 0; j < 8; ++j) sum[j] += bf2f((bf16_t)u[j]); }
            const float inv = 1.f / (float)n; u32x4 o;
            o.x = pk2(sum[0] * inv - bf2f((bf16_t)u0[0]), sum[1] * inv - bf2f((bf16_t)u0[1])); o.y = pk2(sum[2] * inv - bf2f((bf16_t)u0[2]), sum[3] * inv - bf2f((bf16_t)u0[3]));
            o.z = pk2(sum[4] * inv - bf2f((bf16_t)u0[4]), sum[5] * inv - bf2f((bf16_t)u0[5])); o.w = pk2(sum[6] * inv - bf2f((bf16_t)u0[6]), sum[7] * inv - bf2f((bf16_t)u0[7]));
            *(LAS u32x4*)(lds + r * RS + cc * 16) = o; }
        __syncthreads();
        f32x4 acc[4][4];
#pragma unroll
        for (int mi = 0; mi < 4; ++mi)
#pragma unroll
            for (int ni = 0; ni < 4; ++ni) acc[mi][ni] = (f32x4){0.f, 0.f, 0.f, 0.f};
#pragma unroll
        for (int ks = 0; ks < 4; ++ks) { bf16x8 a[4];
#pragma unroll
            for (int mi = 0; mi < 4; ++mi) a[mi] = *(const LAS bf16x8*)(lds + (mi * 16 + fr) * RS + (g * 128 + ks * 32 + 8 * fq) * 2);
#pragma unroll
            for (int mi = 0; mi < 4; ++mi)
#pragma unroll
                for (int ni = 0; ni < 4; ++ni) acc[mi][ni] = __builtin_amdgcn_mfma_f32_16x16x32_bf16(bfr[ni][ks], a[mi], acc[mi][ni], 0, 0, 0); }
#pragma unroll
        for (int mi = 0; mi < 4; ++mi) { float s = 0.f;
#pragma unroll
            for (int ni = 0; ni < 4; ++ni) { acc[mi][ni] = (acc[mi][ni] + bias[ni]) * scl[ni]; const f32x4 v = acc[mi][ni]; s += (v[0] * v[0] + v[1] * v[1]) + (v[2] * v[2] + v[3] * v[3]); }
            s += __shfl_xor(s, 16); s += __shfl_xor(s, 32);
            if (fq == 0) PS[(mi * 16 + fr) * 8 + w] = s; }
        __syncthreads();
#pragma unroll
        for (int mi = 0; mi < 4; ++mi) { const int r = mi * 16 + fr; const f32x4 p0 = *(const LAS f32x4*)(PS + r * 8), p1 = *(const LAS f32x4*)(PS + r * 8 + 4);
            const float rstd = 1.f / sqrtf((((p0[0] + p0[1]) + (p0[2] + p0[3])) + ((p1[0] + p1[1]) + (p1[2] + p1[3]))) * (1.f / 512.f) + RMS_EPS);
            bf16_t* mp = (bf16_t*)(P.ws + WS_MIX) + (size_t)(t0 + r) * 1024 + 512 + g * 128 + dh + 4 * fq;
#pragma unroll
            for (int ni = 0; ni < 4; ++ni) { const f32x4 v = acc[mi][ni] * rstd; u32x2 o; o.x = pk2(v[0], v[1]); o.y = pk2(v[2], v[3]); *(u32x2*)(mp + ni * 16) = o; } }
        __syncthreads();
    }
}

#define VB_FOR(vb, NVB) for (int vb = blockIdx.x * 2 + (int)(threadIdx.x >> 8); vb < (NVB); vb += gridDim.x * 2)

__device__ __forceinline__ void nv_gemm_f32(const bf16_t* A, int lda, const bf16_t* Bt, int ldb, float* C, int ldc, int K, int nbx, int nby) {
    const int tid = threadIdx.x & 255, lane = tid & 63, w = tid >> 6, wr = w >> 1, wc = w & 1, fr = lane & 15, fq = lane >> 4;
    VB_FOR(vb, nbx * nby) {
        const int bx = vb % nbx, by = vb / nbx;
        const int row0 = by * 64 + wr * 32, col0 = bx * 128 + wc * 64;
        f32x4 acc[2][4];
#pragma unroll
        for (int i = 0; i < 2; ++i)
#pragma unroll
            for (int j = 0; j < 4; ++j) acc[i][j] = (f32x4){0.f, 0.f, 0.f, 0.f};
        for (int k0 = 0; k0 < K; k0 += 32) {
            bf16x8 a[2], b[4];
#pragma unroll
            for (int i = 0; i < 2; ++i) a[i] = *(const bf16x8*)(A + (size_t)(row0 + i * 16 + fr) * lda + k0 + 8 * fq);
#pragma unroll
            for (int j = 0; j < 4; ++j) b[j] = *(const bf16x8*)(Bt + (size_t)(col0 + j * 16 + fr) * ldb + k0 + 8 * fq);
#pragma unroll
            for (int i = 0; i < 2; ++i)
#pragma unroll
                for (int j = 0; j < 4; ++j) acc[i][j] = __builtin_amdgcn_mfma_f32_16x16x32_bf16(a[i], b[j], acc[i][j], 0, 0, 0);
        }
#pragma unroll
        for (int i = 0; i < 2; ++i)
#pragma unroll
            for (int j = 0; j < 4; ++j)
#pragma unroll
                for (int r = 0; r < 4; ++r) C[(size_t)(row0 + i * 16 + fq * 4 + r) * ldc + col0 + j * 16 + fr] = acc[i][j][r];
    }
}

#define GW_SETUP const int tid = tid_opaque(), lane = tid & 63, wave = tid >> 6; const int gw = blockIdx.x * NWAVES + wave, NGW = gridDim.x * NWAVES; (void)lane; (void)gw; (void)NGW;
#define GT_FOR(i, N) for (size_t i = (size_t)blockIdx.x * 512 + threadIdx.x; i < (size_t)(N); i += (size_t)gridDim.x * 512)

__device__ __forceinline__ void ph_prologue(const Ptrs& P, float* ldsf) {
    GW_SETUP
    float* scr = ldsf + wave * (64 * 33);
    for (int it = gw; it < IT_TOTAL; it += NGW) prologue_item(P, it, scr, lane);
    { bf16_t* w = (bf16_t*)(P.ws + WS_WIN) + (size_t)DINP * 1024; const int n8 = (1024 - DINP) * 1024 / 8;
      GT_FOR(i, n8) ((u32x4*)w)[i] = (u32x4){0u, 0u, 0u, 0u}; }
    for (int m = gw; m < T; m += NGW) rms_row_to_bf16(P.x + (size_t)m * D, P.g_attn, (bf16_t*)(P.ws + WS_XN) + (size_t)m * D, lane);
    { float* C = (float*)(P.ws + WS_COS); float* S = (float*)(P.ws + WS_SIN);
      GT_FOR(i, T * 16) { const int t = (int)(i >> 4), j = (int)(i & 15);
          const float inv = (float)pow(10000.0, -(double)j / 16.0); const float ang = (float)P.pos[t] * inv;
          C[i] = (float)cos((double)ang); S[i] = (float)sin((double)ang); } }
}
__device__ __forceinline__ void ph_e1(const Ptrs& P) {
    GW_SETUP
    const float* PROJ = (const float*)(P.ws + WS_TMP);
    const float* COS = (const float*)(P.ws + WS_COS); const float* SIN = (const float*)(P.ws + WS_SIN);
    for (int t = gw; t < T; t += NGW) {
        const float* pr = PROJ + (size_t)t * 1024;
        bf16_t* u = (bf16_t*)(P.ws + WS_U) + (size_t)t * 512;
        for (int c = lane; c < 512; c += 64) u[c] = (bf16_t)f2bf(pr[c]);
        { float v[4]; float s = 0.f; for (int j = 0; j < 4; ++j) { v[j] = pr[512 + lane + 64 * j]; s += v[j] * v[j]; }
          const float rstd = 1.f / sqrtf(wave_sum(s) * (1.f / 256.f) + RMS_EPS);
          bf16_t* q = (bf16_t*)(P.ws + WS_QN) + (size_t)t * 256;
          for (int j = 0; j < 4; ++j) q[lane + 64 * j] = (bf16_t)f2bf(v[j] * rstd * P.g_q_a[lane + 64 * j]); }
        { float v[2]; float s = 0.f; for (int j = 0; j < 2; ++j) { v[j] = pr[768 + lane + 64 * j]; s += v[j] * v[j]; }
          const float rstd = 1.f / sqrtf(wave_sum(s) * (1.f / 128.f) + RMS_EPS);
          bf16_t* q = (bf16_t*)(P.ws + WS_KVN) + (size_t)t * 128;
          for (int j = 0; j < 2; ++j) q[lane + 64 * j] = (bf16_t)f2bf(v[j] * rstd * P.g_kv_a[lane + 64 * j]); }
        if (lane < 16) { const float x1 = pr[896 + lane], x2 = pr[896 + 16 + lane]; const float c = COS[t * 16 + lane], s = SIN[t * 16 + lane];
          bf16_t* kr = (bf16_t*)(P.ws + WS_KR) + (size_t)t * 32; kr[lane] = (bf16_t)f2bf(x1 * c - x2 * s); kr[16 + lane] = (bf16_t)f2bf(x2 * c + x1 * s); }
    }
}
__device__ __forceinline__ void ph_e2q(const Ptrs& P) {
    const float* TMP = (const float*)(P.ws + WS_TMP); const float* COS = (const float*)(P.ws + WS_COS); const float* SIN = (const float*)(P.ws + WS_SIN);
    bf16_t* Q = (bf16_t*)(P.ws + WS_Q);
    GT_FOR(i, (size_t)T * 768) {
        const int t = (int)(i / 768), c = (int)(i % 768), h = c / 96, d = c % 96; float v;
        if (d < 64) v = TMP[i];
        else { const int j = (d - 64) & 15; const float x1 = TMP[(size_t)t * 768 + h * 96 + 64 + j], x2 = TMP[(size_t)t * 768 + h * 96 + 80 + j]; const float cc = COS[t * 16 + j], ss = SIN[t * 16 + j];
               v = (d < 80) ? (x1 * cc - x2 * ss) : (x2 * cc + x1 * ss); }
        Q[i] = (bf16_t)f2bf(v * QSCALE);
    }
}
__device__ __forceinline__ void ph_e2kv(const Ptrs& P) {
    const float* TMP = (const float*)(P.ws + WS_TMP) + (size_t)T * 1024;
    bf16_t* K = (bf16_t*)(P.ws + WS_K); bf16_t* V = (bf16_t*)(P.ws + WS_V);
    GT_FOR(i, (size_t)T * 512) {
        const int t = (int)(i / 512), c = (int)(i % 512), h = c / 64, d = c % 64;
        K[i] = (bf16_t)f2bf(TMP[(size_t)t * 1024 + h * 128 + d]);
        V[i] = (bf16_t)f2bf(TMP[(size_t)t * 1024 + h * 128 + 64 + d]);
    }
}
__device__ __forceinline__ void ph_pooldiff(const Ptrs& P) {
    const bf16_t* U = (const bf16_t*)(P.ws + WS_U); bf16_t* DIFF = (bf16_t*)(P.ws + WS_H);
    GT_FOR(i, (size_t)T * 512) {
        const int t = (int)(i / 512), c = (int)(i % 512), g = c / 128, s = t % SEQ, w = 2 << g; const int n = s + 1 < w ? s + 1 : w;
        float sum = 0.f; for (int j = 0; j < n; ++j) sum += bf2f(U[(size_t)(t - j) * 512 + c]);
        DIFF[i] = (bf16_t)f2bf(sum / (float)n - bf2f(U[i]));
    }
}
__device__ __forceinline__ void ph_epool(const Ptrs& P, const float* TP) {
    GW_SETUP
    for (int t = gw; t < T; t += NGW) {
        float v[8]; float s = 0.f;
        for (int j = 0; j < 8; ++j) { const int c = lane + 64 * j; v[j] = (TP[(size_t)t * 512 + c] + P.b_pool[c]) * P.pool_scale[c]; s += v[j] * v[j]; }
        const float rstd = 1.f / sqrtf(wave_sum(s) * (1.f / 512.f) + RMS_EPS);
        bf16_t* m = (bf16_t*)(P.ws + WS_MIX) + (size_t)t * 1024 + 512;
        for (int j = 0; j < 8; ++j) m[lane + 64 * j] = (bf16_t)f2bf(v[j] * rstd);
    }
}
__device__ __forceinline__ void ph_attn_naive(const Ptrs& P, float* ldsf) {
    GW_SETUP
    float* qs = ldsf + wave * 96;
    const bf16_t* Q = (const bf16_t*)(P.ws + WS_Q); const bf16_t* K = (const bf16_t*)(P.ws + WS_K); const bf16_t* V = (const bf16_t*)(P.ws + WS_V); const bf16_t* KRp = (const bf16_t*)(P.ws + WS_KR);
    bf16_t* MIX = (bf16_t*)(P.ws + WS_MIX); float* SSQ = (float*)(P.ws + WS_SSQ);
    for (int item = gw; item < T * 8; item += NGW) {
        const int t = item >> 3, h = item & 7, b = t / SEQ, s = t % SEQ;
        for (int d = lane; d < 96; d += 64) qs[d] = bf2f(Q[(size_t)t * 768 + h * 96 + d]);
        asm volatile("s_waitcnt lgkmcnt(0)" ::: "memory");
        float m = -1e30f, l = 0.f, o = 0.f;
        const int ntile = s / 64 + 1;
        for (int kt = 0; kt < ntile; ++kt) {
            const int key = kt * 64 + lane; const size_t krow = (size_t)(b * SEQ + key);
            float sc = -__builtin_inff();
            if (key <= s) { float a = 0.f;
                for (int d8 = 0; d8 < 12; ++d8) { const bf16x8 kv = d8 < 8 ? *(const bf16x8*)(K + krow * 512 + h * 64 + d8 * 8) : *(const bf16x8*)(KRp + krow * 32 + (d8 - 8) * 8);
#pragma unroll
                    for (int j = 0; j < 8; ++j) a += qs[d8 * 8 + j] * bf2f((bf16_t)kv[j]); }
                sc = a; }
            const float mn = fmaxf(m, wave_max(sc)); const float alpha = exp2f(m - mn); const float p = exp2f(sc - mn);
            const float pb = bf2f((bf16_t)f2bf(p));
            l = l * alpha + wave_sum(pb); o *= alpha; m = mn;
            const int nk = (kt == ntile - 1) ? (s - kt * 64 + 1) : 64;
            for (int j = 0; j < nk; ++j) { const float pj = __shfl(pb, j); o += pj * bf2f(V[(size_t)(b * SEQ + kt * 64 + j) * 512 + h * 64 + lane]); }
        }
        const float ov = o / l;
        MIX[(size_t)t * 1024 + h * 64 + lane] = (bf16_t)f2bf(ov);
        const float ss = wave_sum(ov * ov);
        if (lane == 0) SSQ[t * 8 + h] = ss;
        asm volatile("s_waitcnt lgkmcnt(0)" ::: "memory");
    }
}
__device__ __forceinline__ void ph_e4(const Ptrs& P) {
    const float* T1 = (const float*)(P.ws + WS_TMP); const float* T2 = T1 + (size_t)T * 1024; const float* SSQ = (const float*)(P.ws + WS_SSQ);
    GT_FOR(i, (size_t)T * 1024) {
        const int t = (int)(i >> 10); float s = 0.f; for (int h = 0; h < 8; ++h) s += SSQ[t * 8 + h];
        const float sa = 1.f / sqrtf(s * (1.f / 512.f) + RMS_EPS);
        P.out[i] = P.x[i] + sa * T1[i] + T2[i];
    }
}
__device__ __forceinline__ void ph_router(const Ptrs& P, float* ldsf) {
    GW_SETUP
    float* hs = ldsf + wave * 1024;
    int* cnt = (int*)(P.ws + WS_CTL) + CW_CNT; int* SLOT = (int*)(P.ws + WS_SLOT); int* LIST = (int*)(P.ws + WS_LIST); float* GLIST = (float*)(P.ws + WS_GLIST);
    for (int t = gw; t < T; t += NGW) {
        const f32x4* xr = (const f32x4*)(P.out + (size_t)t * 1024) + lane; const f32x4* gr = (const f32x4*)P.g_ffn + lane;
        f32x4 v[4]; float s = 0.f;
        for (int j = 0; j < 4; ++j) { v[j] = xr[64 * j]; s += (v[j].x * v[j].x + v[j].y * v[j].y) + (v[j].z * v[j].z + v[j].w * v[j].w); }
        const float rstd = 1.f / sqrtf(wave_sum(s) * (1.f / 1024.f) + RMS_EPS);
        u32x2* ho = (u32x2*)((bf16_t*)(P.ws + WS_H) + (size_t)t * 1024) + lane;
        for (int j = 0; j < 4; ++j) { const f32x4 gg = gr[64 * j]; f32x4 hv = {v[j].x * rstd * gg.x, v[j].y * rstd * gg.y, v[j].z * rstd * gg.z, v[j].w * rstd * gg.w};
            ((f32x4*)hs)[lane + 64 * j] = hv; u32x2 w; w.x = pk2(hv.x, hv.y); w.y = pk2(hv.z, hv.w); ho[64 * j] = w; }
        asm volatile("s_waitcnt lgkmcnt(0)" ::: "memory");
        const int e = lane & 31, half = lane >> 5; float a = 0.f;
        for (int c = half * 512; c < half * 512 + 512; ++c) a += hs[c] * P.w_router[c * 32 + e];
        a += __shfl_xor(a, 32); a += P.b_router[e];
        float lv[4]; int li[4]; unsigned used = 0u;
        for (int k = 0; k < 4; ++k) { float best = -__builtin_inff(); int bi = 0;
            for (int j = 0; j < 32; ++j) { const float x = __shfl(a, j); if (!((used >> j) & 1u) && x > best) { best = x; bi = j; } }
            lv[k] = best; li[k] = bi; used |= 1u << bi; }
        const float e1 = expf(lv[1] - lv[0]), e2 = expf(lv[2] - lv[0]), e3 = expf(lv[3] - lv[0]); const float inv = 1.f / (1.f + e1 + e2 + e3);
        if (lane < 4) { const int ex = lane == 0 ? li[0] : lane == 1 ? li[1] : lane == 2 ? li[2] : li[3]; const float gt = (lane == 0 ? 1.f : lane == 1 ? e1 : lane == 2 ? e2 : e3) * inv;
            const int pos = atomicAdd(&cnt[ex], 1); SLOT[t * 4 + lane] = ex * T + pos; LIST[ex * T + pos] = t; GLIST[ex * T + pos] = gt; }
        asm volatile("s_waitcnt lgkmcnt(0)" ::: "memory");
    }
}
__device__ __forceinline__ int slot_base(const int* cnt, int e) { int s = 0; for (int i = 0; i < e; ++i) s += (cnt[i] + 255) & ~255; return s; }
__device__ __forceinline__ void ph_moe1_naive(const Ptrs& P) {
    const int* cnt = (const int*)(P.ws + WS_CTL) + CW_CNT;
    const int tid = threadIdx.x & 255, lane = tid & 63, w = tid >> 6, wr = w >> 1, wc = w & 1, fr = lane & 15, fq = lane >> 4;
    const bf16_t* H = (const bf16_t*)(P.ws + WS_H); bf16_t* ACT = (bf16_t*)(P.ws + WS_ACT);
    VB_FOR(vb, 16 * 256 * 32) {
        const int bx = vb & 15, by = (vb >> 4) & 255, e = vb >> 12; const int n = cnt[e], m0 = by * 64; if (m0 >= n) continue;
        const int* LIST = (const int*)(P.ws + WS_LIST) + (size_t)e * T;
        const bf16_t* W = (const bf16_t*)(P.ws + WS_WGU) + (size_t)e * 2048 * 1024;
        const int ca0 = bx * 64 + wc * 32; const int p = ca0 >> 7, r0 = ca0 & 127;
        int tok[2]; for (int i = 0; i < 2; ++i) { int m = m0 + wr * 32 + i * 16 + fr; if (m >= n) m = 0; tok[i] = LIST[m]; }
        f32x4 ag[2][2], au[2][2];
        for (int i = 0; i < 2; ++i) for (int j = 0; j < 2; ++j) { ag[i][j] = (f32x4){0.f, 0.f, 0.f, 0.f}; au[i][j] = (f32x4){0.f, 0.f, 0.f, 0.f}; }
        for (int k0 = 0; k0 < 1024; k0 += 32) {
            bf16x8 a[2], bg[2], bu[2];
            for (int i = 0; i < 2; ++i) a[i] = *(const bf16x8*)(H + (size_t)tok[i] * 1024 + k0 + 8 * fq);
            for (int j = 0; j < 2; ++j) { bg[j] = *(const bf16x8*)(W + (size_t)(256 * p + r0 + j * 16 + fr) * 1024 + k0 + 8 * fq); bu[j] = *(const bf16x8*)(W + (size_t)(256 * p + 128 + r0 + j * 16 + fr) * 1024 + k0 + 8 * fq); }
            for (int i = 0; i < 2; ++i) for (int j = 0; j < 2; ++j) { ag[i][j] = __builtin_amdgcn_mfma_f32_16x16x32_bf16(a[i], bg[j], ag[i][j], 0, 0, 0); au[i][j] = __builtin_amdgcn_mfma_f32_16x16x32_bf16(a[i], bu[j], au[i][j], 0, 0, 0); }
        }
        const int sb = slot_base(cnt, e);
        for (int i = 0; i < 2; ++i) for (int j = 0; j < 2; ++j) for (int r = 0; r < 4; ++r) {
            const int m = m0 + wr * 32 + i * 16 + fq * 4 + r, c = ca0 + j * 16 + fr; if (m >= n) continue;
            float g = ag[i][j][r] + P.b_gu[e * 2048 + c], u = au[i][j][r] + P.b_gu[e * 2048 + 1024 + c];
            g = fminf(g, 7.f); u = fminf(fmaxf(u, -7.f), 7.f);
            const float act = g * (1.f / (1.f + expf(-1.702f * g))) * (u + 1.f);
            ACT[(size_t)(sb + m) * 1024 + c] = (bf16_t)f2bf(act);
        }
    }
}
__device__ __forceinline__ void ph_moe2_naive(const Ptrs& P) {
    const int* cnt = (const int*)(P.ws + WS_CTL) + CW_CNT;
    const int tid = threadIdx.x & 255, lane = tid & 63, w = tid >> 6, wr = w >> 1, wc = w & 1, fr = lane & 15, fq = lane >> 4;
    VB_FOR(vb, 8 * 256 * 32) {
        const int bx = vb & 7, by = (vb >> 3) & 255, e = vb >> 11; const int n = cnt[e], m0 = by * 64; if (m0 >= n) continue;
        const int sb = slot_base(cnt, e); const bf16_t* ACT = (const bf16_t*)(P.ws + WS_ACT) + (size_t)sb * 1024; bf16_t* Y = (bf16_t*)(P.ws + WS_Y) + (size_t)sb * 1024;
        const bf16_t* W = (const bf16_t*)(P.ws + WS_WD) + (size_t)e * 1024 * 1024; const float* GL = (const float*)(P.ws + WS_GLIST) + (size_t)e * T;
        const int col0 = bx * 128 + wc * 64, row0 = m0 + wr * 32;
        f32x4 acc[2][4]; for (int i = 0; i < 2; ++i) for (int j = 0; j < 4; ++j) acc[i][j] = (f32x4){0.f, 0.f, 0.f, 0.f};
        for (int k0 = 0; k0 < 1024; k0 += 32) {
            bf16x8 a[2], b[4];
            for (int i = 0; i < 2; ++i) { int m = row0 + i * 16 + fr; if (m >= n) m = 0; a[i] = *(const bf16x8*)(ACT + (size_t)m * 1024 + k0 + 8 * fq); }
            for (int j = 0; j < 4; ++j) b[j] = *(const bf16x8*)(W + (size_t)(col0 + j * 16 + fr) * 1024 + k0 + 8 * fq);
            for (int i = 0; i < 2; ++i) for (int j = 0; j < 4; ++j) acc[i][j] = __builtin_amdgcn_mfma_f32_16x16x32_bf16(a[i], b[j], acc[i][j], 0, 0, 0);
        }
        for (int i = 0; i < 2; ++i) for (int j = 0; j < 4; ++j) for (int r = 0; r < 4; ++r) {
            const int m = row0 + i * 16 + fq * 4 + r, c = col0 + j * 16 + fr; if (m >= n) continue;
            Y[(size_t)m * 1024 + c] = (bf16_t)f2bf((acc[i][j][r] + P.b_down[e * 1024 + c]) * GL[m]);
        }
    }
}
__device__ __forceinline__ void ph_final(const Ptrs& P, int* sbase) {
    GW_SETUP
    const int* cnt = (const int*)(P.ws + WS_CTL) + CW_CNT; const int* SLOT = (const int*)(P.ws + WS_SLOT); const bf16_t* Y = (const bf16_t*)(P.ws + WS_Y);
    if (tid < 32) sbase[tid] = slot_base(cnt, tid);
    __syncthreads();
    for (int t = gw; t < T; t += NGW) {
        f32x4* xr = (f32x4*)(P.out + (size_t)t * 1024) + lane; const f32x4* gr = (const f32x4*)P.g_final + lane;
        f32x4 v[4]; for (int j = 0; j < 4; ++j) v[j] = xr[64 * j];
        for (int k = 0; k < 4; ++k) { const int sl = SLOT[t * 4 + k]; const int e = sl / T, pos = sl % T; const u32x2* yr = (const u32x2*)(Y + (size_t)(sbase[e] + pos) * 1024) + lane;
            for (int j = 0; j < 4; ++j) { const u32x2 w = yr[64 * j]; v[j].x += __builtin_bit_cast(float, w.x << 16); v[j].y += __builtin_bit_cast(float, w.x & 0xffff0000u); v[j].z += __builtin_bit_cast(float, w.y << 16); v[j].w += __builtin_bit_cast(float, w.y & 0xffff0000u); } }
        float s = 0.f; for (int j = 0; j < 4; ++j) s += (v[j].x * v[j].x + v[j].y * v[j].y) + (v[j].z * v[j].z + v[j].w * v[j].w);
        const float rstd = 1.f / sqrtf(wave_sum(s) * (1.f / 1024.f) + RMS_EPS);
        for (int j = 0; j < 4; ++j) { const f32x4 gg = gr[64 * j]; xr[64 * j] = (f32x4){v[j].x * rstd * gg.x, v[j].y * rstd * gg.y, v[j].z * rstd * gg.z, v[j].w * rstd * gg.w}; }
    }
}

__global__ void __launch_bounds__(NWAVES * 64, 2) mega_fwd(Ptrs P) {
    extern __shared__ __attribute__((aligned(16))) unsigned char lds[];
    const int tid = threadIdx.x;
    for (int u = tid; u < (LDS_BYTES - LDSCTL_OFF) / 4; u += NWAVES * 64) ((LAS unsigned*)((LAS unsigned char*)lds + LDSCTL_OFF))[u] = 0u;
    __syncthreads();
    unsigned* ctl = (unsigned*)(P.ws + WS_CTL);
    XcdBarrier bar = xcd_barrier_post(ctl + CW_BAR, (volatile LAS unsigned*)((LAS unsigned char*)lds + MISC_OFF) + 8);
    float* ldsf = (float*)lds;
    float* TMP = (float*)(P.ws + WS_TMP);
    unsigned char* ws = P.ws;
#define GRID_BAR() xcd_barrier(bar)
#ifndef PROBE_REP
#define PROBE_REP (-1)
#endif
#if PROBE_REP >= 0
#define REPS(k) int _reps##k = 1 + ((PROBE_REP) == (k) ? 1 : 0); asm volatile("" : "+s"(_reps##k)); for (int _r = 0; _r < _reps##k; ++_r)
#else
#define REPS(k)
#endif
    { REPS(0) { ph_prologue(P, ldsf); GRID_BAR(); } }
    LAS unsigned char* L = (LAS unsigned char*)lds; const int G = gridDim.x, c = blockIdx.x;
#if FAST_INPROJ
    { REPS(1) {
    { pg8::DenseOrder S; S.init(ws + WS_XN, ws + WS_WIN, T, 1024, 1024, G, c);
      pg8::EpiInProj E{(bf16_t*)(ws + WS_U), (bf16_t*)(ws + WS_QN), (bf16_t*)(ws + WS_KVN), (bf16_t*)(ws + WS_KR), P.g_q_a, P.g_kv_a, (const float*)(ws + WS_COS), (const float*)(ws + WS_SIN)};
      pg8::gemm_phase<pg8::EpiInProj, pg8::DenseOrder, false, false>(L, 1024, S, E); }
    GRID_BAR(); } }
#else
    nv_gemm_f32((const bf16_t*)(ws + WS_XN), 1024, (const bf16_t*)(ws + WS_WIN), 1024, TMP, 1024, 1024, 8, T / 64); GRID_BAR();
    ph_e1(P); GRID_BAR();
#endif
#if FAST_QKV
    { REPS(2) {
#ifndef NO_QB
    { pg8::DenseOrder S; S.init(ws + WS_QN, ws + WS_WQB, T, 768, 256, G, c);
      pg8::EpiQ E{(bf16_t*)(ws + WS_Q), (const float*)(ws + WS_COS), (const float*)(ws + WS_SIN)};
      pg8::gemm_phase<pg8::EpiQ, pg8::DenseOrder, true, false>(L, 256, S, E); }
#endif
#ifndef NO_KVB
    { pg8::DenseOrder S; S.init(ws + WS_KVN, ws + WS_WKVB, T, 1024, 128, G, c);
      pg8::EpiKV E{(bf16_t*)(ws + WS_K), (bf16_t*)(ws + WS_V)};
      pg8::gemm_phase<pg8::EpiKV, pg8::DenseOrder, true, false>(L, 128, S, E); }
#endif
#if FAST_POOL
    pool_phase(P, L);
#else
    ph_pooldiff(P);
#endif
    GRID_BAR(); } }
#else
    nv_gemm_f32((const bf16_t*)(ws + WS_QN), 256, (const bf16_t*)(ws + WS_WQB), 256, TMP, 768, 256, 6, T / 64);
    nv_gemm_f32((const bf16_t*)(ws + WS_KVN), 128, (const bf16_t*)(ws + WS_WKVB), 128, TMP + (size_t)T * 1024, 1024, 128, 8, T / 64);
    ph_pooldiff(P); GRID_BAR();
    ph_e2q(P); ph_e2kv(P);
#endif
#if !(FAST_POOL && FAST_QKV)
    for (int g = 0; g < 4; ++g)
        nv_gemm_f32((const bf16_t*)(ws + WS_H) + g * 128, 512, (const bf16_t*)(ws + WS_WPOOL) + (size_t)g * 128 * 128, 128, (float*)(ws + WS_ACT) + g * 128, 512, 128, 1, T / 64);
    GRID_BAR();
    ph_epool(P, (const float*)(ws + WS_ACT));
#endif
#if FAST_ATTN
    { REPS(3) { att::attn_phase(P, (char*)lds); GRID_BAR(); } }
#else
    ph_attn_naive(P, ldsf); GRID_BAR();
#endif
#if FAST_WOUT
    { REPS(4) {
    { pg8::DenseOrder S; S.init(ws + WS_MIX, ws + WS_WOUT, T, 1024, 1024, G, c);
      pg8::EpiOut E{P.x, P.out, (const float*)(ws + WS_SSQ), SA_OFF};
      pg8::gemm_phase<pg8::EpiOut, pg8::DenseOrder, false, false>(L, 1024, S, E); }
    GRID_BAR(); } }
#else
    nv_gemm_f32((const bf16_t*)(ws + WS_MIX), 1024, (const bf16_t*)(ws + WS_WOUT), 1024, TMP, 1024, 512, 8, T / 64);
    nv_gemm_f32((const bf16_t*)(ws + WS_MIX) + 512, 1024, (const bf16_t*)(ws + WS_WOUT) + 512, 1024, TMP + (size_t)T * 1024, 1024, 512, 8, T / 64);
    GRID_BAR();
    ph_e4(P); GRID_BAR();
#endif
#if FAST_ROUTER
    router_phase(P, L); GRID_BAR();
#else
    ph_router(P, ldsf); GRID_BAR();
#endif
#if FAST_MOE
    { REPS(6) {
#if FP8_MOE
    { pg8::MoeOrder<true> S{(const char*)(ws + WS_H), (const char*)(ws + WS_WGU), (size_t)2048 * 1024, 8, G, c, GT_OFF, (const LAS int*)(L + TS_OFF), 1024};
      moe_setup<true>(P, L, S);
      pg8::EpiSwiglu8 E{P.b_gu, ws + WS_ACT};
      pg8::gemm_phase<pg8::EpiSwiglu8, pg8::MoeOrder<true>, true, true, true>(L, 512, S, E); }
    GRID_BAR(); } }
    { REPS(7) {
    { pg8::MoeOrder<false> S{(const char*)(ws + WS_ACT), (const char*)(ws + WS_WD), (size_t)1024 * 1024, 4, G, c, 0, (const LAS int*)(L + TS_OFF), 1024};
      moe_setup<false>(P, L, S);
      pg8::EpiDown8 E{P.b_down, (const float*)(ws + WS_GLIST), (bf16_t*)(ws + WS_Y)};
      pg8::gemm_phase<pg8::EpiDown8, pg8::MoeOrder<false>, true, false, true>(L, 512, S, E); }
    GRID_BAR(); } }
#else
    { pg8::MoeOrder<true> S{(const char*)(ws + WS_H), (const char*)(ws + WS_WGU), (size_t)2048 * 1024 * 2, 8, G, c, GT_OFF, (const LAS int*)(L + TS_OFF), 2048};
      moe_setup<true>(P, L, S);
      pg8::EpiSwiglu E{P.b_gu, (bf16_t*)(ws + WS_ACT)};
      pg8::gemm_phase<pg8::EpiSwiglu, pg8::MoeOrder<true>, true, true>(L, 1024, S, E); }
    GRID_BAR(); } }
    { REPS(7) {
    { pg8::MoeOrder<false> S{(const char*)(ws + WS_ACT), (const char*)(ws + WS_WD), (size_t)1024 * 1024 * 2, 4, G, c, 0, (const LAS int*)(L + TS_OFF), 2048};
      moe_setup<false>(P, L, S);
      pg8::EpiDown E{P.b_down, (const float*)(ws + WS_GLIST), (bf16_t*)(ws + WS_Y)};
      pg8::gemm_phase<pg8::EpiDown, pg8::MoeOrder<false>, true, false>(L, 1024, S, E); }
    GRID_BAR(); } }
#endif
#else
    ph_moe1_naive(P); GRID_BAR();
    ph_moe2_naive(P); GRID_BAR();
#endif
    ph_final(P, (int*)lds);
}

extern "C" void kernel_launch(void* const* d_in, const int* in_sizes, int n_in, void* d_out, int out_size, void* d_ws, size_t ws_size, hipStream_t stream) {
    static int grid = 0;
    if (grid == 0) {
        if (n_in != 22 || out_size != T * D || ws_size < WS_END) { fprintf(stderr, "kernel_launch: unexpected shapes (n_in %d out %d ws %zu)\n", n_in, out_size, ws_size); grid = -1; return; }
        int dev = 0, cus = 0, per_cu = 0;
        if (hipGetDevice(&dev) != hipSuccess || hipDeviceGetAttribute(&cus, hipDeviceAttributeMultiprocessorCount, dev) != hipSuccess) { grid = -1; return; }
        if (hipFuncSetAttribute((const void*)mega_fwd, hipFuncAttributeMaxDynamicSharedMemorySize, LDS_BYTES) != hipSuccess) { fprintf(stderr, "kernel_launch: hipFuncSetAttribute failed\n"); grid = -1; return; }
        if (hipOccupancyMaxActiveBlocksPerMultiprocessor(&per_cu, (const void*)mega_fwd, NWAVES * 64, LDS_BYTES) != hipSuccess || per_cu < 1) fprintf(stderr, "kernel_launch: occupancy query reports %d\n", per_cu);
        (void)hipGetLastError();
        grid = cus;
    }
    if (grid < 0) return;
    Ptrs P{};
    P.x = (const float*)d_in[0]; P.pos = (const int*)d_in[1]; P.g_attn = (const float*)d_in[2]; P.w_in = (const float*)d_in[3]; P.w_pool = (const float*)d_in[4];
    P.b_pool = (const float*)d_in[5]; P.pool_scale = (const float*)d_in[6]; P.g_q_a = (const float*)d_in[7]; P.w_q_b = (const float*)d_in[8]; P.g_kv_a = (const float*)d_in[9];
    P.w_kv_b = (const float*)d_in[10]; P.g_out_pool = (const float*)d_in[11]; P.g_out_attn = (const float*)d_in[12]; P.w_out = (const float*)d_in[13]; P.g_ffn = (const float*)d_in[14];
    P.w_router = (const float*)d_in[15]; P.b_router = (const float*)d_in[16]; P.w_gu = (const float*)d_in[17]; P.b_gu = (const float*)d_in[18]; P.w_down = (const float*)d_in[19];
    P.b_down = (const float*)d_in[20]; P.g_final = (const float*)d_in[21]; P.out = (float*)d_out; P.ws = (unsigned char*)d_ws;
    if (hipMemsetAsync((unsigned char*)d_ws + WS_CTL, 0, CTL_BYTES, stream) != hipSuccess) { fprintf(stderr, "kernel_launch: memset failed\n"); return; }
    hipLaunchKernelGGL(mega_fwd, dim3(grid), dim3(NWAVES * 64), LDS_BYTES, stream, P);
}
```

```cpp
#include <hip/hip_runtime.h>
#ifndef FP8_MOE
#define FP8_MOE 1
#endif
#include <cstdint>
#include <cstdio>

typedef unsigned short bf16_t;
typedef short bf16x8 __attribute__((ext_vector_type(8)));
typedef float f32x4 __attribute__((ext_vector_type(4)));
typedef unsigned u32x4 __attribute__((ext_vector_type(4)));
typedef unsigned u32x2 __attribute__((ext_vector_type(2)));

constexpr int BATCH = 2, SEQ = 8192, T = BATCH * SEQ, D = 1024;
constexpr int DPOOL = 512, NPG = 4, PGD = 128;
constexpr int NH = 8, VD = 64, QKN = 64, QKR = 32, QKD = 96;
constexpr int QLR = 256, KVLR = 128, DINP = 928;
constexpr int NE = 32, TOPK = 4, DE = 1024;
constexpr float RMS_EPS = 1e-6f;
constexpr float QSCALE = 0.10206207261596577f * 1.4426950408889634f;
constexpr int SLOT_ROWS = T * TOPK + NE * 256;

constexpr size_t MiB = 1u << 20;
constexpr size_t WS_CTL = 0;
constexpr size_t CTL_BYTES = 1 * MiB;
constexpr size_t WS_COS = 1 * MiB, WS_SIN = 2 * MiB;
constexpr size_t WS_WIN = 4 * MiB;
constexpr size_t WS_WQB = 6 * MiB;
constexpr size_t WS_WKVB = 7 * MiB;
constexpr size_t WS_WPOOL = 7 * MiB + 512 * 1024;
constexpr size_t WS_WOUT = 8 * MiB;
constexpr size_t WS_WGU = 16 * MiB;
constexpr size_t WS_WD = 144 * MiB;
constexpr size_t WS_XN = 208 * MiB;
constexpr size_t WS_U = 240 * MiB;
constexpr size_t WS_QN = 256 * MiB;
constexpr size_t WS_KVN = 264 * MiB;
constexpr size_t WS_KR = 268 * MiB;
constexpr size_t WS_Q = 272 * MiB;
constexpr size_t WS_K = 296 * MiB;
constexpr size_t WS_V = 320 * MiB;
constexpr size_t WS_MIX = 336 * MiB;
constexpr size_t WS_SSQ = 368 * MiB;
constexpr size_t WS_H = 370 * MiB;
constexpr size_t WS_SLOT = 402 * MiB;
constexpr size_t WS_LIST = 403 * MiB;
constexpr size_t WS_GLIST = 405 * MiB;
constexpr size_t WS_ACT = 408 * MiB;
constexpr size_t WS_Y = 552 * MiB;
constexpr size_t WS_TMP = 700 * MiB;
constexpr size_t WS_END = 828 * MiB;
constexpr int CW_CNT = 64;

__device__ __forceinline__ unsigned f2bf(float f) { unsigned u = __builtin_bit_cast(unsigned, f); return (u + 0x7fffu + ((u >> 16) & 1u)) >> 16; }
__device__ __forceinline__ unsigned pk2(float lo, float hi) { return f2bf(lo) | (f2bf(hi) << 16); }
__device__ __forceinline__ float bf2f(bf16_t b) { return __builtin_bit_cast(float, (unsigned)b << 16); }
__device__ __forceinline__ float wave_sum(float v) {
#pragma unroll
    for (int o = 1; o < 64; o <<= 1) v += __shfl_xor(v, o);
    return v;
}
__device__ __forceinline__ float wave_max(float v) {
#pragma unroll
    for (int o = 1; o < 64; o <<= 1) v = fmaxf(v, __shfl_xor(v, o));
    return v;
}

typedef int v8i_t __attribute__((ext_vector_type(8)));
constexpr float W8_SCALE = 64.f, W8_INV = 1.f / 64.f;
__device__ __forceinline__ float clamp8(float x) { return fminf(fmaxf(x, -448.f), 448.f); }
__device__ __forceinline__ unsigned pk4_fp8(float a, float b, float c, float d) {
    int p = 0; p = __builtin_amdgcn_cvt_pk_fp8_f32(clamp8(a), clamp8(b), p, false); p = __builtin_amdgcn_cvt_pk_fp8_f32(clamp8(c), clamp8(d), p, true); return (unsigned)p; }
__device__ __forceinline__ int tid_opaque() { int t = threadIdx.x; asm volatile("" : "+v"(t)); return t; }

__device__ __forceinline__ void transpose_item(const float* W, int ldw, int k0, int n0, bf16_t* WT, int ldt, int dn0, int dk0,
                                               const float* ksc, float* scr, int lane) {
    { const int kq = lane >> 3, n4 = (lane & 7) * 4; f32x4 v[8];
#pragma unroll
      for (int i = 0; i < 8; ++i) v[i] = *(const f32x4*)(W + (size_t)(k0 + 8 * i + kq) * ldw + n0 + n4);
#pragma unroll
      for (int i = 0; i < 8; ++i) { const int kk = 8 * i + kq; f32x4 x = v[i]; if (ksc) x = x * ksc[kk];
          scr[kk * 33 + n4 + 0] = x[0]; scr[kk * 33 + n4 + 1] = x[1]; scr[kk * 33 + n4 + 2] = x[2]; scr[kk * 33 + n4 + 3] = x[3]; } }
    asm volatile("s_waitcnt lgkmcnt(0)" ::: "memory");
    const int c = lane & 7;
#pragma unroll
    for (int j = 0; j < 4; ++j) { const int n = (lane >> 3) + 8 * j; const float* s = scr + (8 * c) * 33 + n;
        u32x4 o; o.x = pk2(s[0 * 33], s[1 * 33]); o.y = pk2(s[2 * 33], s[3 * 33]); o.z = pk2(s[4 * 33], s[5 * 33]); o.w = pk2(s[6 * 33], s[7 * 33]);
        *(u32x4*)(WT + (size_t)(dn0 + n) * ldt + dk0 + 8 * c) = o; }
    asm volatile("s_waitcnt lgkmcnt(0)" ::: "memory");
}

__device__ __forceinline__ void transpose_item8(const float* W, int ldw, int k0, int n0, unsigned char* WT, int ldt, int dn0, int dk0, float* scr, int lane) {
    { const int kq = lane >> 3, n4 = (lane & 7) * 4; f32x4 v[8];
#pragma unroll
      for (int i = 0; i < 8; ++i) v[i] = *(const f32x4*)(W + (size_t)(k0 + 8 * i + kq) * ldw + n0 + n4);
#pragma unroll
      for (int i = 0; i < 8; ++i) { const int kk = 8 * i + kq; const f32x4 x = v[i] * W8_SCALE;
          scr[kk * 33 + n4 + 0] = x[0]; scr[kk * 33 + n4 + 1] = x[1]; scr[kk * 33 + n4 + 2] = x[2]; scr[kk * 33 + n4 + 3] = x[3]; } }
    asm volatile("s_waitcnt lgkmcnt(0)" ::: "memory");
    const int c = lane & 7;
#pragma unroll
    for (int j = 0; j < 4; ++j) { const int n = (lane >> 3) + 8 * j; const float* q = scr + (8 * c) * 33 + n;
        u32x2 o; o.x = pk4_fp8(q[0 * 33], q[1 * 33], q[2 * 33], q[3 * 33]); o.y = pk4_fp8(q[4 * 33], q[5 * 33], q[6 * 33], q[7 * 33]);
        *(u32x2*)(WT + (size_t)(dn0 + n) * ldt + dk0 + 8 * c) = o; }
    asm volatile("s_waitcnt lgkmcnt(0)" ::: "memory");
}

struct Ptrs {
    const float* x; const int* pos; const float* g_attn; const float* w_in; const float* w_pool; const float* b_pool; const float* pool_scale;
    const float* g_q_a; const float* w_q_b; const float* g_kv_a; const float* w_kv_b; const float* g_out_pool; const float* g_out_attn; const float* w_out;
    const float* g_ffn; const float* w_router; const float* b_router; const float* w_gu; const float* b_gu; const float* w_down; const float* b_down; const float* g_final;
    float* out; unsigned char* ws;
};

constexpr int IT_IN = 16 * 29, IT_QB = 4 * 24, IT_KVB = 2 * 32, IT_POOL = 4 * 2 * 4, IT_OUT = 16 * 32, IT_GU = 32 * 16 * 64, IT_DN = 32 * 16 * 32;
constexpr int IT_TOTAL = IT_IN + IT_QB + IT_KVB + IT_POOL + IT_OUT + IT_GU + IT_DN;

__device__ __forceinline__ void prologue_item(const Ptrs& P, int it, float* scr, int lane) {
    unsigned char* ws = P.ws;
    int r = it;
    if (r < IT_IN) { const int kb = r / 29, nb = r % 29; transpose_item(P.w_in, DINP, 64 * kb, 32 * nb, (bf16_t*)(ws + WS_WIN), 1024, 32 * nb, 64 * kb, nullptr, scr, lane); return; } r -= IT_IN;
    if (r < IT_QB) { const int kb = r / 24, nb = r % 24; transpose_item(P.w_q_b, 768, 64 * kb, 32 * nb, (bf16_t*)(ws + WS_WQB), 256, 32 * nb, 64 * kb, nullptr, scr, lane); return; } r -= IT_QB;
    if (r < IT_KVB) { const int kb = r / 32, nb = r % 32; transpose_item(P.w_kv_b, 1024, 64 * kb, 32 * nb, (bf16_t*)(ws + WS_WKVB), 128, 32 * nb, 64 * kb, nullptr, scr, lane); return; } r -= IT_KVB;
    if (r < IT_POOL) { const int g = r / 8, kb = (r % 8) / 4, nb = r % 4; transpose_item(P.w_pool + (size_t)g * 128 * 128, 128, 64 * kb, 32 * nb, (bf16_t*)(ws + WS_WPOOL) + (size_t)g * 128 * 128, 128, 32 * nb, 64 * kb, nullptr, scr, lane); return; } r -= IT_POOL;
    if (r < IT_OUT) { const int kb = r / 32, nb = r % 32, k0 = 64 * kb; const float* ksc = k0 < 512 ? P.g_out_pool + k0 : P.g_out_attn + (k0 - 512);
        transpose_item(P.w_out, 1024, k0, 32 * nb, (bf16_t*)(ws + WS_WOUT), 1024, 32 * nb, (k0 + 512) & 1023, ksc, scr, lane); return; } r -= IT_OUT;
    if (r < IT_GU) { const int e = r / 1024, q = r % 1024, kb = q / 64, nb = q % 64, n0 = 32 * nb; const int nn = n0 & 1023, p = nn >> 7, dn0 = 256 * p + (n0 >= 1024 ? 128 : 0) + (nn & 127);
#if FP8_MOE
        transpose_item8(P.w_gu + (size_t)e * 1024 * 2048, 2048, 64 * kb, n0, ws + WS_WGU + (size_t)e * 2048 * 1024, 1024, dn0, 64 * kb, scr, lane); return; } r -= IT_GU;
#else
        transpose_item(P.w_gu + (size_t)e * 1024 * 2048, 2048, 64 * kb, n0, (bf16_t*)(ws + WS_WGU) + (size_t)e * 2048 * 1024, 1024, dn0, 64 * kb, nullptr, scr, lane); return; } r -= IT_GU;
#endif
    { const int e = r / 512, q = r % 512, kb = q / 32, nb = q % 32;
#if FP8_MOE
        transpose_item8(P.w_down + (size_t)e * 1024 * 1024, 1024, 64 * kb, 32 * nb, ws + WS_WD + (size_t)e * 1024 * 1024, 1024, 32 * nb, 64 * kb, scr, lane); }
#else
        transpose_item(P.w_down + (size_t)e * 1024 * 1024, 1024, 64 * kb, 32 * nb, (bf16_t*)(ws + WS_WD) + (size_t)e * 1024 * 1024, 1024, 32 * nb, 64 * kb, nullptr, scr, lane); }
#endif
}

__device__ __forceinline__ void rms_row_to_bf16(const float* xrow, const float* g, bf16_t* orow, int lane) {
    const f32x4* xr = (const f32x4*)xrow + lane; const f32x4* gr = (const f32x4*)g + lane;
    f32x4 v[4]; float s = 0.f;
#pragma unroll
    for (int j = 0; j < 4; ++j) { v[j] = xr[64 * j]; s += (v[j].x * v[j].x + v[j].y * v[j].y) + (v[j].z * v[j].z + v[j].w * v[j].w); }
    const float rstd = 1.f / sqrtf(wave_sum(s) * (1.f / 1024.f) + RMS_EPS);
    u32x2* o8 = (u32x2*)orow + lane;
#pragma unroll
    for (int j = 0; j < 4; ++j) { const f32x4 gg = gr[64 * j]; u32x2 w; w.x = pk2(v[j].x * rstd * gg.x, v[j].y * rstd * gg.y); w.y = pk2(v[j].z * rstd * gg.z, v[j].w * rstd * gg.w); o8[64 * j] = w; }
}

#define LAS __attribute__((address_space(3)))
#define XB_TMO      128
#define XB_XCNT(j)  (256  + 64 * (j))
#define XB_XSUB(j)  (1280 + 64 * (j))
#define XB_XGEN(j)  (2304 + 64 * (j))
#define XB_TOP      3328
#define XB_TOPGEN   3392
#define XCD_BAR_WORDS 3456
#define XB_SPIN_CAP (1u << 18)
__device__ __forceinline__ unsigned xb_ld(unsigned* p)              { return __hip_atomic_load(p, __ATOMIC_RELAXED, __HIP_MEMORY_SCOPE_AGENT); }
__device__ __forceinline__ unsigned xb_add(unsigned* p, unsigned v) { return __hip_atomic_fetch_add(p, v, __ATOMIC_RELAXED, __HIP_MEMORY_SCOPE_AGENT); }
__device__ __forceinline__ unsigned xb_xcc_id() { return (unsigned)__builtin_amdgcn_s_getreg((3 << 11) | 20) & 0xFu; }
#define XB_SPIN(cond, bar) do { unsigned _sp = 0; while (cond) { __builtin_amdgcn_s_sleep(1); \
    if ((++_sp & 255u) == 0u) { if (xb_ld(&(bar)[XB_TMO])) break; if (_sp > XB_SPIN_CAP) { atomicAdd(&(bar)[XB_TMO], 1u); break; } } } } while (0)
struct XcdBarrier { unsigned* bar; unsigned x; volatile LAS unsigned* st; };
__device__ __forceinline__ XcdBarrier xcd_barrier_post(unsigned* bar, volatile LAS unsigned* st) {
    XcdBarrier b; b.bar = bar; b.x = xb_xcc_id(); b.st = st;
    if (threadIdx.x == 0) (void)xb_add(&bar[XB_XCNT(b.x)], 1u);
    return b;
}
__device__ __forceinline__ void xcd_barrier_complete(unsigned* bar, unsigned x, unsigned& nloc, unsigned& nx) {
    const unsigned G = gridDim.x * gridDim.y * gridDim.z;
    unsigned sum, cnt, mine, sp = 0u;
    for (;;) {
        sum = 0u; cnt = 0u; mine = 0u;
#pragma unroll
        for (unsigned j = 0; j < 16; ++j) { const unsigned c = xb_ld(&bar[XB_XCNT(j)]); sum += c; cnt += (c > 0u) ? 1u : 0u; mine = (j == x) ? c : mine; }
        if (sum == G) break;
        __builtin_amdgcn_s_sleep(1);
        if ((++sp & 255u) == 0u) { if (xb_ld(&bar[XB_TMO])) break; if (sp > XB_SPIN_CAP) { atomicAdd(&bar[XB_TMO], 1u); break; } }
    }
    nloc = mine > 0u ? mine : 1u; nx = cnt > 0u ? cnt : 1u;
}
__device__ __forceinline__ void xcd_barrier(const XcdBarrier& b) {
    asm volatile("s_waitcnt vmcnt(0)" ::: "memory");
    __syncthreads();
    if (threadIdx.x == 0) {
        unsigned* bar = b.bar;
        __builtin_amdgcn_s_waitcnt(0);
        unsigned nloc = b.st[0], nx = b.st[1];
        if (nloc == 0u) { xcd_barrier_complete(bar, b.x, nloc, nx); b.st[0] = nloc; b.st[1] = nx; }
        const unsigned old = xb_add(&bar[XB_XSUB(b.x)], 1u);
        const unsigned gen = old / nloc;
        if (old + 1u == (gen + 1u) * nloc) {
            __builtin_amdgcn_fence(__ATOMIC_RELEASE, "agent");
            asm volatile("s_waitcnt vmcnt(0)" ::: "memory");
            const unsigned og = xb_add(&bar[XB_TOP], 1u);
            const unsigned tg = og / nx;
            if (og + 1u == (tg + 1u) * nx) xb_add(&bar[XB_TOPGEN], 1u);
            else XB_SPIN(xb_ld(&bar[XB_TOPGEN]) == tg, bar);
            __builtin_amdgcn_fence(__ATOMIC_ACQUIRE, "agent");
            xb_add(&bar[XB_XGEN(b.x)], 1u);
            asm volatile("s_waitcnt vmcnt(0)" ::: "memory");
        } else {
            XB_SPIN(xb_ld(&bar[XB_XGEN(b.x)]) == gen, bar);
            __builtin_amdgcn_fence(__ATOMIC_ACQUIRE, "agent");
            asm volatile("s_waitcnt vmcnt(0)" ::: "memory");
        }
    }
    __syncthreads();
}

constexpr int NWAVES = 8;
constexpr int RING_BYTES = 131072;
constexpr int LDSCTL_OFF = RING_BYTES, MISC_OFF = LDSCTL_OFF + 320;
constexpr int LDS_BYTES = 147456;
constexpr int CW_BAR = 4096;
constexpr int TS_OFF = 131584;
constexpr int SA_OFF = 131840;
constexpr int GT_OFF = 132864;
static_assert(GT_OFF + 9 * 1024 <= LDS_BYTES, "LDS map");
#ifndef FAST_INPROJ
#define FAST_INPROJ 1
#endif
#ifndef FAST_QKV
#define FAST_QKV 1
#endif
#ifndef FAST_WOUT
#define FAST_WOUT 1
#endif
#ifndef FAST_MOE
#define FAST_MOE 1
#endif
#ifndef FAST_ATTN
#define FAST_ATTN 1
#endif
#ifndef FAST_ROUTER
#define FAST_ROUTER 1
#endif
#ifndef FAST_POOL
#define FAST_POOL 1
#endif


namespace pg8 {
typedef int v4i_t __attribute__((ext_vector_type(4)));
#define PG8_LAS __attribute__((address_space(3)))
constexpr int BM = 256, BK = 64, HALF = 128, HTB = HALF * BK * 2, STAGE_BYTES = 8 * HTB, NXCD = 8, WGM = 8;
__host__ __device__ __forceinline__ int lds_byte(int r, int c) { const int st = (r >> 4) * 2 + (c >> 5), rr = r & 15, cc = c & 31, ob = rr * 64 + cc * 2; return st * 1024 + (ob ^ (((ob >> 9) & 1) << 5)); }
__host__ __device__ __forceinline__ void stage_rc(int b, int& R, int& C) { const int st = b / 1024, sb = b % 1024, swz = sb ^ (((sb >> 9) & 1) << 5); R = (st >> 1) * 16 + swz / 64; C = (st & 1) * 32 + (swz % 64) / 2; }
__host__ __device__ __forceinline__ int perm32(int rho) { const int n = rho >> 4, i = rho & 15; return 8 * (i >> 2) + 4 * n + (i & 3); }
__device__ __forceinline__ unsigned cvt_pk_bf16(float lo, float hi) { unsigned r; asm volatile("v_cvt_pk_bf16_f32 %0, %1, %2" : "=v"(r) : "v"(lo), "v"(hi)); return r; }

struct Unit { const char* a; const char* b; int pm, pn, e, rt; };

struct DenseOrder {
    const char* A; const char* Bt; int nM, nN, nwg, G, c, K;
    __device__ void init(const void* A_, const void* Bt_, int M, int N, int K_, int G_, int c_) { A = (const char*)A_; Bt = (const char*)Bt_; nM = M / BM; nN = N / BM; nwg = nM * nN; G = G_; c = c_; K = K_; }
    __device__ bool next(int i, Unit& u) const {
        const long L = (long)i * G + c; if (L >= nwg) return false;
        int wgid = (int)L; { const int q = nwg / NXCD, r = nwg % NXCD, xcd = wgid % NXCD, off = wgid / NXCD; wgid = (xcd < r ? xcd * (q + 1) : r * (q + 1) + (xcd - r) * q) + off; }
        const int nig = WGM * nN, gid = wgid / nig, fm = gid * WGM, gsz = (nM - fm) < WGM ? (nM - fm) : WGM;
        u.pm = fm + ((wgid % nig) % gsz); u.pn = (wgid % nig) / gsz; u.e = 0; u.rt = 0;
        u.a = A + (size_t)u.pm * BM * K * 2; u.b = Bt + (size_t)u.pn * BM * K * 2; return true;
    }
};

template <class Epi, class Sched, bool ALIGN_EPI, bool GATHER, bool FP8 = false>
__device__ __forceinline__ void gemm_phase(PG8_LAS unsigned char* lds, const int K_, const Sched& S, const Epi& E) {
    int K = K_; asm volatile("" : "+s"(K));
    const int tid = tid_opaque(), wid = __builtin_amdgcn_readfirstlane(tid >> 6), lane = tid & 63, wr = wid >> 2, wc = wid & 3, fr = lane & 15, fq = lane >> 4;
    const int nt = K / BK;
    unsigned voffA0, voffB0; int rowA0;
    { int R, C; stage_rc(tid * 16, R, C); const int Rb = Epi::PERM ? ((R & ~31) + perm32(R & 31)) : R;
      voffA0 = GATHER ? (unsigned)(C * 2) : (unsigned)(R * K + C) * 2u; voffB0 = (unsigned)(Rb * K + C) * 2u; rowA0 = R; }
    const unsigned r64 = (unsigned)(64 * K * 2);
    const size_t kstep = (size_t)(BK * 2);
    const size_t hstep = (size_t)HALF * K * 2;
    const unsigned ldsw = (unsigned)wid * 1024u;
    const int aoff = lds_byte(wr * 64 + fr, fq * 8), boff = lds_byte(wc * 32 + fr, fq * 8);
#define PG8_SA(b, h) (((b) * 2 + (h)) * HTB)
#define PG8_SB(b, h) ((4 + (b) * 2 + (h)) * HTB)
#define PG8_STAGE(bufoff, gbase, voff) do { _Pragma("unroll") for (int _i = 0; _i < 2; ++_i) \
        __builtin_amdgcn_global_load_lds((const unsigned*)((const char*)(gbase) + (size_t)(_i * r64) + (voff)), (PG8_LAS unsigned*)(lds + (bufoff) + ldsw + _i * 8192), 16, 0, 0); } while (0)
#define PG8_STAGE_A(bufoff, abase, rtab, h, koff) do { if constexpr (GATHER) { _Pragma("unroll") for (int _i = 0; _i < 2; ++_i) { \
            const unsigned _ro = *(const PG8_LAS unsigned*)(lds + (rtab) + ((h) * HALF + _i * 64 + rowA0) * 4); \
            __builtin_amdgcn_global_load_lds((const unsigned*)((const char*)(abase) + (koff) + (size_t)(_ro + voffA0)), (PG8_LAS unsigned*)(lds + (bufoff) + ldsw + _i * 8192), 16, 0, 0); } } \
        else { PG8_STAGE(bufoff, (const char*)(abase) + (h) * hstep + (koff), voffA0); } } while (0)
#define PG8_LDA(dst, b, h) do { _Pragma("unroll") for (int m = 0; m < 4; ++m) _Pragma("unroll") for (int k = 0; k < 2; ++k) dst[m][k] = *(const PG8_LAS bf16x8*)(lds + PG8_SA(b, h) + aoff + m * 2048 + k * 1024); } while (0)
#define PG8_LDB(dst, b, h) do { _Pragma("unroll") for (int n = 0; n < 2; ++n) _Pragma("unroll") for (int k = 0; k < 2; ++k) dst[n][k] = *(const PG8_LAS bf16x8*)(lds + PG8_SB(b, h) + boff + n * 2048 + k * 1024); } while (0)
#define PG8_CAT(x) __builtin_shufflevector(__builtin_bit_cast(v4i_t, (x)[0]), __builtin_bit_cast(v4i_t, (x)[1]), 0, 1, 2, 3, 4, 5, 6, 7)
#define PG8_MMA(ai, bj, At, Bt) do { __builtin_amdgcn_s_setprio(1); \
        if constexpr (FP8) { _Pragma("unroll") for (int m = 0; m < 4; ++m) _Pragma("unroll") for (int n = 0; n < 2; ++n) \
            asm volatile("v_mfma_scale_f32_16x16x128_f8f6f4 %0, %1, %2, %0, %3, %3 op_sel_hi:[0,0,0]" : "+v"(acc[ai][bj][m][n]) : "v"(PG8_CAT(Bt[n])), "v"(PG8_CAT(At[m])), "v"(sc1)); } \
        else { _Pragma("unroll") for (int m = 0; m < 4; ++m) _Pragma("unroll") for (int n = 0; n < 2; ++n) _Pragma("unroll") for (int k = 0; k < 2; ++k) \
            acc[ai][bj][m][n] = __builtin_amdgcn_mfma_f32_16x16x32_bf16(Bt[n][k], At[m][k], acc[ai][bj][m][n], 0, 0, 0); } \
        __builtin_amdgcn_s_setprio(0); } while (0)
#define PG8_WAIT_V(n) asm volatile("s_waitcnt vmcnt(" #n ")" ::: "memory")
#define PG8_WAIT_L(n) asm volatile("s_waitcnt lgkmcnt(" #n ")" ::: "memory")
#define PG8_BAR __builtin_amdgcn_s_barrier()
#define PG8_SCHED __builtin_amdgcn_sched_barrier(0)
    Unit cur, nxt; int ui = 0;
    if (!S.next(0, cur)) return;
    f32x4 acc[2][2][4][2];
#pragma unroll
    for (int a = 0; a < 2; ++a)
#pragma unroll
        for (int b = 0; b < 2; ++b)
#pragma unroll
            for (int m = 0; m < 4; ++m)
#pragma unroll
                for (int n = 0; n < 2; ++n) acc[a][b][m][n] = (f32x4){0.f, 0.f, 0.f, 0.f};
    bf16x8 At[4][2], B0[2][2], B1[2][2];
    int sc1 = 0x7f7f7f7f; asm volatile("" : "+v"(sc1));
    const char* cA = cur.a; const char* cB = cur.b; int cR = cur.rt;
    if constexpr (Epi::MID) E.pre(cur, lds, tid);
    PG8_STAGE(PG8_SB(0, 0), cB, voffB0); PG8_STAGE(PG8_SB(0, 1), cB + hstep, voffB0); PG8_STAGE_A(PG8_SA(0, 0), cA, cR, 0, 0); PG8_STAGE_A(PG8_SA(0, 1), cA, cR, 1, 0);
    if (wr == 1) PG8_BAR;
    PG8_WAIT_V(2); PG8_BAR;
    PG8_STAGE(PG8_SB(1, 0), cB + kstep, voffB0); PG8_STAGE_A(PG8_SA(1, 0), cA, cR, 0, kstep); PG8_STAGE(PG8_SB(1, 1), cB + hstep + kstep, voffB0);
    PG8_WAIT_V(6); PG8_BAR;
    for (;;) {
        const bool has_next = S.next(ui + 1, nxt);
        const char* nA = has_next ? nxt.a : cA; const char* nB = has_next ? nxt.b : cB; const int nR = has_next ? nxt.rt : cR;
        for (int t = 0; t < nt; t += 2) {
            const bool last = (t == nt - 2);
            if constexpr (Epi::MID) { if (t == nt / 2) E.mid(acc, wr, fr, lds); }
            const size_t k1 = (size_t)(t + 1) * kstep;
            const char* a2 = last ? nA : cA; const char* b2 = last ? nB : cB + (size_t)(t + 2) * kstep; const int r2 = last ? nR : cR;
            const size_t k2 = last ? 0 : (size_t)(t + 2) * kstep, k3 = k2 + kstep; const char* b3 = b2 + kstep;
            PG8_LDB(B0, 0, 0); PG8_LDB(B1, 0, 1); PG8_SCHED; PG8_LDA(At, 0, 0); PG8_STAGE_A(PG8_SA(1, 1), cA, cR, 1, k1);
            PG8_WAIT_V(8); PG8_WAIT_L(0); PG8_BAR; PG8_MMA(0, 0, At, B0); PG8_MMA(0, 1, At, B1); PG8_BAR; PG8_SCHED;
            PG8_LDA(At, 0, 1); PG8_STAGE(PG8_SB(0, 0), b2, voffB0); PG8_STAGE(PG8_SB(0, 1), b2 + hstep, voffB0); PG8_STAGE_A(PG8_SA(0, 0), a2, r2, 0, k2);
            PG8_WAIT_V(8); PG8_WAIT_L(0); PG8_BAR; PG8_MMA(1, 0, At, B0); PG8_MMA(1, 1, At, B1); PG8_BAR; PG8_SCHED;
            PG8_LDB(B0, 1, 0); PG8_LDB(B1, 1, 1); PG8_SCHED; PG8_LDA(At, 1, 0); PG8_STAGE_A(PG8_SA(0, 1), a2, r2, 1, k2);
            PG8_WAIT_V(8); PG8_WAIT_L(0); PG8_BAR; PG8_MMA(0, 0, At, B0); PG8_MMA(0, 1, At, B1); PG8_BAR; PG8_SCHED;
            PG8_LDA(At, 1, 1); PG8_STAGE(PG8_SB(1, 0), b3, voffB0); PG8_STAGE(PG8_SB(1, 1), b3 + hstep, voffB0); PG8_STAGE_A(PG8_SA(1, 0), a2, r2, 0, k3);
            PG8_WAIT_V(8); PG8_WAIT_L(0); PG8_BAR; PG8_MMA(1, 0, At, B0); PG8_MMA(1, 1, At, B1); PG8_BAR; PG8_SCHED;
        }
        if constexpr (ALIGN_EPI) { if (wr == 0) PG8_BAR; }
        if constexpr (FP8) {
            asm volatile("s_nop 15\n\ts_nop 15\n\ts_nop 7" ::: "memory");
            _Pragma("unroll") for (int a = 0; a < 2; ++a) _Pragma("unroll") for (int b = 0; b < 2; ++b) _Pragma("unroll") for (int m = 0; m < 4; ++m) _Pragma("unroll") for (int n = 0; n < 2; ++n)
                asm volatile("" : "+v"(acc[a][b][m][n]));
        }
        if constexpr (!Epi::AFTER_DRAIN) { E(acc, cur, wr, wc, fr, fq); }
        if (!has_next) break;
#pragma unroll
        for (int a = 0; a < 2; ++a)
#pragma unroll
            for (int b = 0; b < 2; ++b)
#pragma unroll
                for (int m = 0; m < 4; ++m)
#pragma unroll
                    for (int n = 0; n < 2; ++n) acc[a][b][m][n] = (f32x4){0.f, 0.f, 0.f, 0.f};
        cur = nxt; cA = nA; cB = nB; cR = nR; ++ui;
        if constexpr (ALIGN_EPI) { if (wr == 1) PG8_BAR; }
    }
    PG8_WAIT_V(0);
    if constexpr (!ALIGN_EPI) { if (wr == 0) PG8_BAR; }
    PG8_BAR;
    if constexpr (Epi::AFTER_DRAIN) { E.fused(acc, cur, wr, wc, fr, fq, lds, wid, lane); }
#undef PG8_SA
#undef PG8_SB
#undef PG8_STAGE
#undef PG8_STAGE_A
#undef PG8_LDA
#undef PG8_LDB
#undef PG8_MMA
#undef PG8_CAT
#undef PG8_WAIT_V
#undef PG8_WAIT_L
#undef PG8_BAR
#undef PG8_SCHED
}

struct EpiInProj {
    static constexpr bool PERM = false, AFTER_DRAIN = true, MID = false;
    bf16_t* U; bf16_t* QN; bf16_t* KVN; bf16_t* KR; const float* g_q_a; const float* g_kv_a; const float* COS; const float* SIN;
    __device__ __forceinline__ void fused(f32x4 (&acc)[2][2][4][2], const Unit& u, int wr, int wc, int fr, int fq, PG8_LAS unsigned char* lds, int wid, int lane) const {
        const int row0 = u.pm * BM + wr * 64 + fr;
        if (u.pn < 2) {
#pragma unroll
            for (int ai = 0; ai < 2; ++ai)
#pragma unroll
                for (int m = 0; m < 4; ++m) { bf16_t* rowp = U + (size_t)(row0 + ai * HALF + m * 16) * 512 + u.pn * 256 + wc * 32 + 4 * fq;
#pragma unroll
                    for (int bj = 0; bj < 2; ++bj)
#pragma unroll
                        for (int n = 0; n < 2; ++n) { const f32x4 v = acc[ai][bj][m][n]; u32x2 w; w.x = cvt_pk_bf16(v[0], v[1]); w.y = cvt_pk_bf16(v[2], v[3]); *(u32x2*)(rowp + bj * HALF + n * 16) = w; } }
            return;
        }
        const bool isq = (u.pn == 2);
        PG8_LAS float* Pp = (PG8_LAS float*)lds;
#pragma unroll
        for (int ai = 0; ai < 2; ++ai)
#pragma unroll
            for (int m = 0; m < 4; ++m) { float s = 0.f;
#pragma unroll
                for (int bj = 0; bj < 2; ++bj) { if (bj == 1 && !isq) continue;
#pragma unroll
                    for (int n = 0; n < 2; ++n) { const f32x4 x = acc[ai][bj][m][n]; s += (x[0] * x[0] + x[1] * x[1]) + (x[2] * x[2] + x[3] * x[3]); } }
                s += __shfl_xor(s, 16); s += __shfl_xor(s, 32);
                if (fq == 0) Pp[(ai * HALF + wr * 64 + m * 16 + fr) * 4 + wc] = s; }
        asm volatile("s_waitcnt lgkmcnt(0)" ::: "memory"); __builtin_amdgcn_s_barrier(); asm volatile("" ::: "memory");
        const float invn = isq ? (1.f / 256.f) : (1.f / 128.f);
#pragma unroll
        for (int ai = 0; ai < 2; ++ai)
#pragma unroll
            for (int m = 0; m < 4; ++m) { const int rl = ai * HALF + wr * 64 + m * 16 + fr; const f32x4 p4 = *(const PG8_LAS f32x4*)(Pp + rl * 4);
                const float rstd = 1.f / sqrtf(((p4[0] + p4[1]) + (p4[2] + p4[3])) * invn + RMS_EPS); const size_t row = (size_t)(u.pm * BM + rl);
                if (isq) {
#pragma unroll
                    for (int bj = 0; bj < 2; ++bj)
#pragma unroll
                        for (int n = 0; n < 2; ++n) { const int c = bj * HALF + wc * 32 + n * 16 + 4 * fq; const f32x4 g = *(const f32x4*)(g_q_a + c); const f32x4 v = acc[ai][bj][m][n] * rstd * g;
                            u32x2 w; w.x = cvt_pk_bf16(v[0], v[1]); w.y = cvt_pk_bf16(v[2], v[3]); *(u32x2*)(QN + row * 256 + c) = w; }
                } else {
#pragma unroll
                    for (int n = 0; n < 2; ++n) { const int c = wc * 32 + n * 16 + 4 * fq; const f32x4 g = *(const f32x4*)(g_kv_a + c); const f32x4 v = acc[ai][0][m][n] * rstd * g;
                        u32x2 w; w.x = cvt_pk_bf16(v[0], v[1]); w.y = cvt_pk_bf16(v[2], v[3]); *(u32x2*)(KVN + row * 128 + c) = w; }
                    if (wc == 0) { const f32x4 x1 = acc[ai][1][m][0], x2 = acc[ai][1][m][1]; const f32x4 cs = *(const f32x4*)(COS + row * 16 + 4 * fq), sn = *(const f32x4*)(SIN + row * 16 + 4 * fq);
                        const f32x4 o1 = x1 * cs - x2 * sn, o2 = x2 * cs + x1 * sn; u32x2 w1, w2; w1.x = cvt_pk_bf16(o1[0], o1[1]); w1.y = cvt_pk_bf16(o1[2], o1[3]); w2.x = cvt_pk_bf16(o2[0], o2[1]); w2.y = cvt_pk_bf16(o2[2], o2[3]);
                        *(u32x2*)(KR + row * 32 + 4 * fq) = w1; *(u32x2*)(KR + row * 32 + 16 + 4 * fq) = w2; }
                } }
    }
};
}
namespace pg8 {
struct EpiQ {
    static constexpr bool PERM = false, AFTER_DRAIN = false, MID = false;
    bf16_t* Q; const float* COS; const float* SIN;
    __device__ __forceinline__ void operator()(const f32x4 (&acc)[2][2][4][2], const Unit& u, int wr, int wc, int fr, int fq) const {
        const int row0 = u.pm * BM + wr * 64 + fr; const int G0 = 8 * u.pn + wc, G1 = G0 + 4; const bool r0 = (G0 % 3) == 2, r1 = (G1 % 3) == 2;
#pragma unroll
        for (int ai = 0; ai < 2; ++ai)
#pragma unroll
            for (int m = 0; m < 4; ++m) { const size_t row = (size_t)(row0 + ai * HALF + m * 16);
                f32x4 cs = {1.f, 1.f, 1.f, 1.f}, sn = {0.f, 0.f, 0.f, 0.f};
                if (r0 || r1) { cs = *(const f32x4*)(COS + row * 16 + 4 * fq); sn = *(const f32x4*)(SIN + row * 16 + 4 * fq); }
#pragma unroll
                for (int bj = 0; bj < 2; ++bj) { const bool rope = bj ? r1 : r0; const int cb = 32 * (bj ? G1 : G0) + 4 * fq; f32x4 o1 = acc[ai][bj][m][0], o2 = acc[ai][bj][m][1];
                    if (rope) { const f32x4 x1 = o1, x2 = o2; o1 = x1 * cs - x2 * sn; o2 = x2 * cs + x1 * sn; }
                    o1 = o1 * QSCALE; o2 = o2 * QSCALE; u32x2 w1, w2; w1.x = cvt_pk_bf16(o1[0], o1[1]); w1.y = cvt_pk_bf16(o1[2], o1[3]); w2.x = cvt_pk_bf16(o2[0], o2[1]); w2.y = cvt_pk_bf16(o2[2], o2[3]);
                    *(u32x2*)(Q + row * 768 + cb) = w1; *(u32x2*)(Q + row * 768 + cb + 16) = w2; }
                asm volatile("" ::: "memory"); }
    }
};
struct EpiKV {
    static constexpr bool PERM = true, AFTER_DRAIN = false, MID = false;
    bf16_t* Kn; bf16_t* V;
    __device__ __forceinline__ void operator()(const f32x4 (&acc)[2][2][4][2], const Unit& u, int wr, int wc, int fr, int fq) const {
        const int row0 = u.pm * BM + wr * 64 + fr;
#pragma unroll
        for (int bj = 0; bj < 2; ++bj) { const int head = 2 * u.pn + bj; bf16_t* dst = (wc < 2 ? Kn + head * 64 + wc * 32 : V + head * 64 + (wc - 2) * 32) + 8 * fq;
#pragma unroll
            for (int ai = 0; ai < 2; ++ai)
#pragma unroll
                for (int m = 0; m < 4; ++m) { const size_t row = (size_t)(row0 + ai * HALF + m * 16); const f32x4 v0 = acc[ai][bj][m][0], v1 = acc[ai][bj][m][1];
                    u32x4 w; w.x = cvt_pk_bf16(v0[0], v0[1]); w.y = cvt_pk_bf16(v0[2], v0[3]); w.z = cvt_pk_bf16(v1[0], v1[1]); w.w = cvt_pk_bf16(v1[2], v1[3]); *(u32x4*)(dst + row * 512) = w; } }
    }
};
struct EpiOut {
    static constexpr bool PERM = false, AFTER_DRAIN = false, MID = true;
    const float* x; float* out; const float* SSQ; int aux_off;
    __device__ __forceinline__ void pre(const Unit& u, PG8_LAS unsigned char* lds, int tid) const {
        if (tid < 256) { const f32x4 a = *(const f32x4*)(SSQ + (size_t)(u.pm * BM + tid) * 8), b = *(const f32x4*)(SSQ + (size_t)(u.pm * BM + tid) * 8 + 4);
            const float s = ((a[0] + a[1]) + (a[2] + a[3])) + ((b[0] + b[1]) + (b[2] + b[3])); ((PG8_LAS float*)(lds + aux_off))[tid] = 1.f / sqrtf(s * (1.f / 512.f) + RMS_EPS); }
    }
    __device__ __forceinline__ void mid(f32x4 (&acc)[2][2][4][2], int wr, int fr, PG8_LAS unsigned char* lds) const {
#pragma unroll
        for (int ai = 0; ai < 2; ++ai)
#pragma unroll
            for (int m = 0; m < 4; ++m) { const float sa = ((const PG8_LAS float*)(lds + aux_off))[ai * HALF + wr * 64 + m * 16 + fr];
#pragma unroll
                for (int bj = 0; bj < 2; ++bj)
#pragma unroll
                    for (int n = 0; n < 2; ++n) acc[ai][bj][m][n] = acc[ai][bj][m][n] * sa; }
    }
    __device__ __forceinline__ void operator()(const f32x4 (&acc)[2][2][4][2], const Unit& u, int wr, int wc, int fr, int fq) const {
        const int row0 = u.pm * BM + wr * 64 + fr, col0 = u.pn * BM + wc * 32 + 4 * fq;
#pragma unroll
        for (int ai = 0; ai < 2; ++ai)
#pragma unroll
            for (int m = 0; m < 4; ++m) { const size_t off = (size_t)(row0 + ai * HALF + m * 16) * 1024 + col0;
#pragma unroll
                for (int bj = 0; bj < 2; ++bj)
#pragma unroll
                    for (int n = 0; n < 2; ++n) *(f32x4*)(out + off + bj * HALF + n * 16) = *(const f32x4*)(x + off + bj * HALF + n * 16) + acc[ai][bj][m][n]; }
    }
};
struct EpiSwiglu {
    static constexpr bool PERM = true, AFTER_DRAIN = false, MID = false;
    const float* bgu; bf16_t* ACT;
    __device__ __forceinline__ void operator()(const f32x4 (&acc)[2][2][4][2], const Unit& u, int wr, int wc, int fr, int fq) const {
        const int row0 = u.pm * BM + wr * 64 + fr, col8 = u.pn * HALF + wc * 32 + 8 * fq;
        f32x4 bg[2], bu[2];
#pragma unroll
        for (int n = 0; n < 2; ++n) { bg[n] = *(const f32x4*)(bgu + (size_t)u.e * 2048 + col8 + 4 * n); bu[n] = *(const f32x4*)(bgu + (size_t)u.e * 2048 + 1024 + col8 + 4 * n); }
#pragma unroll
        for (int ai = 0; ai < 2; ++ai)
#pragma unroll
            for (int m = 0; m < 4; ++m) { f32x4 a[2];
#pragma unroll
                for (int n = 0; n < 2; ++n) { const f32x4 g4 = acc[ai][0][m][n] + bg[n], u4 = acc[ai][1][m][n] + bu[n];
#pragma unroll
                    for (int j = 0; j < 4; ++j) { const float g = fminf(g4[j], 7.f), uu = fminf(fmaxf(u4[j], -7.f), 7.f);
                        const float sg = __builtin_amdgcn_rcpf(1.f + __builtin_amdgcn_exp2f(-1.702f * 1.4426950408889634f * g)); a[n][j] = g * sg * (uu + 1.f); } }
                u32x4 w; w.x = cvt_pk_bf16(a[0][0], a[0][1]); w.y = cvt_pk_bf16(a[0][2], a[0][3]); w.z = cvt_pk_bf16(a[1][0], a[1][1]); w.w = cvt_pk_bf16(a[1][2], a[1][3]);
                *(u32x4*)(ACT + (size_t)(row0 + ai * HALF + m * 16) * 1024 + col8) = w; }
    }
};
struct EpiDown {
    static constexpr bool PERM = true, AFTER_DRAIN = false, MID = false;
    const float* bd; const float* GL; bf16_t* Y;
    __device__ __forceinline__ void operator()(const f32x4 (&acc)[2][2][4][2], const Unit& u, int wr, int wc, int fr, int fq) const {
        const int col0 = u.pn * BM + wc * 32 + 8 * fq;
        f32x4 bv[2][2];
#pragma unroll
        for (int bj = 0; bj < 2; ++bj)
#pragma unroll
            for (int n = 0; n < 2; ++n) bv[bj][n] = *(const f32x4*)(bd + (size_t)u.e * 1024 + col0 + bj * HALF + 4 * n);
#pragma unroll
        for (int ai = 0; ai < 2; ++ai)
#pragma unroll
            for (int m = 0; m < 4; ++m) { const int rl = ai * HALF + wr * 64 + m * 16 + fr; const float gt = GL[(size_t)u.e * T + u.rt + rl]; bf16_t* rowp = Y + (size_t)(u.pm * BM + rl) * 1024 + col0;
#pragma unroll
                for (int bj = 0; bj < 2; ++bj) { const f32x4 v0 = (acc[ai][bj][m][0] + bv[bj][0]) * gt, v1 = (acc[ai][bj][m][1] + bv[bj][1]) * gt;
                    u32x4 w; w.x = cvt_pk_bf16(v0[0], v0[1]); w.y = cvt_pk_bf16(v0[2], v0[3]); w.z = cvt_pk_bf16(v1[0], v1[1]); w.w = cvt_pk_bf16(v1[2], v1[3]); *(u32x4*)(rowp + bj * HALF) = w; } }
    }
};
struct EpiSwiglu8 {
    static constexpr bool PERM = true, AFTER_DRAIN = false, MID = false;
    const float* bgu; unsigned char* ACT;
    __device__ __forceinline__ void operator()(const f32x4 (&acc)[2][2][4][2], const Unit& u, int wr, int wc, int fr, int fq) const {
        const int row0 = u.pm * BM + wr * 64 + fr, col8 = u.pn * HALF + wc * 32 + 8 * fq;
        f32x4 bg[2], bu[2];
#pragma unroll
        for (int n = 0; n < 2; ++n) { bg[n] = *(const f32x4*)(bgu + (size_t)u.e * 2048 + col8 + 4 * n); bu[n] = *(const f32x4*)(bgu + (size_t)u.e * 2048 + 1024 + col8 + 4 * n); }
#pragma unroll
        for (int ai = 0; ai < 2; ++ai)
#pragma unroll
            for (int m = 0; m < 4; ++m) { f32x4 a[2];
#pragma unroll
                for (int n = 0; n < 2; ++n) { const f32x4 g4 = acc[ai][0][m][n] * W8_INV + bg[n], u4 = acc[ai][1][m][n] * W8_INV + bu[n];
#pragma unroll
                    for (int j = 0; j < 4; ++j) { const float g = fminf(g4[j], 7.f), uu = fminf(fmaxf(u4[j], -7.f), 7.f);
                        const float sg = __builtin_amdgcn_rcpf(1.f + __builtin_amdgcn_exp2f(-1.702f * 1.4426950408889634f * g)); a[n][j] = g * sg * (uu + 1.f); } }
                u32x2 w; w.x = pk4_fp8(a[0][0], a[0][1], a[0][2], a[0][3]); w.y = pk4_fp8(a[1][0], a[1][1], a[1][2], a[1][3]);
                *(u32x2*)(ACT + (size_t)(row0 + ai * HALF + m * 16) * 1024 + col8) = w; }
    }
};
struct EpiDown8 {
    static constexpr bool PERM = true, AFTER_DRAIN = false, MID = false;
    const float* bd; const float* GL; bf16_t* Y;
    __device__ __forceinline__ void operator()(const f32x4 (&acc)[2][2][4][2], const Unit& u, int wr, int wc, int fr, int fq) const {
        const int col0 = u.pn * BM + wc * 32 + 8 * fq;
        f32x4 bv[2][2];
#pragma unroll
        for (int bj = 0; bj < 2; ++bj)
#pragma unroll
            for (int n = 0; n < 2; ++n) bv[bj][n] = *(const f32x4*)(bd + (size_t)u.e * 1024 + col0 + bj * HALF + 4 * n);
#pragma unroll
        for (int ai = 0; ai < 2; ++ai)
#pragma unroll
            for (int m = 0; m < 4; ++m) { const int rl = ai * HALF + wr * 64 + m * 16 + fr; const float gt = GL[(size_t)u.e * T + u.rt + rl]; bf16_t* rowp = Y + (size_t)(u.pm * BM + rl) * 1024 + col0;
#pragma unroll
                for (int bj = 0; bj < 2; ++bj) { const f32x4 v0 = (acc[ai][bj][m][0] * W8_INV + bv[bj][0]) * gt, v1 = (acc[ai][bj][m][1] * W8_INV + bv[bj][1]) * gt;
                    u32x4 w; w.x = cvt_pk_bf16(v0[0], v0[1]); w.y = cvt_pk_bf16(v0[2], v0[3]); w.z = cvt_pk_bf16(v1[0], v1[1]); w.w = cvt_pk_bf16(v1[2], v1[3]); *(u32x4*)(rowp + bj * HALF) = w; } }
    }
};
template <bool GATHER>
struct MoeOrder {
    const char* A; const char* W; size_t wstride; int NN, G, c, rt0; const PG8_LAS int* tstart; int rowbytes;
    __device__ bool next(int i, Unit& u) const {
        const int nwg = tstart[32] * NN; const long L = (long)i * G + c; if (L >= nwg) return false;
        int wgid = (int)L; { const int q = nwg / NXCD, r = nwg % NXCD, xcd = wgid % NXCD, off = wgid / NXCD; wgid = (xcd < r ? xcd * (q + 1) : r * (q + 1) + (xcd - r) * q) + off; }
        const int mt = wgid / NN, pn = wgid % NN; int e = 0;
        for (int k = 1; k < 32; ++k) e += (tstart[k] <= mt) ? 1 : 0;
        u.pm = mt; u.pn = pn; u.e = e; const int jt = mt - tstart[e];
        u.a = GATHER ? A : A + (size_t)mt * BM * rowbytes; u.b = W + (size_t)e * wstride + (size_t)pn * BM * rowbytes;
        u.rt = GATHER ? rt0 + i * 1024 : jt * 256;
        return true;
    }
};
}

template <bool GATHER>
__device__ __forceinline__ void moe_setup(const Ptrs& P, LAS unsigned char* lds, const pg8::MoeOrder<GATHER>& S) {
    const int tid = threadIdx.x; const int* cnt = (const int*)(P.ws + WS_CTL) + CW_CNT;
    if (tid < 33) { int s = 0; for (int e = 0; e < tid; ++e) s += (cnt[e] + 255) >> 8; ((LAS int*)(lds + TS_OFF))[tid] = s; }
    __syncthreads();
    if constexpr (GATHER) {
        const int* LIST = (const int*)(P.ws + WS_LIST); pg8::Unit u;
        for (int i = 0; i < 9 && S.next(i, u); ++i) {
            if (tid < 256) { const int jt = u.pm - S.tstart[u.e]; int pos = jt * 256 + tid; const int n = cnt[u.e]; if (pos >= n) pos = n - 1;
                ((LAS unsigned*)(lds + GT_OFF + i * 1024))[tid] = (unsigned)LIST[(size_t)u.e * T + pos] * (unsigned)S.rowbytes; }
        }
        __syncthreads();
    }
}
namespace att {
typedef short s16x4 __attribute__((ext_vector_type(4)));
typedef float f32x16 __attribute__((ext_vector_type(16)));
constexpr int NW = 8, QBLK = 32, KVBLK = 64, QB = NW * QBLK;
constexpr int SHM_V = KVBLK * 64 * 2, SHM_K = KVBLK * 256;
constexpr int OFF_V = 0, OFF_K = 2 * SHM_V, OFF_WS = OFF_K + 2 * SHM_K, OFF_OST = OFF_WS + NW * 64 * 4, ATT_LDS = OFF_OST + NW * 4096;
constexpr float THR2 = 11.5f;
#define KSWZ(row, colB) ((row) * 256 + ((colB) ^ (((row) & 7) << 4)))
#define SBAR() __builtin_amdgcn_sched_barrier(0)
__device__ __forceinline__ int v_st(int k, int c) { const int kk = (k & ~0xC) | ((k & 4) << 1) | ((k & 8) >> 1); return ((kk >> 3) * 2 + (c >> 5)) * 512 + ((kk & 7) * 32 + (c & 31)) * 2; }
__device__ __forceinline__ int v_rd_base(int lane) { return ((lane & 3) << 3) | (((lane >> 2) & 3) << 6) | (((lane >> 4) & 1) << 5) | (((lane >> 5) & 1) << 8); }
__device__ __forceinline__ int crow(int r, int hi) { return (r & 3) + 8 * (r >> 2) + 4 * hi; }
__device__ __forceinline__ unsigned cvtpk(float lo, float hi) { unsigned r; asm volatile("v_cvt_pk_bf16_f32 %0, %1, %2" : "=v"(r) : "v"(lo), "v"(hi)); return r; }
__device__ __forceinline__ void mask_tile(f32x16& p0, f32x16& p1, int dq) {
    const float NEG = -__builtin_inff();
#pragma unroll
    for (int r = 0; r < 16; ++r) { const int c = (r & 3) + 8 * (r >> 2); if (dq - c < 0) p0[r] = NEG; if (dq - c - 32 < 0) p1[r] = NEG; }
}
__device__ __forceinline__ void partialSM(f32x16& p0, f32x16& p1, float& m_reg, float& mn, float& alpha) {
    float pmax = p0[0];
#pragma unroll
    for (int r = 1; r < 16; ++r) pmax = fmaxf(pmax, p0[r]);
#pragma unroll
    for (int r = 0; r < 16; ++r) pmax = fmaxf(pmax, p1[r]);
    { auto rr = __builtin_amdgcn_permlane32_swap(__float_as_uint(pmax), __float_as_uint(pmax), false, false); pmax = fmaxf(__uint_as_float(rr[0]), __uint_as_float(rr[1])); }
    if (__builtin_expect(__all((pmax - m_reg) <= THR2), 1)) { mn = m_reg; alpha = 1.f; }
    else { mn = fmaxf(m_reg, pmax); alpha = __builtin_amdgcn_exp2f(m_reg - mn); m_reg = mn; }
#pragma unroll
    for (int r = 0; r < 16; ++r) p0[r] = p0[r] - mn;
#pragma unroll
    for (int r = 0; r < 16; ++r) p1[r] = p1[r] - mn;
#pragma unroll
    for (int r = 0; r < 16; ++r) p0[r] = __builtin_amdgcn_exp2f(p0[r]);
}
__device__ __forceinline__ void finishSM(f32x16& p0, f32x16& p1, float alpha, float& l_reg, bf16x8& pa0, bf16x8& pa1, bf16x8& pa2, bf16x8& pa3) {
#pragma unroll
    for (int r = 0; r < 16; ++r) p1[r] = __builtin_amdgcn_exp2f(p1[r]);
    float ps = 0;
#pragma unroll
    for (int r = 0; r < 16; ++r) ps += p0[r];
#pragma unroll
    for (int r = 0; r < 16; ++r) ps += p1[r];
    { auto rr = __builtin_amdgcn_permlane32_swap(__float_as_uint(ps), __float_as_uint(ps), false, false); ps = __uint_as_float(rr[0]) + __uint_as_float(rr[1]); }
    l_reg = l_reg * alpha + ps;
#define PK4(P, B_, OUT) do { unsigned a0 = cvtpk(P[B_+0], P[B_+1]), a1 = cvtpk(P[B_+2], P[B_+3]); unsigned b0 = cvtpk(P[B_+4], P[B_+5]), b1 = cvtpk(P[B_+6], P[B_+7]); \
        auto r0 = __builtin_amdgcn_permlane32_swap(a0, b0, false, false); auto r1 = __builtin_amdgcn_permlane32_swap(a1, b1, false, false); \
        u32x4 w = {r0[0], r1[0], r0[1], r1[1]}; OUT = *reinterpret_cast<bf16x8*>(&w); } while (0)
    PK4(p0, 0, pa0); PK4(p0, 8, pa1); PK4(p1, 0, pa2); PK4(p1, 8, pa3);
#undef PK4
}
template <int KB>
__device__ __forceinline__ void qkt(f32x16& p0, f32x16& p1, const char* K_lds, int r32, int hi, const bf16x8* qr) {
    p0 = f32x16{}; p1 = f32x16{};
    const char* kb[4];
#pragma unroll
    for (int dd = 0; dd < 4; ++dd) kb[dd] = K_lds + KB * SHM_K + KSWZ(r32, (dd * 16 + hi * 8) * 2);
#pragma unroll
    for (int d0 = 0; d0 < 6; ++d0) { const char* a = kb[d0 & 3] + (d0 >> 2) * 128;
        bf16x8 b0 = *reinterpret_cast<const bf16x8*>(a);
        bf16x8 b1 = *reinterpret_cast<const bf16x8*>(a + 32 * 256);
        p0 = __builtin_amdgcn_mfma_f32_32x32x16_bf16(b0, qr[d0], p0, 0, 0, 0);
        p1 = __builtin_amdgcn_mfma_f32_32x32x16_bf16(b1, qr[d0], p1, 0, 0, 0); }
}
template <int VB>
__device__ __forceinline__ void pv_tile(f32x16* o, int vb0, bf16x8 pa0, bf16x8 pa1, bf16x8 pa2, bf16x8 pa3) {
#define TRRD(dst, off) asm volatile("ds_read_b64_tr_b16 %0, %1 offset:%2" : "=&v"(dst) : "v"(vb0), "i"(off) : "memory")
#define PV_D0(d0) do { s16x4 l0, l1, l2, l3, h0, h1, h2, h3; constexpr int b_ = OFF_V + VB * SHM_V + (d0) * 512; \
        TRRD(l0, b_); TRRD(h0, b_ + 1024); TRRD(l1, b_ + 2048); TRRD(h1, b_ + 3072); TRRD(l2, b_ + 4096); TRRD(h2, b_ + 5120); TRRD(l3, b_ + 6144); TRRD(h3, b_ + 7168); \
        asm volatile("s_waitcnt lgkmcnt(0)" ::: "memory"); SBAR(); \
        o[d0] = __builtin_amdgcn_mfma_f32_32x32x16_bf16(pa0, (bf16x8){l0[0], l0[1], l0[2], l0[3], h0[0], h0[1], h0[2], h0[3]}, o[d0], 0, 0, 0); \
        o[d0] = __builtin_amdgcn_mfma_f32_32x32x16_bf16(pa1, (bf16x8){l1[0], l1[1], l1[2], l1[3], h1[0], h1[1], h1[2], h1[3]}, o[d0], 0, 0, 0); \
        o[d0] = __builtin_amdgcn_mfma_f32_32x32x16_bf16(pa2, (bf16x8){l2[0], l2[1], l2[2], l2[3], h2[0], h2[1], h2[2], h2[3]}, o[d0], 0, 0, 0); \
        o[d0] = __builtin_amdgcn_mfma_f32_32x32x16_bf16(pa3, (bf16x8){l3[0], l3[1], l3[2], l3[3], h3[0], h3[1], h3[2], h3[3]}, o[d0], 0, 0, 0); } while (0)
    PV_D0(0); PV_D0(1);
#undef PV_D0
#undef TRRD
}
struct BlockRef { const bf16_t* Q; const bf16_t* Kn; const bf16_t* KR; const bf16_t* V; bf16_t* O; float* SSQ; int P0; };
struct Seam { bf16x8 qr[6]; bf16x8 st_v0, st_k0, st_k1; };
#define VMW() asm volatile("s_waitcnt vmcnt(0)" ::: "memory")
#define VMWN(n) asm volatile("s_waitcnt vmcnt(%0)" :: "i"(n) : "memory")
#define KSRC(B, k0, rr) ((ch < 8 ? (B).Kn + (size_t)((k0) + (rr)) * 512 + ch * 8 : (B).KR + (size_t)((k0) + (rr)) * 32 + (ch - 8) * 8))
#define SLOAD_H(B, k0) do { S.st_v0 = *(const bf16x8*)((B).V + (size_t)((k0) + vk) * 512 + vc); \
                            if (ch < 12) { S.st_k0 = *(const bf16x8*)KSRC(B, k0, sr); S.st_k1 = *(const bf16x8*)KSRC(B, k0, 32 + sr); } } while (0)
#define SWRITE_HK(bf) do { if (ch < 12) { *(bf16x8*)(K_lds + (bf) * SHM_K + kws) = S.st_k0; *(bf16x8*)(K_lds + (bf) * SHM_K + kws + 32 * 256) = S.st_k1; } } while (0)
#define SWRITE_HV(bf) do { *(bf16x8*)(V_lds + (bf) * SHM_V + vst0) = S.st_v0; } while (0)
#define SWRITE_H(bf) do { SWRITE_HV(bf); SWRITE_HK(bf); } while (0)
__device__ __forceinline__ void attn_prime(const BlockRef& cur, char* lds, Seam& S) {
    const int tid = tid_opaque(), wid = __builtin_amdgcn_readfirstlane(tid >> 6), lane = tid & 63, r32 = lane & 31, hi = lane >> 5;
    const int sr = tid >> 4, ch = tid & 15, kws = KSWZ(sr, ch * 16), vk = tid >> 3, vc = (tid & 7) * 8; char* K_lds = lds + OFF_K;
#pragma unroll
    for (int d0 = 0; d0 < 6; ++d0) S.qr[d0] = *(const bf16x8*)(cur.Q + (size_t)(wid * QBLK + r32) * 768 + d0 * 16 + hi * 8);
    SLOAD_H(cur, 0); VMW(); SWRITE_HK(0);
    __syncthreads();
}
__device__ __forceinline__ void attn_block(const BlockRef& cur, const BlockRef& nxt, char* lds, Seam& S) {
    const int tid = tid_opaque(), wid = __builtin_amdgcn_readfirstlane(tid >> 6), lane = tid & 63, r32 = lane & 31, hi = lane >> 5;
    const int NT = (cur.P0 + QB) / KVBLK;
    const int qlo = cur.P0 + wid * QBLK, qm = qlo + r32 - 4 * hi;
    char* V_lds = lds + OFF_V; char* K_lds = lds + OFF_K;
    float* ws = (float*)(lds + OFF_WS) + wid * 64; float* li_l = ws, * al_l = ws + 32;
    float m_reg = -1e30f, l_reg = 0; f32x16 o[2] = {};
    const int sr = tid >> 4, ch = tid & 15, kws = KSWZ(sr, ch * 16), vk = tid >> 3, vc = (tid & 7) * 8, vst0 = v_st(vk, vc);
    const int vb0 = (int)(uintptr_t)lds + v_rd_base(lane);
#define RESC(a) do { if (__any((a) < 1.f)) { if (hi == 0) al_l[r32] = (a); asm volatile("s_waitcnt lgkmcnt(0)" ::: "memory"); \
                     _Pragma("unroll") for (int d_ = 0; d_ < 2; ++d_) _Pragma("unroll") for (int r = 0; r < 16; ++r) o[d_][r] *= al_l[crow(r, hi)]; } } while (0)
#define KBASE(t) ((t) * KVBLK)
#define MASKT(P0_, P1_, t) do { const int kb_ = KBASE(t); if (kb_ + KVBLK - 1 > qlo) mask_tile(P0_, P1_, qm - kb_); } while (0)
    constexpr int NQL = 6;
#define SEAM_K0() do { VMWN(NQL); SWRITE_HK(0); SBAR(); } while (0)
    f32x16 pA0, pA1, pB0, pB1; float mnA, mnB, alA, alB; bf16x8 pa0, pa1, pa2, pa3;
    SWRITE_HV(0); SBAR();
    if (NT > 1) SLOAD_H(cur, KBASE(1));
    SBAR(); qkt<0>(pA0, pA1, K_lds, r32, hi, S.qr);
    MASKT(pA0, pA1, 0); partialSM(pA0, pA1, m_reg, mnA, alA);
    if (NT > 1) { VMW(); SWRITE_H(1); }
    __syncthreads();
#define HALF_STEP(PX0, PX1, mnX, alX, PY0, PY1, alY, t, KB, VB, SB) do { \
        SBAR(); qkt<KB>(PX0, PX1, K_lds, r32, hi, S.qr); \
        finishSM(PY0, PY1, alY, l_reg, pa0, pa1, pa2, pa3); SBAR(); \
        if ((t) + 1 < NT) { SLOAD_H(cur, KBASE((t) + 1)); SBAR(); } \
        pv_tile<VB>(o, vb0, pa0, pa1, pa2, pa3); MASKT(PX0, PX1, (t)); partialSM(PX0, PX1, m_reg, mnX, alX); \
        __syncthreads(); \
        if ((t) + 1 < NT) { VMW(); SWRITE_H(SB); } \
        RESC(alX); __syncthreads(); } while (0)
    for (int t = 1; t + 1 < NT; t += 2) {
        HALF_STEP(pB0, pB1, mnB, alB, pA0, pA1, alA, t, 1, 0, 0);
        HALF_STEP(pA0, pA1, mnA, alA, pB0, pB1, alB, t + 1, 0, 1, 1);
    }
    SBAR(); qkt<1>(pB0, pB1, K_lds, r32, hi, S.qr); SBAR();
    SLOAD_H(nxt, 0); SBAR();
#pragma unroll
    for (int d0 = 0; d0 < 6; ++d0) S.qr[d0] = *(const bf16x8*)(nxt.Q + (size_t)(wid * QBLK + r32) * 768 + d0 * 16 + hi * 8);
    SBAR();
    finishSM(pA0, pA1, alA, l_reg, pa0, pa1, pa2, pa3); SBAR();
    pv_tile<0>(o, vb0, pa0, pa1, pa2, pa3);
    MASKT(pB0, pB1, NT - 1); partialSM(pB0, pB1, m_reg, mnB, alB); __syncthreads(); RESC(alB);
    finishSM(pB0, pB1, alB, l_reg, pa0, pa1, pa2, pa3); SBAR(); pv_tile<1>(o, vb0, pa0, pa1, pa2, pa3);
    SBAR(); SEAM_K0();
    if (hi == 0) li_l[r32] = l_reg; asm volatile("s_waitcnt lgkmcnt(0)" ::: "memory");
    float rli[16];
#pragma unroll
    for (int r = 0; r < 16; ++r) rli[r] = __builtin_amdgcn_rcpf(li_l[crow(r, hi)]);
    { bf16_t* stg = (bf16_t*)(lds + OFF_OST) + wid * 2048;
#pragma unroll
      for (int r = 0; r < 16; ++r) { const int orow = crow(r, hi);
#pragma unroll
          for (int d0 = 0; d0 < 2; ++d0) stg[orow * 64 + d0 * 32 + r32] = (bf16_t)f2bf(o[d0][r] * rli[r]); }
      asm volatile("s_waitcnt lgkmcnt(0)" ::: "memory");
#pragma unroll
      for (int i = 0; i < 4; ++i) { const int row = i * 8 + (lane >> 3), c8 = lane & 7; const u32x4 v = *(const u32x4*)(stg + row * 64 + c8 * 8);
          *(u32x4*)(cur.O + (size_t)(wid * QBLK + row) * 1024 + c8 * 8) = v;
          float s = 0.f;
#pragma unroll
          for (int j = 0; j < 4; ++j) { const float a = __builtin_bit_cast(float, v[j] << 16), b = __builtin_bit_cast(float, v[j] & 0xffff0000u); s += a * a + b * b; }
          s += __shfl_xor(s, 1); s += __shfl_xor(s, 2); s += __shfl_xor(s, 4);
          if (c8 == 0) cur.SSQ[(size_t)(wid * QBLK + row) * 8] = s; } }
    __syncthreads();
#undef RESC
#undef KBASE
#undef MASKT
#undef SEAM_K0
#undef HALF_STEP
}
#undef VMW
#undef VMWN
#undef KSRC
#undef SLOAD_H
#undef SWRITE_HK
#undef SWRITE_HV
#undef SWRITE_H
#undef KSWZ
#undef SBAR
__device__ __forceinline__ BlockRef block_ref(const Ptrs& P, int bh, int qb) {
    const int b = bh >> 3, h = bh & 7; const size_t r0 = (size_t)b * SEQ + (size_t)qb * QB; BlockRef r;
    r.Q = (const bf16_t*)(P.ws + WS_Q) + r0 * 768 + h * 96; r.Kn = (const bf16_t*)(P.ws + WS_K) + (size_t)b * SEQ * 512 + h * 64; r.KR = (const bf16_t*)(P.ws + WS_KR) + (size_t)b * SEQ * 32;
    r.V = (const bf16_t*)(P.ws + WS_V) + (size_t)b * SEQ * 512 + h * 64; r.O = (bf16_t*)(P.ws + WS_MIX) + r0 * 1024 + h * 64; r.SSQ = (float*)(P.ws + WS_SSQ) + r0 * 8 + h; r.P0 = qb * QB; return r;
}
__device__ __forceinline__ void attn_phase(const Ptrs& P, char* lds) {
    const int G = gridDim.x, c = blockIdx.x; const int vcu = (G % 8 == 0) ? (c % 8) * (G / 8) + c / 8 : c;
    Seam S;
    for (int it = vcu; it < 256; it += G) {
        const int bh = it >> 4, x = it & 15;
        const BlockRef b0 = block_ref(P, bh, x), b1 = block_ref(P, bh, 31 - x);
        attn_prime(b0, lds, S);
        attn_block(b0, b1, lds, S);
        attn_block(b1, b1, lds, S);
    }
}
}
typedef float f32x16r __attribute__((ext_vector_type(16)));
__device__ __forceinline__ void router_phase(const Ptrs& P, LAS unsigned char* lds) {
    const int tid = tid_opaque(), lane = tid & 63, w = __builtin_amdgcn_readfirstlane(tid >> 6), i32 = lane & 31, kk = lane >> 5;
    LAS float* RED = (LAS float*)lds;
    LAS float* SSQ = (LAS float*)(lds + 8 * 32 * 33 * 4);
    LAS float* LOG = SSQ + 8 * 32;
    LAS float* RSTD = LOG + 32 * 33;
    LAS int* HIST = (LAS int*)(RSTD + 32);
    LAS int* SELE = HIST + 32;
    LAS int* SELR = SELE + 128;
    LAS float* SELG = (LAS float*)(SELR + 128);
    int* cnt = (int*)(P.ws + WS_CTL) + CW_CNT; int* SLOT = (int*)(P.ws + WS_SLOT); int* LIST = (int*)(P.ws + WS_LIST); float* GLIST = (float*)(P.ws + WS_GLIST);
    for (int rb = blockIdx.x; rb < T / 32; rb += gridDim.x) {
        const int t0 = rb * 32;
        const float* xr = P.out + (size_t)(t0 + i32) * 1024 + 128 * w + 64 * kk;
        f32x4 av[16]; float ssq = 0.f;
#pragma unroll
        for (int m = 0; m < 16; ++m) { const f32x4 a = *(const f32x4*)(xr + 4 * m); const f32x4 g = *(const f32x4*)(P.g_ffn + 128 * w + 64 * kk + 4 * m);
            ssq += (a[0] * a[0] + a[1] * a[1]) + (a[2] * a[2] + a[3] * a[3]); av[m] = a * g; }
        f32x16r acc = {};
        const float* wr = P.w_router + (size_t)(128 * w + 64 * kk) * 32 + i32;
#pragma unroll
        for (int m = 0; m < 16; ++m) {
#pragma unroll
            for (int j = 0; j < 4; ++j) acc = __builtin_amdgcn_mfma_f32_32x32x2f32(av[m][j], wr[(4 * m + j) * 32], acc, 0, 0, 0); }
        ssq += __shfl_xor(ssq, 32);
        if (kk == 0) SSQ[w * 32 + i32] = ssq;
#pragma unroll
        for (int r = 0; r < 16; ++r) RED[(w * 32 + (r & 3) + 8 * (r >> 2) + 4 * kk) * 33 + i32] = acc[r];
        if (tid < 32) HIST[tid] = 0;
        __syncthreads();
        if (tid < 32) { float s = 0.f;
#pragma unroll
            for (int q = 0; q < 8; ++q) s += SSQ[q * 32 + tid];
            RSTD[tid] = 1.f / sqrtf(s * (1.f / 1024.f) + RMS_EPS); }
        __syncthreads();
#pragma unroll
        for (int q = 0; q < 2; ++q) { const int idx = tid + 512 * q, row = idx >> 5, e = idx & 31; float s = 0.f;
#pragma unroll
            for (int p = 0; p < 8; ++p) s += RED[(p * 32 + row) * 33 + e];
            LOG[row * 33 + e] = s * RSTD[row] + P.b_router[e]; }
#if FP8_MOE
        { const float rs = RSTD[i32]; unsigned char* hp = P.ws + WS_H + (size_t)(t0 + i32) * 1024 + 128 * w + 64 * kk;
#pragma unroll
          for (int q = 0; q < 4; ++q) { u32x4 o;
              { const f32x4 v = av[4 * q + 0] * rs; o.x = pk4_fp8(v[0], v[1], v[2], v[3]); } { const f32x4 v = av[4 * q + 1] * rs; o.y = pk4_fp8(v[0], v[1], v[2], v[3]); }
              { const f32x4 v = av[4 * q + 2] * rs; o.z = pk4_fp8(v[0], v[1], v[2], v[3]); } { const f32x4 v = av[4 * q + 3] * rs; o.w = pk4_fp8(v[0], v[1], v[2], v[3]); }
              *(u32x4*)(hp + 16 * q) = o; } }
#else
        { const float rs = RSTD[i32]; bf16_t* hp = (bf16_t*)(P.ws + WS_H) + (size_t)(t0 + i32) * 1024 + 128 * w + 64 * kk;
#pragma unroll
          for (int q = 0; q < 8; ++q) { const f32x4 v0 = av[2 * q] * rs, v1 = av[2 * q + 1] * rs; u32x4 o; o.x = pk2(v0[0], v0[1]); o.y = pk2(v0[2], v0[3]); o.z = pk2(v1[0], v1[1]); o.w = pk2(v1[2], v1[3]); *(u32x4*)(hp + 8 * q) = o; } }
#endif
        __syncthreads();
        if (tid < 32) { const int row = tid; float lv[4]; int li[4]; unsigned used = 0u;
            for (int k = 0; k < 4; ++k) { float best = -__builtin_inff(); int bi = 0;
                for (int e = 0; e < 32; ++e) { const float x = LOG[row * 33 + e]; if (!((used >> e) & 1u) && x > best) { best = x; bi = e; } }
                lv[k] = best; li[k] = bi; used |= 1u << bi; }
            const float e1 = expf(lv[1] - lv[0]), e2 = expf(lv[2] - lv[0]), e3 = expf(lv[3] - lv[0]); const float inv = 1.f / (1.f + e1 + e2 + e3);
            const float gt[4] = {inv, e1 * inv, e2 * inv, e3 * inv};
            for (int k = 0; k < 4; ++k) { SELE[row * 4 + k] = li[k]; SELG[row * 4 + k] = gt[k]; SELR[row * 4 + k] = atomicAdd((int*)&HIST[li[k]], 1); } }
        __syncthreads();
        if (tid < 32) { const int n = HIST[tid]; HIST[tid] = n > 0 ? atomicAdd(&cnt[tid], n) : 0; }
        __syncthreads();
        if (tid < 128) { const int row = tid >> 2, k = tid & 3, e = SELE[tid], pos = HIST[e] + SELR[tid]; const int t = t0 + row;
            SLOT[t * 4 + k] = e * T + pos; LIST[e * T + pos] = t; GLIST[e * T + pos] = SELG[tid]; }
        __syncthreads();
    }
}
__device__ __forceinline__ void pool_phase(const Ptrs& P, LAS unsigned char* lds) {
    const int tid = tid_opaque(), lane = tid & 63, w = __builtin_amdgcn_readfirstlane(tid >> 6), fr = lane & 15, fq = lane >> 4;
    constexpr int RS = 1040;
    LAS float* PS = (LAS float*)(lds + 64 * RS);
    const bf16_t* U = (const bf16_t*)(P.ws + WS_U);
    const int g = w >> 1, dh = (w & 1) * 64;
    bf16x8 bfr[4][4];
    { const bf16_t* Wt = (const bf16_t*)(P.ws + WS_WPOOL) + (size_t)g * 128 * 128;
#pragma unroll
      for (int ni = 0; ni < 4; ++ni)
#pragma unroll
          for (int ks = 0; ks < 4; ++ks) bfr[ni][ks] = *(const bf16x8*)(Wt + (size_t)(dh + ni * 16 + fr) * 128 + ks * 32 + 8 * fq); }
    f32x4 bias[4], scl[4];
#pragma unroll
    for (int ni = 0; ni < 4; ++ni) { const int c = g * 128 + dh + ni * 16 + 4 * fq; bias[ni] = *(const f32x4*)(P.b_pool + c); scl[ni] = *(const f32x4*)(P.pool_scale + c); }
    for (int tile = blockIdx.x; tile < T / 64; tile += gridDim.x) {
        const int t0 = tile * 64;
#pragma unroll 2
        for (int q = 0; q < 8; ++q) { const int task = tid + 512 * q, r = task >> 6, cc = task & 63, gg = cc >> 4, win = 2 << gg; const int t = t0 + r, s = t & (SEQ - 1); const int n = s + 1 < win ? s + 1 : win;
            float sum[8];
#pragma unroll
            for (int j = 0; j < 8; ++j) sum[j] = 0.f;
            bf16x8 u0 = {};
            for (int k = 0; k < n; ++k) { const bf16x8 u = *(const bf16x8*)(U + (size_t)(t - k) * 512 + cc * 8); if (k == 0) u0 = u;
#pragma unroll
                for (int j = 0; j < 8; ++j) sum[j] += bf2f((bf16_t)u[j]); }
            const float inv = 1.f / (float)n; u32x4 o;
            o.x = pk2(sum[0] * inv - bf2f((bf16_t)u0[0]), sum[1] * inv - bf2f((bf16_t)u0[1])); o.y = pk2(sum[2] * inv - bf2f((bf16_t)u0[2]), sum[3] * inv - bf2f((bf16_t)u0[3]));
            o.z = pk2(sum[4] * inv - bf2f((bf16_t)u0[4]), sum[5] * inv - bf2f((bf16_t)u0[5])); o.w = pk2(sum[6] * inv - bf2f((bf16_t)u0[6]), sum[7] * inv - bf2f((bf16_t)u0[7]));
            *(LAS u32x4*)(lds + r * RS + cc * 16) = o; }
        __syncthreads();
        f32x4 acc[4][4];
#pragma unroll
        for (int mi = 0; mi < 4; ++mi)
#pragma unroll
            for (int ni = 0; ni < 4; ++ni) acc[mi][ni] = (f32x4){0.f, 0.f, 0.f, 0.f};
#pragma unroll
        for (int ks = 0; ks < 4; ++ks) { bf16x8 a[4];
#pragma unroll
            for (int mi = 0; mi < 4; ++mi) a[mi] = *(const LAS bf16x8*)(lds + (mi * 16 + fr) * RS + (g * 128 + ks * 32 + 8 * fq) * 2);
#pragma unroll
            for (int mi = 0; mi < 4; ++mi)
#pragma unroll
                for (int ni = 0; ni < 4; ++ni) acc[mi][ni] = __builtin_amdgcn_mfma_f32_16x16x32_bf16(bfr[ni][ks], a[mi], acc[mi][ni], 0, 0, 0); }
#pragma unroll
        for (int mi = 0; mi < 4; ++mi) { float s = 0.f;
#pragma unroll
            for (int ni = 0; ni < 4; ++ni) { acc[mi][ni] = (acc[mi][ni] + bias[ni]) * scl[ni]; const f32x4 v = acc[mi][ni]; s += (v[0] * v[0] + v[1] * v[1]) + (v[2] * v[2] + v[3] * v[3]); }
            s += __shfl_xor(s, 16); s += __shfl_xor(s, 32);
            if (fq == 0) PS[(mi * 16 + fr) * 8 + w] = s; }
        __syncthreads();
#pragma unroll
        for (int mi = 0; mi < 4; ++mi) { const int r = mi * 16 + fr; const f32x4 p0 = *(const LAS f32x4*)(PS + r * 8), p1 = *(const LAS f32x4*)(PS + r * 8 + 4);
            const float rstd = 1.f / sqrtf((((p0[0] + p0[1]) + (p0[2] + p0[3])) + ((p1[0] + p1[1]) + (p1[2] + p1[3]))) * (1.f / 512.f) + RMS_EPS);
            bf16_t* mp = (bf16_t*)(P.ws + WS_MIX) + (size_t)(t0 + r) * 1024 + 512 + g * 128 + dh + 4 * fq;
#pragma unroll
            for (int ni = 0; ni < 4; ++ni) { const f32x4 v = acc[mi][ni] * rstd; u32x2 o; o.x = pk2(v[0], v[1]); o.y = pk2(v[2], v[3]); *(u32x2*)(mp + ni * 16) = o; } }
        __syncthreads();
    }
}

#define VB_FOR(vb, NVB) for (int vb = blockIdx.x * 2 + (int)(threadIdx.x >> 8); vb < (NVB); vb += gridDim.x * 2)

__device__ __forceinline__ void nv_gemm_f32(const bf16_t* A, int lda, const bf16_t* Bt, int ldb, float* C, int ldc, int K, int nbx, int nby) {
    const int tid = threadIdx.x & 255, lane = tid & 63, w = tid >> 6, wr = w >> 1, wc = w & 1, fr = lane & 15, fq = lane >> 4;
    VB_FOR(vb, nbx * nby) {
        const int bx = vb % nbx, by = vb / nbx;
        const int row0 = by * 64 + wr * 32, col0 = bx * 128 + wc * 64;
        f32x4 acc[2][4];
#pragma unroll
        for (int i = 0; i < 2; ++i)
#pragma unroll
            for (int j = 0; j < 4; ++j) acc[i][j] = (f32x4){0.f, 0.f, 0.f, 0.f};
        for (int k0 = 0; k0 < K; k0 += 32) {
            bf16x8 a[2], b[4];
#pragma unroll
            for (int i = 0; i < 2; ++i) a[i] = *(const bf16x8*)(A + (size_t)(row0 + i * 16 + fr) * lda + k0 + 8 * fq);
#pragma unroll
            for (int j = 0; j < 4; ++j) b[j] = *(const bf16x8*)(Bt + (size_t)(col0 + j * 16 + fr) * ldb + k0 + 8 * fq);
#pragma unroll
            for (int i = 0; i < 2; ++i)
#pragma unroll
                for (int j = 0; j < 4; ++j) acc[i][j] = __builtin_amdgcn_mfma_f32_16x16x32_bf16(a[i], b[j], acc[i][j], 0, 0, 0);
        }
#pragma unroll
        for (int i = 0; i < 2; ++i)
#pragma unroll
            for (int j = 0; j < 4; ++j)
#pragma unroll
                for (int r = 0; r < 4; ++r) C[(size_t)(row0 + i * 16 + fq * 4 + r) * ldc + col0 + j * 16 + fr] = acc[i][j][r];
    }
}

#define GW_SETUP const int tid = tid_opaque(), lane = tid & 63, wave = tid >> 6; const int gw = blockIdx.x * NWAVES + wave, NGW = gridDim.x * NWAVES; (void)lane; (void)gw; (void)NGW;
#define GT_FOR(i, N) for (size_t i = (size_t)blockIdx.x * 512 + threadIdx.x; i < (size_t)(N); i += (size_t)gridDim.x * 512)

__device__ __forceinline__ void ph_prologue(const Ptrs& P, float* ldsf) {
    GW_SETUP
    float* scr = ldsf + wave * (64 * 33);
    for (int it = gw; it < IT_TOTAL; it += NGW) prologue_item(P, it, scr, lane);
    { bf16_t* w = (bf16_t*)(P.ws + WS_WIN) + (size_t)DINP * 1024; const int n8 = (1024 - DINP) * 1024 / 8;
      GT_FOR(i, n8) ((u32x4*)w)[i] = (u32x4){0u, 0u, 0u, 0u}; }
    for (int m = gw; m < T; m += NGW) rms_row_to_bf16(P.x + (size_t)m * D, P.g_attn, (bf16_t*)(P.ws + WS_XN) + (size_t)m * D, lane);
    { float* C = (float*)(P.ws + WS_COS); float* S = (float*)(P.ws + WS_SIN);
      GT_FOR(i, T * 16) { const int t = (int)(i >> 4), j = (int)(i & 15);
          const float inv = (float)pow(10000.0, -(double)j / 16.0); const float ang = (float)P.pos[t] * inv;
          C[i] = (float)cos((double)ang); S[i] = (float)sin((double)ang); } }
}
__device__ __forceinline__ void ph_e1(const Ptrs& P) {
    GW_SETUP
    const float* PROJ = (const float*)(P.ws + WS_TMP);
    const float* COS = (const float*)(P.ws + WS_COS); const float* SIN = (const float*)(P.ws + WS_SIN);
    for (int t = gw; t < T; t += NGW) {
        const float* pr = PROJ + (size_t)t * 1024;
        bf16_t* u = (bf16_t*)(P.ws + WS_U) + (size_t)t * 512;
        for (int c = lane; c < 512; c += 64) u[c] = (bf16_t)f2bf(pr[c]);
        { float v[4]; float s = 0.f; for (int j = 0; j < 4; ++j) { v[j] = pr[512 + lane + 64 * j]; s += v[j] * v[j]; }
          const float rstd = 1.f / sqrtf(wave_sum(s) * (1.f / 256.f) + RMS_EPS);
          bf16_t* q = (bf16_t*)(P.ws + WS_QN) + (size_t)t * 256;
          for (int j = 0; j < 4; ++j) q[lane + 64 * j] = (bf16_t)f2bf(v[j] * rstd * P.g_q_a[lane + 64 * j]); }
        { float v[2]; float s = 0.f; for (int j = 0; j < 2; ++j) { v[j] = pr[768 + lane + 64 * j]; s += v[j] * v[j]; }
          const float rstd = 1.f / sqrtf(wave_sum(s) * (1.f / 128.f) + RMS_EPS);
          bf16_t* q = (bf16_t*)(P.ws + WS_KVN) + (size_t)t * 128;
          for (int j = 0; j < 2; ++j) q[lane + 64 * j] = (bf16_t)f2bf(v[j] * rstd * P.g_kv_a[lane + 64 * j]); }
        if (lane < 16) { const float x1 = pr[896 + lane], x2 = pr[896 + 16 + lane]; const float c = COS[t * 16 + lane], s = SIN[t * 16 + lane];
          bf16_t* kr = (bf16_t*)(P.ws + WS_KR) + (size_t)t * 32; kr[lane] = (bf16_t)f2bf(x1 * c - x2 * s); kr[16 + lane] = (bf16_t)f2bf(x2 * c + x1 * s); }
    }
}
__device__ __forceinline__ void ph_e2q(const Ptrs& P) {
    const float* TMP = (const float*)(P.ws + WS_TMP); const float* COS = (const float*)(P.ws + WS_COS); const float* SIN = (const float*)(P.ws + WS_SIN);
    bf16_t* Q = (bf16_t*)(P.ws + WS_Q);
    GT_FOR(i, (size_t)T * 768) {
        const int t = (int)(i / 768), c = (int)(i % 768), h = c / 96, d = c % 96; float v;
        if (d < 64) v = TMP[i];
        else { const int j = (d - 64) & 15; const float x1 = TMP[(size_t)t * 768 + h * 96 + 64 + j], x2 = TMP[(size_t)t * 768 + h * 96 + 80 + j]; const float cc = COS[t * 16 + j], ss = SIN[t * 16 + j];
               v = (d < 80) ? (x1 * cc - x2 * ss) : (x2 * cc + x1 * ss); }
        Q[i] = (bf16_t)f2bf(v * QSCALE);
    }
}
__device__ __forceinline__ void ph_e2kv(const Ptrs& P) {
    const float* TMP = (const float*)(P.ws + WS_TMP) + (size_t)T * 1024;
    bf16_t* K = (bf16_t*)(P.ws + WS_K); bf16_t* V = (bf16_t*)(P.ws + WS_V);
    GT_FOR(i, (size_t)T * 512) {
        const int t = (int)(i / 512), c = (int)(i % 512), h = c / 64, d = c % 64;
        K[i] = (bf16_t)f2bf(TMP[(size_t)t * 1024 + h * 128 + d]);
        V[i] = (bf16_t)f2bf(TMP[(size_t)t * 1024 + h * 128 + 64 + d]);
    }
}
__device__ __forceinline__ void ph_pooldiff(const Ptrs& P) {
    const bf16_t* U = (const bf16_t*)(P.ws + WS_U); bf16_t* DIFF = (bf16_t*)(P.ws + WS_H);
    GT_FOR(i, (size_t)T * 512) {
        const int t = (int)(i / 512), c = (int)(i % 512), g = c / 128, s = t % SEQ, w = 2 << g; const int n = s + 1 < w ? s + 1 : w;
        float sum = 0.f; for (int j = 0; j < n; ++j) sum += bf2f(U[(size_t)(t - j) * 512 + c]);
        DIFF[i] = (bf16_t)f2bf(sum / (float)n - bf2f(U[i]));
    }
}
__device__ __forceinline__ void ph_epool(const Ptrs& P, const float* TP) {
    GW_SETUP
    for (int t = gw; t < T; t += NGW) {
        float v[8]; float s = 0.f;
        for (int j = 0; j < 8; ++j) { const int c = lane + 64 * j; v[j] = (TP[(size_t)t * 512 + c] + P.b_pool[c]) * P.pool_scale[c]; s += v[j] * v[j]; }
        const float rstd = 1.f / sqrtf(wave_sum(s) * (1.f / 512.f) + RMS_EPS);
        bf16_t* m = (bf16_t*)(P.ws + WS_MIX) + (size_t)t * 1024 + 512;
        for (int j = 0; j < 8; ++j) m[lane + 64 * j] = (bf16_t)f2bf(v[j] * rstd);
    }
}
__device__ __forceinline__ void ph_attn_naive(const Ptrs& P, float* ldsf) {
    GW_SETUP
    float* qs = ldsf + wave * 96;
    const bf16_t* Q = (const bf16_t*)(P.ws + WS_Q); const bf16_t* K = (const bf16_t*)(P.ws + WS_K); const bf16_t* V = (const bf16_t*)(P.ws + WS_V); const bf16_t* KRp = (const bf16_t*)(P.ws + WS_KR);
    bf16_t* MIX = (bf16_t*)(P.ws + WS_MIX); float* SSQ = (float*)(P.ws + WS_SSQ);
    for (int item = gw; item < T * 8; item += NGW) {
        const int t = item >> 3, h = item & 7, b = t / SEQ, s = t % SEQ;
        for (int d = lane; d < 96; d += 64) qs[d] = bf2f(Q[(size_t)t * 768 + h * 96 + d]);
        asm volatile("s_waitcnt lgkmcnt(0)" ::: "memory");
        float m = -1e30f, l = 0.f, o = 0.f;
        const int ntile = s / 64 + 1;
        for (int kt = 0; kt < ntile; ++kt) {
            const int key = kt * 64 + lane; const size_t krow = (size_t)(b * SEQ + key);
            float sc = -__builtin_inff();
            if (key <= s) { float a = 0.f;
                for (int d8 = 0; d8 < 12; ++d8) { const bf16x8 kv = d8 < 8 ? *(const bf16x8*)(K + krow * 512 + h * 64 + d8 * 8) : *(const bf16x8*)(KRp + krow * 32 + (d8 - 8) * 8);
#pragma unroll
                    for (int j = 0; j < 8; ++j) a += qs[d8 * 8 + j] * bf2f((bf16_t)kv[j]); }
                sc = a; }
            const float mn = fmaxf(m, wave_max(sc)); const float alpha = exp2f(m - mn); const float p = exp2f(sc - mn);
            const float pb = bf2f((bf16_t)f2bf(p));
            l = l * alpha + wave_sum(pb); o *= alpha; m = mn;
            const int nk = (kt == ntile - 1) ? (s - kt * 64 + 1) : 64;
            for (int j = 0; j < nk; ++j) { const float pj = __shfl(pb, j); o += pj * bf2f(V[(size_t)(b * SEQ + kt * 64 + j) * 512 + h * 64 + lane]); }
        }
        const float ov = o / l;
        MIX[(size_t)t * 1024 + h * 64 + lane] = (bf16_t)f2bf(ov);
        const float ss = wave_sum(ov * ov);
        if (lane == 0) SSQ[t * 8 + h] = ss;
        asm volatile("s_waitcnt lgkmcnt(0)" ::: "memory");
    }
}
__device__ __forceinline__ void ph_e4(const Ptrs& P) {
    const float* T1 = (const float*)(P.ws + WS_TMP); const float* T2 = T1 + (size_t)T * 1024; const float* SSQ = (const float*)(P.ws + WS_SSQ);
    GT_FOR(i, (size_t)T * 1024) {
        const int t = (int)(i >> 10); float s = 0.f; for (int h = 0; h < 8; ++h) s += SSQ[t * 8 + h];
        const float sa = 1.f / sqrtf(s * (1.f / 512.f) + RMS_EPS);
        P.out[i] = P.x[i] + sa * T1[i] + T2[i];
    }
}
__device__ __forceinline__ void ph_router(const Ptrs& P, float* ldsf) {
    GW_SETUP
    float* hs = ldsf + wave * 1024;
    int* cnt = (int*)(P.ws + WS_CTL) + CW_CNT; int* SLOT = (int*)(P.ws + WS_SLOT); int* LIST = (int*)(P.ws + WS_LIST); float* GLIST = (float*)(P.ws + WS_GLIST);
    for (int t = gw; t < T; t += NGW) {
        const f32x4* xr = (const f32x4*)(P.out + (size_t)t * 1024) + lane; const f32x4* gr = (const f32x4*)P.g_ffn + lane;
        f32x4 v[4]; float s = 0.f;
        for (int j = 0; j < 4; ++j) { v[j] = xr[64 * j]; s += (v[j].x * v[j].x + v[j].y * v[j].y) + (v[j].z * v[j].z + v[j].w * v[j].w); }
        const float rstd = 1.f / sqrtf(wave_sum(s) * (1.f / 1024.f) + RMS_EPS);
        u32x2* ho = (u32x2*)((bf16_t*)(P.ws + WS_H) + (size_t)t * 1024) + lane;
        for (int j = 0; j < 4; ++j) { const f32x4 gg = gr[64 * j]; f32x4 hv = {v[j].x * rstd * gg.x, v[j].y * rstd * gg.y, v[j].z * rstd * gg.z, v[j].w * rstd * gg.w};
            ((f32x4*)hs)[lane + 64 * j] = hv; u32x2 w; w.x = pk2(hv.x, hv.y); w.y = pk2(hv.z, hv.w); ho[64 * j] = w; }
        asm volatile("s_waitcnt lgkmcnt(0)" ::: "memory");
        const int e = lane & 31, half = lane >> 5; float a = 0.f;
        for (int c = half * 512; c < half * 512 + 512; ++c) a += hs[c] * P.w_router[c * 32 + e];
        a += __shfl_xor(a, 32); a += P.b_router[e];
        float lv[4]; int li[4]; unsigned used = 0u;
        for (int k = 0; k < 4; ++k) { float best = -__builtin_inff(); int bi = 0;
            for (int j = 0; j < 32; ++j) { const float x = __shfl(a, j); if (!((used >> j) & 1u) && x > best) { best = x; bi = j; } }
            lv[k] = best; li[k] = bi; used |= 1u << bi; }
        const float e1 = expf(lv[1] - lv[0]), e2 = expf(lv[2] - lv[0]), e3 = expf(lv[3] - lv[0]); const float inv = 1.f / (1.f + e1 + e2 + e3);
        if (lane < 4) { const int ex = lane == 0 ? li[0] : lane == 1 ? li[1] : lane == 2 ? li[2] : li[3]; const float gt = (lane == 0 ? 1.f : lane == 1 ? e1 : lane == 2 ? e2 : e3) * inv;
            const int pos = atomicAdd(&cnt[ex], 1); SLOT[t * 4 + lane] = ex * T + pos; LIST[ex * T + pos] = t; GLIST[ex * T + pos] = gt; }
        asm volatile("s_waitcnt lgkmcnt(0)" ::: "memory");
    }
}
__device__ __forceinline__ int slot_base(const int* cnt, int e) { int s = 0; for (int i = 0; i < e; ++i) s += (cnt[i] + 255) & ~255; return s; }
__device__ __forceinline__ void ph_moe1_naive(const Ptrs& P) {
    const int* cnt = (const int*)(P.ws + WS_CTL) + CW_CNT;
    const int tid = threadIdx.x & 255, lane = tid & 63, w = tid >> 6, wr = w >> 1, wc = w & 1, fr = lane & 15, fq = lane >> 4;
    const bf16_t* H = (const bf16_t*)(P.ws + WS_H); bf16_t* ACT = (bf16_t*)(P.ws + WS_ACT);
    VB_FOR(vb, 16 * 256 * 32) {
        const int bx = vb & 15, by = (vb >> 4) & 255, e = vb >> 12; const int n = cnt[e], m0 = by * 64; if (m0 >= n) continue;
        const int* LIST = (const int*)(P.ws + WS_LIST) + (size_t)e * T;
        const bf16_t* W = (const bf16_t*)(P.ws + WS_WGU) + (size_t)e * 2048 * 1024;
        const int ca0 = bx * 64 + wc * 32; const int p = ca0 >> 7, r0 = ca0 & 127;
        int tok[2]; for (int i = 0; i < 2; ++i) { int m = m0 + wr * 32 + i * 16 + fr; if (m >= n) m = 0; tok[i] = LIST[m]; }
        f32x4 ag[2][2], au[2][2];
        for (int i = 0; i < 2; ++i) for (int j = 0; j < 2; ++j) { ag[i][j] = (f32x4){0.f, 0.f, 0.f, 0.f}; au[i][j] = (f32x4){0.f, 0.f, 0.f, 0.f}; }
        for (int k0 = 0; k0 < 1024; k0 += 32) {
            bf16x8 a[2], bg[2], bu[2];
            for (int i = 0; i < 2; ++i) a[i] = *(const bf16x8*)(H + (size_t)tok[i] * 1024 + k0 + 8 * fq);
            for (int j = 0; j < 2; ++j) { bg[j] = *(const bf16x8*)(W + (size_t)(256 * p + r0 + j * 16 + fr) * 1024 + k0 + 8 * fq); bu[j] = *(const bf16x8*)(W + (size_t)(256 * p + 128 + r0 + j * 16 + fr) * 1024 + k0 + 8 * fq); }
            for (int i = 0; i < 2; ++i) for (int j = 0; j < 2; ++j) { ag[i][j] = __builtin_amdgcn_mfma_f32_16x16x32_bf16(a[i], bg[j], ag[i][j], 0, 0, 0); au[i][j] = __builtin_amdgcn_mfma_f32_16x16x32_bf16(a[i], bu[j], au[i][j], 0, 0, 0); }
        }
        const int sb = slot_base(cnt, e);
        for (int i = 0; i < 2; ++i) for (int j = 0; j < 2; ++j) for (int r = 0; r < 4; ++r) {
            const int m = m0 + wr * 32 + i * 16 + fq * 4 + r, c = ca0 + j * 16 + fr; if (m >= n) continue;
            float g = ag[i][j][r] + P.b_gu[e * 2048 + c], u = au[i][j][r] + P.b_gu[e * 2048 + 1024 + c];
            g = fminf(g, 7.f); u = fminf(fmaxf(u, -7.f), 7.f);
            const float act = g * (1.f / (1.f + expf(-1.702f * g))) * (u + 1.f);
            ACT[(size_t)(sb + m) * 1024 + c] = (bf16_t)f2bf(act);
        }
    }
}
__device__ __forceinline__ void ph_moe2_naive(const Ptrs& P) {
    const int* cnt = (const int*)(P.ws + WS_CTL) + CW_CNT;
    const int tid = threadIdx.x & 255, lane = tid & 63, w = tid >> 6, wr = w >> 1, wc = w & 1, fr = lane & 15, fq = lane >> 4;
    VB_FOR(vb, 8 * 256 * 32) {
        const int bx = vb & 7, by = (vb >> 3) & 255, e = vb >> 11; const int n = cnt[e], m0 = by * 64; if (m0 >= n) continue;
        const int sb = slot_base(cnt, e); const bf16_t* ACT = (const bf16_t*)(P.ws + WS_ACT) + (size_t)sb * 1024; bf16_t* Y = (bf16_t*)(P.ws + WS_Y) + (size_t)sb * 1024;
        const bf16_t* W = (const bf16_t*)(P.ws + WS_WD) + (size_t)e * 1024 * 1024; const float* GL = (const float*)(P.ws + WS_GLIST) + (size_t)e * T;
        const int col0 = bx * 128 + wc * 64, row0 = m0 + wr * 32;
        f32x4 acc[2][4]; for (int i = 0; i < 2; ++i) for (int j = 0; j < 4; ++j) acc[i][j] = (f32x4){0.f, 0.f, 0.f, 0.f};
        for (int k0 = 0; k0 < 1024; k0 += 32) {
            bf16x8 a[2], b[4];
            for (int i = 0; i < 2; ++i) { int m = row0 + i * 16 + fr; if (m >= n) m = 0; a[i] = *(const bf16x8*)(ACT + (size_t)m * 1024 + k0 + 8 * fq); }
            for (int j = 0; j < 4; ++j) b[j] = *(const bf16x8*)(W + (size_t)(col0 + j * 16 + fr) * 1024 + k0 + 8 * fq);
            for (int i = 0; i < 2; ++i) for (int j = 0; j < 4; ++j) acc[i][j] = __builtin_amdgcn_mfma_f32_16x16x32_bf16(a[i], b[j], acc[i][j], 0, 0, 0);
        }
        for (int i = 0; i < 2; ++i) for (int j = 0; j < 4; ++j) for (int r = 0; r < 4; ++r) {
            const int m = row0 + i * 16 + fq * 4 + r, c = col0 + j * 16 + fr; if (m >= n) continue;
            Y[(size_t)m * 1024 + c] = (bf16_t)f2bf((acc[i][j][r] + P.b_down[e * 1024 + c]) * GL[m]);
        }
    }
}
__device__ __forceinline__ void ph_final(const Ptrs& P, int* sbase) {
    GW_SETUP
    const int* cnt = (const int*)(P.ws + WS_CTL) + CW_CNT; const int* SLOT = (const int*)(P.ws + WS_SLOT); const bf16_t* Y = (const bf16_t*)(P.ws + WS_Y);
    if (tid < 32) sbase[tid] = slot_base(cnt, tid);
    __syncthreads();
    for (int t = gw; t < T; t += NGW) {
        f32x4* xr = (f32x4*)(P.out + (size_t)t * 1024) + lane; const f32x4* gr = (const f32x4*)P.g_final + lane;
        f32x4 v[4]; for (int j = 0; j < 4; ++j) v[j] = xr[64 * j];
        for (int k = 0; k < 4; ++k) { const int sl = SLOT[t * 4 + k]; const int e = sl / T, pos = sl % T; const u32x2* yr = (const u32x2*)(Y + (size_t)(sbase[e] + pos) * 1024) + lane;
            for (int j = 0; j < 4; ++j) { const u32x2 w = yr[64 * j]; v[j].x += __builtin_bit_cast(float, w.x << 16); v[j].y += __builtin_bit_cast(float, w.x & 0xffff0000u); v[j].z += __builtin_bit_cast(float, w.y << 16); v[j].w += __builtin_bit_cast(float, w.y & 0xffff0000u); } }
        float s = 0.f; for (int j = 0; j < 4; ++j) s += (v[j].x * v[j].x + v[j].y * v[j].y) + (v[j].z * v[j].z + v[j].w * v[j].w);
        const float rstd = 1.f / sqrtf(wave_sum(s) * (1.f / 1024.f) + RMS_EPS);
        for (int j = 0; j < 4; ++j) { const f32x4 gg = gr[64 * j]; xr[64 * j] = (f32x4){v[j].x * rstd * gg.x, v[j].y * rstd * gg.y, v[j].z * rstd * gg.z, v[j].w * rstd * gg.w}; }
    }
}

__global__ void __launch_bounds__(NWAVES * 64, 2) mega_fwd(Ptrs P) {
    extern __shared__ __attribute__((aligned(16))) unsigned char lds[];
    const int tid = threadIdx.x;
    for (int u = tid; u < (LDS_BYTES - LDSCTL_OFF) / 4; u += NWAVES * 64) ((LAS unsigned*)((LAS unsigned char*)lds + LDSCTL_OFF))[u] = 0u;
    __syncthreads();
    unsigned* ctl = (unsigned*)(P.ws + WS_CTL);
    XcdBarrier bar = xcd_barrier_post(ctl + CW_BAR, (volatile LAS unsigned*)((LAS unsigned char*)lds + MISC_OFF) + 8);
    float* ldsf = (float*)lds;
    float* TMP = (float*)(P.ws + WS_TMP);
    unsigned char* ws = P.ws;
#define GRID_BAR() xcd_barrier(bar)
#ifndef PROBE_REP
#define PROBE_REP (-1)
#endif
#if PROBE_REP >= 0
#define REPS(k) int _reps##k = 1 + ((PROBE_REP) == (k) ? 1 : 0); asm volatile("" : "+s"(_reps##k)); for (int _r = 0; _r < _reps##k; ++_r)
#else
#define REPS(k)
#endif
    { REPS(0) { ph_prologue(P, ldsf); GRID_BAR(); } }
    LAS unsigned char* L = (LAS unsigned char*)lds; const int G = gridDim.x, c = blockIdx.x;
#if FAST_INPROJ
    { REPS(1) {
    { pg8::DenseOrder S; S.init(ws + WS_XN, ws + WS_WIN, T, 1024, 1024, G, c);
      pg8::EpiInProj E{(bf16_t*)(ws + WS_U), (bf16_t*)(ws + WS_QN), (bf16_t*)(ws + WS_KVN), (bf16_t*)(ws + WS_KR), P.g_q_a, P.g_kv_a, (const float*)(ws + WS_COS), (const float*)(ws + WS_SIN)};
      pg8::gemm_phase<pg8::EpiInProj, pg8::DenseOrder, false, false>(L, 1024, S, E); }
    GRID_BAR(); } }
#else
    nv_gemm_f32((const bf16_t*)(ws + WS_XN), 1024, (const bf16_t*)(ws + WS_WIN), 1024, TMP, 1024, 1024, 8, T / 64); GRID_BAR();
    ph_e1(P); GRID_BAR();
#endif
#if FAST_QKV
    { REPS(2) {
#ifndef NO_QB
    { pg8::DenseOrder S; S.init(ws + WS_QN, ws + WS_WQB, T, 768, 256, G, c);
      pg8::EpiQ E{(bf16_t*)(ws + WS_Q), (const float*)(ws + WS_COS), (const float*)(ws + WS_SIN)};
      pg8::gemm_phase<pg8::EpiQ, pg8::DenseOrder, true, false>(L, 256, S, E); }
#endif
#ifndef NO_KVB
    { pg8::DenseOrder S; S.init(ws + WS_KVN, ws + WS_WKVB, T, 1024, 128, G, c);
      pg8::EpiKV E{(bf16_t*)(ws + WS_K), (bf16_t*)(ws + WS_V)};
      pg8::gemm_phase<pg8::EpiKV, pg8::DenseOrder, true, false>(L, 128, S, E); }
#endif
#if FAST_POOL
    pool_phase(P, L);
#else
    ph_pooldiff(P);
#endif
    GRID_BAR(); } }
#else
    nv_gemm_f32((const bf16_t*)(ws + WS_QN), 256, (const bf16_t*)(ws + WS_WQB), 256, TMP, 768, 256, 6, T / 64);
    nv_gemm_f32((const bf16_t*)(ws + WS_KVN), 128, (const bf16_t*)(ws + WS_WKVB), 128, TMP + (size_t)T * 1024, 1024, 128, 8, T / 64);
    ph_pooldiff(P); GRID_BAR();
    ph_e2q(P); ph_e2kv(P);
#endif
#if !(FAST_POOL && FAST_QKV)
    for (int g = 0; g < 4; ++g)
        nv_gemm_f32((const bf16_t*)(ws + WS_H) + g * 128, 512, (const bf16_t*)(ws + WS_WPOOL) + (size_t)g * 128 * 128, 128, (float*)(ws + WS_ACT) + g * 128, 512, 128, 1, T / 64);
    GRID_BAR();
    ph_epool(P, (const float*)(ws + WS_ACT));
#endif
#if FAST_ATTN
    { REPS(3) { att::attn_phase(P, (char*)lds); GRID_BAR(); } }
#else
    ph_attn_naive(P, ldsf); GRID_BAR();
#endif
#if FAST_WOUT
    { REPS(4) {
    { pg8::DenseOrder S; S.init(ws + WS_MIX, ws + WS_WOUT, T, 1024, 1024, G, c);
      pg8::EpiOut E{P.x, P.out, (const float*)(ws + WS_SSQ), SA_OFF};
      pg8::gemm_phase<pg8::EpiOut, pg8::DenseOrder, false, false>(L, 1024, S, E); }
    GRID_BAR(); } }
#else
    nv_gemm_f32((const bf16_t*)(ws + WS_MIX), 1024, (const bf16_t*)(ws + WS_WOUT), 1024, TMP, 1024, 512, 8, T / 64);
    nv_gemm_f32((const bf16_t*)(ws + WS_MIX) + 512, 1024, (const bf16_t*)(ws + WS_WOUT) + 512, 1024, TMP + (size_t)T * 1024, 1024, 512, 8, T / 64);
    GRID_BAR();
    ph_e4(P); GRID_BAR();
#endif
#if FAST_ROUTER
    router_phase(P, L); GRID_BAR();
#else
    ph_router(P, ldsf); GRID_BAR();
#endif
#if FAST_MOE
    { REPS(6) {
#if FP8_MOE
    { pg8::MoeOrder<true> S{(const char*)(ws + WS_H), (const char*)(ws + WS_WGU), (size_t)2048 * 1024, 8, G, c, GT_OFF, (const LAS int*)(L + TS_OFF), 1024};
      moe_setup<true>(P, L, S);
      pg8::EpiSwiglu8 E{P.b_gu, ws + WS_ACT};
      pg8::gemm_phase<pg8::EpiSwiglu8, pg8::MoeOrder<true>, true, true, true>(L, 512, S, E); }
    GRID_BAR(); } }
    { REPS(7) {
    { pg8::MoeOrder<false> S{(const char*)(ws + WS_ACT), (const char*)(ws + WS_WD), (size_t)1024 * 1024, 4, G, c, 0, (const LAS int*)(L + TS_OFF), 1024};
      moe_setup<false>(P, L, S);
      pg8::EpiDown8 E{P.b_down, (const float*)(ws + WS_GLIST), (bf16_t*)(ws + WS_Y)};
      pg8::gemm_phase<pg8::EpiDown8, pg8::MoeOrder<false>, true, false, true>(L, 512, S, E); }
    GRID_BAR(); } }
#else
    { pg8::MoeOrder<true> S{(const char*)(ws + WS_H), (const char*)(ws + WS_WGU), (size_t)2048 * 1024 * 2, 8, G, c, GT_OFF, (const LAS int*)(L + TS_OFF), 2048};
      moe_setup<true>(P, L, S);
      pg8::EpiSwiglu E{P.b_gu, (bf16_t*)(ws + WS_ACT)};
      pg8::gemm_phase<pg8::EpiSwiglu, pg8::MoeOrder<true>, true, true>(L, 1024, S, E); }
    GRID_BAR(); } }
    { REPS(7) {
    { pg8::MoeOrder<false> S{(const char*)(ws + WS_ACT), (const char*)(ws + WS_WD), (size_t)1024 * 1024 * 2, 4, G, c, 0, (const LAS int*)(L + TS_OFF), 2048};
      moe_setup<false>(P, L, S);
      pg8::EpiDown E{P.b_down, (const float*)(ws + WS_GLIST), (bf16_t*)(ws + WS_Y)};
      pg8::gemm_phase<pg8::EpiDown, pg8::MoeOrder<false>, true, false>(L, 1024, S, E); }
    GRID_BAR(); } }
#endif
#else
    ph_moe1_naive(P); GRID_BAR();
    ph_moe2_naive(P); GRID_BAR();
#endif
    ph_final(P, (int*)lds);
}

extern "C" void kernel_launch(void* const* d_in, const int* in_sizes, int n_in, void* d_out, int out_size, void* d_ws, size_t ws_size, hipStream_t stream) {
    static int grid = 0;
    if (grid == 0) {
        if (n_in != 22 || out_size != T * D || ws_size < WS_END) { fprintf(stderr, "kernel_launch: unexpected shapes (n_in %d out %d ws %zu)\n", n_in, out_size, ws_size); grid = -1; return; }
        int dev = 0, cus = 0, per_cu = 0;
        if (hipGetDevice(&dev) != hipSuccess || hipDeviceGetAttribute(&cus, hipDeviceAttributeMultiprocessorCount, dev) != hipSuccess) { grid = -1; return; }
        if (hipFuncSetAttribute((const void*)mega_fwd, hipFuncAttributeMaxDynamicSharedMemorySize, LDS_BYTES) != hipSuccess) { fprintf(stderr, "kernel_launch: hipFuncSetAttribute failed\n"); grid = -1; return; }
        if (hipOccupancyMaxActiveBlocksPerMultiprocessor(&per_cu, (const void*)mega_fwd, NWAVES * 64, LDS_BYTES) != hipSuccess || per_cu < 1) fprintf(stderr, "kernel_launch: occupancy query reports %d\n", per_cu);
        (void)hipGetLastError();
        grid = cus;
    }
    if (grid < 0) return;
    Ptrs P{};
    P.x = (const float*)d_in[0]; P.pos = (const int*)d_in[1]; P.g_attn = (const float*)d_in[2]; P.w_in = (const float*)d_in[3]; P.w_pool = (const float*)d_in[4];
    P.b_pool = (const float*)d_in[5]; P.pool_scale = (const float*)d_in[6]; P.g_q_a = (const float*)d_in[7]; P.w_q_b = (const float*)d_in[8]; P.g_kv_a = (const float*)d_in[9];
    P.w_kv_b = (const float*)d_in[10]; P.g_out_pool = (const float*)d_in[11]; P.g_out_attn = (const float*)d_in[12]; P.w_out = (const float*)d_in[13]; P.g_ffn = (const float*)d_in[14];
    P.w_router = (const float*)d_in[15]; P.b_router = (const float*)d_in[16]; P.w_gu = (const float*)d_in[17]; P.b_gu = (const float*)d_in[18]; P.w_down = (const float*)d_in[19];
    P.b_down = (const float*)d_in[20]; P.g_final = (const float*)d_in[21]; P.out = (float*)d_out; P.ws = (unsigned char*)d_ws;
    if (hipMemsetAsync((unsigned char*)d_ws + WS_CTL, 0, CTL_BYTES, stream) != hipSuccess) { fprintf(stderr, "kernel_launch: memset failed\n"); return; }
    hipLaunchKernelGGL(mega_fwd, dim3(grid), dim3(NWAVES * 64), LDS_BYTES, stream, P);
}
```

```cpp
#include <hip/hip_runtime.h>
#ifndef FP8_MOE
#define FP8_MOE 1
#endif
#ifndef CONV_IN_ATTN
#define CONV_IN_ATTN 1
#endif
#include <cstdint>
#include <cstdio>

typedef unsigned short bf16_t;
typedef short bf16x8 __attribute__((ext_vector_type(8)));
typedef float f32x4 __attribute__((ext_vector_type(4)));
typedef unsigned u32x4 __attribute__((ext_vector_type(4)));
typedef unsigned u32x2 __attribute__((ext_vector_type(2)));

constexpr int BATCH = 2, SEQ = 8192, T = BATCH * SEQ, D = 1024;
constexpr int DPOOL = 512, NPG = 4, PGD = 128;
constexpr int NH = 8, VD = 64, QKN = 64, QKR = 32, QKD = 96;
constexpr int QLR = 256, KVLR = 128, DINP = 928;
constexpr int NE = 32, TOPK = 4, DE = 1024;
constexpr float RMS_EPS = 1e-6f;
constexpr float QSCALE = 0.10206207261596577f * 1.4426950408889634f;
constexpr int SLOT_ROWS = T * TOPK + NE * 256;

constexpr size_t MiB = 1u << 20;
constexpr size_t WS_CTL = 0;
constexpr size_t CTL_BYTES = 32 * 1024;
constexpr size_t WS_COS = 1 * MiB, WS_SIN = 2 * MiB;
constexpr size_t WS_WIN = 4 * MiB;
constexpr size_t WS_WQB = 6 * MiB;
constexpr size_t WS_WKVB = 7 * MiB;
constexpr size_t WS_WPOOL = 7 * MiB + 512 * 1024;
constexpr size_t WS_WOUT = 8 * MiB;
constexpr size_t WS_WGU = 16 * MiB;
constexpr size_t WS_WD = 144 * MiB;
constexpr size_t WS_XN = 208 * MiB;
constexpr size_t WS_U = 240 * MiB;
constexpr size_t WS_QN = 256 * MiB;
constexpr size_t WS_KVN = 264 * MiB;
constexpr size_t WS_KR = 268 * MiB;
constexpr size_t WS_Q = 272 * MiB;
constexpr size_t WS_K = 296 * MiB;
constexpr size_t WS_V = 320 * MiB;
constexpr size_t WS_MIX = 336 * MiB;
constexpr size_t WS_SSQ = 368 * MiB;
constexpr size_t WS_H = 370 * MiB;
constexpr size_t WS_SLOT = 402 * MiB;
constexpr size_t WS_LIST = 403 * MiB;
constexpr size_t WS_GLIST = 405 * MiB;
constexpr size_t WS_ACT = 408 * MiB;
constexpr size_t WS_Y = 552 * MiB;
constexpr size_t WS_TMP = 700 * MiB;
constexpr size_t WS_END = 828 * MiB;
constexpr int CW_CNT = 64;

__device__ __forceinline__ unsigned f2bf(float f) { unsigned u = __builtin_bit_cast(unsigned, f); return (u + 0x7fffu + ((u >> 16) & 1u)) >> 16; }
__device__ __forceinline__ unsigned pk2(float lo, float hi) { return f2bf(lo) | (f2bf(hi) << 16); }
__device__ __forceinline__ float bf2f(bf16_t b) { return __builtin_bit_cast(float, (unsigned)b << 16); }
__device__ __forceinline__ float wave_sum(float v) {
#pragma unroll
    for (int o = 1; o < 64; o <<= 1) v += __shfl_xor(v, o);
    return v;
}
__device__ __forceinline__ float wave_max(float v) {
#pragma unroll
    for (int o = 1; o < 64; o <<= 1) v = fmaxf(v, __shfl_xor(v, o));
    return v;
}

typedef int v8i_t __attribute__((ext_vector_type(8)));
constexpr float W8_SCALE = 64.f, W8_INV = 1.f / 64.f;
__device__ __forceinline__ float clamp8(float x) { return __builtin_amdgcn_fmed3f(x, -448.f, 448.f); }
__device__ __forceinline__ unsigned pk4_fp8(float a, float b, float c, float d) {
    int p = 0; p = __builtin_amdgcn_cvt_pk_fp8_f32(clamp8(a), clamp8(b), p, false); p = __builtin_amdgcn_cvt_pk_fp8_f32(clamp8(c), clamp8(d), p, true); return (unsigned)p; }
__device__ __forceinline__ unsigned pk4_fp8_nc(float a, float b, float c, float d) {
    int p = 0; p = __builtin_amdgcn_cvt_pk_fp8_f32(a, b, p, false); p = __builtin_amdgcn_cvt_pk_fp8_f32(c, d, p, true); return (unsigned)p; }
__device__ __forceinline__ int tid_opaque() { int t = threadIdx.x; asm volatile("" : "+v"(t)); return t; }

__device__ __forceinline__ void transpose_item(const float* W, int ldw, int k0, int n0, bf16_t* WT, int ldt, int dn0, int dk0,
                                               const float* ksc, float* scr, int lane) {
    { const int kq = lane >> 3, n4 = (lane & 7) * 4; f32x4 v[8];
#pragma unroll
      for (int i = 0; i < 8; ++i) v[i] = *(const f32x4*)(W + (size_t)(k0 + 8 * i + kq) * ldw + n0 + n4);
#pragma unroll
      for (int i = 0; i < 8; ++i) { const int kk = 8 * i + kq; f32x4 x = v[i]; if (ksc) x = x * ksc[kk];
          scr[kk * 33 + n4 + 0] = x[0]; scr[kk * 33 + n4 + 1] = x[1]; scr[kk * 33 + n4 + 2] = x[2]; scr[kk * 33 + n4 + 3] = x[3]; } }
    asm volatile("s_waitcnt lgkmcnt(0)" ::: "memory");
    const int c = lane & 7;
#pragma unroll
    for (int j = 0; j < 4; ++j) { const int n = (lane >> 3) + 8 * j; const float* s = scr + (8 * c) * 33 + n;
        u32x4 o; o.x = pk2(s[0 * 33], s[1 * 33]); o.y = pk2(s[2 * 33], s[3 * 33]); o.z = pk2(s[4 * 33], s[5 * 33]); o.w = pk2(s[6 * 33], s[7 * 33]);
        *(u32x4*)(WT + (size_t)(dn0 + n) * ldt + dk0 + 8 * c) = o; }
    asm volatile("s_waitcnt lgkmcnt(0)" ::: "memory");
}

__device__ __forceinline__ void transpose_item8(const float* W, int ldw, int k0, int n0, unsigned char* WT, int ldt, int dn0, int dk0, float* scr, int lane) {
    { const int kq = lane >> 3, n4 = (lane & 7) * 4; f32x4 v[8];
#pragma unroll
      for (int i = 0; i < 8; ++i) v[i] = *(const f32x4*)(W + (size_t)(k0 + 8 * i + kq) * ldw + n0 + n4);
#pragma unroll
      for (int i = 0; i < 8; ++i) { const int kk = 8 * i + kq; const f32x4 x = v[i] * W8_SCALE;
          scr[kk * 33 + n4 + 0] = x[0]; scr[kk * 33 + n4 + 1] = x[1]; scr[kk * 33 + n4 + 2] = x[2]; scr[kk * 33 + n4 + 3] = x[3]; } }
    asm volatile("s_waitcnt lgkmcnt(0)" ::: "memory");
    const int c = lane & 7;
#pragma unroll
    for (int j = 0; j < 4; ++j) { const int n = (lane >> 3) + 8 * j; const float* q = scr + (8 * c) * 33 + n;
        u32x2 o; o.x = pk4_fp8(q[0 * 33], q[1 * 33], q[2 * 33], q[3 * 33]); o.y = pk4_fp8(q[4 * 33], q[5 * 33], q[6 * 33], q[7 * 33]);
        *(u32x2*)(WT + (size_t)(dn0 + n) * ldt + dk0 + 8 * c) = o; }
    asm volatile("s_waitcnt lgkmcnt(0)" ::: "memory");
}

struct Ptrs {
    const float* x; const int* pos; const float* g_attn; const float* w_in; const float* w_pool; const float* b_pool; const float* pool_scale;
    const float* g_q_a; const float* w_q_b; const float* g_kv_a; const float* w_kv_b; const float* g_out_pool; const float* g_out_attn; const float* w_out;
    const float* g_ffn; const float* w_router; const float* b_router; const float* w_gu; const float* b_gu; const float* w_down; const float* b_down; const float* g_final;
    float* out; unsigned char* ws;
};

constexpr int IT_IN = 16 * 29, IT_QB = 4 * 24, IT_KVB = 2 * 32, IT_POOL = 4 * 2 * 4, IT_OUT = 16 * 32, IT_GU = 32 * 16 * 64, IT_DN = 32 * 16 * 32;
constexpr int IT_TOTAL = IT_IN + IT_QB + IT_KVB + IT_POOL + IT_OUT + IT_GU + IT_DN;

__device__ __forceinline__ void prologue_item(const Ptrs& P, int it, float* scr, int lane) {
    unsigned char* ws = P.ws;
    int r = it;
    if (r < IT_IN) { const int kb = r / 29, nb = r % 29; transpose_item(P.w_in, DINP, 64 * kb, 32 * nb, (bf16_t*)(ws + WS_WIN), 1024, 32 * nb, 64 * kb, nullptr, scr, lane); return; } r -= IT_IN;
    if (r < IT_QB) { const int kb = r / 24, nb = r % 24; transpose_item(P.w_q_b, 768, 64 * kb, 32 * nb, (bf16_t*)(ws + WS_WQB), 256, 32 * nb, 64 * kb, nullptr, scr, lane); return; } r -= IT_QB;
    if (r < IT_KVB) { const int kb = r / 32, nb = r % 32; transpose_item(P.w_kv_b, 1024, 64 * kb, 32 * nb, (bf16_t*)(ws + WS_WKVB), 128, 32 * nb, 64 * kb, nullptr, scr, lane); return; } r -= IT_KVB;
    if (r < IT_POOL) { const int g = r / 8, kb = (r % 8) / 4, nb = r % 4; transpose_item(P.w_pool + (size_t)g * 128 * 128, 128, 64 * kb, 32 * nb, (bf16_t*)(ws + WS_WPOOL) + (size_t)g * 128 * 128, 128, 32 * nb, 64 * kb, nullptr, scr, lane); return; } r -= IT_POOL;
    if (r < IT_OUT) { const int kb = r / 32, nb = r % 32, k0 = 64 * kb; const float* ksc = k0 < 512 ? P.g_out_pool + k0 : P.g_out_attn + (k0 - 512);
        transpose_item(P.w_out, 1024, k0, 32 * nb, (bf16_t*)(ws + WS_WOUT), 1024, 32 * nb, (k0 + 512) & 1023, ksc, scr, lane); return; } r -= IT_OUT;
    if (r < IT_GU) { const int e = r / 1024, q = r % 1024, kb = q / 64, nb = q % 64, n0 = 32 * nb; const int nn = n0 & 1023, p = nn >> 7, dn0 = 256 * p + (n0 >= 1024 ? 128 : 0) + (nn & 127);
#if FP8_MOE
        transpose_item8(P.w_gu + (size_t)e * 1024 * 2048, 2048, 64 * kb, n0, ws + WS_WGU + (size_t)e * 2048 * 1024, 1024, dn0, 64 * kb, scr, lane); return; } r -= IT_GU;
#else
        transpose_item(P.w_gu + (size_t)e * 1024 * 2048, 2048, 64 * kb, n0, (bf16_t*)(ws + WS_WGU) + (size_t)e * 2048 * 1024, 1024, dn0, 64 * kb, nullptr, scr, lane); return; } r -= IT_GU;
#endif
    { const int e = r / 512, q = r % 512, kb = q / 32, nb = q % 32;
#if FP8_MOE
        transpose_item8(P.w_down + (size_t)e * 1024 * 1024, 1024, 64 * kb, 32 * nb, ws + WS_WD + (size_t)e * 1024 * 1024, 1024, 32 * nb, 64 * kb, scr, lane); }
#else
        transpose_item(P.w_down + (size_t)e * 1024 * 1024, 1024, 64 * kb, 32 * nb, (bf16_t*)(ws + WS_WD) + (size_t)e * 1024 * 1024, 1024, 32 * nb, 64 * kb, nullptr, scr, lane); }
#endif
}

__device__ __forceinline__ void rms_row_to_bf16(const float* xrow, const float* g, bf16_t* orow, int lane) {
    const f32x4* xr = (const f32x4*)xrow + lane; const f32x4* gr = (const f32x4*)g + lane;
    f32x4 v[4]; float s = 0.f;
#pragma unroll
    for (int j = 0; j < 4; ++j) { v[j] = xr[64 * j]; s += (v[j].x * v[j].x + v[j].y * v[j].y) + (v[j].z * v[j].z + v[j].w * v[j].w); }
    const float rstd = 1.f / sqrtf(wave_sum(s) * (1.f / 1024.f) + RMS_EPS);
    u32x2* o8 = (u32x2*)orow + lane;
#pragma unroll
    for (int j = 0; j < 4; ++j) { const f32x4 gg = gr[64 * j]; u32x2 w; w.x = pk2(v[j].x * rstd * gg.x, v[j].y * rstd * gg.y); w.y = pk2(v[j].z * rstd * gg.z, v[j].w * rstd * gg.w); o8[64 * j] = w; }
}

#define LAS __attribute__((address_space(3)))
#define XB_TMO      128
#define XB_XCNT(j)  (256  + 64 * (j))
#define XB_XSUB(j)  (1280 + 64 * (j))
#define XB_XGEN(j)  (2304 + 64 * (j))
#define XB_TOP      3328
#define XB_TOPGEN   3392
#define XCD_BAR_WORDS 3456
#define XB_SPIN_CAP (1u << 18)
__device__ __forceinline__ unsigned xb_ld(unsigned* p)              { return __hip_atomic_load(p, __ATOMIC_RELAXED, __HIP_MEMORY_SCOPE_AGENT); }
__device__ __forceinline__ unsigned xb_add(unsigned* p, unsigned v) { return __hip_atomic_fetch_add(p, v, __ATOMIC_RELAXED, __HIP_MEMORY_SCOPE_AGENT); }
__device__ __forceinline__ unsigned xb_xcc_id() { return (unsigned)__builtin_amdgcn_s_getreg((3 << 11) | 20) & 0xFu; }
#define XB_SPIN(cond, bar) do { unsigned _sp = 0; while (cond) { __builtin_amdgcn_s_sleep(1); \
    if ((++_sp & 255u) == 0u) { if (xb_ld(&(bar)[XB_TMO])) break; if (_sp > XB_SPIN_CAP) { atomicAdd(&(bar)[XB_TMO], 1u); break; } } } } while (0)
struct XcdBarrier { unsigned* bar; unsigned x; volatile LAS unsigned* st; };
__device__ __forceinline__ XcdBarrier xcd_barrier_post(unsigned* bar, volatile LAS unsigned* st) {
    XcdBarrier b; b.bar = bar; b.x = xb_xcc_id(); b.st = st;
    if (threadIdx.x == 0) (void)xb_add(&bar[XB_XCNT(b.x)], 1u);
    return b;
}
__device__ __forceinline__ void xcd_barrier_complete(unsigned* bar, unsigned x, unsigned& nloc, unsigned& nx) {
    const unsigned G = gridDim.x * gridDim.y * gridDim.z;
    unsigned sum, cnt, mine, sp = 0u;
    for (;;) {
        sum = 0u; cnt = 0u; mine = 0u;
#pragma unroll
        for (unsigned j = 0; j < 16; ++j) { const unsigned c = xb_ld(&bar[XB_XCNT(j)]); sum += c; cnt += (c > 0u) ? 1u : 0u; mine = (j == x) ? c : mine; }
        if (sum == G) break;
        __builtin_amdgcn_s_sleep(1);
        if ((++sp & 255u) == 0u) { if (xb_ld(&bar[XB_TMO])) break; if (sp > XB_SPIN_CAP) { atomicAdd(&bar[XB_TMO], 1u); break; } }
    }
    nloc = mine > 0u ? mine : 1u; nx = cnt > 0u ? cnt : 1u;
}
__device__ __forceinline__ void xcd_barrier(const XcdBarrier& b) {
    asm volatile("s_waitcnt vmcnt(0)" ::: "memory");
    __syncthreads();
    if (threadIdx.x == 0) {
        unsigned* bar = b.bar;
        __builtin_amdgcn_s_waitcnt(0);
        unsigned nloc = b.st[0], nx = b.st[1];
        if (nloc == 0u) { xcd_barrier_complete(bar, b.x, nloc, nx); b.st[0] = nloc; b.st[1] = nx; }
        const unsigned old = xb_add(&bar[XB_XSUB(b.x)], 1u);
        const unsigned gen = old / nloc;
        if (old + 1u == (gen + 1u) * nloc) {
            __builtin_amdgcn_fence(__ATOMIC_RELEASE, "agent");
            asm volatile("s_waitcnt vmcnt(0)" ::: "memory");
            const unsigned og = xb_add(&bar[XB_TOP], 1u);
            const unsigned tg = og / nx;
            if (og + 1u == (tg + 1u) * nx) xb_add(&bar[XB_TOPGEN], 1u);
            else XB_SPIN(xb_ld(&bar[XB_TOPGEN]) == tg, bar);
            __builtin_amdgcn_fence(__ATOMIC_ACQUIRE, "agent");
            xb_add(&bar[XB_XGEN(b.x)], 1u);
            asm volatile("s_waitcnt vmcnt(0)" ::: "memory");
        } else {
            XB_SPIN(xb_ld(&bar[XB_XGEN(b.x)]) == gen, bar);
            __builtin_amdgcn_fence(__ATOMIC_ACQUIRE, "agent");
            asm volatile("s_waitcnt vmcnt(0)" ::: "memory");
        }
    }
    __syncthreads();
}

constexpr int NWAVES = 8;
constexpr int RING_BYTES = 131072;
constexpr int LDSCTL_OFF = RING_BYTES, MISC_OFF = LDSCTL_OFF + 320;
constexpr int LDS_BYTES = 147456;
constexpr int CW_BAR = 4096;
constexpr int TS_OFF = 131584;
constexpr int SA_OFF = 131840;
constexpr int GT_OFF = 132864;
static_assert(GT_OFF + 9 * 1024 <= LDS_BYTES, "LDS map");
#ifndef FAST_INPROJ
#define FAST_INPROJ 1
#endif
#ifndef FAST_QKV
#define FAST_QKV 1
#endif
#ifndef FAST_WOUT
#define FAST_WOUT 1
#endif
#ifndef FAST_MOE
#define FAST_MOE 1
#endif
#ifndef FAST_ATTN
#define FAST_ATTN 1
#endif
#ifndef FAST_ROUTER
#define FAST_ROUTER 1
#endif
#ifndef FAST_POOL
#define FAST_POOL 1
#endif


namespace pg8 {
typedef int v4i_t __attribute__((ext_vector_type(4)));
#define PG8_LAS __attribute__((address_space(3)))
constexpr int BM = 256, BK = 64, HALF = 128, HTB = HALF * BK * 2, STAGE_BYTES = 8 * HTB, NXCD = 8, WGM = 8;
__host__ __device__ __forceinline__ int lds_byte(int r, int c) { const int st = (r >> 4) * 2 + (c >> 5), rr = r & 15, cc = c & 31, ob = rr * 64 + cc * 2; return st * 1024 + (ob ^ (((ob >> 9) & 1) << 5)); }
__host__ __device__ __forceinline__ void stage_rc(int b, int& R, int& C) { const int st = b / 1024, sb = b % 1024, swz = sb ^ (((sb >> 9) & 1) << 5); R = (st >> 1) * 16 + swz / 64; C = (st & 1) * 32 + (swz % 64) / 2; }
__host__ __device__ __forceinline__ int perm32(int rho) { const int n = rho >> 4, i = rho & 15; return 8 * (i >> 2) + 4 * n + (i & 3); }
__device__ __forceinline__ unsigned cvt_pk_bf16(float lo, float hi) { unsigned r; asm volatile("v_cvt_pk_bf16_f32 %0, %1, %2" : "=v"(r) : "v"(lo), "v"(hi)); return r; }

struct Unit { const char* a; const char* b; int pm, pn, e, rt; };

struct DenseOrder {
    const char* A; const char* Bt; int nM, nN, nwg, G, c, K;
    __device__ void init(const void* A_, const void* Bt_, int M, int N, int K_, int G_, int c_) { A = (const char*)A_; Bt = (const char*)Bt_; nM = M / BM; nN = N / BM; nwg = nM * nN; G = G_; c = c_; K = K_; }
    __device__ bool next(int i, Unit& u) const {
        const long L = (long)i * G + c; if (L >= nwg) return false;
        int wgid = (int)L; { const int q = nwg / NXCD, r = nwg % NXCD, xcd = wgid % NXCD, off = wgid / NXCD; wgid = (xcd < r ? xcd * (q + 1) : r * (q + 1) + (xcd - r) * q) + off; }
        const int nig = WGM * nN, gid = wgid / nig, fm = gid * WGM, gsz = (nM - fm) < WGM ? (nM - fm) : WGM;
        u.pm = fm + ((wgid % nig) % gsz); u.pn = (wgid % nig) / gsz; u.e = 0; u.rt = 0;
        u.a = A + (size_t)u.pm * BM * K * 2; u.b = Bt + (size_t)u.pn * BM * K * 2; return true;
    }
};

template <class Epi, class Sched, bool ALIGN_EPI, bool GATHER, bool FP8 = false>
__device__ __forceinline__ void gemm_phase(PG8_LAS unsigned char* lds, const int K_, const Sched& S, const Epi& E) {
    int K = K_; asm volatile("" : "+s"(K));
    const int tid = tid_opaque(), wid = __builtin_amdgcn_readfirstlane(tid >> 6), lane = tid & 63, wr = wid >> 2, wc = wid & 3, fr = lane & 15, fq = lane >> 4;
    const int nt = K / BK;
    unsigned voffA0, voffB0; int rowA0;
    { int R, C; stage_rc(tid * 16, R, C); const int Rb = Epi::PERM ? ((R & ~31) + perm32(R & 31)) : R;
      voffA0 = GATHER ? (unsigned)(C * 2) : (unsigned)(R * K + C) * 2u; voffB0 = (unsigned)(Rb * K + C) * 2u; rowA0 = R; }
    const unsigned r64 = (unsigned)(64 * K * 2);
    const size_t kstep = (size_t)(BK * 2);
    const size_t hstep = (size_t)HALF * K * 2;
    const unsigned ldsw = (unsigned)wid * 1024u;
    const int aoff = lds_byte(wr * 64 + fr, fq * 8), boff = lds_byte(wc * 32 + fr, fq * 8);
#define PG8_SA(b, h) (((b) * 2 + (h)) * HTB)
#define PG8_SB(b, h) ((4 + (b) * 2 + (h)) * HTB)
#define PG8_STAGE(bufoff, gbase, voff) do { _Pragma("unroll") for (int _i = 0; _i < 2; ++_i) \
        __builtin_amdgcn_global_load_lds((const unsigned*)((const char*)(gbase) + (size_t)(_i * r64) + (voff)), (PG8_LAS unsigned*)(lds + (bufoff) + ldsw + _i * 8192), 16, 0, 0); } while (0)
#define PG8_STAGE_A(bufoff, abase, rtab, h, koff) do { if constexpr (GATHER) { _Pragma("unroll") for (int _i = 0; _i < 2; ++_i) { \
            const unsigned _ro = *(const PG8_LAS unsigned*)(lds + (rtab) + ((h) * HALF + _i * 64 + rowA0) * 4); \
            __builtin_amdgcn_global_load_lds((const unsigned*)((const char*)(abase) + (koff) + (size_t)(_ro + voffA0)), (PG8_LAS unsigned*)(lds + (bufoff) + ldsw + _i * 8192), 16, 0, 0); } } \
        else { PG8_STAGE(bufoff, (const char*)(abase) + (h) * hstep + (koff), voffA0); } } while (0)
#define PG8_LDA(dst, b, h) do { _Pragma("unroll") for (int m = 0; m < 4; ++m) _Pragma("unroll") for (int k = 0; k < 2; ++k) dst[m][k] = *(const PG8_LAS bf16x8*)(lds + PG8_SA(b, h) + aoff + m * 2048 + k * 1024); } while (0)
#define PG8_LDB(dst, b, h) do { _Pragma("unroll") for (int n = 0; n < 2; ++n) _Pragma("unroll") for (int k = 0; k < 2; ++k) dst[n][k] = *(const PG8_LAS bf16x8*)(lds + PG8_SB(b, h) + boff + n * 2048 + k * 1024); } while (0)
#define PG8_CAT(x) __builtin_shufflevector(__builtin_bit_cast(v4i_t, (x)[0]), __builtin_bit_cast(v4i_t, (x)[1]), 0, 1, 2, 3, 4, 5, 6, 7)
#define PG8_MMA(ai, bj, At, Bt) do { __builtin_amdgcn_s_setprio(1); \
        if constexpr (FP8) { _Pragma("unroll") for (int m = 0; m < 4; ++m) _Pragma("unroll") for (int n = 0; n < 2; ++n) \
            asm volatile("v_mfma_scale_f32_16x16x128_f8f6f4 %0, %1, %2, %0, %3, %3 op_sel_hi:[0,0,0]" : "+v"(acc[ai][bj][m][n]) : "v"(PG8_CAT(Bt[n])), "v"(PG8_CAT(At[m])), "v"(sc1)); } \
        else { _Pragma("unroll") for (int m = 0; m < 4; ++m) _Pragma("unroll") for (int n = 0; n < 2; ++n) _Pragma("unroll") for (int k = 0; k < 2; ++k) \
            acc[ai][bj][m][n] = __builtin_amdgcn_mfma_f32_16x16x32_bf16(Bt[n][k], At[m][k], acc[ai][bj][m][n], 0, 0, 0); } \
        __builtin_amdgcn_s_setprio(0); } while (0)
#define PG8_WAIT_V(n) asm volatile("s_waitcnt vmcnt(" #n ")" ::: "memory")
#define PG8_WAIT_L(n) asm volatile("s_waitcnt lgkmcnt(" #n ")" ::: "memory")
#define PG8_BAR __builtin_amdgcn_s_barrier()
#define PG8_SCHED __builtin_amdgcn_sched_barrier(0)
    Unit cur, nxt; int ui = 0;
    if (!S.next(0, cur)) return;
    f32x4 acc[2][2][4][2];
#pragma unroll
    for (int a = 0; a < 2; ++a)
#pragma unroll
        for (int b = 0; b < 2; ++b)
#pragma unroll
            for (int m = 0; m < 4; ++m)
#pragma unroll
                for (int n = 0; n < 2; ++n) acc[a][b][m][n] = (f32x4){0.f, 0.f, 0.f, 0.f};
    bf16x8 At[4][2], B0[2][2], B1[2][2];
    int sc1 = 0x7f7f7f7f; asm volatile("" : "+v"(sc1));
    const char* cA = cur.a; const char* cB = cur.b; int cR = cur.rt;
    if constexpr (Epi::MID) E.pre(cur, lds, tid);
    PG8_STAGE(PG8_SB(0, 0), cB, voffB0); PG8_STAGE(PG8_SB(0, 1), cB + hstep, voffB0); PG8_STAGE_A(PG8_SA(0, 0), cA, cR, 0, 0); PG8_STAGE_A(PG8_SA(0, 1), cA, cR, 1, 0);
    if (wr == 1) PG8_BAR;
    PG8_WAIT_V(2); PG8_BAR;
    PG8_STAGE(PG8_SB(1, 0), cB + kstep, voffB0); PG8_STAGE_A(PG8_SA(1, 0), cA, cR, 0, kstep); PG8_STAGE(PG8_SB(1, 1), cB + hstep + kstep, voffB0);
    PG8_WAIT_V(6); PG8_BAR;
    for (;;) {
        const bool has_next = S.next(ui + 1, nxt);
        const char* nA = has_next ? nxt.a : cA; const char* nB = has_next ? nxt.b : cB; const int nR = has_next ? nxt.rt : cR;
        for (int t = 0; t < nt; t += 2) {
            const bool last = (t == nt - 2);
            if constexpr (Epi::MID) { if (t == nt / 2) E.mid(acc, wr, fr, lds); }
            const size_t k1 = (size_t)(t + 1) * kstep;
            const char* a2 = last ? nA : cA; const char* b2 = last ? nB : cB + (size_t)(t + 2) * kstep; const int r2 = last ? nR : cR;
            const size_t k2 = last ? 0 : (size_t)(t + 2) * kstep, k3 = k2 + kstep; const char* b3 = b2 + kstep;
            PG8_LDB(B0, 0, 0); PG8_LDB(B1, 0, 1); PG8_SCHED; PG8_LDA(At, 0, 0); PG8_STAGE_A(PG8_SA(1, 1), cA, cR, 1, k1);
            PG8_WAIT_V(8); PG8_WAIT_L(0); PG8_BAR; PG8_MMA(0, 0, At, B0); PG8_MMA(0, 1, At, B1); PG8_BAR; PG8_SCHED;
            PG8_LDA(At, 0, 1); PG8_STAGE(PG8_SB(0, 0), b2, voffB0); PG8_STAGE(PG8_SB(0, 1), b2 + hstep, voffB0); PG8_STAGE_A(PG8_SA(0, 0), a2, r2, 0, k2);
            PG8_WAIT_V(8); PG8_WAIT_L(0); PG8_BAR; PG8_MMA(1, 0, At, B0); PG8_MMA(1, 1, At, B1); PG8_BAR; PG8_SCHED;
            PG8_LDB(B0, 1, 0); PG8_LDB(B1, 1, 1); PG8_SCHED; PG8_LDA(At, 1, 0); PG8_STAGE_A(PG8_SA(0, 1), a2, r2, 1, k2);
            PG8_WAIT_V(8); PG8_WAIT_L(0); PG8_BAR; PG8_MMA(0, 0, At, B0); PG8_MMA(0, 1, At, B1); PG8_BAR; PG8_SCHED;
            PG8_LDA(At, 1, 1); PG8_STAGE(PG8_SB(1, 0), b3, voffB0); PG8_STAGE(PG8_SB(1, 1), b3 + hstep, voffB0); PG8_STAGE_A(PG8_SA(1, 0), a2, r2, 0, k3);
            PG8_WAIT_V(8); PG8_WAIT_L(0); PG8_BAR; PG8_MMA(1, 0, At, B0); PG8_MMA(1, 1, At, B1); PG8_BAR; PG8_SCHED;
        }
        if constexpr (ALIGN_EPI) { if (wr == 0) PG8_BAR; }
        if constexpr (FP8) {
            asm volatile("s_nop 15\n\ts_nop 15\n\ts_nop 7" ::: "memory");
            _Pragma("unroll") for (int a = 0; a < 2; ++a) _Pragma("unroll") for (int b = 0; b < 2; ++b) _Pragma("unroll") for (int m = 0; m < 4; ++m) _Pragma("unroll") for (int n = 0; n < 2; ++n)
                asm volatile("" : "+v"(acc[a][b][m][n]));
        }
        if constexpr (!Epi::AFTER_DRAIN) { E(acc, cur, wr, wc, fr, fq); }
        if (!has_next) break;
#pragma unroll
        for (int a = 0; a < 2; ++a)
#pragma unroll
            for (int b = 0; b < 2; ++b)
#pragma unroll
                for (int m = 0; m < 4; ++m)
#pragma unroll
                    for (int n = 0; n < 2; ++n) acc[a][b][m][n] = (f32x4){0.f, 0.f, 0.f, 0.f};
        cur = nxt; cA = nA; cB = nB; cR = nR; ++ui;
        if constexpr (ALIGN_EPI) { if (wr == 1) PG8_BAR; }
    }
    PG8_WAIT_V(0);
    if constexpr (!ALIGN_EPI) { if (wr == 0) PG8_BAR; }
    PG8_BAR;
    if constexpr (Epi::AFTER_DRAIN) { E.fused(acc, cur, wr, wc, fr, fq, lds, wid, lane); }
#undef PG8_SA
#undef PG8_SB
#undef PG8_STAGE
#undef PG8_STAGE_A
#undef PG8_LDA
#undef PG8_LDB
#undef PG8_MMA
#undef PG8_CAT
#undef PG8_WAIT_V
#undef PG8_WAIT_L
#undef PG8_BAR
#undef PG8_SCHED
}

struct EpiInProj {
    static constexpr bool PERM = false, AFTER_DRAIN = true, MID = false;
    bf16_t* U; bf16_t* QN; bf16_t* KVN; bf16_t* KR; const float* g_q_a; const float* g_kv_a; const float* COS; const float* SIN;
    __device__ __forceinline__ void fused(f32x4 (&acc)[2][2][4][2], const Unit& u, int wr, int wc, int fr, int fq, PG8_LAS unsigned char* lds, int wid, int lane) const {
        const int row0 = u.pm * BM + wr * 64 + fr;
        if (u.pn < 2) {
#pragma unroll
            for (int ai = 0; ai < 2; ++ai)
#pragma unroll
                for (int m = 0; m < 4; ++m) { bf16_t* rowp = U + (size_t)(row0 + ai * HALF + m * 16) * 512 + u.pn * 256 + wc * 32 + 4 * fq;
#pragma unroll
                    for (int bj = 0; bj < 2; ++bj)
#pragma unroll
                        for (int n = 0; n < 2; ++n) { const f32x4 v = acc[ai][bj][m][n]; u32x2 w; w.x = cvt_pk_bf16(v[0], v[1]); w.y = cvt_pk_bf16(v[2], v[3]); *(u32x2*)(rowp + bj * HALF + n * 16) = w; } }
            return;
        }
        const bool isq = (u.pn == 2);
        PG8_LAS float* Pp = (PG8_LAS float*)lds;
#pragma unroll
        for (int ai = 0; ai < 2; ++ai)
#pragma unroll
            for (int m = 0; m < 4; ++m) { float s = 0.f;
#pragma unroll
                for (int bj = 0; bj < 2; ++bj) { if (bj == 1 && !isq) continue;
#pragma unroll
                    for (int n = 0; n < 2; ++n) { const f32x4 x = acc[ai][bj][m][n]; s += (x[0] * x[0] + x[1] * x[1]) + (x[2] * x[2] + x[3] * x[3]); } }
                s += __shfl_xor(s, 16); s += __shfl_xor(s, 32);
                if (fq == 0) Pp[(ai * HALF + wr * 64 + m * 16 + fr) * 4 + wc] = s; }
        asm volatile("s_waitcnt lgkmcnt(0)" ::: "memory"); __builtin_amdgcn_s_barrier(); asm volatile("" ::: "memory");
        const float invn = isq ? (1.f / 256.f) : (1.f / 128.f);
#pragma unroll
        for (int ai = 0; ai < 2; ++ai)
#pragma unroll
            for (int m = 0; m < 4; ++m) { const int rl = ai * HALF + wr * 64 + m * 16 + fr; const f32x4 p4 = *(const PG8_LAS f32x4*)(Pp + rl * 4);
                const float rstd = 1.f / sqrtf(((p4[0] + p4[1]) + (p4[2] + p4[3])) * invn + RMS_EPS); const size_t row = (size_t)(u.pm * BM + rl);
                if (isq) {
#pragma unroll
                    for (int bj = 0; bj < 2; ++bj)
#pragma unroll
                        for (int n = 0; n < 2; ++n) { const int c = bj * HALF + wc * 32 + n * 16 + 4 * fq; const f32x4 g = *(const f32x4*)(g_q_a + c); const f32x4 v = acc[ai][bj][m][n] * rstd * g;
                            u32x2 w; w.x = cvt_pk_bf16(v[0], v[1]); w.y = cvt_pk_bf16(v[2], v[3]); *(u32x2*)(QN + row * 256 + c) = w; }
                } else {
#pragma unroll
                    for (int n = 0; n < 2; ++n) { const int c = wc * 32 + n * 16 + 4 * fq; const f32x4 g = *(const f32x4*)(g_kv_a + c); const f32x4 v = acc[ai][0][m][n] * rstd * g;
                        u32x2 w; w.x = cvt_pk_bf16(v[0], v[1]); w.y = cvt_pk_bf16(v[2], v[3]); *(u32x2*)(KVN + row * 128 + c) = w; }
                    if (wc == 0) { const f32x4 x1 = acc[ai][1][m][0], x2 = acc[ai][1][m][1]; const f32x4 cs = *(const f32x4*)(COS + row * 16 + 4 * fq), sn = *(const f32x4*)(SIN + row * 16 + 4 * fq);
                        const f32x4 o1 = x1 * cs - x2 * sn, o2 = x2 * cs + x1 * sn; u32x2 w1, w2; w1.x = cvt_pk_bf16(o1[0], o1[1]); w1.y = cvt_pk_bf16(o1[2], o1[3]); w2.x = cvt_pk_bf16(o2[0], o2[1]); w2.y = cvt_pk_bf16(o2[2], o2[3]);
                        *(u32x2*)(KR + row * 32 + 4 * fq) = w1; *(u32x2*)(KR + row * 32 + 16 + 4 * fq) = w2; }
                } }
    }
};
}
namespace pg8 {
constexpr float QN8_SCALE = 8.f;
struct EpiQ {
    static constexpr bool PERM = false, AFTER_DRAIN = false, MID = false;
    unsigned char* QF; const float* COS; const float* SIN;
    __device__ __forceinline__ void operator()(const f32x4 (&acc)[2][2][4][2], const Unit& u, int wr, int wc, int fr, int fq) const {
        const int row0 = u.pm * BM + wr * 64 + fr; const int G0 = 8 * u.pn + wc, G1 = G0 + 4; const bool r0 = (G0 % 3) == 2, r1 = (G1 % 3) == 2;
#pragma unroll
        for (int ai = 0; ai < 2; ++ai)
#pragma unroll
            for (int m = 0; m < 4; ++m) { const size_t row = (size_t)(row0 + ai * HALF + m * 16);
                f32x4 cs = {1.f, 1.f, 1.f, 1.f}, sn = {0.f, 0.f, 0.f, 0.f};
                if (r0 || r1) { cs = *(const f32x4*)(COS + row * 16 + 4 * fq); sn = *(const f32x4*)(SIN + row * 16 + 4 * fq); }
#pragma unroll
                for (int bj = 0; bj < 2; ++bj) { const bool rope = bj ? r1 : r0; const int G = bj ? G1 : G0; f32x4 o1 = acc[ai][bj][m][0], o2 = acc[ai][bj][m][1];
                    unsigned char* hp = QF + row * 1024 + (G / 3) * 128;
                    if (rope) { const f32x4 x1 = o1, x2 = o2; o1 = (x1 * cs - x2 * sn) * QSCALE; o2 = (x2 * cs + x1 * sn) * QSCALE;
                        u32x2 w1, w2; w1.x = cvt_pk_bf16(o1[0], o1[1]); w1.y = cvt_pk_bf16(o1[2], o1[3]); w2.x = cvt_pk_bf16(o2[0], o2[1]); w2.y = cvt_pk_bf16(o2[2], o2[3]);
                        *(u32x2*)(hp + 64 + 8 * fq) = w1; *(u32x2*)(hp + 64 + 32 + 8 * fq) = w2; }
                    else { o1 = o1 * (QSCALE * QN8_SCALE); o2 = o2 * (QSCALE * QN8_SCALE); const int cb = 32 * (G % 3) + 4 * fq;
                        *(unsigned*)(hp + cb) = pk4_fp8(o1[0], o1[1], o1[2], o1[3]); *(unsigned*)(hp + cb + 16) = pk4_fp8(o2[0], o2[1], o2[2], o2[3]); } }
                asm volatile("" ::: "memory"); }
    }
};
struct EpiKV {
    static constexpr bool PERM = true, AFTER_DRAIN = false, MID = false;
    unsigned char* Kn8; bf16_t* V;
    __device__ __forceinline__ void operator()(const f32x4 (&acc)[2][2][4][2], const Unit& u, int wr, int wc, int fr, int fq) const {
        const int row0 = u.pm * BM + wr * 64 + fr;
#pragma unroll
        for (int bj = 0; bj < 2; ++bj) { const int head = 2 * u.pn + bj;
#pragma unroll
            for (int ai = 0; ai < 2; ++ai)
#pragma unroll
                for (int m = 0; m < 4; ++m) { const size_t row = (size_t)(row0 + ai * HALF + m * 16); const f32x4 v0 = acc[ai][bj][m][0], v1 = acc[ai][bj][m][1];
                    if (wc < 2) { u32x2 w; w.x = pk4_fp8(v0[0], v0[1], v0[2], v0[3]); w.y = pk4_fp8(v1[0], v1[1], v1[2], v1[3]); *(u32x2*)(Kn8 + row * 512 + head * 64 + wc * 32 + 8 * fq) = w; }
                    else { u32x4 w; w.x = cvt_pk_bf16(v0[0], v0[1]); w.y = cvt_pk_bf16(v0[2], v0[3]); w.z = cvt_pk_bf16(v1[0], v1[1]); w.w = cvt_pk_bf16(v1[2], v1[3]); *(u32x4*)(V + row * 512 + head * 64 + (wc - 2) * 32 + 8 * fq) = w; } } }
    }
};
struct EpiOut {
    static constexpr bool PERM = true, AFTER_DRAIN = false, MID = true;
    const float* x; float* out; const float* SSQ; int aux_off;
    __device__ __forceinline__ void pre(const Unit& u, PG8_LAS unsigned char* lds, int tid) const {
        if (tid < 256) { const f32x4 a = *(const f32x4*)(SSQ + (size_t)(u.pm * BM + tid) * 8), b = *(const f32x4*)(SSQ + (size_t)(u.pm * BM + tid) * 8 + 4);
            const float s = ((a[0] + a[1]) + (a[2] + a[3])) + ((b[0] + b[1]) + (b[2] + b[3])); ((PG8_LAS float*)(lds + aux_off))[tid] = 1.f / sqrtf(s * (1.f / 512.f) + RMS_EPS); }
    }
    __device__ __forceinline__ void mid(f32x4 (&acc)[2][2][4][2], int wr, int fr, PG8_LAS unsigned char* lds) const {
#pragma unroll
        for (int ai = 0; ai < 2; ++ai)
#pragma unroll
            for (int m = 0; m < 4; ++m) { const float sa = ((const PG8_LAS float*)(lds + aux_off))[ai * HALF + wr * 64 + m * 16 + fr];
#pragma unroll
                for (int bj = 0; bj < 2; ++bj)
#pragma unroll
                    for (int n = 0; n < 2; ++n) acc[ai][bj][m][n] = acc[ai][bj][m][n] * sa; }
    }
    __device__ __forceinline__ void operator()(const f32x4 (&acc)[2][2][4][2], const Unit& u, int wr, int wc, int fr, int fq) const {
        const int row0 = u.pm * BM + wr * 64 + fr, col0 = u.pn * BM + wc * 32 + 8 * fq;
#pragma unroll
        for (int ai = 0; ai < 2; ++ai)
#pragma unroll
            for (int m = 0; m < 4; ++m) { const size_t off = (size_t)(row0 + ai * HALF + m * 16) * 1024 + col0;
#pragma unroll
                for (int bj = 0; bj < 2; ++bj)
#pragma unroll
                    for (int n = 0; n < 2; ++n) *(f32x4*)(out + off + bj * HALF + n * 4) = *(const f32x4*)(x + off + bj * HALF + n * 4) + acc[ai][bj][m][n]; }
    }
};
struct EpiSwiglu {
    static constexpr bool PERM = true, AFTER_DRAIN = false, MID = false;
    const float* bgu; bf16_t* ACT;
    __device__ __forceinline__ void operator()(const f32x4 (&acc)[2][2][4][2], const Unit& u, int wr, int wc, int fr, int fq) const {
        const int row0 = u.pm * BM + wr * 64 + fr, col8 = u.pn * HALF + wc * 32 + 8 * fq;
        f32x4 bg[2], bu[2];
#pragma unroll
        for (int n = 0; n < 2; ++n) { bg[n] = *(const f32x4*)(bgu + (size_t)u.e * 2048 + col8 + 4 * n); bu[n] = *(const f32x4*)(bgu + (size_t)u.e * 2048 + 1024 + col8 + 4 * n); }
#pragma unroll
        for (int ai = 0; ai < 2; ++ai)
#pragma unroll
            for (int m = 0; m < 4; ++m) { f32x4 a[2];
#pragma unroll
                for (int n = 0; n < 2; ++n) { const f32x4 g4 = acc[ai][0][m][n] + bg[n], u4 = acc[ai][1][m][n] + bu[n];
#pragma unroll
                    for (int j = 0; j < 4; ++j) { const float g = fminf(g4[j], 7.f), uu = fminf(fmaxf(u4[j], -7.f), 7.f);
                        const float sg = __builtin_amdgcn_rcpf(1.f + __builtin_amdgcn_exp2f(-1.702f * 1.4426950408889634f * g)); a[n][j] = g * sg * (uu + 1.f); } }
                u32x4 w; w.x = cvt_pk_bf16(a[0][0], a[0][1]); w.y = cvt_pk_bf16(a[0][2], a[0][3]); w.z = cvt_pk_bf16(a[1][0], a[1][1]); w.w = cvt_pk_bf16(a[1][2], a[1][3]);
                *(u32x4*)(ACT + (size_t)(row0 + ai * HALF + m * 16) * 1024 + col8) = w; }
    }
};
struct EpiDown {
    static constexpr bool PERM = true, AFTER_DRAIN = false, MID = false;
    const float* bd; const float* GL; bf16_t* Y;
    __device__ __forceinline__ void operator()(const f32x4 (&acc)[2][2][4][2], const Unit& u, int wr, int wc, int fr, int fq) const {
        const int col0 = u.pn * BM + wc * 32 + 8 * fq;
        f32x4 bv[2][2];
#pragma unroll
        for (int bj = 0; bj < 2; ++bj)
#pragma unroll
            for (int n = 0; n < 2; ++n) bv[bj][n] = *(const f32x4*)(bd + (size_t)u.e * 1024 + col0 + bj * HALF + 4 * n);
#pragma unroll
        for (int ai = 0; ai < 2; ++ai)
#pragma unroll
            for (int m = 0; m < 4; ++m) { const int rl = ai * HALF + wr * 64 + m * 16 + fr; const float gt = GL[(size_t)u.e * T + u.rt + rl]; bf16_t* rowp = Y + (size_t)(u.pm * BM + rl) * 1024 + col0;
#pragma unroll
                for (int bj = 0; bj < 2; ++bj) { const f32x4 v0 = (acc[ai][bj][m][0] + bv[bj][0]) * gt, v1 = (acc[ai][bj][m][1] + bv[bj][1]) * gt;
                    u32x4 w; w.x = cvt_pk_bf16(v0[0], v0[1]); w.y = cvt_pk_bf16(v0[2], v0[3]); w.z = cvt_pk_bf16(v1[0], v1[1]); w.w = cvt_pk_bf16(v1[2], v1[3]); *(u32x4*)(rowp + bj * HALF) = w; } }
    }
};
struct EpiSwiglu8 {
    static constexpr bool PERM = true, AFTER_DRAIN = false, MID = false;
    const float* bgu; unsigned char* ACT;
    __device__ __forceinline__ void operator()(const f32x4 (&acc)[2][2][4][2], const Unit& u, int wr, int wc, int fr, int fq) const {
        const int row0 = u.pm * BM + wr * 64 + fr, col8 = u.pn * HALF + wc * 32 + 8 * fq;
        f32x4 bg[2], bu[2];
#pragma unroll
        for (int n = 0; n < 2; ++n) { bg[n] = *(const f32x4*)(bgu + (size_t)u.e * 2048 + col8 + 4 * n); bu[n] = *(const f32x4*)(bgu + (size_t)u.e * 2048 + 1024 + col8 + 4 * n); }
#pragma unroll
        for (int ai = 0; ai < 2; ++ai)
#pragma unroll
            for (int m = 0; m < 4; ++m) { f32x4 a[2];
#pragma unroll
                for (int n = 0; n < 2; ++n) { const f32x4 g4 = acc[ai][0][m][n] * W8_INV + bg[n], u4 = acc[ai][1][m][n] * W8_INV + bu[n];
#pragma unroll
                    for (int j = 0; j < 4; ++j) { const float g = fminf(g4[j], 7.f), uu = fminf(fmaxf(u4[j], -7.f), 7.f);
                        const float sg = __builtin_amdgcn_rcpf(1.f + __builtin_amdgcn_exp2f(-1.702f * 1.4426950408889634f * g)); a[n][j] = g * sg * (uu + 1.f); } }
                u32x2 w; w.x = pk4_fp8_nc(a[0][0], a[0][1], a[0][2], a[0][3]); w.y = pk4_fp8_nc(a[1][0], a[1][1], a[1][2], a[1][3]);
                *(u32x2*)(ACT + (size_t)(row0 + ai * HALF + m * 16) * 1024 + col8) = w; }
    }
};
constexpr float Y8_SCALE = 16.f, Y8_INV = 1.f / 16.f;
struct EpiDown8 {
    static constexpr bool PERM = true, AFTER_DRAIN = false, MID = false;
    const float* bd; const float* GL; unsigned char* Y;
    __device__ __forceinline__ void operator()(const f32x4 (&acc)[2][2][4][2], const Unit& u, int wr, int wc, int fr, int fq) const {
        const int col0 = u.pn * BM + wc * 32 + 8 * fq;
        f32x4 bv[2][2];
#pragma unroll
        for (int bj = 0; bj < 2; ++bj)
#pragma unroll
            for (int n = 0; n < 2; ++n) bv[bj][n] = *(const f32x4*)(bd + (size_t)u.e * 1024 + col0 + bj * HALF + 4 * n);
#pragma unroll
        for (int ai = 0; ai < 2; ++ai)
#pragma unroll
            for (int m = 0; m < 4; ++m) { const int rl = ai * HALF + wr * 64 + m * 16 + fr; const float gt = GL[(size_t)u.e * T + u.rt + rl] * Y8_SCALE; unsigned char* rowp = Y + (size_t)(u.pm * BM + rl) * 1024 + col0;
#pragma unroll
                for (int bj = 0; bj < 2; ++bj) { const f32x4 v0 = (acc[ai][bj][m][0] * W8_INV + bv[bj][0]) * gt, v1 = (acc[ai][bj][m][1] * W8_INV + bv[bj][1]) * gt;
                    u32x2 w; w.x = pk4_fp8(v0[0], v0[1], v0[2], v0[3]); w.y = pk4_fp8(v1[0], v1[1], v1[2], v1[3]); *(u32x2*)(rowp + bj * HALF) = w; } }
    }
};
template <bool GATHER>
struct MoeOrder {
    const char* A; const char* W; size_t wstride; int NN, G, c, rt0; const PG8_LAS int* tstart; int rowbytes;
    __device__ bool next(int i, Unit& u) const {
        const int nwg = tstart[32] * NN; const long L = (long)i * G + c; if (L >= nwg) return false;
        int wgid = (int)L; { const int q = nwg / NXCD, r = nwg % NXCD, xcd = wgid % NXCD, off = wgid / NXCD; wgid = (xcd < r ? xcd * (q + 1) : r * (q + 1) + (xcd - r) * q) + off; }
        const int mt = wgid / NN, pn = wgid % NN; int e = 0;
        for (int k = 1; k < 32; ++k) e += (tstart[k] <= mt) ? 1 : 0;
        u.pm = mt; u.pn = pn; u.e = e; const int jt = mt - tstart[e];
        u.a = GATHER ? A : A + (size_t)mt * BM * rowbytes; u.b = W + (size_t)e * wstride + (size_t)pn * BM * rowbytes;
        u.rt = GATHER ? rt0 + i * 1024 : jt * 256;
        return true;
    }
};
}

template <bool GATHER>
__device__ __forceinline__ void moe_setup(const Ptrs& P, LAS unsigned char* lds, const pg8::MoeOrder<GATHER>& S) {
    const int tid = threadIdx.x; const int* cnt = (const int*)(P.ws + WS_CTL) + CW_CNT;
    if (tid < 33) { int s = 0; for (int e = 0; e < tid; ++e) s += (cnt[e] + 255) >> 8; ((LAS int*)(lds + TS_OFF))[tid] = s; }
    __syncthreads();
    if constexpr (GATHER) {
        const int* LIST = (const int*)(P.ws + WS_LIST); pg8::Unit u;
        for (int i = 0; i < 9 && S.next(i, u); ++i) {
            if (tid < 256) { const int jt = u.pm - S.tstart[u.e]; int pos = jt * 256 + tid; const int n = cnt[u.e]; if (pos >= n) pos = n - 1;
                ((LAS unsigned*)(lds + GT_OFF + i * 1024))[tid] = (unsigned)LIST[(size_t)u.e * T + pos] * (unsigned)S.rowbytes; }
        }
        __syncthreads();
    }
}
namespace att {
typedef short s16x4 __attribute__((ext_vector_type(4)));
typedef float f32x16 __attribute__((ext_vector_type(16)));
constexpr int NW = 8, QBLK = 32, KVBLK = 64, QB = NW * QBLK;
constexpr int SHM_V = KVBLK * 64 * 2, SHM_K = KVBLK * 128;
constexpr int NVS = 3;
constexpr int OFF_V = 0, OFF_K = NVS * SHM_V, OFF_WS = OFF_K + 2 * SHM_K, OFF_OST = OFF_WS + NW * 64 * 4, ATT_LDS = OFF_OST + NW * 4096;
constexpr float THR2 = 11.5f;
#define KSWZ(row, ch) ((row) * 128 + ((((ch) ^ (((row) >> 1) & 7))) << 4))
#define SBAR() __builtin_amdgcn_sched_barrier(0)
__device__ __forceinline__ int v_st(int k, int c) { return ((k >> 3) * 2 + (c >> 5)) * 512 + ((k & 7) * 32 + (c & 31)) * 2; }
__device__ __forceinline__ int v_rd_base(int lane) { return ((lane & 3) << 3) | (((lane >> 2) & 3) << 6) | (((lane >> 4) & 1) << 5) | (((lane >> 5) & 1) << 8); }
__device__ __forceinline__ int crow(int r, int hi) { return (r & 3) + 8 * (r >> 2) + 4 * hi; }
__device__ __forceinline__ unsigned cvtpk(float lo, float hi) { unsigned r; asm volatile("v_cvt_pk_bf16_f32 %0, %1, %2" : "=v"(r) : "v"(lo), "v"(hi)); return r; }
__device__ __forceinline__ void mask_tile(f32x16& p0, f32x16& p1, int dq) {
    const float NEG = -__builtin_inff();
#pragma unroll
    for (int r = 0; r < 16; ++r) { const int c = (r & 3) + 8 * (r >> 2); if (dq - c < 0) p0[r] = NEG; if (dq - c - 32 < 0) p1[r] = NEG; }
}
template <bool FIRST, int VAR = 0>
__device__ __forceinline__ void partialSM(f32x16& p0, f32x16& p1, float& m_reg, f32x16& negm, float& alpha) {
    if constexpr (VAR == 1) { alpha = 1.f; return; }
    float pmax = p0[0];
#pragma unroll
    for (int r = 1; r < 16; ++r) pmax = fmaxf(pmax, p0[r]);
#pragma unroll
    for (int r = 0; r < 16; ++r) pmax = fmaxf(pmax, p1[r]);
    { auto rr = __builtin_amdgcn_permlane32_swap(__float_as_uint(pmax), __float_as_uint(pmax), false, false); pmax = fmaxf(__uint_as_float(rr[0]), __uint_as_float(rr[1])); }
    if (!FIRST && __builtin_expect(__all(pmax <= THR2), 1)) { alpha = 1.f; }
    else { const float dl = FIRST ? pmax : fmaxf(pmax, 0.f); m_reg += dl; alpha = FIRST ? 1.f : __builtin_amdgcn_exp2f(-dl);
#pragma unroll
        for (int r = 0; r < 16; ++r) { p0[r] -= dl; p1[r] -= dl; }
#pragma unroll
        for (int r = 0; r < 16; ++r) negm[r] = -m_reg;
        asm volatile("" : "+v"(negm)); }
#pragma unroll
    for (int r = 0; r < 16; ++r) p0[r] = __builtin_amdgcn_exp2f(p0[r]);
}
template <int VAR = 0>
__device__ __forceinline__ void finishSM(f32x16& p0, f32x16& p1, float alpha, float& l_reg, bf16x8& pa0, bf16x8& pa1, bf16x8& pa2, bf16x8& pa3) {
    if constexpr (VAR != 1) {
#pragma unroll
    for (int r = 0; r < 16; ++r) p1[r] = __builtin_amdgcn_exp2f(p1[r]); }
    float ps = 0;
#pragma unroll
    for (int r = 0; r < 16; ++r) ps += p0[r];
#pragma unroll
    for (int r = 0; r < 16; ++r) ps += p1[r];
    { auto rr = __builtin_amdgcn_permlane32_swap(__float_as_uint(ps), __float_as_uint(ps), false, false); ps = __uint_as_float(rr[0]) + __uint_as_float(rr[1]); }
    l_reg = l_reg * alpha + ps;
#define PK4(P, B_, OUT) do { u32x4 w = {cvtpk(P[B_+0], P[B_+1]), cvtpk(P[B_+2], P[B_+3]), cvtpk(P[B_+4], P[B_+5]), cvtpk(P[B_+6], P[B_+7])}; OUT = *reinterpret_cast<bf16x8*>(&w); } while (0)
    PK4(p0, 0, pa0); PK4(p0, 8, pa1); PK4(p1, 0, pa2); PK4(p1, 8, pa3);
#undef PK4
}
typedef int v8i_a __attribute__((ext_vector_type(8)));
typedef int v4i_a __attribute__((ext_vector_type(4)));
template <int KB, int VAR = 0>
__device__ __forceinline__ void qkt(f32x16& p0, f32x16& p1, const char* K_lds, int r32, int hi, const v8i_a& qn, const bf16x8* qro, const f32x16& negm) {
    if constexpr (VAR == 2) { p0 = negm; p1 = negm; asm volatile("" : "+v"(p0), "+v"(p1)); return; }
    const char* kb = K_lds + KB * SHM_K;
    const v4i_a a0 = *reinterpret_cast<const v4i_a*>(kb + KSWZ(r32, 2 * hi)), a1 = *reinterpret_cast<const v4i_a*>(kb + KSWZ(r32, 2 * hi + 1));
    const v4i_a b0 = *reinterpret_cast<const v4i_a*>(kb + KSWZ(32 + r32, 2 * hi)), b1 = *reinterpret_cast<const v4i_a*>(kb + KSWZ(32 + r32, 2 * hi + 1));
    const bf16x8 c0 = *reinterpret_cast<const bf16x8*>(kb + KSWZ(r32, 4 + hi)), c1 = *reinterpret_cast<const bf16x8*>(kb + KSWZ(r32, 6 + hi));
    const bf16x8 d0 = *reinterpret_cast<const bf16x8*>(kb + KSWZ(32 + r32, 4 + hi)), d1 = *reinterpret_cast<const bf16x8*>(kb + KSWZ(32 + r32, 6 + hi));
    __builtin_amdgcn_s_setprio(1);
    p0 = __builtin_amdgcn_mfma_scale_f32_32x32x64_f8f6f4(__builtin_shufflevector(a0, a1, 0, 1, 2, 3, 4, 5, 6, 7), qn, negm, 0, 0, 0, 0x7f7f7f7f, 0, 0x7c7c7c7c);
    p1 = __builtin_amdgcn_mfma_scale_f32_32x32x64_f8f6f4(__builtin_shufflevector(b0, b1, 0, 1, 2, 3, 4, 5, 6, 7), qn, negm, 0, 0, 0, 0x7f7f7f7f, 0, 0x7c7c7c7c);
    p0 = __builtin_amdgcn_mfma_f32_32x32x16_bf16(c0, qro[0], p0, 0, 0, 0);
    p1 = __builtin_amdgcn_mfma_f32_32x32x16_bf16(d0, qro[0], p1, 0, 0, 0);
    p0 = __builtin_amdgcn_mfma_f32_32x32x16_bf16(c1, qro[1], p0, 0, 0, 0);
    p1 = __builtin_amdgcn_mfma_f32_32x32x16_bf16(d1, qro[1], p1, 0, 0, 0);
    __builtin_amdgcn_s_setprio(0);
}
typedef short v4i16_t __attribute__((ext_vector_type(4)));
__device__ __forceinline__ s16x4 vtr(const char* p) { return __builtin_bit_cast(s16x4, __builtin_amdgcn_ds_read_tr16_b64_v4i16((__attribute__((address_space(3))) v4i16_t*)(p))); }
template <int VAR = 0>
__device__ __forceinline__ void pv_tile(f32x16* o, const char* vb, bf16x8 pa0, bf16x8 pa1, bf16x8 pa2, bf16x8 pa3) {
    if constexpr (VAR == 2) { asm volatile("" :: "v"(pa0), "v"(pa1), "v"(pa2), "v"(pa3)); return; }
#pragma unroll
    for (int d0 = 0; d0 < 2; ++d0) { const char* b_ = vb + d0 * 512;
        const s16x4 l0 = vtr(b_), h0 = vtr(b_ + 1024), l1 = vtr(b_ + 2048), h1 = vtr(b_ + 3072), l2 = vtr(b_ + 4096), h2 = vtr(b_ + 5120), l3 = vtr(b_ + 6144), h3 = vtr(b_ + 7168);
        __builtin_amdgcn_s_setprio(1);
        o[d0] = __builtin_amdgcn_mfma_f32_32x32x16_bf16(pa0, (bf16x8){l0[0], l0[1], l0[2], l0[3], h0[0], h0[1], h0[2], h0[3]}, o[d0], 0, 0, 0);
        o[d0] = __builtin_amdgcn_mfma_f32_32x32x16_bf16(pa1, (bf16x8){l1[0], l1[1], l1[2], l1[3], h1[0], h1[1], h1[2], h1[3]}, o[d0], 0, 0, 0);
        o[d0] = __builtin_amdgcn_mfma_f32_32x32x16_bf16(pa2, (bf16x8){l2[0], l2[1], l2[2], l2[3], h2[0], h2[1], h2[2], h2[3]}, o[d0], 0, 0, 0);
        o[d0] = __builtin_amdgcn_mfma_f32_32x32x16_bf16(pa3, (bf16x8){l3[0], l3[1], l3[2], l3[3], h3[0], h3[1], h3[2], h3[3]}, o[d0], 0, 0, 0);
        __builtin_amdgcn_s_setprio(0); }
}
constexpr int CV_UNITS = 32 * 768, CV_BUF = 64 * 68 * 4, OFF_CV = ATT_LDS, OFF_CVT = OFF_CV + 2 * CV_BUF, CV_MAXJ = 128;
static_assert(OFF_CV % 16 == 0 && OFF_CVT + CV_MAXJ * 16 <= 131072, "conversion images + unit table fit beside the attention scratch");
struct Cv { f32x4 a0, a1, b0, b1; int next, nj, pa, pb, emit, sb; };
typedef unsigned u32x4_cv __attribute__((ext_vector_type(4)));
__device__ __forceinline__ void cv_build_table(const Ptrs& P, char* lds, int nj, int tid) {
    if (tid < nj) { const int u = (int)blockIdx.x + tid * (int)gridDim.x; const int e = u / 768, q = u % 768; u32x4_cv t;
        if (q < 512) { const int kb = q >> 5, nb = q & 31, n0 = 64 * nb; const int nn = n0 & 1023, p = nn >> 7, dn0 = 256 * p + (n0 >= 1024 ? 128 : 0) + (nn & 127);
            t.x = (unsigned)(((size_t)e * 1024 * 2048 + (size_t)(64 * kb) * 2048 + n0) * 4); t.y = (unsigned)(WS_WGU + (size_t)e * 2048 * 1024 + (size_t)dn0 * 1024 + 64 * kb); t.z = 2048u * 4u; t.w = 0u; }
        else { const int qq = q - 512, kb = qq >> 4, nb = qq & 15;
            t.x = (unsigned)(((size_t)e * 1024 * 1024 + (size_t)(64 * kb) * 1024 + 64 * nb) * 4); t.y = (unsigned)(WS_WD + (size_t)e * 1024 * 1024 + (size_t)(64 * nb) * 1024 + 64 * kb); t.z = 1024u * 4u; t.w = 1u; }
        *(u32x4_cv*)(lds + OFF_CVT + tid * 16) = t; }
}
__device__ __forceinline__ void cv_load(const Ptrs& P, const char* lds, int j, f32x4& r0, f32x4& r1, int tid) {
    const u32x4_cv t = *(const u32x4_cv*)(lds + OFF_CVT + j * 16);
    const char* p = (t.w ? (const char*)P.w_down : (const char*)P.w_gu) + t.x + (unsigned)(tid >> 4) * t.z + (tid & 15) * 16;
    r0 = __builtin_nontemporal_load((const f32x4*)p); r1 = __builtin_nontemporal_load((const f32x4*)(p + 32u * t.z));
}
__device__ __forceinline__ void cv_stage(const f32x4& r0, const f32x4& r1, char* buf, int tid) {
    const int k = tid >> 4, c4 = (tid & 15) * 4;
    *(f32x4*)(buf + (k * 68 + ((c4 + 4 * (k >> 3)) & 63)) * 4) = r0 * W8_SCALE;
    *(f32x4*)(buf + ((k + 32) * 68 + ((c4 + 4 * ((k + 32) >> 3)) & 63)) * 4) = r1 * W8_SCALE;
}
__device__ __forceinline__ void cv_begin(const Ptrs& P, Cv& cv, char* lds, int tid) {
    const bool on = cv.emit >= 0; const int n = tid >> 3, g = tid & 7;
    const float* q = (const float*)(lds + OFF_CV + (cv.sb ^ 1) * CV_BUF) + (8 * g) * 68 + ((n + 4 * g) & 63);
    u32x2 o; o.x = pk4_fp8(q[0 * 68], q[1 * 68], q[2 * 68], q[3 * 68]); o.y = pk4_fp8(q[4 * 68], q[5 * 68], q[6 * 68], q[7 * 68]);
    const unsigned doff = on ? *(const unsigned*)(lds + OFF_CVT + cv.emit * 16 + 4) + (unsigned)(n * 1024 + 8 * g) : (unsigned)(WS_TMP + (size_t)blockIdx.x * 4096 + tid * 8);
    *(u32x2*)(P.ws + doff) = o;
}
__device__ __forceinline__ void cv_mid(const Ptrs& P, Cv& cv, f32x4& r0, f32x4& r1, int& pend, char* lds, int tid) {
    int staged = -1;
    if (pend >= 0) { cv_stage(r0, r1, lds + OFF_CV + cv.sb * CV_BUF, tid); staged = pend; }
    const bool more = cv.next < cv.nj;
    cv_load(P, lds, more ? cv.next : 0, r0, r1, tid); pend = more ? cv.next : -1; if (more) cv.next += 1;
    cv.emit = staged; if (staged >= 0) cv.sb ^= 1;
}
struct BlockRef { const unsigned char* Q; const unsigned char* Kn; const unsigned char* KR; const bf16_t* V; bf16_t* O; float* SSQ; int P0; };
struct Seam { v8i_a qn; bf16x8 qro[2]; bf16x8 st_v0, st_k0; };
#define VMW() asm volatile("s_waitcnt vmcnt(0)" ::: "memory")
#define VMWN(n) asm volatile("s_waitcnt vmcnt(%0)" :: "i"(n) : "memory")
#define KSRC(B, k0) (ch < 4 ? (B).Kn + (size_t)((k0) + sr) * 512 + ch * 16 : (B).KR + (size_t)((k0) + sr) * 64 + (ch - 4) * 16)
#define SLOAD_H(B, k0) do { S.st_v0 = *(const bf16x8*)((B).V + (size_t)((k0) + vk) * 512 + vc); S.st_k0 = *(const bf16x8*)KSRC(B, k0); } while (0)
#define SWRITE_HK(bf) do { *(bf16x8*)(K_lds + (bf) * SHM_K + kws) = S.st_k0; } while (0)
#define QLOAD(B) do { const unsigned char* qp_ = (B).Q + (size_t)(wid * QBLK + r32) * 1024; \
        const v4i_a q0_ = *(const v4i_a*)(qp_ + 32 * hi), q1_ = *(const v4i_a*)(qp_ + 32 * hi + 16); S.qn = __builtin_shufflevector(q0_, q1_, 0, 1, 2, 3, 4, 5, 6, 7); \
        S.qro[0] = *(const bf16x8*)(qp_ + 64 + 16 * hi); S.qro[1] = *(const bf16x8*)(qp_ + 96 + 16 * hi); } while (0)
#define SWRITE_HV(vs) do { *(bf16x8*)(V_lds + (vs) * SHM_V + vst0) = S.st_v0; } while (0)
#define SWRITE_H(bf, vs) do { SWRITE_HV(vs); SWRITE_HK(bf); } while (0)
__device__ __forceinline__ void attn_prime(const BlockRef& cur, char* lds, Seam& S) {
    const int tid = tid_opaque(), wid = __builtin_amdgcn_readfirstlane(tid >> 6), lane = tid & 63, r32 = lane & 31, hi = lane >> 5;
    const int sr = tid >> 3, ch = tid & 7, kws = KSWZ(sr, ch), vk = tid >> 3, vc = (tid & 7) * 8; char* K_lds = lds + OFF_K;
    QLOAD(cur);
    SLOAD_H(cur, 0); VMW(); SWRITE_HK(0);
    __syncthreads();
}
template <int VAR = 0>
__device__ __forceinline__ void attn_block(const Ptrs& P, Cv& cv, const BlockRef& cur, const BlockRef& nxt, char* lds, Seam& S) {
    const int tid = tid_opaque(), wid = __builtin_amdgcn_readfirstlane(tid >> 6), lane = tid & 63, r32 = lane & 31, hi = lane >> 5;
    const int NT = (cur.P0 + QB) / KVBLK;
    const int qlo = cur.P0 + wid * QBLK, qm = qlo + r32 - 4 * hi;
    char* V_lds = lds + OFF_V; char* K_lds = lds + OFF_K;
    float* ws = (float*)(lds + OFF_WS) + wid * 64; float* li_l = ws, * al_l = ws + 32;
    float m_reg = 0.f, l_reg = 0; f32x16 o[2] = {}; f32x16 negm = {}; asm volatile("" : "+v"(negm));
    const int sr = tid >> 3, ch = tid & 7, kws = KSWZ(sr, ch), vk = tid >> 3, vc = (tid & 7) * 8, vst0 = v_st(vk, vc);
    const char* vrd = lds + OFF_V + v_rd_base(lane);
#define RESC(a) do { if (__any((a) < 1.f)) { if (hi == 0) al_l[r32] = (a); asm volatile("s_waitcnt lgkmcnt(0)" ::: "memory"); \
                     _Pragma("unroll") for (int d_ = 0; d_ < 2; ++d_) _Pragma("unroll") for (int r = 0; r < 16; ++r) o[d_][r] *= al_l[crow(r, hi)]; } } while (0)
#define KBASE(t) ((t) * KVBLK)
#define MASKT(P0_, P1_, t) do { const int kb_ = KBASE(t); if (VAR != 1 && kb_ + KVBLK - 1 > qlo) mask_tile(P0_, P1_, qm - kb_); } while (0)
    constexpr int NQL = 4;
#define SEAM_K0() do { VMWN(NQL); SWRITE_HK(0); SBAR(); } while (0)
#define VROT(x) ((x) == (NVS - 1) * SHM_V ? 0 : (x) + SHM_V)
    f32x16 pA0, pA1, pB0, pB1; float alA, alB; bf16x8 pa0, pa1, pa2, pa3;
    int vrs = 0, vws = SHM_V;
    SWRITE_HV(0); SBAR();
    if (NT > 1) SLOAD_H(cur, KBASE(1));
    SBAR(); qkt<0, VAR>(pA0, pA1, K_lds, r32, hi, S.qn, S.qro, negm);
    MASKT(pA0, pA1, 0); partialSM<true, VAR>(pA0, pA1, m_reg, negm, alA);
    if (NT > 1) { VMW(); *(bf16x8*)(V_lds + vws + vst0) = S.st_v0; SWRITE_HK(1); }
    if (CONV_IN_ATTN) { SBAR(); if (VAR == 0) { cv_begin(P, cv, lds, tid); SBAR(); } SLOAD_H(cur, KBASE(2)); SBAR(); if (VAR == 0) { cv_mid(P, cv, cv.b0, cv.b1, cv.pb, lds, tid); SBAR(); } }
    __syncthreads();
#if CONV_IN_ATTN
#define HALF_STEP(PX0, PX1, alX, PY0, PY1, alY, t, KB, KBN, CR0, CR1, CPEND) do { \
        SBAR(); if (VAR == 0) { cv_begin(P, cv, lds, tid); SBAR(); } \
        qkt<KB, VAR>(PX0, PX1, K_lds, r32, hi, S.qn, S.qro, negm); \
        finishSM<VAR>(PY0, PY1, alY, l_reg, pa0, pa1, pa2, pa3); SBAR(); \
        pv_tile<VAR>(o, vrd + vrs, pa0, pa1, pa2, pa3); MASKT(PX0, PX1, (t)); partialSM<false, VAR>(PX0, PX1, m_reg, negm, alX); \
        vrs = VROT(vrs); vws = VROT(vws); SBAR(); \
        if ((t) + 1 < NT) { *(bf16x8*)(V_lds + vws + vst0) = S.st_v0; SWRITE_HK(KBN); } SBAR(); \
        { const int tn_ = (t) + 2 < NT ? (t) + 2 : NT - 1; SLOAD_H(cur, KBASE(tn_)); } SBAR(); \
        if (VAR == 0) { cv_mid(P, cv, CR0, CR1, CPEND, lds, tid); SBAR(); } \
        RESC(alX); __syncthreads(); } while (0)
#else
#define HALF_STEP(PX0, PX1, alX, PY0, PY1, alY, t, KB, KBN, CR0, CR1, CPEND) do { \
        SBAR(); qkt<KB, VAR>(PX0, PX1, K_lds, r32, hi, S.qn, S.qro, negm); \
        finishSM<VAR>(PY0, PY1, alY, l_reg, pa0, pa1, pa2, pa3); SBAR(); \
        if ((t) + 1 < NT) { SLOAD_H(cur, KBASE((t) + 1)); SBAR(); } \
        pv_tile<VAR>(o, vrd + vrs, pa0, pa1, pa2, pa3); MASKT(PX0, PX1, (t)); partialSM<false, VAR>(PX0, PX1, m_reg, negm, alX); \
        vrs = VROT(vrs); vws = VROT(vws); \
        if ((t) + 1 < NT) { VMW(); *(bf16x8*)(V_lds + vws + vst0) = S.st_v0; SWRITE_HK(KBN); } \
        RESC(alX); __syncthreads(); } while (0)
#endif
    for (int t = 1; t + 1 < NT; t += 2) {
        HALF_STEP(pB0, pB1, alB, pA0, pA1, alA, t, 1, 0, cv.a0, cv.a1, cv.pa);
        HALF_STEP(pA0, pA1, alA, pB0, pB1, alB, t + 1, 0, 1, cv.b0, cv.b1, cv.pb);
    }
    SBAR(); qkt<1, VAR>(pB0, pB1, K_lds, r32, hi, S.qn, S.qro, negm); SBAR();
    SLOAD_H(nxt, 0); SBAR();
    QLOAD(nxt);
    SBAR();
    finishSM<VAR>(pA0, pA1, alA, l_reg, pa0, pa1, pa2, pa3); SBAR();
    pv_tile<VAR>(o, vrd + vrs, pa0, pa1, pa2, pa3);
    MASKT(pB0, pB1, NT - 1); partialSM<false, VAR>(pB0, pB1, m_reg, negm, alB); RESC(alB);
    vrs = VROT(vrs);
    finishSM<VAR>(pB0, pB1, alB, l_reg, pa0, pa1, pa2, pa3); SBAR(); pv_tile<VAR>(o, vrd + vrs, pa0, pa1, pa2, pa3);
    SBAR(); SEAM_K0();
    if (hi == 0) li_l[r32] = l_reg; asm volatile("s_waitcnt lgkmcnt(0)" ::: "memory");
    float rli[16];
#pragma unroll
    for (int r = 0; r < 16; ++r) rli[r] = __builtin_amdgcn_rcpf(li_l[crow(r, hi)]);
    { bf16_t* stg = (bf16_t*)(lds + OFF_OST) + wid * 2048;
#pragma unroll
      for (int r = 0; r < 16; ++r) { const int orow = crow(r, hi);
#pragma unroll
          for (int d0 = 0; d0 < 2; ++d0) stg[orow * 64 + d0 * 32 + r32] = (bf16_t)f2bf(o[d0][r] * rli[r]); }
      asm volatile("s_waitcnt lgkmcnt(0)" ::: "memory");
#pragma unroll
      for (int i = 0; i < 4; ++i) { const int row = i * 8 + (lane >> 3), c8 = lane & 7; const u32x4 v = *(const u32x4*)(stg + row * 64 + c8 * 8);
          *(u32x4*)(cur.O + (size_t)(wid * QBLK + row) * 1024 + c8 * 8) = v;
          float s = 0.f;
#pragma unroll
          for (int j = 0; j < 4; ++j) { const float a = __builtin_bit_cast(float, v[j] << 16), b = __builtin_bit_cast(float, v[j] & 0xffff0000u); s += a * a + b * b; }
          s += __shfl_xor(s, 1); s += __shfl_xor(s, 2); s += __shfl_xor(s, 4);
          if (c8 == 0) cur.SSQ[(size_t)(wid * QBLK + row) * 8] = s; } }
    __syncthreads();
#undef RESC
#undef KBASE
#undef MASKT
#undef SEAM_K0
#undef HALF_STEP
#undef VROT
}
#undef VMW
#undef VMWN
#undef KSRC
#undef SLOAD_H
#undef QLOAD
#undef SWRITE_HK
#undef SWRITE_HV
#undef SWRITE_H
#undef KSWZ
#undef SBAR
__device__ __forceinline__ BlockRef block_ref(const Ptrs& P, int bh, int qb) {
    const int b = bh >> 3, h = bh & 7; const size_t r0 = (size_t)b * SEQ + (size_t)qb * QB; BlockRef r;
    r.Q = P.ws + WS_Q + r0 * 1024 + h * 128; r.Kn = P.ws + WS_K + (size_t)b * SEQ * 512 + h * 64; r.KR = P.ws + WS_KR + (size_t)b * SEQ * 64;
    r.V = (const bf16_t*)(P.ws + WS_V) + (size_t)b * SEQ * 512 + h * 64; r.O = (bf16_t*)(P.ws + WS_MIX) + r0 * 1024 + h * 64; r.SSQ = (float*)(P.ws + WS_SSQ) + r0 * 8 + h; r.P0 = qb * QB; return r;
}
template <int VAR = 0>
__device__ __forceinline__ void attn_phase(const Ptrs& P, char* lds) {
    const int G = gridDim.x, c = blockIdx.x; const int vcu = (G % 8 == 0) ? (c % 8) * (G / 8) + c / 8 : c;
    Seam S; Cv cv; cv.a0 = (f32x4){0.f, 0.f, 0.f, 0.f}; cv.a1 = cv.a0; cv.b0 = cv.a0; cv.b1 = cv.a0; cv.next = 0; cv.pa = -1; cv.pb = -1; cv.emit = -1; cv.sb = 0;
    cv.nj = (CONV_IN_ATTN && VAR == 0 && c < CV_UNITS) ? (CV_UNITS - c + G - 1) / G : 0; if (cv.nj > CV_MAXJ) cv.nj = CV_MAXJ;
    if (CONV_IN_ATTN && VAR == 0) { cv_build_table(P, lds, cv.nj > 0 ? cv.nj : 1, tid_opaque()); __syncthreads(); }
    for (int it = vcu; it < 256; it += G) {
        const int bh = it >> 4, x = it & 15;
        BlockRef b0 = block_ref(P, bh, x), b1 = block_ref(P, bh, 31 - x);
        if (VAR != 0) { b0.O = (bf16_t*)(P.ws + WS_TMP) + (b0.O - (bf16_t*)(P.ws + WS_MIX)); b1.O = (bf16_t*)(P.ws + WS_TMP) + (b1.O - (bf16_t*)(P.ws + WS_MIX));
                        b0.SSQ = (float*)(P.ws + WS_TMP + 64 * MiB) + (b0.SSQ - (float*)(P.ws + WS_SSQ)); b1.SSQ = (float*)(P.ws + WS_TMP + 64 * MiB) + (b1.SSQ - (float*)(P.ws + WS_SSQ)); }
        attn_prime(b0, lds, S);
        attn_block<VAR>(P, cv, b0, b1, lds, S);
        attn_block<VAR>(P, cv, b1, b1, lds, S);
    }
    if (CONV_IN_ATTN && VAR == 0) {
        const int tid = tid_opaque();
        while (cv.emit >= 0 || cv.pa >= 0 || cv.pb >= 0 || cv.next < cv.nj) {
            cv_begin(P, cv, lds, tid); cv_mid(P, cv, cv.a0, cv.a1, cv.pa, lds, tid); __syncthreads();
            cv_begin(P, cv, lds, tid); cv_mid(P, cv, cv.b0, cv.b1, cv.pb, lds, tid); __syncthreads();
        }
    }
}
}
typedef float f32x16r __attribute__((ext_vector_type(16)));
__device__ __forceinline__ void router_phase(const Ptrs& P, LAS unsigned char* lds) {
    const int tid = tid_opaque(), lane = tid & 63, w = __builtin_amdgcn_readfirstlane(tid >> 6), i32 = lane & 31, kk = lane >> 5;
    LAS float* RED = (LAS float*)lds;
    LAS float* SSQ = (LAS float*)(lds + 8 * 32 * 33 * 4);
    LAS float* LOG = SSQ + 8 * 32;
    LAS float* RSTD = LOG + 32 * 33;
    LAS int* HIST = (LAS int*)(RSTD + 32);
    LAS int* SELE = HIST + 32;
    LAS int* SELR = SELE + 128;
    LAS float* SELG = (LAS float*)(SELR + 128);
    int* cnt = (int*)(P.ws + WS_CTL) + CW_CNT; int* SLOT = (int*)(P.ws + WS_SLOT); int* LIST = (int*)(P.ws + WS_LIST); float* GLIST = (float*)(P.ws + WS_GLIST);
    float wrv[64];
    { const float* wr = P.w_router + (size_t)(128 * w + 64 * kk) * 32 + i32;
#pragma unroll
      for (int q = 0; q < 64; ++q) wrv[q] = wr[q * 32]; }
    for (int rb = blockIdx.x; rb < T / 32; rb += gridDim.x) {
        const int t0 = rb * 32;
        { f32x4 t[16];
#pragma unroll
          for (int i = 0; i < 4; ++i)
#pragma unroll
              for (int j = 0; j < 4; ++j) t[4 * i + j] = *(const f32x4*)(P.out + (size_t)(t0 + 4 * w + i) * 1024 + 4 * (lane + 64 * j));
#pragma unroll
          for (int i = 0; i < 4; ++i)
#pragma unroll
              for (int j = 0; j < 4; ++j) { const int r = 4 * w + i; *(LAS f32x4*)(lds + r * 4096 + (((lane + 64 * j) + r) & 255) * 16) = t[4 * i + j]; } }
        __syncthreads();
        f32x4 av[16]; float ssq = 0.f;
#pragma unroll
        for (int m = 0; m < 16; ++m) { const int c = 32 * w + 16 * kk + m;
            const f32x4 a = *(const LAS f32x4*)(lds + i32 * 4096 + ((c + i32) & 255) * 16); const f32x4 g = *(const f32x4*)(P.g_ffn + 128 * w + 64 * kk + 4 * m);
            ssq += (a[0] * a[0] + a[1] * a[1]) + (a[2] * a[2] + a[3] * a[3]); av[m] = a * g; }
        __syncthreads();
        f32x16r acc = {};
#pragma unroll
        for (int m = 0; m < 16; ++m) {
#pragma unroll
            for (int j = 0; j < 4; ++j) acc = __builtin_amdgcn_mfma_f32_32x32x2f32(av[m][j], wrv[4 * m + j], acc, 0, 0, 0); }
        ssq += __shfl_xor(ssq, 32);
        if (kk == 0) SSQ[w * 32 + i32] = ssq;
#pragma unroll
        for (int r = 0; r < 16; ++r) RED[(w * 32 + (r & 3) + 8 * (r >> 2) + 4 * kk) * 33 + i32] = acc[r];
        if (tid < 32) HIST[tid] = 0;
        __syncthreads();
        if (tid < 32) { float s = 0.f;
#pragma unroll
            for (int q = 0; q < 8; ++q) s += SSQ[q * 32 + tid];
            RSTD[tid] = 1.f / sqrtf(s * (1.f / 1024.f) + RMS_EPS); }
        __syncthreads();
#pragma unroll
        for (int q = 0; q < 2; ++q) { const int idx = tid + 512 * q, row = idx >> 5, e = idx & 31; float s = 0.f;
#pragma unroll
            for (int p = 0; p < 8; ++p) s += RED[(p * 32 + row) * 33 + e];
            LOG[row * 33 + e] = s * RSTD[row] + P.b_router[e]; }
#if FP8_MOE
        { const float rs = RSTD[i32]; unsigned char* hp = P.ws + WS_H + (size_t)(t0 + i32) * 1024 + 128 * w + 64 * kk;
#pragma unroll
          for (int q = 0; q < 4; ++q) { u32x4 o;
              { const f32x4 v = av[4 * q + 0] * rs; o.x = pk4_fp8(v[0], v[1], v[2], v[3]); } { const f32x4 v = av[4 * q + 1] * rs; o.y = pk4_fp8(v[0], v[1], v[2], v[3]); }
              { const f32x4 v = av[4 * q + 2] * rs; o.z = pk4_fp8(v[0], v[1], v[2], v[3]); } { const f32x4 v = av[4 * q + 3] * rs; o.w = pk4_fp8(v[0], v[1], v[2], v[3]); }
              *(u32x4*)(hp + 16 * q) = o; } }
#else
        { const float rs = RSTD[i32]; bf16_t* hp = (bf16_t*)(P.ws + WS_H) + (size_t)(t0 + i32) * 1024 + 128 * w + 64 * kk;
#pragma unroll
          for (int q = 0; q < 8; ++q) { const f32x4 v0 = av[2 * q] * rs, v1 = av[2 * q + 1] * rs; u32x4 o; o.x = pk2(v0[0], v0[1]); o.y = pk2(v0[2], v0[3]); o.z = pk2(v1[0], v1[1]); o.w = pk2(v1[2], v1[3]); *(u32x4*)(hp + 8 * q) = o; } }
#endif
        __syncthreads();
        if (tid < 32) { const int row = tid; float lv[4]; int li[4]; unsigned used = 0u; float lg[32];
#pragma unroll
            for (int e = 0; e < 32; ++e) lg[e] = LOG[row * 33 + e];
#pragma unroll
            for (int k = 0; k < 4; ++k) { float best = -__builtin_inff(); int bi = 0;
#pragma unroll
                for (int e = 0; e < 32; ++e) { const bool take = !((used >> e) & 1u) && lg[e] > best; best = take ? lg[e] : best; bi = take ? e : bi; }
                lv[k] = best; li[k] = bi; used |= 1u << bi; }
            const float e1 = expf(lv[1] - lv[0]), e2 = expf(lv[2] - lv[0]), e3 = expf(lv[3] - lv[0]); const float inv = 1.f / (1.f + e1 + e2 + e3);
            const float gt[4] = {inv, e1 * inv, e2 * inv, e3 * inv};
            for (int k = 0; k < 4; ++k) { SELE[row * 4 + k] = li[k]; SELG[row * 4 + k] = gt[k]; SELR[row * 4 + k] = atomicAdd((int*)&HIST[li[k]], 1); } }
        __syncthreads();
        if (tid < 32) { const int n = HIST[tid]; HIST[tid] = n > 0 ? atomicAdd(&cnt[tid], n) : 0; }
        __syncthreads();
        if (tid < 128) { const int row = tid >> 2, k = tid & 3, e = SELE[tid], pos = HIST[e] + SELR[tid]; const int t = t0 + row;
            SLOT[t * 4 + k] = e * T + pos; LIST[e * T + pos] = t; GLIST[e * T + pos] = SELG[tid]; }
        __syncthreads();
    }
}
__device__ __forceinline__ void pool_phase(const Ptrs& P, LAS unsigned char* lds, int tile0, int tstride) {
    const int tid = tid_opaque(), lane = tid & 63, w = __builtin_amdgcn_readfirstlane(tid >> 6), fr = lane & 15, fq = lane >> 4;
    constexpr int RS = 1040;
    LAS float* PS = (LAS float*)(lds + 64 * RS);
    const bf16_t* U = (const bf16_t*)(P.ws + WS_U);
    const int g = w >> 1, dh = (w & 1) * 64;
    bf16x8 bfr[4][4];
    { const bf16_t* Wt = (const bf16_t*)(P.ws + WS_WPOOL) + (size_t)g * 128 * 128;
#pragma unroll
      for (int ni = 0; ni < 4; ++ni)
#pragma unroll
          for (int ks = 0; ks < 4; ++ks) bfr[ni][ks] = *(const bf16x8*)(Wt + (size_t)(dh + ni * 16 + fr) * 128 + ks * 32 + 8 * fq); }
    f32x4 bias[4], scl[4];
#pragma unroll
    for (int ni = 0; ni < 4; ++ni) { const int c = g * 128 + dh + ni * 16 + 4 * fq; bias[ni] = *(const f32x4*)(P.b_pool + c); scl[ni] = *(const f32x4*)(P.pool_scale + c); }
    for (int tile = tile0; tile < T / 64; tile += tstride) {
        const int t0 = tile * 64;
        { const int gg = w >> 1, win = 2 << gg, cc = gg * 16 + (lane & 15), r0 = 8 * ((lane >> 4) + 4 * (w & 1)); const int tb = t0 + r0, sb = tb & (SEQ - 1);
          const bf16_t* up = U + (size_t)tb * 512 + cc * 8;
          float sum[8];
#pragma unroll
          for (int j = 0; j < 8; ++j) sum[j] = 0.f;
          for (int k = 1; k < win; ++k) { if (sb - k >= 0) { const bf16x8 u = *(const bf16x8*)(up - (size_t)k * 512);
#pragma unroll
                  for (int j = 0; j < 8; ++j) sum[j] += bf2f((bf16_t)u[j]); } }
#pragma unroll
          for (int i = 0; i < 8; ++i) { const bf16x8 u = *(const bf16x8*)(up + (size_t)i * 512); const int s_ = sb + i; const int n = s_ + 1 < win ? s_ + 1 : win; const float inv = 1.f / (float)n;
              float d[8];
#pragma unroll
              for (int j = 0; j < 8; ++j) { const float uj = bf2f((bf16_t)u[j]); sum[j] += uj; d[j] = sum[j] * inv - uj; }
              u32x4 o; o.x = pk2(d[0], d[1]); o.y = pk2(d[2], d[3]); o.z = pk2(d[4], d[5]); o.w = pk2(d[6], d[7]);
              *(LAS u32x4*)(lds + (r0 + i) * RS + cc * 16) = o;
              if (s_ - win + 1 >= 0) { const bf16x8 ul = *(const bf16x8*)(up + ((long)i - (long)(win - 1)) * 512);
#pragma unroll
                  for (int j = 0; j < 8; ++j) sum[j] -= bf2f((bf16_t)ul[j]); } } }
        __syncthreads();
        f32x4 acc[4][4];
#pragma unroll
        for (int mi = 0; mi < 4; ++mi)
#pragma unroll
            for (int ni = 0; ni < 4; ++ni) acc[mi][ni] = (f32x4){0.f, 0.f, 0.f, 0.f};
#pragma unroll
        for (int ks = 0; ks < 4; ++ks) { bf16x8 a[4];
#pragma unroll
            for (int mi = 0; mi < 4; ++mi) a[mi] = *(const LAS bf16x8*)(lds + (mi * 16 + fr) * RS + (g * 128 + ks * 32 + 8 * fq) * 2);
#pragma unroll
            for (int mi = 0; mi < 4; ++mi)
#pragma unroll
                for (int ni = 0; ni < 4; ++ni) acc[mi][ni] = __builtin_amdgcn_mfma_f32_16x16x32_bf16(bfr[ni][ks], a[mi], acc[mi][ni], 0, 0, 0); }
#pragma unroll
        for (int mi = 0; mi < 4; ++mi) { float s = 0.f;
#pragma unroll
            for (int ni = 0; ni < 4; ++ni) { acc[mi][ni] = (acc[mi][ni] + bias[ni]) * scl[ni]; const f32x4 v = acc[mi][ni]; s += (v[0] * v[0] + v[1] * v[1]) + (v[2] * v[2] + v[3] * v[3]); }
            s += __shfl_xor(s, 16); s += __shfl_xor(s, 32);
            if (fq == 0) PS[(mi * 16 + fr) * 8 + w] = s; }
        __syncthreads();
#pragma unroll
        for (int mi = 0; mi < 4; ++mi) { const int r = mi * 16 + fr; const f32x4 p0 = *(const LAS f32x4*)(PS + r * 8), p1 = *(const LAS f32x4*)(PS + r * 8 + 4);
            const float rstd = 1.f / sqrtf((((p0[0] + p0[1]) + (p0[2] + p0[3])) + ((p1[0] + p1[1]) + (p1[2] + p1[3]))) * (1.f / 512.f) + RMS_EPS);
            bf16_t* mp = (bf16_t*)(P.ws + WS_MIX) + (size_t)(t0 + r) * 1024 + 512 + g * 128 + dh + 4 * fq;
#pragma unroll
            for (int ni = 0; ni < 4; ++ni) { const f32x4 v = acc[mi][ni] * rstd; u32x2 o; o.x = pk2(v[0], v[1]); o.y = pk2(v[2], v[3]); *(u32x2*)(mp + ni * 16) = o; } }
        __syncthreads();
    }
}

#define VB_FOR(vb, NVB) for (int vb = blockIdx.x * 2 + (int)(threadIdx.x >> 8); vb < (NVB); vb += gridDim.x * 2)

__device__ __forceinline__ void nv_gemm_f32(const bf16_t* A, int lda, const bf16_t* Bt, int ldb, float* C, int ldc, int K, int nbx, int nby) {
    const int tid = threadIdx.x & 255, lane = tid & 63, w = tid >> 6, wr = w >> 1, wc = w & 1, fr = lane & 15, fq = lane >> 4;
    VB_FOR(vb, nbx * nby) {
        const int bx = vb % nbx, by = vb / nbx;
        const int row0 = by * 64 + wr * 32, col0 = bx * 128 + wc * 64;
        f32x4 acc[2][4];
#pragma unroll
        for (int i = 0; i < 2; ++i)
#pragma unroll
            for (int j = 0; j < 4; ++j) acc[i][j] = (f32x4){0.f, 0.f, 0.f, 0.f};
        for (int k0 = 0; k0 < K; k0 += 32) {
            bf16x8 a[2], b[4];
#pragma unroll
            for (int i = 0; i < 2; ++i) a[i] = *(const bf16x8*)(A + (size_t)(row0 + i * 16 + fr) * lda + k0 + 8 * fq);
#pragma unroll
            for (int j = 0; j < 4; ++j) b[j] = *(const bf16x8*)(Bt + (size_t)(col0 + j * 16 + fr) * ldb + k0 + 8 * fq);
#pragma unroll
            for (int i = 0; i < 2; ++i)
#pragma unroll
                for (int j = 0; j < 4; ++j) acc[i][j] = __builtin_amdgcn_mfma_f32_16x16x32_bf16(a[i], b[j], acc[i][j], 0, 0, 0);
        }
#pragma unroll
        for (int i = 0; i < 2; ++i)
#pragma unroll
            for (int j = 0; j < 4; ++j)
#pragma unroll
                for (int r = 0; r < 4; ++r) C[(size_t)(row0 + i * 16 + fq * 4 + r) * ldc + col0 + j * 16 + fr] = acc[i][j][r];
    }
}

struct W8Tile { const float* src; unsigned char* dst; int ldw; };
__device__ __forceinline__ W8Tile w8_tile(const Ptrs& P, int r) {
    W8Tile d; const int e = r / 192, q = r % 192;
    if (q < 128) { const int kb = q >> 4, nb = q & 15, n0 = 128 * nb; const int p = nb & 7, dn0 = 256 * p + (nb >= 8 ? 128 : 0);
        d.src = P.w_gu + (size_t)e * 1024 * 2048 + (size_t)(128 * kb) * 2048 + n0; d.ldw = 2048; d.dst = P.ws + WS_WGU + (size_t)e * 2048 * 1024 + (size_t)dn0 * 1024 + 128 * kb; }
    else { const int qq = q - 128, kb = qq >> 3, nb = qq & 7;
        d.src = P.w_down + (size_t)e * 1024 * 1024 + (size_t)(128 * kb) * 1024 + 128 * nb; d.ldw = 1024; d.dst = P.ws + WS_WD + (size_t)e * 1024 * 1024 + (size_t)(128 * nb) * 1024 + 128 * kb; }
    return d;
}
__device__ __forceinline__ void w8_tile_load(const W8Tile& d, f32x4 (&v)[8], int tid) {
    const int kr = tid >> 5, n4 = (tid & 31) * 4;
#pragma unroll
    for (int i = 0; i < 8; ++i) v[i] = __builtin_nontemporal_load((const f32x4*)(d.src + (size_t)(kr + 16 * i) * d.ldw + n4));
}
__device__ __forceinline__ void w8_tile_emit(const W8Tile& d, float* scr, int tid) {
    const int n = tid >> 2, kq = (tid & 3) * 32; const float* q = scr + kq * 132 + ((n + 8 * (tid & 3)) & 127);
    u32x4 o0, o1;
    o0.x = pk4_fp8(q[0 * 132], q[1 * 132], q[2 * 132], q[3 * 132]); o0.y = pk4_fp8(q[4 * 132], q[5 * 132], q[6 * 132], q[7 * 132]);
    o0.z = pk4_fp8(q[8 * 132], q[9 * 132], q[10 * 132], q[11 * 132]); o0.w = pk4_fp8(q[12 * 132], q[13 * 132], q[14 * 132], q[15 * 132]);
    o1.x = pk4_fp8(q[16 * 132], q[17 * 132], q[18 * 132], q[19 * 132]); o1.y = pk4_fp8(q[20 * 132], q[21 * 132], q[22 * 132], q[23 * 132]);
    o1.z = pk4_fp8(q[24 * 132], q[25 * 132], q[26 * 132], q[27 * 132]); o1.w = pk4_fp8(q[28 * 132], q[29 * 132], q[30 * 132], q[31 * 132]);
    unsigned char* dp = d.dst + (size_t)n * 1024 + kq; *(u32x4*)dp = o0; *(u32x4*)(dp + 16) = o1;
}
__device__ __forceinline__ void w8_tile_stage(const f32x4 (&v)[8], float* scr, int tid) {
    const int kr = tid >> 5, n4 = (tid & 31) * 4;
#pragma unroll
    for (int i = 0; i < 8; ++i) { const int k = kr + 16 * i; *(f32x4*)(scr + k * 132 + ((n4 + 8 * (k >> 5)) & 127)) = v[i] * W8_SCALE; }
}
__device__ __forceinline__ void w8_convert_tiles(const Ptrs& P, float* scr) {
    const int tid = tid_opaque(); constexpr int N = 32 * 192; const int G = gridDim.x;
    int it = blockIdx.x; if (it >= N) return;
    W8Tile ta = w8_tile(P, it), tb = ta; f32x4 va[8], vb[8];
    w8_tile_load(ta, va, tid);
    if (it + G < N) { tb = w8_tile(P, it + G); w8_tile_load(tb, vb, tid); }
    for (;;) {
        { w8_tile_stage(va, scr, tid); const W8Tile cur = ta; const int n2 = it + 2 * G;
          if (n2 < N) { ta = w8_tile(P, n2); w8_tile_load(ta, va, tid); }
          __syncthreads(); w8_tile_emit(cur, scr, tid); __syncthreads(); }
        it += G; if (it >= N) break;
        { w8_tile_stage(vb, scr, tid); const W8Tile cur = tb; const int n2 = it + 2 * G;
          if (n2 < N) { tb = w8_tile(P, n2); w8_tile_load(tb, vb, tid); }
          __syncthreads(); w8_tile_emit(cur, scr, tid); __syncthreads(); }
        it += G; if (it >= N) break;
    }
}

#define GW_SETUP const int tid = tid_opaque(), lane = tid & 63, wave = tid >> 6; const int gw = blockIdx.x * NWAVES + wave, NGW = gridDim.x * NWAVES; (void)lane; (void)gw; (void)NGW;
#define GT_FOR(i, N) for (size_t i = (size_t)blockIdx.x * 512 + threadIdx.x; i < (size_t)(N); i += (size_t)gridDim.x * 512)

#ifndef PROBE_PHASE
#define PROBE_PHASE (-1)
#endif
#define TPP(k, var) do { if ((PROBE_PHASE) == (k)) { __syncthreads(); var = __builtin_amdgcn_s_memrealtime(); } } while (0)
__device__ __forceinline__ void ph_prologue(const Ptrs& P, float* ldsf, unsigned long long& tq0, unsigned long long& tq1) {
    GW_SETUP
    TPP(10, tq0);
    float* scr = ldsf + wave * (64 * 33);
#if FP8_MOE
    for (int it = gw; it < IT_TOTAL - IT_GU - IT_DN; it += NGW) prologue_item(P, it, scr, lane);
    TPP(10, tq1); TPP(11, tq0);
#if !CONV_IN_ATTN
    __syncthreads();
    w8_convert_tiles(P, ldsf);
#endif
    TPP(11, tq1); TPP(12, tq0);
#else
    for (int it = gw; it < IT_TOTAL; it += NGW) prologue_item(P, it, scr, lane);
#endif
    { bf16_t* w = (bf16_t*)(P.ws + WS_WIN) + (size_t)DINP * 1024; const int n8 = (1024 - DINP) * 1024 / 8;
      GT_FOR(i, n8) ((u32x4*)w)[i] = (u32x4){0u, 0u, 0u, 0u}; }
    for (int m = gw; m < T; m += 2 * NGW) {
        const int m2 = m + NGW; const bool two = m2 < T;
        const f32x4* xa = (const f32x4*)(P.x + (size_t)m * D) + lane; const f32x4* xb = (const f32x4*)(P.x + (size_t)(two ? m2 : m) * D) + lane; const f32x4* gr = (const f32x4*)P.g_attn + lane;
        f32x4 a[4], b[4]; float sa = 0.f, sb = 0.f;
#pragma unroll
        for (int j = 0; j < 4; ++j) { a[j] = __builtin_nontemporal_load(xa + 64 * j); b[j] = __builtin_nontemporal_load(xb + 64 * j); }
#pragma unroll
        for (int j = 0; j < 4; ++j) { sa += (a[j].x * a[j].x + a[j].y * a[j].y) + (a[j].z * a[j].z + a[j].w * a[j].w); sb += (b[j].x * b[j].x + b[j].y * b[j].y) + (b[j].z * b[j].z + b[j].w * b[j].w); }
        const float ra = 1.f / sqrtf(wave_sum(sa) * (1.f / 1024.f) + RMS_EPS), rb = 1.f / sqrtf(wave_sum(sb) * (1.f / 1024.f) + RMS_EPS);
        u32x2* oa = (u32x2*)((bf16_t*)(P.ws + WS_XN) + (size_t)m * D) + lane; u32x2* ob = (u32x2*)((bf16_t*)(P.ws + WS_XN) + (size_t)m2 * D) + lane;
#pragma unroll
        for (int j = 0; j < 4; ++j) { const f32x4 gg = gr[64 * j]; u32x2 w; w.x = pk2(a[j].x * ra * gg.x, a[j].y * ra * gg.y); w.y = pk2(a[j].z * ra * gg.z, a[j].w * ra * gg.w); oa[64 * j] = w;
            if (two) { u32x2 w2; w2.x = pk2(b[j].x * rb * gg.x, b[j].y * rb * gg.y); w2.y = pk2(b[j].z * rb * gg.z, b[j].w * rb * gg.w); ob[64 * j] = w2; } }
    }
    TPP(12, tq1); TPP(13, tq0);
    { float* C = (float*)(P.ws + WS_COS); float* S = (float*)(P.ws + WS_SIN);
      GT_FOR(i, T * 16) { const int t = (int)(i >> 4), j = (int)(i & 15);
          const float inv = (float)pow(10000.0, -(double)j / 16.0); const float ang = (float)P.pos[t] * inv;
          C[i] = (float)cos((double)ang); S[i] = (float)sin((double)ang); } }
    TPP(13, tq1);
}
__device__ __forceinline__ void ph_e1(const Ptrs& P) {
    GW_SETUP
    const float* PROJ = (const float*)(P.ws + WS_TMP);
    const float* COS = (const float*)(P.ws + WS_COS); const float* SIN = (const float*)(P.ws + WS_SIN);
    for (int t = gw; t < T; t += NGW) {
        const float* pr = PROJ + (size_t)t * 1024;
        bf16_t* u = (bf16_t*)(P.ws + WS_U) + (size_t)t * 512;
        for (int c = lane; c < 512; c += 64) u[c] = (bf16_t)f2bf(pr[c]);
        { float v[4]; float s = 0.f; for (int j = 0; j < 4; ++j) { v[j] = pr[512 + lane + 64 * j]; s += v[j] * v[j]; }
          const float rstd = 1.f / sqrtf(wave_sum(s) * (1.f / 256.f) + RMS_EPS);
          bf16_t* q = (bf16_t*)(P.ws + WS_QN) + (size_t)t * 256;
          for (int j = 0; j < 4; ++j) q[lane + 64 * j] = (bf16_t)f2bf(v[j] * rstd * P.g_q_a[lane + 64 * j]); }
        { float v[2]; float s = 0.f; for (int j = 0; j < 2; ++j) { v[j] = pr[768 + lane + 64 * j]; s += v[j] * v[j]; }
          const float rstd = 1.f / sqrtf(wave_sum(s) * (1.f / 128.f) + RMS_EPS);
          bf16_t* q = (bf16_t*)(P.ws + WS_KVN) + (size_t)t * 128;
          for (int j = 0; j < 2; ++j) q[lane + 64 * j] = (bf16_t)f2bf(v[j] * rstd * P.g_kv_a[lane + 64 * j]); }
        if (lane < 16) { const float x1 = pr[896 + lane], x2 = pr[896 + 16 + lane]; const float c = COS[t * 16 + lane], s = SIN[t * 16 + lane];
          bf16_t* kr = (bf16_t*)(P.ws + WS_KR) + (size_t)t * 32; kr[lane] = (bf16_t)f2bf(x1 * c - x2 * s); kr[16 + lane] = (bf16_t)f2bf(x2 * c + x1 * s); }
    }
}
__device__ __forceinline__ void ph_e2q(const Ptrs& P) {
    const float* TMP = (const float*)(P.ws + WS_TMP); const float* COS = (const float*)(P.ws + WS_COS); const float* SIN = (const float*)(P.ws + WS_SIN);
    bf16_t* Q = (bf16_t*)(P.ws + WS_Q);
    GT_FOR(i, (size_t)T * 768) {
        const int t = (int)(i / 768), c = (int)(i % 768), h = c / 96, d = c % 96; float v;
        if (d < 64) v = TMP[i];
        else { const int j = (d - 64) & 15; const float x1 = TMP[(size_t)t * 768 + h * 96 + 64 + j], x2 = TMP[(size_t)t * 768 + h * 96 + 80 + j]; const float cc = COS[t * 16 + j], ss = SIN[t * 16 + j];
               v = (d < 80) ? (x1 * cc - x2 * ss) : (x2 * cc + x1 * ss); }
        Q[i] = (bf16_t)f2bf(v * QSCALE);
    }
}
__device__ __forceinline__ void ph_e2kv(const Ptrs& P) {
    const float* TMP = (const float*)(P.ws + WS_TMP) + (size_t)T * 1024;
    bf16_t* K = (bf16_t*)(P.ws + WS_K); bf16_t* V = (bf16_t*)(P.ws + WS_V);
    GT_FOR(i, (size_t)T * 512) {
        const int t = (int)(i / 512), c = (int)(i % 512), h = c / 64, d = c % 64;
        K[i] = (bf16_t)f2bf(TMP[(size_t)t * 1024 + h * 128 + d]);
        V[i] = (bf16_t)f2bf(TMP[(size_t)t * 1024 + h * 128 + 64 + d]);
    }
}
__device__ __forceinline__ void ph_pooldiff(const Ptrs& P) {
    const bf16_t* U = (const bf16_t*)(P.ws + WS_U); bf16_t* DIFF = (bf16_t*)(P.ws + WS_H);
    GT_FOR(i, (size_t)T * 512) {
        const int t = (int)(i / 512), c = (int)(i % 512), g = c / 128, s = t % SEQ, w = 2 << g; const int n = s + 1 < w ? s + 1 : w;
        float sum = 0.f; for (int j = 0; j < n; ++j) sum += bf2f(U[(size_t)(t - j) * 512 + c]);
        DIFF[i] = (bf16_t)f2bf(sum / (float)n - bf2f(U[i]));
    }
}
__device__ __forceinline__ void ph_epool(const Ptrs& P, const float* TP) {
    GW_SETUP
    for (int t = gw; t < T; t += NGW) {
        float v[8]; float s = 0.f;
        for (int j = 0; j < 8; ++j) { const int c = lane + 64 * j; v[j] = (TP[(size_t)t * 512 + c] + P.b_pool[c]) * P.pool_scale[c]; s += v[j] * v[j]; }
        const float rstd = 1.f / sqrtf(wave_sum(s) * (1.f / 512.f) + RMS_EPS);
        bf16_t* m = (bf16_t*)(P.ws + WS_MIX) + (size_t)t * 1024 + 512;
        for (int j = 0; j < 8; ++j) m[lane + 64 * j] = (bf16_t)f2bf(v[j] * rstd);
    }
}
__device__ __forceinline__ void ph_attn_naive(const Ptrs& P, float* ldsf) {
    GW_SETUP
    float* qs = ldsf + wave * 96;
    const bf16_t* Q = (const bf16_t*)(P.ws + WS_Q); const bf16_t* K = (const bf16_t*)(P.ws + WS_K); const bf16_t* V = (const bf16_t*)(P.ws + WS_V); const bf16_t* KRp = (const bf16_t*)(P.ws + WS_KR);
    bf16_t* MIX = (bf16_t*)(P.ws + WS_MIX); float* SSQ = (float*)(P.ws + WS_SSQ);
    for (int item = gw; item < T * 8; item += NGW) {
        const int t = item >> 3, h = item & 7, b = t / SEQ, s = t % SEQ;
        for (int d = lane; d < 96; d += 64) qs[d] = bf2f(Q[(size_t)t * 768 + h * 96 + d]);
        asm volatile("s_waitcnt lgkmcnt(0)" ::: "memory");
        float m = -1e30f, l = 0.f, o = 0.f;
        const int ntile = s / 64 + 1;
        for (int kt = 0; kt < ntile; ++kt) {
            const int key = kt * 64 + lane; const size_t krow = (size_t)(b * SEQ + key);
            float sc = -__builtin_inff();
            if (key <= s) { float a = 0.f;
                for (int d8 = 0; d8 < 12; ++d8) { const bf16x8 kv = d8 < 8 ? *(const bf16x8*)(K + krow * 512 + h * 64 + d8 * 8) : *(const bf16x8*)(KRp + krow * 32 + (d8 - 8) * 8);
#pragma unroll
                    for (int j = 0; j < 8; ++j) a += qs[d8 * 8 + j] * bf2f((bf16_t)kv[j]); }
                sc = a; }
            const float mn = fmaxf(m, wave_max(sc)); const float alpha = exp2f(m - mn); const float p = exp2f(sc - mn);
            const float pb = bf2f((bf16_t)f2bf(p));
            l = l * alpha + wave_sum(pb); o *= alpha; m = mn;
            const int nk = (kt == ntile - 1) ? (s - kt * 64 + 1) : 64;
            for (int j = 0; j < nk; ++j) { const float pj = __shfl(pb, j); o += pj * bf2f(V[(size_t)(b * SEQ + kt * 64 + j) * 512 + h * 64 + lane]); }
        }
        const float ov = o / l;
        MIX[(size_t)t * 1024 + h * 64 + lane] = (bf16_t)f2bf(ov);
        const float ss = wave_sum(ov * ov);
        if (lane == 0) SSQ[t * 8 + h] = ss;
        asm volatile("s_waitcnt lgkmcnt(0)" ::: "memory");
    }
}
__device__ __forceinline__ void ph_e4(const Ptrs& P) {
    const float* T1 = (const float*)(P.ws + WS_TMP); const float* T2 = T1 + (size_t)T * 1024; const float* SSQ = (const float*)(P.ws + WS_SSQ);
    GT_FOR(i, (size_t)T * 1024) {
        const int t = (int)(i >> 10); float s = 0.f; for (int h = 0; h < 8; ++h) s += SSQ[t * 8 + h];
        const float sa = 1.f / sqrtf(s * (1.f / 512.f) + RMS_EPS);
        P.out[i] = P.x[i] + sa * T1[i] + T2[i];
    }
}
__device__ __forceinline__ void ph_router(const Ptrs& P, float* ldsf) {
    GW_SETUP
    float* hs = ldsf + wave * 1024;
    int* cnt = (int*)(P.ws + WS_CTL) + CW_CNT; int* SLOT = (int*)(P.ws + WS_SLOT); int* LIST = (int*)(P.ws + WS_LIST); float* GLIST = (float*)(P.ws + WS_GLIST);
    for (int t = gw; t < T; t += NGW) {
        const f32x4* xr = (const f32x4*)(P.out + (size_t)t * 1024) + lane; const f32x4* gr = (const f32x4*)P.g_ffn + lane;
        f32x4 v[4]; float s = 0.f;
        for (int j = 0; j < 4; ++j) { v[j] = xr[64 * j]; s += (v[j].x * v[j].x + v[j].y * v[j].y) + (v[j].z * v[j].z + v[j].w * v[j].w); }
        const float rstd = 1.f / sqrtf(wave_sum(s) * (1.f / 1024.f) + RMS_EPS);
        u32x2* ho = (u32x2*)((bf16_t*)(P.ws + WS_H) + (size_t)t * 1024) + lane;
        for (int j = 0; j < 4; ++j) { const f32x4 gg = gr[64 * j]; f32x4 hv = {v[j].x * rstd * gg.x, v[j].y * rstd * gg.y, v[j].z * rstd * gg.z, v[j].w * rstd * gg.w};
            ((f32x4*)hs)[lane + 64 * j] = hv; u32x2 w; w.x = pk2(hv.x, hv.y); w.y = pk2(hv.z, hv.w); ho[64 * j] = w; }
        asm volatile("s_waitcnt lgkmcnt(0)" ::: "memory");
        const int e = lane & 31, half = lane >> 5; float a = 0.f;
        for (int c = half * 512; c < half * 512 + 512; ++c) a += hs[c] * P.w_router[c * 32 + e];
        a += __shfl_xor(a, 32); a += P.b_router[e];
        float lv[4]; int li[4]; unsigned used = 0u;
        for (int k = 0; k < 4; ++k) { float best = -__builtin_inff(); int bi = 0;
            for (int j = 0; j < 32; ++j) { const float x = __shfl(a, j); if (!((used >> j) & 1u) && x > best) { best = x; bi = j; } }
            lv[k] = best; li[k] = bi; used |= 1u << bi; }
        const float e1 = expf(lv[1] - lv[0]), e2 = expf(lv[2] - lv[0]), e3 = expf(lv[3] - lv[0]); const float inv = 1.f / (1.f + e1 + e2 + e3);
        if (lane < 4) { const int ex = lane == 0 ? li[0] : lane == 1 ? li[1] : lane == 2 ? li[2] : li[3]; const float gt = (lane == 0 ? 1.f : lane == 1 ? e1 : lane == 2 ? e2 : e3) * inv;
            const int pos = atomicAdd(&cnt[ex], 1); SLOT[t * 4 + lane] = ex * T + pos; LIST[ex * T + pos] = t; GLIST[ex * T + pos] = gt; }
        asm volatile("s_waitcnt lgkmcnt(0)" ::: "memory");
    }
}
__device__ __forceinline__ int slot_base(const int* cnt, int e) { int s = 0; for (int i = 0; i < e; ++i) s += (cnt[i] + 255) & ~255; return s; }
__device__ __forceinline__ void ph_moe1_naive(const Ptrs& P) {
    const int* cnt = (const int*)(P.ws + WS_CTL) + CW_CNT;
    const int tid = threadIdx.x & 255, lane = tid & 63, w = tid >> 6, wr = w >> 1, wc = w & 1, fr = lane & 15, fq = lane >> 4;
    const bf16_t* H = (const bf16_t*)(P.ws + WS_H); bf16_t* ACT = (bf16_t*)(P.ws + WS_ACT);
    VB_FOR(vb, 16 * 256 * 32) {
        const int bx = vb & 15, by = (vb >> 4) & 255, e = vb >> 12; const int n = cnt[e], m0 = by * 64; if (m0 >= n) continue;
        const int* LIST = (const int*)(P.ws + WS_LIST) + (size_t)e * T;
        const bf16_t* W = (const bf16_t*)(P.ws + WS_WGU) + (size_t)e * 2048 * 1024;
        const int ca0 = bx * 64 + wc * 32; const int p = ca0 >> 7, r0 = ca0 & 127;
        int tok[2]; for (int i = 0; i < 2; ++i) { int m = m0 + wr * 32 + i * 16 + fr; if (m >= n) m = 0; tok[i] = LIST[m]; }
        f32x4 ag[2][2], au[2][2];
        for (int i = 0; i < 2; ++i) for (int j = 0; j < 2; ++j) { ag[i][j] = (f32x4){0.f, 0.f, 0.f, 0.f}; au[i][j] = (f32x4){0.f, 0.f, 0.f, 0.f}; }
        for (int k0 = 0; k0 < 1024; k0 += 32) {
            bf16x8 a[2], bg[2], bu[2];
            for (int i = 0; i < 2; ++i) a[i] = *(const bf16x8*)(H + (size_t)tok[i] * 1024 + k0 + 8 * fq);
            for (int j = 0; j < 2; ++j) { bg[j] = *(const bf16x8*)(W + (size_t)(256 * p + r0 + j * 16 + fr) * 1024 + k0 + 8 * fq); bu[j] = *(const bf16x8*)(W + (size_t)(256 * p + 128 + r0 + j * 16 + fr) * 1024 + k0 + 8 * fq); }
            for (int i = 0; i < 2; ++i) for (int j = 0; j < 2; ++j) { ag[i][j] = __builtin_amdgcn_mfma_f32_16x16x32_bf16(a[i], bg[j], ag[i][j], 0, 0, 0); au[i][j] = __builtin_amdgcn_mfma_f32_16x16x32_bf16(a[i], bu[j], au[i][j], 0, 0, 0); }
        }
        const int sb = slot_base(cnt, e);
        for (int i = 0; i < 2; ++i) for (int j = 0; j < 2; ++j) for (int r = 0; r < 4; ++r) {
            const int m = m0 + wr * 32 + i * 16 + fq * 4 + r, c = ca0 + j * 16 + fr; if (m >= n) continue;
            float g = ag[i][j][r] + P.b_gu[e * 2048 + c], u = au[i][j][r] + P.b_gu[e * 2048 + 1024 + c];
            g = fminf(g, 7.f); u = fminf(fmaxf(u, -7.f), 7.f);
            const float act = g * (1.f / (1.f + expf(-1.702f * g))) * (u + 1.f);
            ACT[(size_t)(sb + m) * 1024 + c] = (bf16_t)f2bf(act);
        }
    }
}
__device__ __forceinline__ void ph_moe2_naive(const Ptrs& P) {
    const int* cnt = (const int*)(P.ws + WS_CTL) + CW_CNT;
    const int tid = threadIdx.x & 255, lane = tid & 63, w = tid >> 6, wr = w >> 1, wc = w & 1, fr = lane & 15, fq = lane >> 4;
    VB_FOR(vb, 8 * 256 * 32) {
        const int bx = vb & 7, by = (vb >> 3) & 255, e = vb >> 11; const int n = cnt[e], m0 = by * 64; if (m0 >= n) continue;
        const int sb = slot_base(cnt, e); const bf16_t* ACT = (const bf16_t*)(P.ws + WS_ACT) + (size_t)sb * 1024; bf16_t* Y = (bf16_t*)(P.ws + WS_Y) + (size_t)sb * 1024;
        const bf16_t* W = (const bf16_t*)(P.ws + WS_WD) + (size_t)e * 1024 * 1024; const float* GL = (const float*)(P.ws + WS_GLIST) + (size_t)e * T;
        const int col0 = bx * 128 + wc * 64, row0 = m0 + wr * 32;
        f32x4 acc[2][4]; for (int i = 0; i < 2; ++i) for (int j = 0; j < 4; ++j) acc[i][j] = (f32x4){0.f, 0.f, 0.f, 0.f};
        for (int k0 = 0; k0 < 1024; k0 += 32) {
            bf16x8 a[2], b[4];
            for (int i = 0; i < 2; ++i) { int m = row0 + i * 16 + fr; if (m >= n) m = 0; a[i] = *(const bf16x8*)(ACT + (size_t)m * 1024 + k0 + 8 * fq); }
            for (int j = 0; j < 4; ++j) b[j] = *(const bf16x8*)(W + (size_t)(col0 + j * 16 + fr) * 1024 + k0 + 8 * fq);
            for (int i = 0; i < 2; ++i) for (int j = 0; j < 4; ++j) acc[i][j] = __builtin_amdgcn_mfma_f32_16x16x32_bf16(a[i], b[j], acc[i][j], 0, 0, 0);
        }
        for (int i = 0; i < 2; ++i) for (int j = 0; j < 4; ++j) for (int r = 0; r < 4; ++r) {
            const int m = row0 + i * 16 + fq * 4 + r, c = col0 + j * 16 + fr; if (m >= n) continue;
            Y[(size_t)m * 1024 + c] = (bf16_t)f2bf((acc[i][j][r] + P.b_down[e * 1024 + c]) * GL[m]);
        }
    }
}
__device__ __forceinline__ void ph_final(const Ptrs& P, int* sbase) {
    GW_SETUP
    const int* cnt = (const int*)(P.ws + WS_CTL) + CW_CNT; const int* SLOT = (const int*)(P.ws + WS_SLOT); const bf16_t* Y = (const bf16_t*)(P.ws + WS_Y);
    if (tid < 32) sbase[tid] = slot_base(cnt, tid);
    __syncthreads();
    for (int t = gw; t < T; t += NGW) {
        f32x4* xr = (f32x4*)(P.out + (size_t)t * 1024) + lane; const f32x4* gr = (const f32x4*)P.g_final + lane;
        f32x4 v[4]; for (int j = 0; j < 4; ++j) v[j] = xr[64 * j];
#if FP8_MOE
        { f32x4 ya[4]; for (int j = 0; j < 4; ++j) ya[j] = (f32x4){0.f, 0.f, 0.f, 0.f};
          for (int k = 0; k < 4; ++k) { const int sl = SLOT[t * 4 + k]; const int e = sl / T, pos = sl % T; const unsigned* yr = (const unsigned*)((const unsigned char*)Y + (size_t)(sbase[e] + pos) * 1024) + lane;
              for (int j = 0; j < 4; ++j) { const unsigned w = __builtin_nontemporal_load(yr + 64 * j); const auto lo = __builtin_amdgcn_cvt_pk_f32_fp8((int)w, false), hi2 = __builtin_amdgcn_cvt_pk_f32_fp8((int)w, true);
                  ya[j].x += lo[0]; ya[j].y += lo[1]; ya[j].z += hi2[0]; ya[j].w += hi2[1]; } }
          for (int j = 0; j < 4; ++j) v[j] = v[j] + ya[j] * (1.f / 16.f); }
#else
        for (int k = 0; k < 4; ++k) { const int sl = SLOT[t * 4 + k]; const int e = sl / T, pos = sl % T; const u32x2* yr = (const u32x2*)(Y + (size_t)(sbase[e] + pos) * 1024) + lane;
            for (int j = 0; j < 4; ++j) { const u32x2 w = yr[64 * j]; v[j].x += __builtin_bit_cast(float, w.x << 16); v[j].y += __builtin_bit_cast(float, w.x & 0xffff0000u); v[j].z += __builtin_bit_cast(float, w.y << 16); v[j].w += __builtin_bit_cast(float, w.y & 0xffff0000u); } }
#endif
        float s = 0.f; for (int j = 0; j < 4; ++j) s += (v[j].x * v[j].x + v[j].y * v[j].y) + (v[j].z * v[j].z + v[j].w * v[j].w);
        const float rstd = 1.f / sqrtf(wave_sum(s) * (1.f / 1024.f) + RMS_EPS);
        for (int j = 0; j < 4; ++j) { const f32x4 gg = gr[64 * j]; __builtin_nontemporal_store((f32x4){v[j].x * rstd * gg.x, v[j].y * rstd * gg.y, v[j].z * rstd * gg.z, v[j].w * rstd * gg.w}, xr + 64 * j); }
    }
}

__global__ void __launch_bounds__(NWAVES * 64, 2) mega_fwd(Ptrs P) {
    extern __shared__ __attribute__((aligned(16))) unsigned char lds[];
    const int tid = threadIdx.x;
    for (int u = tid; u < (LDS_BYTES - LDSCTL_OFF) / 4; u += NWAVES * 64) ((LAS unsigned*)((LAS unsigned char*)lds + LDSCTL_OFF))[u] = 0u;
    __syncthreads();
    unsigned* ctl = (unsigned*)(P.ws + WS_CTL);
    XcdBarrier bar = xcd_barrier_post(ctl + CW_BAR, (volatile LAS unsigned*)((LAS unsigned char*)lds + MISC_OFF) + 8);
    float* ldsf = (float*)lds;
    float* TMP = (float*)(P.ws + WS_TMP);
    unsigned char* ws = P.ws;
#define GRID_BAR() xcd_barrier(bar)
#ifndef PROBE_PHASE
#define PROBE_PHASE (-1)
#endif
    unsigned long long tp0 = 0ull, tp1 = 0ull; (void)tp0; (void)tp1;
#define TP_BEGIN(k) do { if ((PROBE_PHASE) == (k)) tp0 = __builtin_amdgcn_s_memrealtime(); } while (0)
#define TP_END(k) do { if ((PROBE_PHASE) == (k)) tp1 = __builtin_amdgcn_s_memrealtime(); } while (0)
#ifndef PROBE_REP
#define PROBE_REP (-1)
#endif
#if PROBE_REP >= 0
#define REPS(k) int _reps##k = 1 + ((PROBE_REP) == (k) ? 1 : 0); asm volatile("" : "+s"(_reps##k)); for (int _r = 0; _r < _reps##k; ++_r)
#else
#define REPS(k)
#endif
    TP_BEGIN(9); TP_BEGIN(0); { REPS(0) { ph_prologue(P, ldsf, tp0, tp1); GRID_BAR(); } } TP_END(0);
    LAS unsigned char* L = (LAS unsigned char*)lds; const int G = gridDim.x, c = blockIdx.x;
    TP_BEGIN(1);
#if FAST_INPROJ
    { REPS(1) {
    { pg8::DenseOrder S; S.init(ws + WS_XN, ws + WS_WIN, T, 1024, 1024, G, c);
      pg8::EpiInProj E{(bf16_t*)(ws + WS_U), (bf16_t*)(ws + WS_QN), (bf16_t*)(ws + WS_KVN), (bf16_t*)(ws + WS_KR), P.g_q_a, P.g_kv_a, (const float*)(ws + WS_COS), (const float*)(ws + WS_SIN)};
      pg8::gemm_phase<pg8::EpiInProj, pg8::DenseOrder, false, false>(L, 1024, S, E); }
    GRID_BAR(); } }
#else
    nv_gemm_f32((const bf16_t*)(ws + WS_XN), 1024, (const bf16_t*)(ws + WS_WIN), 1024, TMP, 1024, 1024, 8, T / 64); GRID_BAR();
    ph_e1(P); GRID_BAR();
#endif
    TP_END(1); TP_BEGIN(2);
#if FAST_QKV
    { REPS(2) {
    { const int nq = (G >= 256) ? 96 : G, nk = (G >= 256) ? 64 : G, np = (G >= 256) ? G - 160 : G;
      const bool split = G >= 256;
      if (!split || c < 96) {
        pg8::DenseOrder S; S.init(ws + WS_QN, ws + WS_WQB, T, 768, 256, nq, c);
        pg8::EpiQ E{ws + WS_Q, (const float*)(ws + WS_COS), (const float*)(ws + WS_SIN)};
        pg8::gemm_phase<pg8::EpiQ, pg8::DenseOrder, true, false>(L, 256, S, E); }
      if (!split || (c >= 96 && c < 160)) {
        pg8::DenseOrder S; S.init(ws + WS_KVN, ws + WS_WKVB, T, 1024, 128, nk, split ? c - 96 : c);
        pg8::EpiKV E{ws + WS_K, (bf16_t*)(ws + WS_V)};
        pg8::gemm_phase<pg8::EpiKV, pg8::DenseOrder, true, false>(L, 128, S, E); }
      if (!split || c >= 160) pool_phase(P, L, split ? c - 160 : c, np); }
    GRID_BAR(); } }
#else
    nv_gemm_f32((const bf16_t*)(ws + WS_QN), 256, (const bf16_t*)(ws + WS_WQB), 256, TMP, 768, 256, 6, T / 64);
    nv_gemm_f32((const bf16_t*)(ws + WS_KVN), 128, (const bf16_t*)(ws + WS_WKVB), 128, TMP + (size_t)T * 1024, 1024, 128, 8, T / 64);
    ph_pooldiff(P); GRID_BAR();
    ph_e2q(P); ph_e2kv(P);
#endif
#if !(FAST_POOL && FAST_QKV)
    for (int g = 0; g < 4; ++g)
        nv_gemm_f32((const bf16_t*)(ws + WS_H) + g * 128, 512, (const bf16_t*)(ws + WS_WPOOL) + (size_t)g * 128 * 128, 128, (float*)(ws + WS_ACT) + g * 128, 512, 128, 1, T / 64);
    GRID_BAR();
    ph_epool(P, (const float*)(ws + WS_ACT));
#endif
    TP_END(2); TP_BEGIN(3);
#if FAST_ATTN
    { REPS(3) { att::attn_phase<0>(P, (char*)lds); GRID_BAR(); } }
#if PROBE_PHASE == 30
    TP_BEGIN(30); att::attn_phase<0>(P, (char*)lds); GRID_BAR(); TP_END(30);
#elif PROBE_PHASE == 31
    TP_BEGIN(31); att::attn_phase<1>(P, (char*)lds); GRID_BAR(); TP_END(31);
#elif PROBE_PHASE == 32
    TP_BEGIN(32); att::attn_phase<2>(P, (char*)lds); GRID_BAR(); TP_END(32);
#endif
#else
    ph_attn_naive(P, ldsf); GRID_BAR();
#endif
    TP_END(3); TP_BEGIN(4);
#if FAST_WOUT
    { REPS(4) {
    { pg8::DenseOrder S; S.init(ws + WS_MIX, ws + WS_WOUT, T, 1024, 1024, G, c);
      pg8::EpiOut E{P.x, P.out, (const float*)(ws + WS_SSQ), SA_OFF};
      pg8::gemm_phase<pg8::EpiOut, pg8::DenseOrder, false, false>(L, 1024, S, E); }
    GRID_BAR(); } }
#else
    nv_gemm_f32((const bf16_t*)(ws + WS_MIX), 1024, (const bf16_t*)(ws + WS_WOUT), 1024, TMP, 1024, 512, 8, T / 64);
    nv_gemm_f32((const bf16_t*)(ws + WS_MIX) + 512, 1024, (const bf16_t*)(ws + WS_WOUT) + 512, 1024, TMP + (size_t)T * 1024, 1024, 512, 8, T / 64);
    GRID_BAR();
    ph_e4(P); GRID_BAR();
#endif
    TP_END(4); TP_BEGIN(5);
#if FAST_ROUTER
    router_phase(P, L); GRID_BAR();
#else
    ph_router(P, ldsf); GRID_BAR();
#endif
    TP_END(5); TP_BEGIN(6);
#if FAST_MOE
    { REPS(6) {
#if FP8_MOE
    { pg8::MoeOrder<true> S{(const char*)(ws + WS_H), (const char*)(ws + WS_WGU), (size_t)2048 * 1024, 8, G, c, GT_OFF, (const LAS int*)(L + TS_OFF), 1024};
      moe_setup<true>(P, L, S);
      pg8::EpiSwiglu8 E{P.b_gu, ws + WS_ACT};
      pg8::gemm_phase<pg8::EpiSwiglu8, pg8::MoeOrder<true>, true, true, true>(L, 512, S, E); }
    GRID_BAR(); } }
    TP_END(6); TP_BEGIN(7);
    { REPS(7) {
    { pg8::MoeOrder<false> S{(const char*)(ws + WS_ACT), (const char*)(ws + WS_WD), (size_t)1024 * 1024, 4, G, c, 0, (const LAS int*)(L + TS_OFF), 1024};
      moe_setup<false>(P, L, S);
      pg8::EpiDown8 E{P.b_down, (const float*)(ws + WS_GLIST), ws + WS_Y};
      pg8::gemm_phase<pg8::EpiDown8, pg8::MoeOrder<false>, true, false, true>(L, 512, S, E); }
    GRID_BAR(); } }
#else
    { pg8::MoeOrder<true> S{(const char*)(ws + WS_H), (const char*)(ws + WS_WGU), (size_t)2048 * 1024 * 2, 8, G, c, GT_OFF, (const LAS int*)(L + TS_OFF), 2048};
      moe_setup<true>(P, L, S);
      pg8::EpiSwiglu E{P.b_gu, (bf16_t*)(ws + WS_ACT)};
      pg8::gemm_phase<pg8::EpiSwiglu, pg8::MoeOrder<true>, true, true>(L, 1024, S, E); }
    GRID_BAR(); } }
    { REPS(7) {
    { pg8::MoeOrder<false> S{(const char*)(ws + WS_ACT), (const char*)(ws + WS_WD), (size_t)1024 * 1024 * 2, 4, G, c, 0, (const LAS int*)(L + TS_OFF), 2048};
      moe_setup<false>(P, L, S);
      pg8::EpiDown E{P.b_down, (const float*)(ws + WS_GLIST), (bf16_t*)(ws + WS_Y)};
      pg8::gemm_phase<pg8::EpiDown, pg8::MoeOrder<false>, true, false>(L, 1024, S, E); }
    GRID_BAR(); } }
#endif
#else
    ph_moe1_naive(P); GRID_BAR();
    ph_moe2_naive(P); GRID_BAR();
#endif
    TP_END(7); TP_BEGIN(8);
    ph_final(P, (int*)lds);
    if ((PROBE_PHASE) >= 0) GRID_BAR();
    TP_END(8); TP_END(9);
    if ((PROBE_PHASE) >= 0 && blockIdx.x == 0 && threadIdx.x == 0) { const unsigned long long t0 = __builtin_amdgcn_s_memrealtime(); while (__builtin_amdgcn_s_memrealtime() - t0 < (tp1 - tp0)) __builtin_amdgcn_s_sleep(8); }
}

extern "C" void kernel_launch(void* const* d_in, const int* in_sizes, int n_in, void* d_out, int out_size, void* d_ws, size_t ws_size, hipStream_t stream) {
    static int grid = 0;
    if (grid == 0) {
        if (n_in != 22 || out_size != T * D || ws_size < WS_END) { fprintf(stderr, "kernel_launch: unexpected shapes (n_in %d out %d ws %zu)\n", n_in, out_size, ws_size); grid = -1; return; }
        int dev = 0, cus = 0, per_cu = 0;
        if (hipGetDevice(&dev) != hipSuccess || hipDeviceGetAttribute(&cus, hipDeviceAttributeMultiprocessorCount, dev) != hipSuccess) { grid = -1; return; }
        if (hipFuncSetAttribute((const void*)mega_fwd, hipFuncAttributeMaxDynamicSharedMemorySize, LDS_BYTES) != hipSuccess) { fprintf(stderr, "kernel_launch: hipFuncSetAttribute failed\n"); grid = -1; return; }
        if (hipOccupancyMaxActiveBlocksPerMultiprocessor(&per_cu, (const void*)mega_fwd, NWAVES * 64, LDS_BYTES) != hipSuccess || per_cu < 1) fprintf(stderr, "kernel_launch: occupancy query reports %d\n", per_cu);
        (void)hipGetLastError();
        grid = cus;
    }
    if (grid < 0) return;
    Ptrs P{};
    P.x = (const float*)d_in[0]; P.pos = (const int*)d_in[1]; P.g_attn = (const float*)d_in[2]; P.w_in = (const float*)d_in[3]; P.w_pool = (const float*)d_in[4];
    P.b_pool = (const float*)d_in[5]; P.pool_scale = (const float*)d_in[6]; P.g_q_a = (const float*)d_in[7]; P.w_q_b = (const float*)d_in[8]; P.g_kv_a = (const float*)d_in[9];
    P.w_kv_b = (const float*)d_in[10]; P.g_out_pool = (const float*)d_in[11]; P.g_out_attn = (const float*)d_in[12]; P.w_out = (const float*)d_in[13]; P.g_ffn = (const float*)d_in[14];
    P.w_router = (const float*)d_in[15]; P.b_router = (const float*)d_in[16]; P.w_gu = (const float*)d_in[17]; P.b_gu = (const float*)d_in[18]; P.w_down = (const float*)d_in[19];
    P.b_down = (const float*)d_in[20]; P.g_final = (const float*)d_in[21]; P.out = (float*)d_out; P.ws = (unsigned char*)d_ws;
    if (hipMemsetAsync((unsigned char*)d_ws + WS_CTL, 0, CTL_BYTES, stream) != hipSuccess) { fprintf(stderr, "kernel_launch: memset failed\n"); return; }
    hipLaunchKernelGGL(mega_fwd, dim3(grid), dim3(NWAVES * 64), LDS_BYTES, stream, P);
}
```

```cpp
#include <hip/hip_runtime.h>
#ifndef FP8_MOE
#define FP8_MOE 1
#endif
#ifndef CONV_IN_ATTN
#define CONV_IN_ATTN 1
#endif
#include <cstdint>
#include <cstdio>

typedef unsigned short bf16_t;
typedef short bf16x8 __attribute__((ext_vector_type(8)));
typedef float f32x4 __attribute__((ext_vector_type(4)));
typedef unsigned u32x4 __attribute__((ext_vector_type(4)));
typedef unsigned u32x2 __attribute__((ext_vector_type(2)));

constexpr int BATCH = 2, SEQ = 8192, T = BATCH * SEQ, D = 1024;
constexpr int DPOOL = 512, NPG = 4, PGD = 128;
constexpr int NH = 8, VD = 64, QKN = 64, QKR = 32, QKD = 96;
constexpr int QLR = 256, KVLR = 128, DINP = 928;
constexpr int NE = 32, TOPK = 4, DE = 1024;
constexpr float RMS_EPS = 1e-6f;
constexpr float QSCALE = 0.10206207261596577f * 1.4426950408889634f;
constexpr int SLOT_ROWS = T * TOPK + NE * 256;

constexpr size_t MiB = 1u << 20;
constexpr size_t WS_CTL = 0;
constexpr size_t CTL_BYTES = 32 * 1024;
constexpr size_t WS_COS = 1 * MiB, WS_SIN = 2 * MiB;
constexpr size_t WS_WIN = 4 * MiB;
constexpr size_t WS_WQB = 6 * MiB;
constexpr size_t WS_WKVB = 7 * MiB;
constexpr size_t WS_WPOOL = 7 * MiB + 512 * 1024;
constexpr size_t WS_WOUT = 8 * MiB;
constexpr size_t WS_WGU = 16 * MiB;
constexpr size_t WS_WD = 144 * MiB;
constexpr size_t WS_XN = 208 * MiB;
constexpr size_t WS_X1 = WS_XN;
constexpr size_t WS_U = 240 * MiB;
constexpr size_t WS_QN = 256 * MiB;
constexpr size_t WS_KVN = 264 * MiB;
constexpr size_t WS_KR = 268 * MiB;
constexpr size_t WS_Q = 272 * MiB;
constexpr size_t WS_K = 296 * MiB;
constexpr size_t WS_V = 320 * MiB;
constexpr size_t WS_MIX = 336 * MiB;
constexpr size_t WS_SSQ = 368 * MiB;
constexpr size_t WS_H = 370 * MiB;
constexpr size_t WS_SLOT = 402 * MiB;
constexpr size_t WS_LIST = 403 * MiB;
constexpr size_t WS_GLIST = 405 * MiB;
constexpr size_t WS_ACT = 408 * MiB;
constexpr size_t WS_Y = 552 * MiB;
constexpr size_t WS_TMP = 700 * MiB;
constexpr size_t WS_END = 828 * MiB;
constexpr int CW_CNT = 64;

__device__ __forceinline__ unsigned f2bf(float f) { unsigned u = __builtin_bit_cast(unsigned, f); return (u + 0x7fffu + ((u >> 16) & 1u)) >> 16; }
__device__ __forceinline__ unsigned pk2(float lo, float hi) { return f2bf(lo) | (f2bf(hi) << 16); }
__device__ __forceinline__ float bf2f(bf16_t b) { return __builtin_bit_cast(float, (unsigned)b << 16); }
__device__ __forceinline__ float wave_sum(float v) {
#pragma unroll
    for (int o = 1; o < 64; o <<= 1) v += __shfl_xor(v, o);
    return v;
}
__device__ __forceinline__ float wave_max(float v) {
#pragma unroll
    for (int o = 1; o < 64; o <<= 1) v = fmaxf(v, __shfl_xor(v, o));
    return v;
}

typedef int v8i_t __attribute__((ext_vector_type(8)));
constexpr float W8_SCALE = 64.f, W8_INV = 1.f / 64.f;
__device__ __forceinline__ float clamp8(float x) { return __builtin_amdgcn_fmed3f(x, -448.f, 448.f); }
__device__ __forceinline__ unsigned pk4_fp8(float a, float b, float c, float d) {
    int p = 0; p = __builtin_amdgcn_cvt_pk_fp8_f32(clamp8(a), clamp8(b), p, false); p = __builtin_amdgcn_cvt_pk_fp8_f32(clamp8(c), clamp8(d), p, true); return (unsigned)p; }
__device__ __forceinline__ unsigned pk4_fp8_nc(float a, float b, float c, float d) {
    int p = 0; p = __builtin_amdgcn_cvt_pk_fp8_f32(a, b, p, false); p = __builtin_amdgcn_cvt_pk_fp8_f32(c, d, p, true); return (unsigned)p; }
__device__ __forceinline__ int tid_opaque() { int t = threadIdx.x; asm volatile("" : "+v"(t)); return t; }

__device__ __forceinline__ void transpose_item(const float* W, int ldw, int k0, int n0, bf16_t* WT, int ldt, int dn0, int dk0,
                                               const float* ksc, float* scr, int lane) {
    { const int kq = lane >> 3, n4 = (lane & 7) * 4; f32x4 v[8];
#pragma unroll
      for (int i = 0; i < 8; ++i) v[i] = *(const f32x4*)(W + (size_t)(k0 + 8 * i + kq) * ldw + n0 + n4);
#pragma unroll
      for (int i = 0; i < 8; ++i) { const int kk = 8 * i + kq; f32x4 x = v[i]; if (ksc) x = x * ksc[kk];
          scr[kk * 33 + n4 + 0] = x[0]; scr[kk * 33 + n4 + 1] = x[1]; scr[kk * 33 + n4 + 2] = x[2]; scr[kk * 33 + n4 + 3] = x[3]; } }
    asm volatile("s_waitcnt lgkmcnt(0)" ::: "memory");
    const int c = lane & 7;
#pragma unroll
    for (int j = 0; j < 4; ++j) { const int n = (lane >> 3) + 8 * j; const float* s = scr + (8 * c) * 33 + n;
        u32x4 o; o.x = pk2(s[0 * 33], s[1 * 33]); o.y = pk2(s[2 * 33], s[3 * 33]); o.z = pk2(s[4 * 33], s[5 * 33]); o.w = pk2(s[6 * 33], s[7 * 33]);
        *(u32x4*)(WT + (size_t)(dn0 + n) * ldt + dk0 + 8 * c) = o; }
    asm volatile("s_waitcnt lgkmcnt(0)" ::: "memory");
}

__device__ __forceinline__ void transpose_item8(const float* W, int ldw, int k0, int n0, unsigned char* WT, int ldt, int dn0, int dk0, float* scr, int lane) {
    { const int kq = lane >> 3, n4 = (lane & 7) * 4; f32x4 v[8];
#pragma unroll
      for (int i = 0; i < 8; ++i) v[i] = *(const f32x4*)(W + (size_t)(k0 + 8 * i + kq) * ldw + n0 + n4);
#pragma unroll
      for (int i = 0; i < 8; ++i) { const int kk = 8 * i + kq; const f32x4 x = v[i] * W8_SCALE;
          scr[kk * 33 + n4 + 0] = x[0]; scr[kk * 33 + n4 + 1] = x[1]; scr[kk * 33 + n4 + 2] = x[2]; scr[kk * 33 + n4 + 3] = x[3]; } }
    asm volatile("s_waitcnt lgkmcnt(0)" ::: "memory");
    const int c = lane & 7;
#pragma unroll
    for (int j = 0; j < 4; ++j) { const int n = (lane >> 3) + 8 * j; const float* q = scr + (8 * c) * 33 + n;
        u32x2 o; o.x = pk4_fp8(q[0 * 33], q[1 * 33], q[2 * 33], q[3 * 33]); o.y = pk4_fp8(q[4 * 33], q[5 * 33], q[6 * 33], q[7 * 33]);
        *(u32x2*)(WT + (size_t)(dn0 + n) * ldt + dk0 + 8 * c) = o; }
    asm volatile("s_waitcnt lgkmcnt(0)" ::: "memory");
}

struct Ptrs {
    const float* x; const int* pos; const float* g_attn; const float* w_in; const float* w_pool; const float* b_pool; const float* pool_scale;
    const float* g_q_a; const float* w_q_b; const float* g_kv_a; const float* w_kv_b; const float* g_out_pool; const float* g_out_attn; const float* w_out;
    const float* g_ffn; const float* w_router; const float* b_router; const float* w_gu; const float* b_gu; const float* w_down; const float* b_down; const float* g_final;
    float* out; unsigned char* ws;
};

constexpr int IT_IN = 16 * 29, IT_QB = 4 * 24, IT_KVB = 2 * 32, IT_POOL = 4 * 2 * 4, IT_OUT = 16 * 32, IT_GU = 32 * 16 * 64, IT_DN = 32 * 16 * 32;
constexpr int IT_TOTAL = IT_IN + IT_QB + IT_KVB + IT_POOL + IT_OUT + IT_GU + IT_DN;

__device__ __forceinline__ void prologue_item(const Ptrs& P, int it, float* scr, int lane) {
    unsigned char* ws = P.ws;
    int r = it;
    if (r < IT_IN) { const int kb = r / 29, nb = r % 29; transpose_item(P.w_in, DINP, 64 * kb, 32 * nb, (bf16_t*)(ws + WS_WIN), 1024, 32 * nb, 64 * kb, nullptr, scr, lane); return; } r -= IT_IN;
    if (r < IT_QB) { const int kb = r / 24, nb = r % 24; transpose_item(P.w_q_b, 768, 64 * kb, 32 * nb, (bf16_t*)(ws + WS_WQB), 256, 32 * nb, 64 * kb, nullptr, scr, lane); return; } r -= IT_QB;
    if (r < IT_KVB) { const int kb = r / 32, nb = r % 32; transpose_item(P.w_kv_b, 1024, 64 * kb, 32 * nb, (bf16_t*)(ws + WS_WKVB), 128, 32 * nb, 64 * kb, nullptr, scr, lane); return; } r -= IT_KVB;
    if (r < IT_POOL) { const int g = r / 8, kb = (r % 8) / 4, nb = r % 4; transpose_item(P.w_pool + (size_t)g * 128 * 128, 128, 64 * kb, 32 * nb, (bf16_t*)(ws + WS_WPOOL) + (size_t)g * 128 * 128, 128, 32 * nb, 64 * kb, nullptr, scr, lane); return; } r -= IT_POOL;
    if (r < IT_OUT) { const int kb = r / 32, nb = r % 32, k0 = 64 * kb; const float* ksc = k0 < 512 ? P.g_out_pool + k0 : P.g_out_attn + (k0 - 512);
        transpose_item(P.w_out, 1024, k0, 32 * nb, (bf16_t*)(ws + WS_WOUT), 1024, 32 * nb, (k0 + 512) & 1023, ksc, scr, lane); return; } r -= IT_OUT;
    if (r < IT_GU) { const int e = r / 1024, q = r % 1024, kb = q / 64, nb = q % 64, n0 = 32 * nb; const int nn = n0 & 1023, p = nn >> 7, dn0 = 256 * p + (n0 >= 1024 ? 128 : 0) + (nn & 127);
#if FP8_MOE
        transpose_item8(P.w_gu + (size_t)e * 1024 * 2048, 2048, 64 * kb, n0, ws + WS_WGU + (size_t)e * 2048 * 1024, 1024, dn0, 64 * kb, scr, lane); return; } r -= IT_GU;
#else
        transpose_item(P.w_gu + (size_t)e * 1024 * 2048, 2048, 64 * kb, n0, (bf16_t*)(ws + WS_WGU) + (size_t)e * 2048 * 1024, 1024, dn0, 64 * kb, nullptr, scr, lane); return; } r -= IT_GU;
#endif
    { const int e = r / 512, q = r % 512, kb = q / 32, nb = q % 32;
#if FP8_MOE
        transpose_item8(P.w_down + (size_t)e * 1024 * 1024, 1024, 64 * kb, 32 * nb, ws + WS_WD + (size_t)e * 1024 * 1024, 1024, 32 * nb, 64 * kb, scr, lane); }
#else
        transpose_item(P.w_down + (size_t)e * 1024 * 1024, 1024, 64 * kb, 32 * nb, (bf16_t*)(ws + WS_WD) + (size_t)e * 1024 * 1024, 1024, 32 * nb, 64 * kb, nullptr, scr, lane); }
#endif
}

__device__ __forceinline__ void rms_row_to_bf16(const float* xrow, const float* g, bf16_t* orow, int lane) {
    const f32x4* xr = (const f32x4*)xrow + lane; const f32x4* gr = (const f32x4*)g + lane;
    f32x4 v[4]; float s = 0.f;
#pragma unroll
    for (int j = 0; j < 4; ++j) { v[j] = xr[64 * j]; s += (v[j].x * v[j].x + v[j].y * v[j].y) + (v[j].z * v[j].z + v[j].w * v[j].w); }
    const float rstd = 1.f / sqrtf(wave_sum(s) * (1.f / 1024.f) + RMS_EPS);
    u32x2* o8 = (u32x2*)orow + lane;
#pragma unroll
    for (int j = 0; j < 4; ++j) { const f32x4 gg = gr[64 * j]; u32x2 w; w.x = pk2(v[j].x * rstd * gg.x, v[j].y * rstd * gg.y); w.y = pk2(v[j].z * rstd * gg.z, v[j].w * rstd * gg.w); o8[64 * j] = w; }
}

#define LAS __attribute__((address_space(3)))
#define XB_TMO      128
#define XB_XCNT(j)  (256  + 64 * (j))
#define XB_XSUB(j)  (1280 + 64 * (j))
#define XB_XGEN(j)  (2304 + 64 * (j))
#define XB_TOP      3328
#define XB_TOPGEN   3392
#define XCD_BAR_WORDS 3456
#define XB_SPIN_CAP (1u << 18)
__device__ __forceinline__ unsigned xb_ld(unsigned* p)              { return __hip_atomic_load(p, __ATOMIC_RELAXED, __HIP_MEMORY_SCOPE_AGENT); }
__device__ __forceinline__ unsigned xb_add(unsigned* p, unsigned v) { return __hip_atomic_fetch_add(p, v, __ATOMIC_RELAXED, __HIP_MEMORY_SCOPE_AGENT); }
__device__ __forceinline__ unsigned xb_xcc_id() { return (unsigned)__builtin_amdgcn_s_getreg((3 << 11) | 20) & 0xFu; }
#define XB_SPIN(cond, bar) do { unsigned _sp = 0; while (cond) { __builtin_amdgcn_s_sleep(1); \
    if ((++_sp & 255u) == 0u) { if (xb_ld(&(bar)[XB_TMO])) break; if (_sp > XB_SPIN_CAP) { atomicAdd(&(bar)[XB_TMO], 1u); break; } } } } while (0)
struct XcdBarrier { unsigned* bar; unsigned x; volatile LAS unsigned* st; };
__device__ __forceinline__ XcdBarrier xcd_barrier_post(unsigned* bar, volatile LAS unsigned* st) {
    XcdBarrier b; b.bar = bar; b.x = xb_xcc_id(); b.st = st;
    if (threadIdx.x == 0) (void)xb_add(&bar[XB_XCNT(b.x)], 1u);
    return b;
}
__device__ __forceinline__ void xcd_barrier_complete(unsigned* bar, unsigned x, unsigned& nloc, unsigned& nx) {
    const unsigned G = gridDim.x * gridDim.y * gridDim.z;
    unsigned sum, cnt, mine, sp = 0u;
    for (;;) {
        sum = 0u; cnt = 0u; mine = 0u;
#pragma unroll
        for (unsigned j = 0; j < 16; ++j) { const unsigned c = xb_ld(&bar[XB_XCNT(j)]); sum += c; cnt += (c > 0u) ? 1u : 0u; mine = (j == x) ? c : mine; }
        if (sum == G) break;
        __builtin_amdgcn_s_sleep(1);
        if ((++sp & 255u) == 0u) { if (xb_ld(&bar[XB_TMO])) break; if (sp > XB_SPIN_CAP) { atomicAdd(&bar[XB_TMO], 1u); break; } }
    }
    nloc = mine > 0u ? mine : 1u; nx = cnt > 0u ? cnt : 1u;
}
__device__ __forceinline__ void xcd_barrier(const XcdBarrier& b) {
    asm volatile("s_waitcnt vmcnt(0)" ::: "memory");
    __syncthreads();
    if (threadIdx.x == 0) {
        unsigned* bar = b.bar;
        __builtin_amdgcn_s_waitcnt(0);
        unsigned nloc = b.st[0], nx = b.st[1];
        if (nloc == 0u) { xcd_barrier_complete(bar, b.x, nloc, nx); b.st[0] = nloc; b.st[1] = nx; }
        const unsigned old = xb_add(&bar[XB_XSUB(b.x)], 1u);
        const unsigned gen = old / nloc;
        if (old + 1u == (gen + 1u) * nloc) {
            __builtin_amdgcn_fence(__ATOMIC_RELEASE, "agent");
            asm volatile("s_waitcnt vmcnt(0)" ::: "memory");
            const unsigned og = xb_add(&bar[XB_TOP], 1u);
            const unsigned tg = og / nx;
            if (og + 1u == (tg + 1u) * nx) xb_add(&bar[XB_TOPGEN], 1u);
            else XB_SPIN(xb_ld(&bar[XB_TOPGEN]) == tg, bar);
            __builtin_amdgcn_fence(__ATOMIC_ACQUIRE, "agent");
            xb_add(&bar[XB_XGEN(b.x)], 1u);
            asm volatile("s_waitcnt vmcnt(0)" ::: "memory");
        } else {
            XB_SPIN(xb_ld(&bar[XB_XGEN(b.x)]) == gen, bar);
            __builtin_amdgcn_fence(__ATOMIC_ACQUIRE, "agent");
            asm volatile("s_waitcnt vmcnt(0)" ::: "memory");
        }
    }
    __syncthreads();
}

constexpr int NWAVES = 8;
constexpr int RING_BYTES = 131072;
constexpr int LDSCTL_OFF = RING_BYTES, MISC_OFF = LDSCTL_OFF + 320;
constexpr int LDS_BYTES = 147456;
constexpr int CW_BAR = 4096;
constexpr int TS_OFF = 131584;
constexpr int SA_OFF = 131840;
constexpr int GT_OFF = 132864;
static_assert(GT_OFF + 9 * 1024 <= LDS_BYTES, "LDS map");
#ifndef FAST_INPROJ
#define FAST_INPROJ 1
#endif
#ifndef FAST_QKV
#define FAST_QKV 1
#endif
#ifndef FAST_WOUT
#define FAST_WOUT 1
#endif
#ifndef FAST_MOE
#define FAST_MOE 1
#endif
#ifndef FAST_ATTN
#define FAST_ATTN 1
#endif
#ifndef FAST_ROUTER
#define FAST_ROUTER 1
#endif
#ifndef FAST_POOL
#define FAST_POOL 1
#endif


namespace pg8 {
typedef int v4i_t __attribute__((ext_vector_type(4)));
#define PG8_LAS __attribute__((address_space(3)))
constexpr int BM = 256, BK = 64, HALF = 128, HTB = HALF * BK * 2, STAGE_BYTES = 8 * HTB, NXCD = 8, WGM = 8;
__host__ __device__ __forceinline__ int lds_byte(int r, int c) { const int st = (r >> 4) * 2 + (c >> 5), rr = r & 15, cc = c & 31, ob = rr * 64 + cc * 2; return st * 1024 + (ob ^ (((ob >> 9) & 1) << 5)); }
__host__ __device__ __forceinline__ void stage_rc(int b, int& R, int& C) { const int st = b / 1024, sb = b % 1024, swz = sb ^ (((sb >> 9) & 1) << 5); R = (st >> 1) * 16 + swz / 64; C = (st & 1) * 32 + (swz % 64) / 2; }
__host__ __device__ __forceinline__ int perm32(int rho) { const int n = rho >> 4, i = rho & 15; return 8 * (i >> 2) + 4 * n + (i & 3); }
__device__ __forceinline__ unsigned cvt_pk_bf16(float lo, float hi) { unsigned r; asm volatile("v_cvt_pk_bf16_f32 %0, %1, %2" : "=v"(r) : "v"(lo), "v"(hi)); return r; }

struct Unit { const char* a; const char* b; int pm, pn, e, rt; };

struct DenseOrder {
    const char* A; const char* Bt; int nM, nN, nwg, G, c, K;
    __device__ void init(const void* A_, const void* Bt_, int M, int N, int K_, int G_, int c_) { A = (const char*)A_; Bt = (const char*)Bt_; nM = M / BM; nN = N / BM; nwg = nM * nN; G = G_; c = c_; K = K_; }
    __device__ bool next(int i, Unit& u) const {
        const long L = (long)i * G + c; if (L >= nwg) return false;
        int wgid = (int)L; { const int q = nwg / NXCD, r = nwg % NXCD, xcd = wgid % NXCD, off = wgid / NXCD; wgid = (xcd < r ? xcd * (q + 1) : r * (q + 1) + (xcd - r) * q) + off; }
        const int nig = WGM * nN, gid = wgid / nig, fm = gid * WGM, gsz = (nM - fm) < WGM ? (nM - fm) : WGM;
        u.pm = fm + ((wgid % nig) % gsz); u.pn = (wgid % nig) / gsz; u.e = 0; u.rt = 0;
        u.a = A + (size_t)u.pm * BM * K * 2; u.b = Bt + (size_t)u.pn * BM * K * 2; return true;
    }
};

template <class Epi, class Sched, bool ALIGN_EPI, bool GATHER, bool FP8 = false>
__device__ __forceinline__ void gemm_phase(PG8_LAS unsigned char* lds, const int K_, const Sched& S, const Epi& E) {
    int K = K_; asm volatile("" : "+s"(K));
    const int tid = tid_opaque(), wid = __builtin_amdgcn_readfirstlane(tid >> 6), lane = tid & 63, wr = wid >> 2, wc = wid & 3, fr = lane & 15, fq = lane >> 4;
    const int nt = K / BK;
    unsigned voffA0, voffB0; int rowA0;
    { int R, C; stage_rc(tid * 16, R, C); const int Rb = Epi::PERM ? ((R & ~31) + perm32(R & 31)) : R;
      voffA0 = GATHER ? (unsigned)(C * 2) : (unsigned)(R * K + C) * 2u; voffB0 = (unsigned)(Rb * K + C) * 2u; rowA0 = R; }
    const unsigned r64 = (unsigned)(64 * K * 2);
    const size_t kstep = (size_t)(BK * 2);
    const size_t hstep = (size_t)HALF * K * 2;
    const unsigned ldsw = (unsigned)wid * 1024u;
    const int aoff = lds_byte(wr * 64 + fr, fq * 8), boff = lds_byte(wc * 32 + fr, fq * 8);
#define PG8_SA(b, h) (((b) * 2 + (h)) * HTB)
#define PG8_SB(b, h) ((4 + (b) * 2 + (h)) * HTB)
#define PG8_STAGE(bufoff, gbase, voff) do { _Pragma("unroll") for (int _i = 0; _i < 2; ++_i) \
        __builtin_amdgcn_global_load_lds((const unsigned*)((const char*)(gbase) + (size_t)(_i * r64) + (voff)), (PG8_LAS unsigned*)(lds + (bufoff) + ldsw + _i * 8192), 16, 0, 0); } while (0)
#define PG8_STAGE_A(bufoff, abase, rtab, h, koff) do { if constexpr (GATHER) { _Pragma("unroll") for (int _i = 0; _i < 2; ++_i) { \
            const unsigned _ro = *(const PG8_LAS unsigned*)(lds + (rtab) + ((h) * HALF + _i * 64 + rowA0) * 4); \
            __builtin_amdgcn_global_load_lds((const unsigned*)((const char*)(abase) + (koff) + (size_t)(_ro + voffA0)), (PG8_LAS unsigned*)(lds + (bufoff) + ldsw + _i * 8192), 16, 0, 0); } } \
        else { PG8_STAGE(bufoff, (const char*)(abase) + (h) * hstep + (koff), voffA0); } } while (0)
#define PG8_LDA(dst, b, h) do { _Pragma("unroll") for (int m = 0; m < 4; ++m) _Pragma("unroll") for (int k = 0; k < 2; ++k) dst[m][k] = *(const PG8_LAS bf16x8*)(lds + PG8_SA(b, h) + aoff + m * 2048 + k * 1024); } while (0)
#define PG8_LDB(dst, b, h) do { _Pragma("unroll") for (int n = 0; n < 2; ++n) _Pragma("unroll") for (int k = 0; k < 2; ++k) dst[n][k] = *(const PG8_LAS bf16x8*)(lds + PG8_SB(b, h) + boff + n * 2048 + k * 1024); } while (0)
#define PG8_CAT(x) __builtin_shufflevector(__builtin_bit_cast(v4i_t, (x)[0]), __builtin_bit_cast(v4i_t, (x)[1]), 0, 1, 2, 3, 4, 5, 6, 7)
#define PG8_MMA(ai, bj, At, Bt) do { __builtin_amdgcn_s_setprio(1); \
        if constexpr (FP8) { _Pragma("unroll") for (int m = 0; m < 4; ++m) _Pragma("unroll") for (int n = 0; n < 2; ++n) \
            asm volatile("v_mfma_scale_f32_16x16x128_f8f6f4 %0, %1, %2, %0, %3, %3 op_sel_hi:[0,0,0]" : "+v"(acc[ai][bj][m][n]) : "v"(PG8_CAT(Bt[n])), "v"(PG8_CAT(At[m])), "v"(sc1)); } \
        else { _Pragma("unroll") for (int m = 0; m < 4; ++m) _Pragma("unroll") for (int n = 0; n < 2; ++n) _Pragma("unroll") for (int k = 0; k < 2; ++k) \
            acc[ai][bj][m][n] = __builtin_amdgcn_mfma_f32_16x16x32_bf16(Bt[n][k], At[m][k], acc[ai][bj][m][n], 0, 0, 0); } \
        __builtin_amdgcn_s_setprio(0); } while (0)
#define PG8_WAIT_V(n) asm volatile("s_waitcnt vmcnt(" #n ")" ::: "memory")
#define PG8_WAIT_L(n) asm volatile("s_waitcnt lgkmcnt(" #n ")" ::: "memory")
#define PG8_BAR __builtin_amdgcn_s_barrier()
#define PG8_SCHED __builtin_amdgcn_sched_barrier(0)
    Unit cur, nxt; int ui = 0;
    if (!S.next(0, cur)) return;
    f32x4 acc[2][2][4][2];
#pragma unroll
    for (int a = 0; a < 2; ++a)
#pragma unroll
        for (int b = 0; b < 2; ++b)
#pragma unroll
            for (int m = 0; m < 4; ++m)
#pragma unroll
                for (int n = 0; n < 2; ++n) acc[a][b][m][n] = (f32x4){0.f, 0.f, 0.f, 0.f};
    bf16x8 At[4][2], B0[2][2], B1[2][2];
    int sc1 = 0x7f7f7f7f; asm volatile("" : "+v"(sc1));
    const char* cA = cur.a; const char* cB = cur.b; int cR = cur.rt;
    if constexpr (Epi::MID) E.pre(cur, lds, tid);
    PG8_STAGE(PG8_SB(0, 0), cB, voffB0); PG8_STAGE(PG8_SB(0, 1), cB + hstep, voffB0); PG8_STAGE_A(PG8_SA(0, 0), cA, cR, 0, 0); PG8_STAGE_A(PG8_SA(0, 1), cA, cR, 1, 0);
    if (wr == 1) PG8_BAR;
    PG8_WAIT_V(2); PG8_BAR;
    PG8_STAGE(PG8_SB(1, 0), cB + kstep, voffB0); PG8_STAGE_A(PG8_SA(1, 0), cA, cR, 0, kstep); PG8_STAGE(PG8_SB(1, 1), cB + hstep + kstep, voffB0);
    PG8_WAIT_V(6); PG8_BAR;
    for (;;) {
        const bool has_next = S.next(ui + 1, nxt);
        const char* nA = has_next ? nxt.a : cA; const char* nB = has_next ? nxt.b : cB; const int nR = has_next ? nxt.rt : cR;
        for (int t = 0; t < nt; t += 2) {
            const bool last = (t == nt - 2);
            if constexpr (Epi::MID) { if (t == nt / 2) E.mid(acc, wr, fr, lds); }
            const size_t k1 = (size_t)(t + 1) * kstep;
            const char* a2 = last ? nA : cA; const char* b2 = last ? nB : cB + (size_t)(t + 2) * kstep; const int r2 = last ? nR : cR;
            const size_t k2 = last ? 0 : (size_t)(t + 2) * kstep, k3 = k2 + kstep; const char* b3 = b2 + kstep;
            PG8_LDB(B0, 0, 0); PG8_LDB(B1, 0, 1); PG8_SCHED; PG8_LDA(At, 0, 0); PG8_STAGE_A(PG8_SA(1, 1), cA, cR, 1, k1);
            PG8_WAIT_V(8); PG8_WAIT_L(0); PG8_BAR; PG8_MMA(0, 0, At, B0); PG8_MMA(0, 1, At, B1); PG8_BAR; PG8_SCHED;
            PG8_LDA(At, 0, 1); PG8_STAGE(PG8_SB(0, 0), b2, voffB0); PG8_STAGE(PG8_SB(0, 1), b2 + hstep, voffB0); PG8_STAGE_A(PG8_SA(0, 0), a2, r2, 0, k2);
            PG8_WAIT_V(8); PG8_WAIT_L(0); PG8_BAR; PG8_MMA(1, 0, At, B0); PG8_MMA(1, 1, At, B1); PG8_BAR; PG8_SCHED;
            PG8_LDB(B0, 1, 0); PG8_LDB(B1, 1, 1); PG8_SCHED; PG8_LDA(At, 1, 0); PG8_STAGE_A(PG8_SA(0, 1), a2, r2, 1, k2);
            PG8_WAIT_V(8); PG8_WAIT_L(0); PG8_BAR; PG8_MMA(0, 0, At, B0); PG8_MMA(0, 1, At, B1); PG8_BAR; PG8_SCHED;
            PG8_LDA(At, 1, 1); PG8_STAGE(PG8_SB(1, 0), b3, voffB0); PG8_STAGE(PG8_SB(1, 1), b3 + hstep, voffB0); PG8_STAGE_A(PG8_SA(1, 0), a2, r2, 0, k3);
            PG8_WAIT_V(8); PG8_WAIT_L(0); PG8_BAR; PG8_MMA(1, 0, At, B0); PG8_MMA(1, 1, At, B1); PG8_BAR; PG8_SCHED;
        }
        if constexpr (ALIGN_EPI) { if (wr == 0) PG8_BAR; }
        if constexpr (FP8) {
            asm volatile("s_nop 15\n\ts_nop 15\n\ts_nop 7" ::: "memory");
            _Pragma("unroll") for (int a = 0; a < 2; ++a) _Pragma("unroll") for (int b = 0; b < 2; ++b) _Pragma("unroll") for (int m = 0; m < 4; ++m) _Pragma("unroll") for (int n = 0; n < 2; ++n)
                asm volatile("" : "+v"(acc[a][b][m][n]));
        }
        if constexpr (!Epi::AFTER_DRAIN) { E(acc, cur, wr, wc, fr, fq); }
        if (!has_next) break;
#pragma unroll
        for (int a = 0; a < 2; ++a)
#pragma unroll
            for (int b = 0; b < 2; ++b)
#pragma unroll
                for (int m = 0; m < 4; ++m)
#pragma unroll
                    for (int n = 0; n < 2; ++n) acc[a][b][m][n] = (f32x4){0.f, 0.f, 0.f, 0.f};
        cur = nxt; cA = nA; cB = nB; cR = nR; ++ui;
        if constexpr (ALIGN_EPI) { if (wr == 1) PG8_BAR; }
    }
    PG8_WAIT_V(0);
    if constexpr (!ALIGN_EPI) { if (wr == 0) PG8_BAR; }
    PG8_BAR;
    if constexpr (Epi::AFTER_DRAIN) { E.fused(acc, cur, wr, wc, fr, fq, lds, wid, lane); }
#undef PG8_SA
#undef PG8_SB
#undef PG8_STAGE
#undef PG8_STAGE_A
#undef PG8_LDA
#undef PG8_LDB
#undef PG8_MMA
#undef PG8_CAT
#undef PG8_WAIT_V
#undef PG8_WAIT_L
#undef PG8_BAR
#undef PG8_SCHED
}

struct EpiInProj {
    static constexpr bool PERM = false, AFTER_DRAIN = true, MID = false;
    bf16_t* U; bf16_t* QN; bf16_t* KVN; bf16_t* KR; const float* g_q_a; const float* g_kv_a; const float* COS; const float* SIN;
    __device__ __forceinline__ void fused(f32x4 (&acc)[2][2][4][2], const Unit& u, int wr, int wc, int fr, int fq, PG8_LAS unsigned char* lds, int wid, int lane) const {
        const int row0 = u.pm * BM + wr * 64 + fr;
        if (u.pn < 2) {
#pragma unroll
            for (int ai = 0; ai < 2; ++ai)
#pragma unroll
                for (int m = 0; m < 4; ++m) { bf16_t* rowp = U + (size_t)(row0 + ai * HALF + m * 16) * 512 + u.pn * 256 + wc * 32 + 4 * fq;
#pragma unroll
                    for (int bj = 0; bj < 2; ++bj)
#pragma unroll
                        for (int n = 0; n < 2; ++n) { const f32x4 v = acc[ai][bj][m][n]; u32x2 w; w.x = cvt_pk_bf16(v[0], v[1]); w.y = cvt_pk_bf16(v[2], v[3]); *(u32x2*)(rowp + bj * HALF + n * 16) = w; } }
            return;
        }
        const bool isq = (u.pn == 2);
        PG8_LAS float* Pp = (PG8_LAS float*)lds;
#pragma unroll
        for (int ai = 0; ai < 2; ++ai)
#pragma unroll
            for (int m = 0; m < 4; ++m) { float s = 0.f;
#pragma unroll
                for (int bj = 0; bj < 2; ++bj) { if (bj == 1 && !isq) continue;
#pragma unroll
                    for (int n = 0; n < 2; ++n) { const f32x4 x = acc[ai][bj][m][n]; s += (x[0] * x[0] + x[1] * x[1]) + (x[2] * x[2] + x[3] * x[3]); } }
                s += __shfl_xor(s, 16); s += __shfl_xor(s, 32);
                if (fq == 0) Pp[(ai * HALF + wr * 64 + m * 16 + fr) * 4 + wc] = s; }
        asm volatile("s_waitcnt lgkmcnt(0)" ::: "memory"); __builtin_amdgcn_s_barrier(); asm volatile("" ::: "memory");
        const float invn = isq ? (1.f / 256.f) : (1.f / 128.f);
#pragma unroll
        for (int ai = 0; ai < 2; ++ai)
#pragma unroll
            for (int m = 0; m < 4; ++m) { const int rl = ai * HALF + wr * 64 + m * 16 + fr; const f32x4 p4 = *(const PG8_LAS f32x4*)(Pp + rl * 4);
                const float rstd = 1.f / sqrtf(((p4[0] + p4[1]) + (p4[2] + p4[3])) * invn + RMS_EPS); const size_t row = (size_t)(u.pm * BM + rl);
                if (isq) {
#pragma unroll
                    for (int bj = 0; bj < 2; ++bj)
#pragma unroll
                        for (int n = 0; n < 2; ++n) { const int c = bj * HALF + wc * 32 + n * 16 + 4 * fq; const f32x4 g = *(const f32x4*)(g_q_a + c); const f32x4 v = acc[ai][bj][m][n] * rstd * g;
                            u32x2 w; w.x = cvt_pk_bf16(v[0], v[1]); w.y = cvt_pk_bf16(v[2], v[3]); *(u32x2*)(QN + row * 256 + c) = w; }
                } else {
#pragma unroll
                    for (int n = 0; n < 2; ++n) { const int c = wc * 32 + n * 16 + 4 * fq; const f32x4 g = *(const f32x4*)(g_kv_a + c); const f32x4 v = acc[ai][0][m][n] * rstd * g;
                        u32x2 w; w.x = cvt_pk_bf16(v[0], v[1]); w.y = cvt_pk_bf16(v[2], v[3]); *(u32x2*)(KVN + row * 128 + c) = w; }
                    if (wc == 0) { const f32x4 x1 = acc[ai][1][m][0], x2 = acc[ai][1][m][1]; const f32x4 cs = *(const f32x4*)(COS + row * 16 + 4 * fq), sn = *(const f32x4*)(SIN + row * 16 + 4 * fq);
                        const f32x4 o1 = x1 * cs - x2 * sn, o2 = x2 * cs + x1 * sn; u32x2 w1, w2; w1.x = cvt_pk_bf16(o1[0], o1[1]); w1.y = cvt_pk_bf16(o1[2], o1[3]); w2.x = cvt_pk_bf16(o2[0], o2[1]); w2.y = cvt_pk_bf16(o2[2], o2[3]);
                        *(u32x2*)(KR + row * 32 + 4 * fq) = w1; *(u32x2*)(KR + row * 32 + 16 + 4 * fq) = w2; }
                } }
    }
};
}
namespace pg8 {
constexpr float QN8_SCALE = 8.f;
struct EpiQ {
    static constexpr bool PERM = false, AFTER_DRAIN = false, MID = false;
    unsigned char* QF; const float* COS; const float* SIN;
    __device__ __forceinline__ void operator()(const f32x4 (&acc)[2][2][4][2], const Unit& u, int wr, int wc, int fr, int fq) const {
        const int row0 = u.pm * BM + wr * 64 + fr; const int G0 = 8 * u.pn + wc, G1 = G0 + 4; const bool r0 = (G0 % 3) == 2, r1 = (G1 % 3) == 2;
#pragma unroll
        for (int ai = 0; ai < 2; ++ai)
#pragma unroll
            for (int m = 0; m < 4; ++m) { const size_t row = (size_t)(row0 + ai * HALF + m * 16);
                f32x4 cs = {1.f, 1.f, 1.f, 1.f}, sn = {0.f, 0.f, 0.f, 0.f};
                if (r0 || r1) { cs = *(const f32x4*)(COS + row * 16 + 4 * fq); sn = *(const f32x4*)(SIN + row * 16 + 4 * fq); }
#pragma unroll
                for (int bj = 0; bj < 2; ++bj) { const bool rope = bj ? r1 : r0; const int G = bj ? G1 : G0; f32x4 o1 = acc[ai][bj][m][0], o2 = acc[ai][bj][m][1];
                    unsigned char* hp = QF + row * 1024 + (G / 3) * 128;
                    if (rope) { const f32x4 x1 = o1, x2 = o2; o1 = (x1 * cs - x2 * sn) * QSCALE; o2 = (x2 * cs + x1 * sn) * QSCALE;
                        u32x2 w1, w2; w1.x = cvt_pk_bf16(o1[0], o1[1]); w1.y = cvt_pk_bf16(o1[2], o1[3]); w2.x = cvt_pk_bf16(o2[0], o2[1]); w2.y = cvt_pk_bf16(o2[2], o2[3]);
                        *(u32x2*)(hp + 64 + 8 * fq) = w1; *(u32x2*)(hp + 64 + 32 + 8 * fq) = w2; }
                    else { o1 = o1 * (QSCALE * QN8_SCALE); o2 = o2 * (QSCALE * QN8_SCALE); const int cb = 32 * (G % 3) + 4 * fq;
                        *(unsigned*)(hp + cb) = pk4_fp8(o1[0], o1[1], o1[2], o1[3]); *(unsigned*)(hp + cb + 16) = pk4_fp8(o2[0], o2[1], o2[2], o2[3]); } }
                asm volatile("" ::: "memory"); }
    }
};
struct EpiKV {
    static constexpr bool PERM = true, AFTER_DRAIN = false, MID = false;
    unsigned char* Kn8; bf16_t* V;
    __device__ __forceinline__ void operator()(const f32x4 (&acc)[2][2][4][2], const Unit& u, int wr, int wc, int fr, int fq) const {
        const int row0 = u.pm * BM + wr * 64 + fr;
#pragma unroll
        for (int bj = 0; bj < 2; ++bj) { const int head = 2 * u.pn + bj;
#pragma unroll
            for (int ai = 0; ai < 2; ++ai)
#pragma unroll
                for (int m = 0; m < 4; ++m) { const size_t row = (size_t)(row0 + ai * HALF + m * 16); const f32x4 v0 = acc[ai][bj][m][0], v1 = acc[ai][bj][m][1];
                    if (wc < 2) { u32x2 w; w.x = pk4_fp8(v0[0], v0[1], v0[2], v0[3]); w.y = pk4_fp8(v1[0], v1[1], v1[2], v1[3]); *(u32x2*)(Kn8 + row * 512 + head * 64 + wc * 32 + 8 * fq) = w; }
                    else { u32x4 w; w.x = cvt_pk_bf16(v0[0], v0[1]); w.y = cvt_pk_bf16(v0[2], v0[3]); w.z = cvt_pk_bf16(v1[0], v1[1]); w.w = cvt_pk_bf16(v1[2], v1[3]); *(u32x4*)(V + row * 512 + head * 64 + (wc - 2) * 32 + 8 * fq) = w; } } }
    }
};
struct EpiOut {
    static constexpr bool PERM = true, AFTER_DRAIN = false, MID = true;
    const float* x; bf16_t* out; const float* SSQ; int aux_off;
    __device__ __forceinline__ void pre(const Unit& u, PG8_LAS unsigned char* lds, int tid) const {
        if (tid < 256) { const f32x4 a = *(const f32x4*)(SSQ + (size_t)(u.pm * BM + tid) * 8), b = *(const f32x4*)(SSQ + (size_t)(u.pm * BM + tid) * 8 + 4);
            const float s = ((a[0] + a[1]) + (a[2] + a[3])) + ((b[0] + b[1]) + (b[2] + b[3])); ((PG8_LAS float*)(lds + aux_off))[tid] = 1.f / sqrtf(s * (1.f / 512.f) + RMS_EPS); }
    }
    __device__ __forceinline__ void mid(f32x4 (&acc)[2][2][4][2], int wr, int fr, PG8_LAS unsigned char* lds) const {
#pragma unroll
        for (int ai = 0; ai < 2; ++ai)
#pragma unroll
            for (int m = 0; m < 4; ++m) { const float sa = ((const PG8_LAS float*)(lds + aux_off))[ai * HALF + wr * 64 + m * 16 + fr];
#pragma unroll
                for (int bj = 0; bj < 2; ++bj)
#pragma unroll
                    for (int n = 0; n < 2; ++n) acc[ai][bj][m][n] = acc[ai][bj][m][n] * sa; }
    }
    __device__ __forceinline__ void operator()(const f32x4 (&acc)[2][2][4][2], const Unit& u, int wr, int wc, int fr, int fq) const {
        const int row0 = u.pm * BM + wr * 64 + fr, col0 = u.pn * BM + wc * 32 + 8 * fq;
#pragma unroll
        for (int ai = 0; ai < 2; ++ai)
#pragma unroll
            for (int m = 0; m < 4; ++m) { const size_t off = (size_t)(row0 + ai * HALF + m * 16) * 1024 + col0;
#pragma unroll
                for (int bj = 0; bj < 2; ++bj) { const f32x4 v0 = *(const f32x4*)(x + off + bj * HALF) + acc[ai][bj][m][0], v1 = *(const f32x4*)(x + off + bj * HALF + 4) + acc[ai][bj][m][1];
                    u32x4 w; w.x = cvt_pk_bf16(v0[0], v0[1]); w.y = cvt_pk_bf16(v0[2], v0[3]); w.z = cvt_pk_bf16(v1[0], v1[1]); w.w = cvt_pk_bf16(v1[2], v1[3]); *(u32x4*)(out + off + bj * HALF) = w; } }
    }
};
struct EpiSwiglu {
    static constexpr bool PERM = true, AFTER_DRAIN = false, MID = false;
    const float* bgu; bf16_t* ACT;
    __device__ __forceinline__ void operator()(const f32x4 (&acc)[2][2][4][2], const Unit& u, int wr, int wc, int fr, int fq) const {
        const int row0 = u.pm * BM + wr * 64 + fr, col8 = u.pn * HALF + wc * 32 + 8 * fq;
        f32x4 bg[2], bu[2];
#pragma unroll
        for (int n = 0; n < 2; ++n) { bg[n] = *(const f32x4*)(bgu + (size_t)u.e * 2048 + col8 + 4 * n); bu[n] = *(const f32x4*)(bgu + (size_t)u.e * 2048 + 1024 + col8 + 4 * n); }
#pragma unroll
        for (int ai = 0; ai < 2; ++ai)
#pragma unroll
            for (int m = 0; m < 4; ++m) { f32x4 a[2];
#pragma unroll
                for (int n = 0; n < 2; ++n) { const f32x4 g4 = acc[ai][0][m][n] + bg[n], u4 = acc[ai][1][m][n] + bu[n];
#pragma unroll
                    for (int j = 0; j < 4; ++j) { const float g = fminf(g4[j], 7.f), uu = fminf(fmaxf(u4[j], -7.f), 7.f);
                        const float sg = __builtin_amdgcn_rcpf(1.f + __builtin_amdgcn_exp2f(-1.702f * 1.4426950408889634f * g)); a[n][j] = g * sg * (uu + 1.f); } }
                u32x4 w; w.x = cvt_pk_bf16(a[0][0], a[0][1]); w.y = cvt_pk_bf16(a[0][2], a[0][3]); w.z = cvt_pk_bf16(a[1][0], a[1][1]); w.w = cvt_pk_bf16(a[1][2], a[1][3]);
                *(u32x4*)(ACT + (size_t)(row0 + ai * HALF + m * 16) * 1024 + col8) = w; }
    }
};
struct EpiDown {
    static constexpr bool PERM = true, AFTER_DRAIN = false, MID = false;
    const float* bd; const float* GL; bf16_t* Y;
    __device__ __forceinline__ void operator()(const f32x4 (&acc)[2][2][4][2], const Unit& u, int wr, int wc, int fr, int fq) const {
        const int col0 = u.pn * BM + wc * 32 + 8 * fq;
        f32x4 bv[2][2];
#pragma unroll
        for (int bj = 0; bj < 2; ++bj)
#pragma unroll
            for (int n = 0; n < 2; ++n) bv[bj][n] = *(const f32x4*)(bd + (size_t)u.e * 1024 + col0 + bj * HALF + 4 * n);
#pragma unroll
        for (int ai = 0; ai < 2; ++ai)
#pragma unroll
            for (int m = 0; m < 4; ++m) { const int rl = ai * HALF + wr * 64 + m * 16 + fr; const float gt = GL[(size_t)u.e * T + u.rt + rl]; bf16_t* rowp = Y + (size_t)(u.pm * BM + rl) * 1024 + col0;
#pragma unroll
                for (int bj = 0; bj < 2; ++bj) { const f32x4 v0 = (acc[ai][bj][m][0] + bv[bj][0]) * gt, v1 = (acc[ai][bj][m][1] + bv[bj][1]) * gt;
                    u32x4 w; w.x = cvt_pk_bf16(v0[0], v0[1]); w.y = cvt_pk_bf16(v0[2], v0[3]); w.z = cvt_pk_bf16(v1[0], v1[1]); w.w = cvt_pk_bf16(v1[2], v1[3]); *(u32x4*)(rowp + bj * HALF) = w; } }
    }
};
struct EpiSwiglu8 {
    static constexpr bool PERM = true, AFTER_DRAIN = false, MID = false;
    const float* bgu; unsigned char* ACT;
    __device__ __forceinline__ void operator()(const f32x4 (&acc)[2][2][4][2], const Unit& u, int wr, int wc, int fr, int fq) const {
        const int row0 = u.pm * BM + wr * 64 + fr, col8 = u.pn * HALF + wc * 32 + 8 * fq;
        f32x4 bg[2], bu[2];
#pragma unroll
        for (int n = 0; n < 2; ++n) { bg[n] = *(const f32x4*)(bgu + (size_t)u.e * 2048 + col8 + 4 * n); bu[n] = *(const f32x4*)(bgu + (size_t)u.e * 2048 + 1024 + col8 + 4 * n); }
#pragma unroll
        for (int ai = 0; ai < 2; ++ai)
#pragma unroll
            for (int m = 0; m < 4; ++m) { f32x4 a[2];
#pragma unroll
                for (int n = 0; n < 2; ++n) { const f32x4 g4 = acc[ai][0][m][n] * W8_INV + bg[n], u4 = acc[ai][1][m][n] * W8_INV + bu[n];
#pragma unroll
                    for (int j = 0; j < 4; ++j) { const float g = fminf(g4[j], 7.f), uu = fminf(fmaxf(u4[j], -7.f), 7.f);
                        const float sg = __builtin_amdgcn_rcpf(1.f + __builtin_amdgcn_exp2f(-1.702f * 1.4426950408889634f * g)); a[n][j] = g * sg * (uu + 1.f); } }
                u32x2 w; w.x = pk4_fp8_nc(a[0][0], a[0][1], a[0][2], a[0][3]); w.y = pk4_fp8_nc(a[1][0], a[1][1], a[1][2], a[1][3]);
                *(u32x2*)(ACT + (size_t)(row0 + ai * HALF + m * 16) * 1024 + col8) = w; }
    }
};
constexpr float Y8_SCALE = 16.f, Y8_INV = 1.f / 16.f;
struct EpiDown8 {
    static constexpr bool PERM = true, AFTER_DRAIN = false, MID = false;
    const float* bd; const float* GL; unsigned char* Y;
    __device__ __forceinline__ void operator()(const f32x4 (&acc)[2][2][4][2], const Unit& u, int wr, int wc, int fr, int fq) const {
        const int col0 = u.pn * BM + wc * 32 + 8 * fq;
        f32x4 bv[2][2];
#pragma unroll
        for (int bj = 0; bj < 2; ++bj)
#pragma unroll
            for (int n = 0; n < 2; ++n) bv[bj][n] = *(const f32x4*)(bd + (size_t)u.e * 1024 + col0 + bj * HALF + 4 * n);
#pragma unroll
        for (int ai = 0; ai < 2; ++ai)
#pragma unroll
            for (int m = 0; m < 4; ++m) { const int rl = ai * HALF + wr * 64 + m * 16 + fr; const float gt = GL[(size_t)u.e * T + u.rt + rl] * Y8_SCALE; unsigned char* rowp = Y + (size_t)(u.pm * BM + rl) * 1024 + col0;
#pragma unroll
                for (int bj = 0; bj < 2; ++bj) { const f32x4 v0 = (acc[ai][bj][m][0] * W8_INV + bv[bj][0]) * gt, v1 = (acc[ai][bj][m][1] * W8_INV + bv[bj][1]) * gt;
                    u32x2 w; w.x = pk4_fp8(v0[0], v0[1], v0[2], v0[3]); w.y = pk4_fp8(v1[0], v1[1], v1[2], v1[3]); *(u32x2*)(rowp + bj * HALF) = w; } }
    }
};
template <bool GATHER>
struct MoeOrder {
    const char* A; const char* W; size_t wstride; int NN, G, c, rt0; const PG8_LAS int* tstart; int rowbytes;
    __device__ bool next(int i, Unit& u) const {
        const int nwg = tstart[32] * NN; const long L = (long)i * G + c; if (L >= nwg) return false;
        int wgid = (int)L; { const int q = nwg / NXCD, r = nwg % NXCD, xcd = wgid % NXCD, off = wgid / NXCD; wgid = (xcd < r ? xcd * (q + 1) : r * (q + 1) + (xcd - r) * q) + off; }
        const int mt = wgid / NN, pn = wgid % NN; int e = 0;
        for (int k = 1; k < 32; ++k) e += (tstart[k] <= mt) ? 1 : 0;
        u.pm = mt; u.pn = pn; u.e = e; const int jt = mt - tstart[e];
        u.a = GATHER ? A : A + (size_t)mt * BM * rowbytes; u.b = W + (size_t)e * wstride + (size_t)pn * BM * rowbytes;
        u.rt = GATHER ? rt0 + i * 1024 : jt * 256;
        return true;
    }
};
}

template <bool GATHER>
__device__ __forceinline__ void moe_setup(const Ptrs& P, LAS unsigned char* lds, const pg8::MoeOrder<GATHER>& S) {
    const int tid = threadIdx.x; const int* cnt = (const int*)(P.ws + WS_CTL) + CW_CNT;
    if (tid < 33) { int s = 0; for (int e = 0; e < tid; ++e) s += (cnt[e] + 255) >> 8; ((LAS int*)(lds + TS_OFF))[tid] = s; }
    __syncthreads();
    if constexpr (GATHER) {
        const int* LIST = (const int*)(P.ws + WS_LIST); pg8::Unit u;
        for (int i = 0; i < 9 && S.next(i, u); ++i) {
            if (tid < 256) { const int jt = u.pm - S.tstart[u.e]; int pos = jt * 256 + tid; const int n = cnt[u.e]; if (pos >= n) pos = n - 1;
                ((LAS unsigned*)(lds + GT_OFF + i * 1024))[tid] = (unsigned)LIST[(size_t)u.e * T + pos] * (unsigned)S.rowbytes; }
        }
        __syncthreads();
    }
}
namespace att {
typedef short s16x4 __attribute__((ext_vector_type(4)));
typedef float f32x16 __attribute__((ext_vector_type(16)));
constexpr int NW = 8, QBLK = 32, KVBLK = 64, QB = NW * QBLK;
constexpr int SHM_V = KVBLK * 64 * 2, SHM_K = KVBLK * 128;
constexpr int NVS = 3;
constexpr int OFF_V = 0, OFF_K = NVS * SHM_V, OFF_WS = OFF_K + 2 * SHM_K, OFF_OST = OFF_WS + NW * 64 * 4, ATT_LDS = OFF_OST + NW * 4096;
constexpr float THR2 = 11.5f;
#define KSWZ(row, ch) ((row) * 128 + ((((ch) ^ (((row) >> 1) & 7))) << 4))
#define SBAR() __builtin_amdgcn_sched_barrier(0)
__device__ __forceinline__ int v_st(int k, int c) { return ((k >> 3) * 2 + (c >> 5)) * 512 + ((k & 7) * 32 + (c & 31)) * 2; }
__device__ __forceinline__ int v_rd_base(int lane) { return ((lane & 3) << 3) | (((lane >> 2) & 3) << 6) | (((lane >> 4) & 1) << 5) | (((lane >> 5) & 1) << 8); }
__device__ __forceinline__ int crow(int r, int hi) { return (r & 3) + 8 * (r >> 2) + 4 * hi; }
__device__ __forceinline__ unsigned cvtpk(float lo, float hi) { unsigned r; asm volatile("v_cvt_pk_bf16_f32 %0, %1, %2" : "=v"(r) : "v"(lo), "v"(hi)); return r; }
__device__ __forceinline__ void mask_tile(f32x16& p0, f32x16& p1, int dq) {
    const float NEG = -__builtin_inff();
#pragma unroll
    for (int r = 0; r < 16; ++r) { const int c = (r & 3) + 8 * (r >> 2); if (dq - c < 0) p0[r] = NEG; if (dq - c - 32 < 0) p1[r] = NEG; }
}
template <bool FIRST, int VAR = 0>
__device__ __forceinline__ void partialSM(f32x16& p0, f32x16& p1, float& m_reg, f32x16& negm, float& alpha) {
    if constexpr (VAR == 1) { alpha = 1.f; return; }
    float pmax = p0[0];
#pragma unroll
    for (int r = 1; r < 16; ++r) pmax = fmaxf(pmax, p0[r]);
#pragma unroll
    for (int r = 0; r < 16; ++r) pmax = fmaxf(pmax, p1[r]);
    { auto rr = __builtin_amdgcn_permlane32_swap(__float_as_uint(pmax), __float_as_uint(pmax), false, false); pmax = fmaxf(__uint_as_float(rr[0]), __uint_as_float(rr[1])); }
    if (!FIRST && __builtin_expect(__all(pmax <= THR2), 1)) { alpha = 1.f; }
    else { const float dl = FIRST ? pmax : fmaxf(pmax, 0.f); m_reg += dl; alpha = FIRST ? 1.f : __builtin_amdgcn_exp2f(-dl);
#pragma unroll
        for (int r = 0; r < 16; ++r) { p0[r] -= dl; p1[r] -= dl; }
#pragma unroll
        for (int r = 0; r < 16; ++r) negm[r] = -m_reg;
        asm volatile("" : "+v"(negm)); }
#pragma unroll
    for (int r = 0; r < 16; ++r) p0[r] = __builtin_amdgcn_exp2f(p0[r]);
}
template <int VAR = 0>
__device__ __forceinline__ void finishSM(f32x16& p0, f32x16& p1, float alpha, float& l_reg, bf16x8& pa0, bf16x8& pa1, bf16x8& pa2, bf16x8& pa3) {
    if constexpr (VAR != 1) {
#pragma unroll
    for (int r = 0; r < 16; ++r) p1[r] = __builtin_amdgcn_exp2f(p1[r]); }
    float ps = 0;
#pragma unroll
    for (int r = 0; r < 16; ++r) ps += p0[r];
#pragma unroll
    for (int r = 0; r < 16; ++r) ps += p1[r];
    { auto rr = __builtin_amdgcn_permlane32_swap(__float_as_uint(ps), __float_as_uint(ps), false, false); ps = __uint_as_float(rr[0]) + __uint_as_float(rr[1]); }
    l_reg = l_reg * alpha + ps;
#define PK4(P, B_, OUT) do { u32x4 w = {cvtpk(P[B_+0], P[B_+1]), cvtpk(P[B_+2], P[B_+3]), cvtpk(P[B_+4], P[B_+5]), cvtpk(P[B_+6], P[B_+7])}; OUT = *reinterpret_cast<bf16x8*>(&w); } while (0)
    PK4(p0, 0, pa0); PK4(p0, 8, pa1); PK4(p1, 0, pa2); PK4(p1, 8, pa3);
#undef PK4
}
typedef int v8i_a __attribute__((ext_vector_type(8)));
typedef int v4i_a __attribute__((ext_vector_type(4)));
template <int KB, int VAR = 0>
__device__ __forceinline__ void qkt(f32x16& p0, f32x16& p1, const char* K_lds, int r32, int hi, const v8i_a& qn, const bf16x8* qro, const f32x16& negm) {
    if constexpr (VAR == 2) { p0 = negm; p1 = negm; asm volatile("" : "+v"(p0), "+v"(p1)); return; }
    const char* kb = K_lds + KB * SHM_K;
    const v4i_a a0 = *reinterpret_cast<const v4i_a*>(kb + KSWZ(r32, 2 * hi)), a1 = *reinterpret_cast<const v4i_a*>(kb + KSWZ(r32, 2 * hi + 1));
    const v4i_a b0 = *reinterpret_cast<const v4i_a*>(kb + KSWZ(32 + r32, 2 * hi)), b1 = *reinterpret_cast<const v4i_a*>(kb + KSWZ(32 + r32, 2 * hi + 1));
    const bf16x8 c0 = *reinterpret_cast<const bf16x8*>(kb + KSWZ(r32, 4 + hi)), c1 = *reinterpret_cast<const bf16x8*>(kb + KSWZ(r32, 6 + hi));
    const bf16x8 d0 = *reinterpret_cast<const bf16x8*>(kb + KSWZ(32 + r32, 4 + hi)), d1 = *reinterpret_cast<const bf16x8*>(kb + KSWZ(32 + r32, 6 + hi));
    __builtin_amdgcn_s_setprio(1);
    p0 = __builtin_amdgcn_mfma_scale_f32_32x32x64_f8f6f4(__builtin_shufflevector(a0, a1, 0, 1, 2, 3, 4, 5, 6, 7), qn, negm, 0, 0, 0, 0x7f7f7f7f, 0, 0x7c7c7c7c);
    p1 = __builtin_amdgcn_mfma_scale_f32_32x32x64_f8f6f4(__builtin_shufflevector(b0, b1, 0, 1, 2, 3, 4, 5, 6, 7), qn, negm, 0, 0, 0, 0x7f7f7f7f, 0, 0x7c7c7c7c);
    p0 = __builtin_amdgcn_mfma_f32_32x32x16_bf16(c0, qro[0], p0, 0, 0, 0);
    p1 = __builtin_amdgcn_mfma_f32_32x32x16_bf16(d0, qro[0], p1, 0, 0, 0);
    p0 = __builtin_amdgcn_mfma_f32_32x32x16_bf16(c1, qro[1], p0, 0, 0, 0);
    p1 = __builtin_amdgcn_mfma_f32_32x32x16_bf16(d1, qro[1], p1, 0, 0, 0);
    __builtin_amdgcn_s_setprio(0);
}
typedef short v4i16_t __attribute__((ext_vector_type(4)));
__device__ __forceinline__ s16x4 vtr(const char* p) { return __builtin_bit_cast(s16x4, __builtin_amdgcn_ds_read_tr16_b64_v4i16((__attribute__((address_space(3))) v4i16_t*)(p))); }
template <int VAR = 0>
__device__ __forceinline__ void pv_tile(f32x16* o, const char* vb, bf16x8 pa0, bf16x8 pa1, bf16x8 pa2, bf16x8 pa3) {
    if constexpr (VAR == 2) { asm volatile("" :: "v"(pa0), "v"(pa1), "v"(pa2), "v"(pa3)); return; }
#pragma unroll
    for (int d0 = 0; d0 < 2; ++d0) { const char* b_ = vb + d0 * 512;
        const s16x4 l0 = vtr(b_), h0 = vtr(b_ + 1024), l1 = vtr(b_ + 2048), h1 = vtr(b_ + 3072), l2 = vtr(b_ + 4096), h2 = vtr(b_ + 5120), l3 = vtr(b_ + 6144), h3 = vtr(b_ + 7168);
        __builtin_amdgcn_s_setprio(1);
        o[d0] = __builtin_amdgcn_mfma_f32_32x32x16_bf16(pa0, (bf16x8){l0[0], l0[1], l0[2], l0[3], h0[0], h0[1], h0[2], h0[3]}, o[d0], 0, 0, 0);
        o[d0] = __builtin_amdgcn_mfma_f32_32x32x16_bf16(pa1, (bf16x8){l1[0], l1[1], l1[2], l1[3], h1[0], h1[1], h1[2], h1[3]}, o[d0], 0, 0, 0);
        o[d0] = __builtin_amdgcn_mfma_f32_32x32x16_bf16(pa2, (bf16x8){l2[0], l2[1], l2[2], l2[3], h2[0], h2[1], h2[2], h2[3]}, o[d0], 0, 0, 0);
        o[d0] = __builtin_amdgcn_mfma_f32_32x32x16_bf16(pa3, (bf16x8){l3[0], l3[1], l3[2], l3[3], h3[0], h3[1], h3[2], h3[3]}, o[d0], 0, 0, 0);
        __builtin_amdgcn_s_setprio(0); }
}
constexpr int CV_UNITS = 32 * 768, CV_BUF = 64 * 68 * 4, OFF_CV = ATT_LDS, OFF_CVT = OFF_CV + 2 * CV_BUF, CV_MAXJ = 128;
static_assert(OFF_CV % 16 == 0 && OFF_CVT + CV_MAXJ * 16 <= 131072, "conversion images + unit table fit beside the attention scratch");
struct Cv { f32x4 a0, a1, b0, b1; int next, nj, pa, pb, emit, sb; };
typedef unsigned u32x4_cv __attribute__((ext_vector_type(4)));
__device__ __forceinline__ void cv_build_table(const Ptrs& P, char* lds, int nj, int tid) {
    if (tid < nj) { const int u = (int)blockIdx.x + tid * (int)gridDim.x; const int e = u / 768, q = u % 768; u32x4_cv t;
        if (q < 512) { const int kb = q >> 5, nb = q & 31, n0 = 64 * nb; const int nn = n0 & 1023, p = nn >> 7, dn0 = 256 * p + (n0 >= 1024 ? 128 : 0) + (nn & 127);
            t.x = (unsigned)(((size_t)e * 1024 * 2048 + (size_t)(64 * kb) * 2048 + n0) * 4); t.y = (unsigned)(WS_WGU + (size_t)e * 2048 * 1024 + (size_t)dn0 * 1024 + 64 * kb); t.z = 2048u * 4u; t.w = 0u; }
        else { const int qq = q - 512, kb = qq >> 4, nb = qq & 15;
            t.x = (unsigned)(((size_t)e * 1024 * 1024 + (size_t)(64 * kb) * 1024 + 64 * nb) * 4); t.y = (unsigned)(WS_WD + (size_t)e * 1024 * 1024 + (size_t)(64 * nb) * 1024 + 64 * kb); t.z = 1024u * 4u; t.w = 1u; }
        *(u32x4_cv*)(lds + OFF_CVT + tid * 16) = t; }
}
__device__ __forceinline__ void cv_load(const Ptrs& P, const char* lds, int j, f32x4& r0, f32x4& r1, int tid) {
    const u32x4_cv t = *(const u32x4_cv*)(lds + OFF_CVT + j * 16);
    const char* p = (t.w ? (const char*)P.w_down : (const char*)P.w_gu) + t.x + (unsigned)(tid >> 4) * t.z + (tid & 15) * 16;
    r0 = __builtin_nontemporal_load((const f32x4*)p); r1 = __builtin_nontemporal_load((const f32x4*)(p + 32u * t.z));
}
__device__ __forceinline__ void cv_stage(const f32x4& r0, const f32x4& r1, char* buf, int tid) {
    const int k = tid >> 4, c4 = (tid & 15) * 4;
    *(f32x4*)(buf + (k * 68 + ((c4 + 4 * (k >> 3)) & 63)) * 4) = r0 * W8_SCALE;
    *(f32x4*)(buf + ((k + 32) * 68 + ((c4 + 4 * ((k + 32) >> 3)) & 63)) * 4) = r1 * W8_SCALE;
}
__device__ __forceinline__ void cv_begin(const Ptrs& P, Cv& cv, char* lds, int tid) {
    const bool on = cv.emit >= 0; const int n = tid >> 3, g = tid & 7;
    const float* q = (const float*)(lds + OFF_CV + (cv.sb ^ 1) * CV_BUF) + (8 * g) * 68 + ((n + 4 * g) & 63);
    u32x2 o; o.x = pk4_fp8(q[0 * 68], q[1 * 68], q[2 * 68], q[3 * 68]); o.y = pk4_fp8(q[4 * 68], q[5 * 68], q[6 * 68], q[7 * 68]);
    const unsigned doff = on ? *(const unsigned*)(lds + OFF_CVT + cv.emit * 16 + 4) + (unsigned)(n * 1024 + 8 * g) : (unsigned)(WS_TMP + (size_t)blockIdx.x * 4096 + tid * 8);
    *(u32x2*)(P.ws + doff) = o;
}
__device__ __forceinline__ void cv_mid(const Ptrs& P, Cv& cv, f32x4& r0, f32x4& r1, int& pend, char* lds, int tid) {
    int staged = -1;
    if (pend >= 0) { cv_stage(r0, r1, lds + OFF_CV + cv.sb * CV_BUF, tid); staged = pend; }
    const bool more = cv.next < cv.nj;
    cv_load(P, lds, more ? cv.next : 0, r0, r1, tid); pend = more ? cv.next : -1; if (more) cv.next += 1;
    cv.emit = staged; if (staged >= 0) cv.sb ^= 1;
}
struct BlockRef { const unsigned char* Q; const unsigned char* Kn; const unsigned char* KR; const bf16_t* V; bf16_t* O; float* SSQ; int P0; };
struct Seam { v8i_a qn; bf16x8 qro[2]; bf16x8 st_v0, st_k0; };
#define VMW() asm volatile("s_waitcnt vmcnt(0)" ::: "memory")
#define VMWN(n) asm volatile("s_waitcnt vmcnt(%0)" :: "i"(n) : "memory")
#define KSRC(B, k0) (ch < 4 ? (B).Kn + (size_t)((k0) + sr) * 512 + ch * 16 : (B).KR + (size_t)((k0) + sr) * 64 + (ch - 4) * 16)
#define SLOAD_H(B, k0) do { S.st_v0 = *(const bf16x8*)((B).V + (size_t)((k0) + vk) * 512 + vc); S.st_k0 = *(const bf16x8*)KSRC(B, k0); } while (0)
#define SWRITE_HK(bf) do { *(bf16x8*)(K_lds + (bf) * SHM_K + kws) = S.st_k0; } while (0)
#define QLOAD(B) do { const unsigned char* qp_ = (B).Q + (size_t)(wid * QBLK + r32) * 1024; \
        const v4i_a q0_ = *(const v4i_a*)(qp_ + 32 * hi), q1_ = *(const v4i_a*)(qp_ + 32 * hi + 16); S.qn = __builtin_shufflevector(q0_, q1_, 0, 1, 2, 3, 4, 5, 6, 7); \
        S.qro[0] = *(const bf16x8*)(qp_ + 64 + 16 * hi); S.qro[1] = *(const bf16x8*)(qp_ + 96 + 16 * hi); } while (0)
#define SWRITE_HV(vs) do { *(bf16x8*)(V_lds + (vs) * SHM_V + vst0) = S.st_v0; } while (0)
#define SWRITE_H(bf, vs) do { SWRITE_HV(vs); SWRITE_HK(bf); } while (0)
__device__ __forceinline__ void attn_prime(const BlockRef& cur, char* lds, Seam& S) {
    const int tid = tid_opaque(), wid = __builtin_amdgcn_readfirstlane(tid >> 6), lane = tid & 63, r32 = lane & 31, hi = lane >> 5;
    const int sr = tid >> 3, ch = tid & 7, kws = KSWZ(sr, ch), vk = tid >> 3, vc = (tid & 7) * 8; char* K_lds = lds + OFF_K;
    QLOAD(cur);
    SLOAD_H(cur, 0); VMW(); SWRITE_HK(0);
    __syncthreads();
}
template <int VAR = 0>
__device__ __forceinline__ void attn_block(const Ptrs& P, Cv& cv, const BlockRef& cur, const BlockRef& nxt, char* lds, Seam& S) {
    const int tid = tid_opaque(), wid = __builtin_amdgcn_readfirstlane(tid >> 6), lane = tid & 63, r32 = lane & 31, hi = lane >> 5;
    const int NT = (cur.P0 + QB) / KVBLK;
    const int qlo = cur.P0 + wid * QBLK, qm = qlo + r32 - 4 * hi;
    char* V_lds = lds + OFF_V; char* K_lds = lds + OFF_K;
    float* ws = (float*)(lds + OFF_WS) + wid * 64; float* li_l = ws, * al_l = ws + 32;
    float m_reg = 0.f, l_reg = 0; f32x16 o[2] = {}; f32x16 negm = {}; asm volatile("" : "+v"(negm));
    const int sr = tid >> 3, ch = tid & 7, kws = KSWZ(sr, ch), vk = tid >> 3, vc = (tid & 7) * 8, vst0 = v_st(vk, vc);
    const char* vrd = lds + OFF_V + v_rd_base(lane);
#define RESC(a) do { if (__any((a) < 1.f)) { if (hi == 0) al_l[r32] = (a); asm volatile("s_waitcnt lgkmcnt(0)" ::: "memory"); \
                     _Pragma("unroll") for (int d_ = 0; d_ < 2; ++d_) _Pragma("unroll") for (int r = 0; r < 16; ++r) o[d_][r] *= al_l[crow(r, hi)]; } } while (0)
#define KBASE(t) ((t) * KVBLK)
#define MASKT(P0_, P1_, t) do { const int kb_ = KBASE(t); if (VAR != 1 && kb_ + KVBLK - 1 > qlo) mask_tile(P0_, P1_, qm - kb_); } while (0)
    constexpr int NQL = 4;
#define SEAM_K0() do { VMWN(NQL); SWRITE_HK(0); SBAR(); } while (0)
#define VROT(x) ((x) == (NVS - 1) * SHM_V ? 0 : (x) + SHM_V)
    f32x16 pA0, pA1, pB0, pB1; float alA, alB; bf16x8 pa0, pa1, pa2, pa3;
    int vrs = 0, vws = SHM_V;
    SWRITE_HV(0); SBAR();
    if (NT > 1) SLOAD_H(cur, KBASE(1));
    SBAR(); qkt<0, VAR>(pA0, pA1, K_lds, r32, hi, S.qn, S.qro, negm);
    MASKT(pA0, pA1, 0); partialSM<true, VAR>(pA0, pA1, m_reg, negm, alA);
    if (NT > 1) { VMW(); *(bf16x8*)(V_lds + vws + vst0) = S.st_v0; SWRITE_HK(1); }
    if (CONV_IN_ATTN) { SBAR(); if (VAR == 0) { cv_begin(P, cv, lds, tid); SBAR(); } SLOAD_H(cur, KBASE(2)); SBAR(); if (VAR == 0) { cv_mid(P, cv, cv.b0, cv.b1, cv.pb, lds, tid); SBAR(); } }
    __syncthreads();
#if CONV_IN_ATTN
#define HALF_STEP(PX0, PX1, alX, PY0, PY1, alY, t, KB, KBN, CR0, CR1, CPEND) do { \
        SBAR(); if (VAR == 0) { cv_begin(P, cv, lds, tid); SBAR(); } \
        qkt<KB, VAR>(PX0, PX1, K_lds, r32, hi, S.qn, S.qro, negm); \
        finishSM<VAR>(PY0, PY1, alY, l_reg, pa0, pa1, pa2, pa3); SBAR(); \
        pv_tile<VAR>(o, vrd + vrs, pa0, pa1, pa2, pa3); MASKT(PX0, PX1, (t)); partialSM<false, VAR>(PX0, PX1, m_reg, negm, alX); \
        vrs = VROT(vrs); vws = VROT(vws); SBAR(); \
        if ((t) + 1 < NT) { *(bf16x8*)(V_lds + vws + vst0) = S.st_v0; SWRITE_HK(KBN); } SBAR(); \
        { const int tn_ = (t) + 2 < NT ? (t) + 2 : NT - 1; SLOAD_H(cur, KBASE(tn_)); } SBAR(); \
        if (VAR == 0) { cv_mid(P, cv, CR0, CR1, CPEND, lds, tid); SBAR(); } \
        RESC(alX); __syncthreads(); } while (0)
#else
#define HALF_STEP(PX0, PX1, alX, PY0, PY1, alY, t, KB, KBN, CR0, CR1, CPEND) do { \
        SBAR(); qkt<KB, VAR>(PX0, PX1, K_lds, r32, hi, S.qn, S.qro, negm); \
        finishSM<VAR>(PY0, PY1, alY, l_reg, pa0, pa1, pa2, pa3); SBAR(); \
        if ((t) + 1 < NT) { SLOAD_H(cur, KBASE((t) + 1)); SBAR(); } \
        pv_tile<VAR>(o, vrd + vrs, pa0, pa1, pa2, pa3); MASKT(PX0, PX1, (t)); partialSM<false, VAR>(PX0, PX1, m_reg, negm, alX); \
        vrs = VROT(vrs); vws = VROT(vws); \
        if ((t) + 1 < NT) { VMW(); *(bf16x8*)(V_lds + vws + vst0) = S.st_v0; SWRITE_HK(KBN); } \
        RESC(alX); __syncthreads(); } while (0)
#endif
    for (int t = 1; t + 1 < NT; t += 2) {
        HALF_STEP(pB0, pB1, alB, pA0, pA1, alA, t, 1, 0, cv.a0, cv.a1, cv.pa);
        HALF_STEP(pA0, pA1, alA, pB0, pB1, alB, t + 1, 0, 1, cv.b0, cv.b1, cv.pb);
    }
    SBAR(); qkt<1, VAR>(pB0, pB1, K_lds, r32, hi, S.qn, S.qro, negm); SBAR();
    SLOAD_H(nxt, 0); SBAR();
    QLOAD(nxt);
    SBAR();
    finishSM<VAR>(pA0, pA1, alA, l_reg, pa0, pa1, pa2, pa3); SBAR();
    pv_tile<VAR>(o, vrd + vrs, pa0, pa1, pa2, pa3);
    MASKT(pB0, pB1, NT - 1); partialSM<false, VAR>(pB0, pB1, m_reg, negm, alB); RESC(alB);
    vrs = VROT(vrs);
    finishSM<VAR>(pB0, pB1, alB, l_reg, pa0, pa1, pa2, pa3); SBAR(); pv_tile<VAR>(o, vrd + vrs, pa0, pa1, pa2, pa3);
    SBAR(); SEAM_K0();
    if (hi == 0) li_l[r32] = l_reg; asm volatile("s_waitcnt lgkmcnt(0)" ::: "memory");
    float rli[16];
#pragma unroll
    for (int r = 0; r < 16; ++r) rli[r] = __builtin_amdgcn_rcpf(li_l[crow(r, hi)]);
    { bf16_t* stg = (bf16_t*)(lds + OFF_OST) + wid * 2048;
#pragma unroll
      for (int r = 0; r < 16; ++r) { const int orow = crow(r, hi);
#pragma unroll
          for (int d0 = 0; d0 < 2; ++d0) stg[orow * 64 + d0 * 32 + r32] = (bf16_t)f2bf(o[d0][r] * rli[r]); }
      asm volatile("s_waitcnt lgkmcnt(0)" ::: "memory");
#pragma unroll
      for (int i = 0; i < 4; ++i) { const int row = i * 8 + (lane >> 3), c8 = lane & 7; const u32x4 v = *(const u32x4*)(stg + row * 64 + c8 * 8);
          *(u32x4*)(cur.O + (size_t)(wid * QBLK + row) * 1024 + c8 * 8) = v;
          float s = 0.f;
#pragma unroll
          for (int j = 0; j < 4; ++j) { const float a = __builtin_bit_cast(float, v[j] << 16), b = __builtin_bit_cast(float, v[j] & 0xffff0000u); s += a * a + b * b; }
          s += __shfl_xor(s, 1); s += __shfl_xor(s, 2); s += __shfl_xor(s, 4);
          if (c8 == 0) cur.SSQ[(size_t)(wid * QBLK + row) * 8] = s; } }
    __syncthreads();
#undef RESC
#undef KBASE
#undef MASKT
#undef SEAM_K0
#undef HALF_STEP
#undef VROT
}
#undef VMW
#undef VMWN
#undef KSRC
#undef SLOAD_H
#undef QLOAD
#undef SWRITE_HK
#undef SWRITE_HV
#undef SWRITE_H
#undef KSWZ
#undef SBAR
__device__ __forceinline__ BlockRef block_ref(const Ptrs& P, int bh, int qb) {
    const int b = bh >> 3, h = bh & 7; const size_t r0 = (size_t)b * SEQ + (size_t)qb * QB; BlockRef r;
    r.Q = P.ws + WS_Q + r0 * 1024 + h * 128; r.Kn = P.ws + WS_K + (size_t)b * SEQ * 512 + h * 64; r.KR = P.ws + WS_KR + (size_t)b * SEQ * 64;
    r.V = (const bf16_t*)(P.ws + WS_V) + (size_t)b * SEQ * 512 + h * 64; r.O = (bf16_t*)(P.ws + WS_MIX) + r0 * 1024 + h * 64; r.SSQ = (float*)(P.ws + WS_SSQ) + r0 * 8 + h; r.P0 = qb * QB; return r;
}
template <int VAR = 0>
__device__ __forceinline__ void attn_phase(const Ptrs& P, char* lds) {
    const int G = gridDim.x, c = blockIdx.x; const int vcu = (G % 8 == 0) ? (c % 8) * (G / 8) + c / 8 : c;
    Seam S; Cv cv; cv.a0 = (f32x4){0.f, 0.f, 0.f, 0.f}; cv.a1 = cv.a0; cv.b0 = cv.a0; cv.b1 = cv.a0; cv.next = 0; cv.pa = -1; cv.pb = -1; cv.emit = -1; cv.sb = 0;
    cv.nj = (CONV_IN_ATTN && VAR == 0 && c < CV_UNITS) ? (CV_UNITS - c + G - 1) / G : 0; if (cv.nj > CV_MAXJ) cv.nj = CV_MAXJ;
    if (CONV_IN_ATTN && VAR == 0) { cv_build_table(P, lds, cv.nj > 0 ? cv.nj : 1, tid_opaque()); __syncthreads(); }
    for (int it = vcu; it < 256; it += G) {
        const int bh = it >> 4, x = it & 15;
        BlockRef b0 = block_ref(P, bh, x), b1 = block_ref(P, bh, 31 - x);
        if (VAR != 0) { b0.O = (bf16_t*)(P.ws + WS_TMP) + (b0.O - (bf16_t*)(P.ws + WS_MIX)); b1.O = (bf16_t*)(P.ws + WS_TMP) + (b1.O - (bf16_t*)(P.ws + WS_MIX));
                        b0.SSQ = (float*)(P.ws + WS_TMP + 64 * MiB) + (b0.SSQ - (float*)(P.ws + WS_SSQ)); b1.SSQ = (float*)(P.ws + WS_TMP + 64 * MiB) + (b1.SSQ - (float*)(P.ws + WS_SSQ)); }
        attn_prime(b0, lds, S);
        attn_block<VAR>(P, cv, b0, b1, lds, S);
        attn_block<VAR>(P, cv, b1, b1, lds, S);
    }
    if (CONV_IN_ATTN && VAR == 0) {
        const int tid = tid_opaque();
        while (cv.emit >= 0 || cv.pa >= 0 || cv.pb >= 0 || cv.next < cv.nj) {
            cv_begin(P, cv, lds, tid); cv_mid(P, cv, cv.a0, cv.a1, cv.pa, lds, tid); __syncthreads();
            cv_begin(P, cv, lds, tid); cv_mid(P, cv, cv.b0, cv.b1, cv.pb, lds, tid); __syncthreads();
        }
    }
}
}
typedef float f32x16r __attribute__((ext_vector_type(16)));
__device__ __forceinline__ void router_phase(const Ptrs& P, LAS unsigned char* lds) {
    const int tid = tid_opaque(), lane = tid & 63, w = __builtin_amdgcn_readfirstlane(tid >> 6), i32 = lane & 31, kk = lane >> 5;
    LAS float* RED = (LAS float*)lds;
    LAS float* SSQ = (LAS float*)(lds + 8 * 32 * 33 * 4);
    LAS float* LOG = SSQ + 8 * 32;
    LAS float* RSTD = LOG + 32 * 33;
    LAS int* HIST = (LAS int*)(RSTD + 32);
    LAS int* SELE = HIST + 32;
    LAS int* SELR = SELE + 128;
    LAS float* SELG = (LAS float*)(SELR + 128);
    int* cnt = (int*)(P.ws + WS_CTL) + CW_CNT; int* SLOT = (int*)(P.ws + WS_SLOT); int* LIST = (int*)(P.ws + WS_LIST); float* GLIST = (float*)(P.ws + WS_GLIST);
    float wrv[64];
    { const float* wr = P.w_router + (size_t)(128 * w + 64 * kk) * 32 + i32;
#pragma unroll
      for (int q = 0; q < 64; ++q) wrv[q] = wr[q * 32]; }
    for (int rb = blockIdx.x; rb < T / 32; rb += gridDim.x) {
        const int t0 = rb * 32;
        { u32x4 t[8];
#pragma unroll
          for (int i = 0; i < 4; ++i)
#pragma unroll
              for (int j = 0; j < 2; ++j) t[2 * i + j] = *(const u32x4*)((const bf16_t*)(P.ws + WS_X1) + (size_t)(t0 + 4 * w + i) * 1024 + 8 * (lane + 64 * j));
#pragma unroll
          for (int i = 0; i < 4; ++i)
#pragma unroll
              for (int j = 0; j < 2; ++j) { const int r = 4 * w + i, cb = 2 * (lane + 64 * j); const u32x4 v = t[2 * i + j];
                  const f32x4 lo = {__builtin_bit_cast(float, v.x << 16), __builtin_bit_cast(float, v.x & 0xffff0000u), __builtin_bit_cast(float, v.y << 16), __builtin_bit_cast(float, v.y & 0xffff0000u)};
                  const f32x4 hi = {__builtin_bit_cast(float, v.z << 16), __builtin_bit_cast(float, v.z & 0xffff0000u), __builtin_bit_cast(float, v.w << 16), __builtin_bit_cast(float, v.w & 0xffff0000u)};
                  *(LAS f32x4*)(lds + r * 4096 + ((cb + r) & 255) * 16) = lo; *(LAS f32x4*)(lds + r * 4096 + ((cb + 1 + r) & 255) * 16) = hi; } }
        __syncthreads();
        f32x4 av[16]; float ssq = 0.f;
#pragma unroll
        for (int m = 0; m < 16; ++m) { const int c = 32 * w + 16 * kk + m;
            const f32x4 a = *(const LAS f32x4*)(lds + i32 * 4096 + ((c + i32) & 255) * 16); const f32x4 g = *(const f32x4*)(P.g_ffn + 128 * w + 64 * kk + 4 * m);
            ssq += (a[0] * a[0] + a[1] * a[1]) + (a[2] * a[2] + a[3] * a[3]); av[m] = a * g; }
        __syncthreads();
        f32x16r acc = {};
#pragma unroll
        for (int m = 0; m < 16; ++m) {
#pragma unroll
            for (int j = 0; j < 4; ++j) acc = __builtin_amdgcn_mfma_f32_32x32x2f32(av[m][j], wrv[4 * m + j], acc, 0, 0, 0); }
        ssq += __shfl_xor(ssq, 32);
        if (kk == 0) SSQ[w * 32 + i32] = ssq;
#pragma unroll
        for (int r = 0; r < 16; ++r) RED[(w * 32 + (r & 3) + 8 * (r >> 2) + 4 * kk) * 33 + i32] = acc[r];
        if (tid < 32) HIST[tid] = 0;
        __syncthreads();
        if (tid < 32) { float s = 0.f;
#pragma unroll
            for (int q = 0; q < 8; ++q) s += SSQ[q * 32 + tid];
            RSTD[tid] = 1.f / sqrtf(s * (1.f / 1024.f) + RMS_EPS); }
        __syncthreads();
#pragma unroll
        for (int q = 0; q < 2; ++q) { const int idx = tid + 512 * q, row = idx >> 5, e = idx & 31; float s = 0.f;
#pragma unroll
            for (int p = 0; p < 8; ++p) s += RED[(p * 32 + row) * 33 + e];
            LOG[row * 33 + e] = s * RSTD[row] + P.b_router[e]; }
#if FP8_MOE
        { const float rs = RSTD[i32]; unsigned char* hp = P.ws + WS_H + (size_t)(t0 + i32) * 1024 + 128 * w + 64 * kk;
#pragma unroll
          for (int q = 0; q < 4; ++q) { u32x4 o;
              { const f32x4 v = av[4 * q + 0] * rs; o.x = pk4_fp8(v[0], v[1], v[2], v[3]); } { const f32x4 v = av[4 * q + 1] * rs; o.y = pk4_fp8(v[0], v[1], v[2], v[3]); }
              { const f32x4 v = av[4 * q + 2] * rs; o.z = pk4_fp8(v[0], v[1], v[2], v[3]); } { const f32x4 v = av[4 * q + 3] * rs; o.w = pk4_fp8(v[0], v[1], v[2], v[3]); }
              *(u32x4*)(hp + 16 * q) = o; } }
#else
        { const float rs = RSTD[i32]; bf16_t* hp = (bf16_t*)(P.ws + WS_H) + (size_t)(t0 + i32) * 1024 + 128 * w + 64 * kk;
#pragma unroll
          for (int q = 0; q < 8; ++q) { const f32x4 v0 = av[2 * q] * rs, v1 = av[2 * q + 1] * rs; u32x4 o; o.x = pk2(v0[0], v0[1]); o.y = pk2(v0[2], v0[3]); o.z = pk2(v1[0], v1[1]); o.w = pk2(v1[2], v1[3]); *(u32x4*)(hp + 8 * q) = o; } }
#endif
        __syncthreads();
        if (tid < 32) { const int row = tid; float lv[4]; int li[4]; unsigned used = 0u; float lg[32];
#pragma unroll
            for (int e = 0; e < 32; ++e) lg[e] = LOG[row * 33 + e];
#pragma unroll
            for (int k = 0; k < 4; ++k) { float best = -__builtin_inff(); int bi = 0;
#pragma unroll
                for (int e = 0; e < 32; ++e) { const bool take = !((used >> e) & 1u) && lg[e] > best; best = take ? lg[e] : best; bi = take ? e : bi; }
                lv[k] = best; li[k] = bi; used |= 1u << bi; }
            const float e1 = expf(lv[1] - lv[0]), e2 = expf(lv[2] - lv[0]), e3 = expf(lv[3] - lv[0]); const float inv = 1.f / (1.f + e1 + e2 + e3);
            const float gt[4] = {inv, e1 * inv, e2 * inv, e3 * inv};
            for (int k = 0; k < 4; ++k) { SELE[row * 4 + k] = li[k]; SELG[row * 4 + k] = gt[k]; SELR[row * 4 + k] = atomicAdd((int*)&HIST[li[k]], 1); } }
        __syncthreads();
        if (tid < 32) { const int n = HIST[tid]; HIST[tid] = n > 0 ? atomicAdd(&cnt[tid], n) : 0; }
        __syncthreads();
        if (tid < 128) { const int row = tid >> 2, k = tid & 3, e = SELE[tid], pos = HIST[e] + SELR[tid]; const int t = t0 + row;
            SLOT[t * 4 + k] = e * T + pos; LIST[e * T + pos] = t; GLIST[e * T + pos] = SELG[tid]; }
        __syncthreads();
    }
}
__device__ __forceinline__ void pool_phase(const Ptrs& P, LAS unsigned char* lds) {
    const int tid = tid_opaque(), lane = tid & 63, w = __builtin_amdgcn_readfirstlane(tid >> 6), fr = lane & 15, fq = lane >> 4;
    constexpr int RS = 1040;
    LAS float* PS = (LAS float*)(lds + 64 * RS);
    const bf16_t* U = (const bf16_t*)(P.ws + WS_U);
    const int g = w >> 1, dh = (w & 1) * 64;
    bf16x8 bfr[4][4];
    { const bf16_t* Wt = (const bf16_t*)(P.ws + WS_WPOOL) + (size_t)g * 128 * 128;
#pragma unroll
      for (int ni = 0; ni < 4; ++ni)
#pragma unroll
          for (int ks = 0; ks < 4; ++ks) bfr[ni][ks] = *(const bf16x8*)(Wt + (size_t)(dh + ni * 16 + fr) * 128 + ks * 32 + 8 * fq); }
    f32x4 bias[4], scl[4];
#pragma unroll
    for (int ni = 0; ni < 4; ++ni) { const int c = g * 128 + dh + ni * 16 + 4 * fq; bias[ni] = *(const f32x4*)(P.b_pool + c); scl[ni] = *(const f32x4*)(P.pool_scale + c); }
    for (int tile = blockIdx.x; tile < T / 64; tile += gridDim.x) {
        const int t0 = tile * 64;
        { const int gg = w >> 1, win = 2 << gg, cc = gg * 16 + (lane & 15), r0 = 8 * ((lane >> 4) + 4 * (w & 1)); const int tb = t0 + r0, sb = tb & (SEQ - 1);
          const bf16_t* up = U + (size_t)tb * 512 + cc * 8;
          float sum[8];
#pragma unroll
          for (int j = 0; j < 8; ++j) sum[j] = 0.f;
          for (int k = 1; k < win; ++k) { if (sb - k >= 0) { const bf16x8 u = *(const bf16x8*)(up - (size_t)k * 512);
#pragma unroll
                  for (int j = 0; j < 8; ++j) sum[j] += bf2f((bf16_t)u[j]); } }
#pragma unroll
          for (int i = 0; i < 8; ++i) { const bf16x8 u = *(const bf16x8*)(up + (size_t)i * 512); const int s_ = sb + i; const int n = s_ + 1 < win ? s_ + 1 : win; const float inv = 1.f / (float)n;
              float d[8];
#pragma unroll
              for (int j = 0; j < 8; ++j) { const float uj = bf2f((bf16_t)u[j]); sum[j] += uj; d[j] = sum[j] * inv - uj; }
              u32x4 o; o.x = pk2(d[0], d[1]); o.y = pk2(d[2], d[3]); o.z = pk2(d[4], d[5]); o.w = pk2(d[6], d[7]);
              *(LAS u32x4*)(lds + (r0 + i) * RS + cc * 16) = o;
              if (s_ - win + 1 >= 0) { const bf16x8 ul = *(const bf16x8*)(up + ((long)i - (long)(win - 1)) * 512);
#pragma unroll
                  for (int j = 0; j < 8; ++j) sum[j] -= bf2f((bf16_t)ul[j]); } } }
        __syncthreads();
        f32x4 acc[4][4];
#pragma unroll
        for (int mi = 0; mi < 4; ++mi)
#pragma unroll
            for (int ni = 0; ni < 4; ++ni) acc[mi][ni] = (f32x4){0.f, 0.f, 0.f, 0.f};
#pragma unroll
        for (int ks = 0; ks < 4; ++ks) { bf16x8 a[4];
#pragma unroll
            for (int mi = 0; mi < 4; ++mi) a[mi] = *(const LAS bf16x8*)(lds + (mi * 16 + fr) * RS + (g * 128 + ks * 32 + 8 * fq) * 2);
#pragma unroll
            for (int mi = 0; mi < 4; ++mi)
#pragma unroll
                for (int ni = 0; ni < 4; ++ni) acc[mi][ni] = __builtin_amdgcn_mfma_f32_16x16x32_bf16(bfr[ni][ks], a[mi], acc[mi][ni], 0, 0, 0); }
#pragma unroll
        for (int mi = 0; mi < 4; ++mi) { float s = 0.f;
#pragma unroll
            for (int ni = 0; ni < 4; ++ni) { acc[mi][ni] = (acc[mi][ni] + bias[ni]) * scl[ni]; const f32x4 v = acc[mi][ni]; s += (v[0] * v[0] + v[1] * v[1]) + (v[2] * v[2] + v[3] * v[3]); }
            s += __shfl_xor(s, 16); s += __shfl_xor(s, 32);
            if (fq == 0) PS[(mi * 16 + fr) * 8 + w] = s; }
        __syncthreads();
#pragma unroll
        for (int mi = 0; mi < 4; ++mi) { const int r = mi * 16 + fr; const f32x4 p0 = *(const LAS f32x4*)(PS + r * 8), p1 = *(const LAS f32x4*)(PS + r * 8 + 4);
            const float rstd = 1.f / sqrtf((((p0[0] + p0[1]) + (p0[2] + p0[3])) + ((p1[0] + p1[1]) + (p1[2] + p1[3]))) * (1.f / 512.f) + RMS_EPS);
            bf16_t* mp = (bf16_t*)(P.ws + WS_MIX) + (size_t)(t0 + r) * 1024 + 512 + g * 128 + dh + 4 * fq;
#pragma unroll
            for (int ni = 0; ni < 4; ++ni) { const f32x4 v = acc[mi][ni] * rstd; u32x2 o; o.x = pk2(v[0], v[1]); o.y = pk2(v[2], v[3]); *(u32x2*)(mp + ni * 16) = o; } }
        __syncthreads();
    }
}

#define VB_FOR(vb, NVB) for (int vb = blockIdx.x * 2 + (int)(threadIdx.x >> 8); vb < (NVB); vb += gridDim.x * 2)

__device__ __forceinline__ void nv_gemm_f32(const bf16_t* A, int lda, const bf16_t* Bt, int ldb, float* C, int ldc, int K, int nbx, int nby) {
    const int tid = threadIdx.x & 255, lane = tid & 63, w = tid >> 6, wr = w >> 1, wc = w & 1, fr = lane & 15, fq = lane >> 4;
    VB_FOR(vb, nbx * nby) {
        const int bx = vb % nbx, by = vb / nbx;
        const int row0 = by * 64 + wr * 32, col0 = bx * 128 + wc * 64;
        f32x4 acc[2][4];
#pragma unroll
        for (int i = 0; i < 2; ++i)
#pragma unroll
            for (int j = 0; j < 4; ++j) acc[i][j] = (f32x4){0.f, 0.f, 0.f, 0.f};
        for (int k0 = 0; k0 < K; k0 += 32) {
            bf16x8 a[2], b[4];
#pragma unroll
            for (int i = 0; i < 2; ++i) a[i] = *(const bf16x8*)(A + (size_t)(row0 + i * 16 + fr) * lda + k0 + 8 * fq);
#pragma unroll
            for (int j = 0; j < 4; ++j) b[j] = *(const bf16x8*)(Bt + (size_t)(col0 + j * 16 + fr) * ldb + k0 + 8 * fq);
#pragma unroll
            for (int i = 0; i < 2; ++i)
#pragma unroll
                for (int j = 0; j < 4; ++j) acc[i][j] = __builtin_amdgcn_mfma_f32_16x16x32_bf16(a[i], b[j], acc[i][j], 0, 0, 0);
        }
#pragma unroll
        for (int i = 0; i < 2; ++i)
#pragma unroll
            for (int j = 0; j < 4; ++j)
#pragma unroll
                for (int r = 0; r < 4; ++r) C[(size_t)(row0 + i * 16 + fq * 4 + r) * ldc + col0 + j * 16 + fr] = acc[i][j][r];
    }
}

struct W8Tile { const float* src; unsigned char* dst; int ldw; };
__device__ __forceinline__ W8Tile w8_tile(const Ptrs& P, int r) {
    W8Tile d; const int e = r / 192, q = r % 192;
    if (q < 128) { const int kb = q >> 4, nb = q & 15, n0 = 128 * nb; const int p = nb & 7, dn0 = 256 * p + (nb >= 8 ? 128 : 0);
        d.src = P.w_gu + (size_t)e * 1024 * 2048 + (size_t)(128 * kb) * 2048 + n0; d.ldw = 2048; d.dst = P.ws + WS_WGU + (size_t)e * 2048 * 1024 + (size_t)dn0 * 1024 + 128 * kb; }
    else { const int qq = q - 128, kb = qq >> 3, nb = qq & 7;
        d.src = P.w_down + (size_t)e * 1024 * 1024 + (size_t)(128 * kb) * 1024 + 128 * nb; d.ldw = 1024; d.dst = P.ws + WS_WD + (size_t)e * 1024 * 1024 + (size_t)(128 * nb) * 1024 + 128 * kb; }
    return d;
}
__device__ __forceinline__ void w8_tile_load(const W8Tile& d, f32x4 (&v)[8], int tid) {
    const int kr = tid >> 5, n4 = (tid & 31) * 4;
#pragma unroll
    for (int i = 0; i < 8; ++i) v[i] = __builtin_nontemporal_load((const f32x4*)(d.src + (size_t)(kr + 16 * i) * d.ldw + n4));
}
__device__ __forceinline__ void w8_tile_emit(const W8Tile& d, float* scr, int tid) {
    const int n = tid >> 2, kq = (tid & 3) * 32; const float* q = scr + kq * 132 + ((n + 8 * (tid & 3)) & 127);
    u32x4 o0, o1;
    o0.x = pk4_fp8(q[0 * 132], q[1 * 132], q[2 * 132], q[3 * 132]); o0.y = pk4_fp8(q[4 * 132], q[5 * 132], q[6 * 132], q[7 * 132]);
    o0.z = pk4_fp8(q[8 * 132], q[9 * 132], q[10 * 132], q[11 * 132]); o0.w = pk4_fp8(q[12 * 132], q[13 * 132], q[14 * 132], q[15 * 132]);
    o1.x = pk4_fp8(q[16 * 132], q[17 * 132], q[18 * 132], q[19 * 132]); o1.y = pk4_fp8(q[20 * 132], q[21 * 132], q[22 * 132], q[23 * 132]);
    o1.z = pk4_fp8(q[24 * 132], q[25 * 132], q[26 * 132], q[27 * 132]); o1.w = pk4_fp8(q[28 * 132], q[29 * 132], q[30 * 132], q[31 * 132]);
    unsigned char* dp = d.dst + (size_t)n * 1024 + kq; *(u32x4*)dp = o0; *(u32x4*)(dp + 16) = o1;
}
__device__ __forceinline__ void w8_tile_stage(const f32x4 (&v)[8], float* scr, int tid) {
    const int kr = tid >> 5, n4 = (tid & 31) * 4;
#pragma unroll
    for (int i = 0; i < 8; ++i) { const int k = kr + 16 * i; *(f32x4*)(scr + k * 132 + ((n4 + 8 * (k >> 5)) & 127)) = v[i] * W8_SCALE; }
}
__device__ __forceinline__ void w8_convert_tiles(const Ptrs& P, float* scr) {
    const int tid = tid_opaque(); constexpr int N = 32 * 192; const int G = gridDim.x;
    int it = blockIdx.x; if (it >= N) return;
    W8Tile ta = w8_tile(P, it), tb = ta; f32x4 va[8], vb[8];
    w8_tile_load(ta, va, tid);
    if (it + G < N) { tb = w8_tile(P, it + G); w8_tile_load(tb, vb, tid); }
    for (;;) {
        { w8_tile_stage(va, scr, tid); const W8Tile cur = ta; const int n2 = it + 2 * G;
          if (n2 < N) { ta = w8_tile(P, n2); w8_tile_load(ta, va, tid); }
          __syncthreads(); w8_tile_emit(cur, scr, tid); __syncthreads(); }
        it += G; if (it >= N) break;
        { w8_tile_stage(vb, scr, tid); const W8Tile cur = tb; const int n2 = it + 2 * G;
          if (n2 < N) { tb = w8_tile(P, n2); w8_tile_load(tb, vb, tid); }
          __syncthreads(); w8_tile_emit(cur, scr, tid); __syncthreads(); }
        it += G; if (it >= N) break;
    }
}

#define GW_SETUP const int tid = tid_opaque(), lane = tid & 63, wave = tid >> 6; const int gw = blockIdx.x * NWAVES + wave, NGW = gridDim.x * NWAVES; (void)lane; (void)gw; (void)NGW;
#define GT_FOR(i, N) for (size_t i = (size_t)blockIdx.x * 512 + threadIdx.x; i < (size_t)(N); i += (size_t)gridDim.x * 512)

#ifndef PROBE_PHASE
#define PROBE_PHASE (-1)
#endif
#define TPP(k, var) do { if ((PROBE_PHASE) == (k)) { __syncthreads(); var = __builtin_amdgcn_s_memrealtime(); } } while (0)
__device__ __forceinline__ void ph_prologue(const Ptrs& P, float* ldsf, unsigned long long& tq0, unsigned long long& tq1) {
    GW_SETUP
    TPP(10, tq0);
    float* scr = ldsf + wave * (64 * 33);
#if FP8_MOE
    for (int it = gw; it < IT_TOTAL - IT_GU - IT_DN; it += NGW) prologue_item(P, it, scr, lane);
    TPP(10, tq1); TPP(11, tq0);
#if !CONV_IN_ATTN
    __syncthreads();
    w8_convert_tiles(P, ldsf);
#endif
    TPP(11, tq1); TPP(12, tq0);
#else
    for (int it = gw; it < IT_TOTAL; it += NGW) prologue_item(P, it, scr, lane);
#endif
    { bf16_t* w = (bf16_t*)(P.ws + WS_WIN) + (size_t)DINP * 1024; const int n8 = (1024 - DINP) * 1024 / 8;
      GT_FOR(i, n8) ((u32x4*)w)[i] = (u32x4){0u, 0u, 0u, 0u}; }
    for (int m = gw; m < T; m += 2 * NGW) {
        const int m2 = m + NGW; const bool two = m2 < T;
        const f32x4* xa = (const f32x4*)(P.x + (size_t)m * D) + lane; const f32x4* xb = (const f32x4*)(P.x + (size_t)(two ? m2 : m) * D) + lane; const f32x4* gr = (const f32x4*)P.g_attn + lane;
        f32x4 a[4], b[4]; float sa = 0.f, sb = 0.f;
#pragma unroll
        for (int j = 0; j < 4; ++j) { a[j] = __builtin_nontemporal_load(xa + 64 * j); b[j] = __builtin_nontemporal_load(xb + 64 * j); }
#pragma unroll
        for (int j = 0; j < 4; ++j) { sa += (a[j].x * a[j].x + a[j].y * a[j].y) + (a[j].z * a[j].z + a[j].w * a[j].w); sb += (b[j].x * b[j].x + b[j].y * b[j].y) + (b[j].z * b[j].z + b[j].w * b[j].w); }
        const float ra = 1.f / sqrtf(wave_sum(sa) * (1.f / 1024.f) + RMS_EPS), rb = 1.f / sqrtf(wave_sum(sb) * (1.f / 1024.f) + RMS_EPS);
        u32x2* oa = (u32x2*)((bf16_t*)(P.ws + WS_XN) + (size_t)m * D) + lane; u32x2* ob = (u32x2*)((bf16_t*)(P.ws + WS_XN) + (size_t)m2 * D) + lane;
#pragma unroll
        for (int j = 0; j < 4; ++j) { const f32x4 gg = gr[64 * j]; u32x2 w; w.x = pk2(a[j].x * ra * gg.x, a[j].y * ra * gg.y); w.y = pk2(a[j].z * ra * gg.z, a[j].w * ra * gg.w); oa[64 * j] = w;
            if (two) { u32x2 w2; w2.x = pk2(b[j].x * rb * gg.x, b[j].y * rb * gg.y); w2.y = pk2(b[j].z * rb * gg.z, b[j].w * rb * gg.w); ob[64 * j] = w2; } }
    }
    TPP(12, tq1); TPP(13, tq0);
    { float* C = (float*)(P.ws + WS_COS); float* S = (float*)(P.ws + WS_SIN);
      GT_FOR(i, T * 16) { const int t = (int)(i >> 4), j = (int)(i & 15);
          const float inv = (float)pow(10000.0, -(double)j / 16.0); const float ang = (float)P.pos[t] * inv;
          C[i] = (float)cos((double)ang); S[i] = (float)sin((double)ang); } }
    TPP(13, tq1);
}
__device__ __forceinline__ void ph_e1(const Ptrs& P) {
    GW_SETUP
    const float* PROJ = (const float*)(P.ws + WS_TMP);
    const float* COS = (const float*)(P.ws + WS_COS); const float* SIN = (const float*)(P.ws + WS_SIN);
    for (int t = gw; t < T; t += NGW) {
        const float* pr = PROJ + (size_t)t * 1024;
        bf16_t* u = (bf16_t*)(P.ws + WS_U) + (size_t)t * 512;
        for (int c = lane; c < 512; c += 64) u[c] = (bf16_t)f2bf(pr[c]);
        { float v[4]; float s = 0.f; for (int j = 0; j < 4; ++j) { v[j] = pr[512 + lane + 64 * j]; s += v[j] * v[j]; }
          const float rstd = 1.f / sqrtf(wave_sum(s) * (1.f / 256.f) + RMS_EPS);
          bf16_t* q = (bf16_t*)(P.ws + WS_QN) + (size_t)t * 256;
          for (int j = 0; j < 4; ++j) q[lane + 64 * j] = (bf16_t)f2bf(v[j] * rstd * P.g_q_a[lane + 64 * j]); }
        { float v[2]; float s = 0.f; for (int j = 0; j < 2; ++j) { v[j] = pr[768 + lane + 64 * j]; s += v[j] * v[j]; }
          const float rstd = 1.f / sqrtf(wave_sum(s) * (1.f / 128.f) + RMS_EPS);
          bf16_t* q = (bf16_t*)(P.ws + WS_KVN) + (size_t)t * 128;
          for (int j = 0; j < 2; ++j) q[lane + 64 * j] = (bf16_t)f2bf(v[j] * rstd * P.g_kv_a[lane + 64 * j]); }
        if (lane < 16) { const float x1 = pr[896 + lane], x2 = pr[896 + 16 + lane]; const float c = COS[t * 16 + lane], s = SIN[t * 16 + lane];
          bf16_t* kr = (bf16_t*)(P.ws + WS_KR) + (size_t)t * 32; kr[lane] = (bf16_t)f2bf(x1 * c - x2 * s); kr[16 + lane] = (bf16_t)f2bf(x2 * c + x1 * s); }
    }
}
__device__ __forceinline__ void ph_e2q(const Ptrs& P) {
    const float* TMP = (const float*)(P.ws + WS_TMP); const float* COS = (const float*)(P.ws + WS_COS); const float* SIN = (const float*)(P.ws + WS_SIN);
    bf16_t* Q = (bf16_t*)(P.ws + WS_Q);
    GT_FOR(i, (size_t)T * 768) {
        const int t = (int)(i / 768), c = (int)(i % 768), h = c / 96, d = c % 96; float v;
        if (d < 64) v = TMP[i];
        else { const int j = (d - 64) & 15; const float x1 = TMP[(size_t)t * 768 + h * 96 + 64 + j], x2 = TMP[(size_t)t * 768 + h * 96 + 80 + j]; const float cc = COS[t * 16 + j], ss = SIN[t * 16 + j];
               v = (d < 80) ? (x1 * cc - x2 * ss) : (x2 * cc + x1 * ss); }
        Q[i] = (bf16_t)f2bf(v * QSCALE);
    }
}
__device__ __forceinline__ void ph_e2kv(const Ptrs& P) {
    const float* TMP = (const float*)(P.ws + WS_TMP) + (size_t)T * 1024;
    bf16_t* K = (bf16_t*)(P.ws + WS_K); bf16_t* V = (bf16_t*)(P.ws + WS_V);
    GT_FOR(i, (size_t)T * 512) {
        const int t = (int)(i / 512), c = (int)(i % 512), h = c / 64, d = c % 64;
        K[i] = (bf16_t)f2bf(TMP[(size_t)t * 1024 + h * 128 + d]);
        V[i] = (bf16_t)f2bf(TMP[(size_t)t * 1024 + h * 128 + 64 + d]);
    }
}
__device__ __forceinline__ void ph_pooldiff(const Ptrs& P) {
    const bf16_t* U = (const bf16_t*)(P.ws + WS_U); bf16_t* DIFF = (bf16_t*)(P.ws + WS_H);
    GT_FOR(i, (size_t)T * 512) {
        const int t = (int)(i / 512), c = (int)(i % 512), g = c / 128, s = t % SEQ, w = 2 << g; const int n = s + 1 < w ? s + 1 : w;
        float sum = 0.f; for (int j = 0; j < n; ++j) sum += bf2f(U[(size_t)(t - j) * 512 + c]);
        DIFF[i] = (bf16_t)f2bf(sum / (float)n - bf2f(U[i]));
    }
}
__device__ __forceinline__ void ph_epool(const Ptrs& P, const float* TP) {
    GW_SETUP
    for (int t = gw; t < T; t += NGW) {
        float v[8]; float s = 0.f;
        for (int j = 0; j < 8; ++j) { const int c = lane + 64 * j; v[j] = (TP[(size_t)t * 512 + c] + P.b_pool[c]) * P.pool_scale[c]; s += v[j] * v[j]; }
        const float rstd = 1.f / sqrtf(wave_sum(s) * (1.f / 512.f) + RMS_EPS);
        bf16_t* m = (bf16_t*)(P.ws + WS_MIX) + (size_t)t * 1024 + 512;
        for (int j = 0; j < 8; ++j) m[lane + 64 * j] = (bf16_t)f2bf(v[j] * rstd);
    }
}
__device__ __forceinline__ void ph_attn_naive(const Ptrs& P, float* ldsf) {
    GW_SETUP
    float* qs = ldsf + wave * 96;
    const bf16_t* Q = (const bf16_t*)(P.ws + WS_Q); const bf16_t* K = (const bf16_t*)(P.ws + WS_K); const bf16_t* V = (const bf16_t*)(P.ws + WS_V); const bf16_t* KRp = (const bf16_t*)(P.ws + WS_KR);
    bf16_t* MIX = (bf16_t*)(P.ws + WS_MIX); float* SSQ = (float*)(P.ws + WS_SSQ);
    for (int item = gw; item < T * 8; item += NGW) {
        const int t = item >> 3, h = item & 7, b = t / SEQ, s = t % SEQ;
        for (int d = lane; d < 96; d += 64) qs[d] = bf2f(Q[(size_t)t * 768 + h * 96 + d]);
        asm volatile("s_waitcnt lgkmcnt(0)" ::: "memory");
        float m = -1e30f, l = 0.f, o = 0.f;
        const int ntile = s / 64 + 1;
        for (int kt = 0; kt < ntile; ++kt) {
            const int key = kt * 64 + lane; const size_t krow = (size_t)(b * SEQ + key);
            float sc = -__builtin_inff();
            if (key <= s) { float a = 0.f;
                for (int d8 = 0; d8 < 12; ++d8) { const bf16x8 kv = d8 < 8 ? *(const bf16x8*)(K + krow * 512 + h * 64 + d8 * 8) : *(const bf16x8*)(KRp + krow * 32 + (d8 - 8) * 8);
#pragma unroll
                    for (int j = 0; j < 8; ++j) a += qs[d8 * 8 + j] * bf2f((bf16_t)kv[j]); }
                sc = a; }
            const float mn = fmaxf(m, wave_max(sc)); const float alpha = exp2f(m - mn); const float p = exp2f(sc - mn);
            const float pb = bf2f((bf16_t)f2bf(p));
            l = l * alpha + wave_sum(pb); o *= alpha; m = mn;
            const int nk = (kt == ntile - 1) ? (s - kt * 64 + 1) : 64;
            for (int j = 0; j < nk; ++j) { const float pj = __shfl(pb, j); o += pj * bf2f(V[(size_t)(b * SEQ + kt * 64 + j) * 512 + h * 64 + lane]); }
        }
        const float ov = o / l;
        MIX[(size_t)t * 1024 + h * 64 + lane] = (bf16_t)f2bf(ov);
        const float ss = wave_sum(ov * ov);
        if (lane == 0) SSQ[t * 8 + h] = ss;
        asm volatile("s_waitcnt lgkmcnt(0)" ::: "memory");
    }
}
__device__ __forceinline__ void ph_e4(const Ptrs& P) {
    const float* T1 = (const float*)(P.ws + WS_TMP); const float* T2 = T1 + (size_t)T * 1024; const float* SSQ = (const float*)(P.ws + WS_SSQ);
    GT_FOR(i, (size_t)T * 1024) {
        const int t = (int)(i >> 10); float s = 0.f; for (int h = 0; h < 8; ++h) s += SSQ[t * 8 + h];
        const float sa = 1.f / sqrtf(s * (1.f / 512.f) + RMS_EPS);
        P.out[i] = P.x[i] + sa * T1[i] + T2[i];
    }
}
__device__ __forceinline__ void ph_router(const Ptrs& P, float* ldsf) {
    GW_SETUP
    float* hs = ldsf + wave * 1024;
    int* cnt = (int*)(P.ws + WS_CTL) + CW_CNT; int* SLOT = (int*)(P.ws + WS_SLOT); int* LIST = (int*)(P.ws + WS_LIST); float* GLIST = (float*)(P.ws + WS_GLIST);
    for (int t = gw; t < T; t += NGW) {
        const f32x4* xr = (const f32x4*)(P.out + (size_t)t * 1024) + lane; const f32x4* gr = (const f32x4*)P.g_ffn + lane;
        f32x4 v[4]; float s = 0.f;
        for (int j = 0; j < 4; ++j) { v[j] = xr[64 * j]; s += (v[j].x * v[j].x + v[j].y * v[j].y) + (v[j].z * v[j].z + v[j].w * v[j].w); }
        const float rstd = 1.f / sqrtf(wave_sum(s) * (1.f / 1024.f) + RMS_EPS);
        u32x2* ho = (u32x2*)((bf16_t*)(P.ws + WS_H) + (size_t)t * 1024) + lane;
        for (int j = 0; j < 4; ++j) { const f32x4 gg = gr[64 * j]; f32x4 hv = {v[j].x * rstd * gg.x, v[j].y * rstd * gg.y, v[j].z * rstd * gg.z, v[j].w * rstd * gg.w};
            ((f32x4*)hs)[lane + 64 * j] = hv; u32x2 w; w.x = pk2(hv.x, hv.y); w.y = pk2(hv.z, hv.w); ho[64 * j] = w; }
        asm volatile("s_waitcnt lgkmcnt(0)" ::: "memory");
        const int e = lane & 31, half = lane >> 5; float a = 0.f;
        for (int c = half * 512; c < half * 512 + 512; ++c) a += hs[c] * P.w_router[c * 32 + e];
        a += __shfl_xor(a, 32); a += P.b_router[e];
        float lv[4]; int li[4]; unsigned used = 0u;
        for (int k = 0; k < 4; ++k) { float best = -__builtin_inff(); int bi = 0;
            for (int j = 0; j < 32; ++j) { const float x = __shfl(a, j); if (!((used >> j) & 1u) && x > best) { best = x; bi = j; } }
            lv[k] = best; li[k] = bi; used |= 1u << bi; }
        const float e1 = expf(lv[1] - lv[0]), e2 = expf(lv[2] - lv[0]), e3 = expf(lv[3] - lv[0]); const float inv = 1.f / (1.f + e1 + e2 + e3);
        if (lane < 4) { const int ex = lane == 0 ? li[0] : lane == 1 ? li[1] : lane == 2 ? li[2] : li[3]; const float gt = (lane == 0 ? 1.f : lane == 1 ? e1 : lane == 2 ? e2 : e3) * inv;
            const int pos = atomicAdd(&cnt[ex], 1); SLOT[t * 4 + lane] = ex * T + pos; LIST[ex * T + pos] = t; GLIST[ex * T + pos] = gt; }
        asm volatile("s_waitcnt lgkmcnt(0)" ::: "memory");
    }
}
__device__ __forceinline__ int slot_base(const int* cnt, int e) { int s = 0; for (int i = 0; i < e; ++i) s += (cnt[i] + 255) & ~255; return s; }
__device__ __forceinline__ void ph_moe1_naive(const Ptrs& P) {
    const int* cnt = (const int*)(P.ws + WS_CTL) + CW_CNT;
    const int tid = threadIdx.x & 255, lane = tid & 63, w = tid >> 6, wr = w >> 1, wc = w & 1, fr = lane & 15, fq = lane >> 4;
    const bf16_t* H = (const bf16_t*)(P.ws + WS_H); bf16_t* ACT = (bf16_t*)(P.ws + WS_ACT);
    VB_FOR(vb, 16 * 256 * 32) {
        const int bx = vb & 15, by = (vb >> 4) & 255, e = vb >> 12; const int n = cnt[e], m0 = by * 64; if (m0 >= n) continue;
        const int* LIST = (const int*)(P.ws + WS_LIST) + (size_t)e * T;
        const bf16_t* W = (const bf16_t*)(P.ws + WS_WGU) + (size_t)e * 2048 * 1024;
        const int ca0 = bx * 64 + wc * 32; const int p = ca0 >> 7, r0 = ca0 & 127;
        int tok[2]; for (int i = 0; i < 2; ++i) { int m = m0 + wr * 32 + i * 16 + fr; if (m >= n) m = 0; tok[i] = LIST[m]; }
        f32x4 ag[2][2], au[2][2];
        for (int i = 0; i < 2; ++i) for (int j = 0; j < 2; ++j) { ag[i][j] = (f32x4){0.f, 0.f, 0.f, 0.f}; au[i][j] = (f32x4){0.f, 0.f, 0.f, 0.f}; }
        for (int k0 = 0; k0 < 1024; k0 += 32) {
            bf16x8 a[2], bg[2], bu[2];
            for (int i = 0; i < 2; ++i) a[i] = *(const bf16x8*)(H + (size_t)tok[i] * 1024 + k0 + 8 * fq);
            for (int j = 0; j < 2; ++j) { bg[j] = *(const bf16x8*)(W + (size_t)(256 * p + r0 + j * 16 + fr) * 1024 + k0 + 8 * fq); bu[j] = *(const bf16x8*)(W + (size_t)(256 * p + 128 + r0 + j * 16 + fr) * 1024 + k0 + 8 * fq); }
            for (int i = 0; i < 2; ++i) for (int j = 0; j < 2; ++j) { ag[i][j] = __builtin_amdgcn_mfma_f32_16x16x32_bf16(a[i], bg[j], ag[i][j], 0, 0, 0); au[i][j] = __builtin_amdgcn_mfma_f32_16x16x32_bf16(a[i], bu[j], au[i][j], 0, 0, 0); }
        }
        const int sb = slot_base(cnt, e);
        for (int i = 0; i < 2; ++i) for (int j = 0; j < 2; ++j) for (int r = 0; r < 4; ++r) {
            const int m = m0 + wr * 32 + i * 16 + fq * 4 + r, c = ca0 + j * 16 + fr; if (m >= n) continue;
            float g = ag[i][j][r] + P.b_gu[e * 2048 + c], u = au[i][j][r] + P.b_gu[e * 2048 + 1024 + c];
            g = fminf(g, 7.f); u = fminf(fmaxf(u, -7.f), 7.f);
            const float act = g * (1.f / (1.f + expf(-1.702f * g))) * (u + 1.f);
            ACT[(size_t)(sb + m) * 1024 + c] = (bf16_t)f2bf(act);
        }
    }
}
__device__ __forceinline__ void ph_moe2_naive(const Ptrs& P) {
    const int* cnt = (const int*)(P.ws + WS_CTL) + CW_CNT;
    const int tid = threadIdx.x & 255, lane = tid & 63, w = tid >> 6, wr = w >> 1, wc = w & 1, fr = lane & 15, fq = lane >> 4;
    VB_FOR(vb, 8 * 256 * 32) {
        const int bx = vb & 7, by = (vb >> 3) & 255, e = vb >> 11; const int n = cnt[e], m0 = by * 64; if (m0 >= n) continue;
        const int sb = slot_base(cnt, e); const bf16_t* ACT = (const bf16_t*)(P.ws + WS_ACT) + (size_t)sb * 1024; bf16_t* Y = (bf16_t*)(P.ws + WS_Y) + (size_t)sb * 1024;
        const bf16_t* W = (const bf16_t*)(P.ws + WS_WD) + (size_t)e * 1024 * 1024; const float* GL = (const float*)(P.ws + WS_GLIST) + (size_t)e * T;
        const int col0 = bx * 128 + wc * 64, row0 = m0 + wr * 32;
        f32x4 acc[2][4]; for (int i = 0; i < 2; ++i) for (int j = 0; j < 4; ++j) acc[i][j] = (f32x4){0.f, 0.f, 0.f, 0.f};
        for (int k0 = 0; k0 < 1024; k0 += 32) {
            bf16x8 a[2], b[4];
            for (int i = 0; i < 2; ++i) { int m = row0 + i * 16 + fr; if (m >= n) m = 0; a[i] = *(const bf16x8*)(ACT + (size_t)m * 1024 + k0 + 8 * fq); }
            for (int j = 0; j < 4; ++j) b[j] = *(const bf16x8*)(W + (size_t)(col0 + j * 16 + fr) * 1024 + k0 + 8 * fq);
            for (int i = 0; i < 2; ++i) for (int j = 0; j < 4; ++j) acc[i][j] = __builtin_amdgcn_mfma_f32_16x16x32_bf16(a[i], b[j], acc[i][j], 0, 0, 0);
        }
        for (int i = 0; i < 2; ++i) for (int j = 0; j < 4; ++j) for (int r = 0; r < 4; ++r) {
            const int m = row0 + i * 16 + fq * 4 + r, c = col0 + j * 16 + fr; if (m >= n) continue;
            Y[(size_t)m * 1024 + c] = (bf16_t)f2bf((acc[i][j][r] + P.b_down[e * 1024 + c]) * GL[m]);
        }
    }
}
__device__ __forceinline__ void ph_final(const Ptrs& P, int* sbase) {
    GW_SETUP
    const int* cnt = (const int*)(P.ws + WS_CTL) + CW_CNT; const int* SLOT = (const int*)(P.ws + WS_SLOT); const bf16_t* Y = (const bf16_t*)(P.ws + WS_Y);
    if (tid < 32) sbase[tid] = slot_base(cnt, tid);
    __syncthreads();
    for (int t = gw; t < T; t += NGW) {
        f32x4* xr = (f32x4*)(P.out + (size_t)t * 1024) + lane; const f32x4* gr = (const f32x4*)P.g_final + lane;
        f32x4 v[4]; { const u32x2* x1r = (const u32x2*)((const bf16_t*)(P.ws + WS_X1) + (size_t)t * 1024) + lane;
          for (int j = 0; j < 4; ++j) { const u32x2 w = __builtin_nontemporal_load(x1r + 64 * j); v[j] = (f32x4){__builtin_bit_cast(float, w.x << 16), __builtin_bit_cast(float, w.x & 0xffff0000u), __builtin_bit_cast(float, w.y << 16), __builtin_bit_cast(float, w.y & 0xffff0000u)}; } }
#if FP8_MOE
        { f32x4 ya[4]; for (int j = 0; j < 4; ++j) ya[j] = (f32x4){0.f, 0.f, 0.f, 0.f};
          for (int k = 0; k < 4; ++k) { const int sl = SLOT[t * 4 + k]; const int e = sl / T, pos = sl % T; const unsigned* yr = (const unsigned*)((const unsigned char*)Y + (size_t)(sbase[e] + pos) * 1024) + lane;
              for (int j = 0; j < 4; ++j) { const unsigned w = __builtin_nontemporal_load(yr + 64 * j); const auto lo = __builtin_amdgcn_cvt_pk_f32_fp8((int)w, false), hi2 = __builtin_amdgcn_cvt_pk_f32_fp8((int)w, true);
                  ya[j].x += lo[0]; ya[j].y += lo[1]; ya[j].z += hi2[0]; ya[j].w += hi2[1]; } }
          for (int j = 0; j < 4; ++j) v[j] = v[j] + ya[j] * (1.f / 16.f); }
#else
        for (int k = 0; k < 4; ++k) { const int sl = SLOT[t * 4 + k]; const int e = sl / T, pos = sl % T; const u32x2* yr = (const u32x2*)(Y + (size_t)(sbase[e] + pos) * 1024) + lane;
            for (int j = 0; j < 4; ++j) { const u32x2 w = yr[64 * j]; v[j].x += __builtin_bit_cast(float, w.x << 16); v[j].y += __builtin_bit_cast(float, w.x & 0xffff0000u); v[j].z += __builtin_bit_cast(float, w.y << 16); v[j].w += __builtin_bit_cast(float, w.y & 0xffff0000u); } }
#endif
        float s = 0.f; for (int j = 0; j < 4; ++j) s += (v[j].x * v[j].x + v[j].y * v[j].y) + (v[j].z * v[j].z + v[j].w * v[j].w);
        const float rstd = 1.f / sqrtf(wave_sum(s) * (1.f / 1024.f) + RMS_EPS);
        for (int j = 0; j < 4; ++j) { const f32x4 gg = gr[64 * j]; __builtin_nontemporal_store((f32x4){v[j].x * rstd * gg.x, v[j].y * rstd * gg.y, v[j].z * rstd * gg.z, v[j].w * rstd * gg.w}, xr + 64 * j); }
    }
}

__global__ void __launch_bounds__(NWAVES * 64, 2) mega_fwd(Ptrs P) {
    extern __shared__ __attribute__((aligned(16))) unsigned char lds[];
    const int tid = threadIdx.x;
    for (int u = tid; u < (LDS_BYTES - LDSCTL_OFF) / 4; u += NWAVES * 64) ((LAS unsigned*)((LAS unsigned char*)lds + LDSCTL_OFF))[u] = 0u;
    __syncthreads();
    unsigned* ctl = (unsigned*)(P.ws + WS_CTL);
    XcdBarrier bar = xcd_barrier_post(ctl + CW_BAR, (volatile LAS unsigned*)((LAS unsigned char*)lds + MISC_OFF) + 8);
    float* ldsf = (float*)lds;
    float* TMP = (float*)(P.ws + WS_TMP);
    unsigned char* ws = P.ws;
#define GRID_BAR() xcd_barrier(bar)
#ifndef PROBE_PHASE
#define PROBE_PHASE (-1)
#endif
    unsigned long long tp0 = 0ull, tp1 = 0ull; (void)tp0; (void)tp1;
#define TP_BEGIN(k) do { if ((PROBE_PHASE) == (k)) tp0 = __builtin_amdgcn_s_memrealtime(); } while (0)
#define TP_END(k) do { if ((PROBE_PHASE) == (k)) tp1 = __builtin_amdgcn_s_memrealtime(); } while (0)
#ifndef PROBE_REP
#define PROBE_REP (-1)
#endif
#if PROBE_REP >= 0
#define REPS(k) int _reps##k = 1 + ((PROBE_REP) == (k) ? 1 : 0); asm volatile("" : "+s"(_reps##k)); for (int _r = 0; _r < _reps##k; ++_r)
#else
#define REPS(k)
#endif
    TP_BEGIN(9); TP_BEGIN(0); { REPS(0) { ph_prologue(P, ldsf, tp0, tp1); GRID_BAR(); } } TP_END(0);
    LAS unsigned char* L = (LAS unsigned char*)lds; const int G = gridDim.x, c = blockIdx.x;
    TP_BEGIN(1);
#if FAST_INPROJ
    { REPS(1) {
    { pg8::DenseOrder S; S.init(ws + WS_XN, ws + WS_WIN, T, 1024, 1024, G, c);
      pg8::EpiInProj E{(bf16_t*)(ws + WS_U), (bf16_t*)(ws + WS_QN), (bf16_t*)(ws + WS_KVN), (bf16_t*)(ws + WS_KR), P.g_q_a, P.g_kv_a, (const float*)(ws + WS_COS), (const float*)(ws + WS_SIN)};
      pg8::gemm_phase<pg8::EpiInProj, pg8::DenseOrder, false, false>(L, 1024, S, E); }
    GRID_BAR(); } }
#else
    nv_gemm_f32((const bf16_t*)(ws + WS_XN), 1024, (const bf16_t*)(ws + WS_WIN), 1024, TMP, 1024, 1024, 8, T / 64); GRID_BAR();
    ph_e1(P); GRID_BAR();
#endif
    TP_END(1); TP_BEGIN(2);
#if FAST_QKV
    { REPS(2) {
#ifndef NO_QB
    TP_BEGIN(20);
    { pg8::DenseOrder S; S.init(ws + WS_QN, ws + WS_WQB, T, 768, 256, G, c);
      pg8::EpiQ E{ws + WS_Q, (const float*)(ws + WS_COS), (const float*)(ws + WS_SIN)};
      pg8::gemm_phase<pg8::EpiQ, pg8::DenseOrder, true, false>(L, 256, S, E); }
    TP_END(20); TP_BEGIN(21);
#endif
#ifndef NO_KVB
    { pg8::DenseOrder S; S.init(ws + WS_KVN, ws + WS_WKVB, T, 1024, 128, G, c);
      pg8::EpiKV E{ws + WS_K, (bf16_t*)(ws + WS_V)};
      pg8::gemm_phase<pg8::EpiKV, pg8::DenseOrder, true, false>(L, 128, S, E); }
    TP_END(21); TP_BEGIN(22);
#endif
#if FAST_POOL
    pool_phase(P, L);
    TP_END(22);
#else
    ph_pooldiff(P);
#endif
    GRID_BAR(); } }
#else
    nv_gemm_f32((const bf16_t*)(ws + WS_QN), 256, (const bf16_t*)(ws + WS_WQB), 256, TMP, 768, 256, 6, T / 64);
    nv_gemm_f32((const bf16_t*)(ws + WS_KVN), 128, (const bf16_t*)(ws + WS_WKVB), 128, TMP + (size_t)T * 1024, 1024, 128, 8, T / 64);
    ph_pooldiff(P); GRID_BAR();
    ph_e2q(P); ph_e2kv(P);
#endif
#if !(FAST_POOL && FAST_QKV)
    for (int g = 0; g < 4; ++g)
        nv_gemm_f32((const bf16_t*)(ws + WS_H) + g * 128, 512, (const bf16_t*)(ws + WS_WPOOL) + (size_t)g * 128 * 128, 128, (float*)(ws + WS_ACT) + g * 128, 512, 128, 1, T / 64);
    GRID_BAR();
    ph_epool(P, (const float*)(ws + WS_ACT));
#endif
    TP_END(2); TP_BEGIN(3);
#if FAST_ATTN
    { REPS(3) { att::attn_phase<0>(P, (char*)lds); GRID_BAR(); } }
#if PROBE_PHASE == 30
    TP_BEGIN(30); att::attn_phase<0>(P, (char*)lds); GRID_BAR(); TP_END(30);
#elif PROBE_PHASE == 31
    TP_BEGIN(31); att::attn_phase<1>(P, (char*)lds); GRID_BAR(); TP_END(31);
#elif PROBE_PHASE == 32
    TP_BEGIN(32); att::attn_phase<2>(P, (char*)lds); GRID_BAR(); TP_END(32);
#endif
#else
    ph_attn_naive(P, ldsf); GRID_BAR();
#endif
    TP_END(3); TP_BEGIN(4);
#if FAST_WOUT
    { REPS(4) {
    { pg8::DenseOrder S; S.init(ws + WS_MIX, ws + WS_WOUT, T, 1024, 1024, G, c);
      pg8::EpiOut E{P.x, (bf16_t*)(ws + WS_X1), (const float*)(ws + WS_SSQ), SA_OFF};
      pg8::gemm_phase<pg8::EpiOut, pg8::DenseOrder, false, false>(L, 1024, S, E); }
    GRID_BAR(); } }
#else
    nv_gemm_f32((const bf16_t*)(ws + WS_MIX), 1024, (const bf16_t*)(ws + WS_WOUT), 1024, TMP, 1024, 512, 8, T / 64);
    nv_gemm_f32((const bf16_t*)(ws + WS_MIX) + 512, 1024, (const bf16_t*)(ws + WS_WOUT) + 512, 1024, TMP + (size_t)T * 1024, 1024, 512, 8, T / 64);
    GRID_BAR();
    ph_e4(P); GRID_BAR();
#endif
    TP_END(4); TP_BEGIN(5);
#if FAST_ROUTER
    router_phase(P, L); GRID_BAR();
#else
    ph_router(P, ldsf); GRID_BAR();
#endif
    TP_END(5); TP_BEGIN(6);
#if FAST_MOE
    { REPS(6) {
#if FP8_MOE
    { pg8::MoeOrder<true> S{(const char*)(ws + WS_H), (const char*)(ws + WS_WGU), (size_t)2048 * 1024, 8, G, c, GT_OFF, (const LAS int*)(L + TS_OFF), 1024};
      moe_setup<true>(P, L, S);
      pg8::EpiSwiglu8 E{P.b_gu, ws + WS_ACT};
      pg8::gemm_phase<pg8::EpiSwiglu8, pg8::MoeOrder<true>, true, true, true>(L, 512, S, E); }
    GRID_BAR(); } }
    TP_END(6); TP_BEGIN(7);
    { REPS(7) {
    { pg8::MoeOrder<false> S{(const char*)(ws + WS_ACT), (const char*)(ws + WS_WD), (size_t)1024 * 1024, 4, G, c, 0, (const LAS int*)(L + TS_OFF), 1024};
      moe_setup<false>(P, L, S);
      pg8::EpiDown8 E{P.b_down, (const float*)(ws + WS_GLIST), ws + WS_Y};
      pg8::gemm_phase<pg8::EpiDown8, pg8::MoeOrder<false>, true, false, true>(L, 512, S, E); }
    GRID_BAR(); } }
#else
    { pg8::MoeOrder<true> S{(const char*)(ws + WS_H), (const char*)(ws + WS_WGU), (size_t)2048 * 1024 * 2, 8, G, c, GT_OFF, (const LAS int*)(L + TS_OFF), 2048};
      moe_setup<true>(P, L, S);
      pg8::EpiSwiglu E{P.b_gu, (bf16_t*)(ws + WS_ACT)};
      pg8::gemm_phase<pg8::EpiSwiglu, pg8::MoeOrder<true>, true, true>(L, 1024, S, E); }
    GRID_BAR(); } }
    { REPS(7) {
    { pg8::MoeOrder<false> S{(const char*)(ws + WS_ACT), (const char*)(ws + WS_WD), (size_t)1024 * 1024 * 2, 4, G, c, 0, (const LAS int*)(L + TS_OFF), 2048};
      moe_setup<false>(P, L, S);
      pg8::EpiDown E{P.b_down, (const float*)(ws + WS_GLIST), (bf16_t*)(ws + WS_Y)};
      pg8::gemm_phase<pg8::EpiDown, pg8::MoeOrder<false>, true, false>(L, 1024, S, E); }
    GRID_BAR(); } }
#endif
#else
    ph_moe1_naive(P); GRID_BAR();
    ph_moe2_naive(P); GRID_BAR();
#endif
    TP_END(7); TP_BEGIN(8);
    ph_final(P, (int*)lds);
    if ((PROBE_PHASE) >= 0) GRID_BAR();
    TP_END(8); TP_END(9);
    if ((PROBE_PHASE) >= 0 && blockIdx.x == 0 && threadIdx.x == 0) { const unsigned long long t0 = __builtin_amdgcn_s_memrealtime(); while (__builtin_amdgcn_s_memrealtime() - t0 < (tp1 - tp0)) __builtin_amdgcn_s_sleep(8); }
}

extern "C" void kernel_launch(void* const* d_in, const int* in_sizes, int n_in, void* d_out, int out_size, void* d_ws, size_t ws_size, hipStream_t stream) {
    static int grid = 0;
    if (grid == 0) {
        if (n_in != 22 || out_size != T * D || ws_size < WS_END) { fprintf(stderr, "kernel_launch: unexpected shapes (n_in %d out %d ws %zu)\n", n_in, out_size, ws_size); grid = -1; return; }
        int dev = 0, cus = 0, per_cu = 0;
        if (hipGetDevice(&dev) != hipSuccess || hipDeviceGetAttribute(&cus, hipDeviceAttributeMultiprocessorCount, dev) != hipSuccess) { grid = -1; return; }
        if (hipFuncSetAttribute((const void*)mega_fwd, hipFuncAttributeMaxDynamicSharedMemorySize, LDS_BYTES) != hipSuccess) { fprintf(stderr, "kernel_launch: hipFuncSetAttribute failed\n"); grid = -1; return; }
        if (hipOccupancyMaxActiveBlocksPerMultiprocessor(&per_cu, (const void*)mega_fwd, NWAVES * 64, LDS_BYTES) != hipSuccess || per_cu < 1) fprintf(stderr, "kernel_launch: occupancy query reports %d\n", per_cu);
        (void)hipGetLastError();
        grid = cus;
    }
    if (grid < 0) return;
    Ptrs P{};
    P.x = (const float*)d_in[0]; P.pos = (const int*)d_in[1]; P.g_attn = (const float*)d_in[2]; P.w_in = (const float*)d_in[3]; P.w_pool = (const float*)d_in[4];
    P.b_pool = (const float*)d_in[5]; P.pool_scale = (const float*)d_in[6]; P.g_q_a = (const float*)d_in[7]; P.w_q_b = (const float*)d_in[8]; P.g_kv_a = (const float*)d_in[9];
    P.w_kv_b = (const float*)d_in[10]; P.g_out_pool = (const float*)d_in[11]; P.g_out_attn = (const float*)d_in[12]; P.w_out = (const float*)d_in[13]; P.g_ffn = (const float*)d_in[14];
    P.w_router = (const float*)d_in[15]; P.b_router = (const float*)d_in[16]; P.w_gu = (const float*)d_in[17]; P.b_gu = (const float*)d_in[18]; P.w_down = (const float*)d_in[19];
    P.b_down = (const float*)d_in[20]; P.g_final = (const float*)d_in[21]; P.out = (float*)d_out; P.ws = (unsigned char*)d_ws;
    if (hipMemsetAsync((unsigned char*)d_ws + WS_CTL, 0, CTL_BYTES, stream) != hipSuccess) { fprintf(stderr, "kernel_launch: memset failed\n"); return; }
    hipLaunchKernelGGL(mega_fwd, dim3(grid), dim3(NWAVES * 64), LDS_BYTES, stream, P);
}
```

```cpp
#include <hip/hip_runtime.h>
#ifndef FP8_MOE
#define FP8_MOE 1
#endif
#ifndef CONV_IN_ATTN
#define CONV_IN_ATTN 1
#endif
#include <cstdint>
#include <cstdio>

typedef unsigned short bf16_t;
typedef short bf16x8 __attribute__((ext_vector_type(8)));
typedef float f32x4 __attribute__((ext_vector_type(4)));
typedef unsigned u32x4 __attribute__((ext_vector_type(4)));
typedef unsigned u32x2 __attribute__((ext_vector_type(2)));

constexpr int BATCH = 2, SEQ = 8192, T = BATCH * SEQ, D = 1024;
constexpr int DPOOL = 512, NPG = 4, PGD = 128;
constexpr int NH = 8, VD = 64, QKN = 64, QKR = 32, QKD = 96;
constexpr int QLR = 256, KVLR = 128, DINP = 928;
constexpr int NE = 32, TOPK = 4, DE = 1024;
constexpr float RMS_EPS = 1e-6f;
constexpr float QSCALE = 0.10206207261596577f * 1.4426950408889634f;
constexpr int SLOT_ROWS = T * TOPK + NE * 256;

constexpr size_t MiB = 1u << 20;
constexpr size_t WS_CTL = 0;
constexpr size_t CTL_BYTES = 32 * 1024;
constexpr size_t WS_COS = 1 * MiB, WS_SIN = 2 * MiB;
constexpr size_t WS_WIN = 4 * MiB;
constexpr size_t WS_WQB = 6 * MiB;
constexpr size_t WS_WKVB = 7 * MiB;
constexpr size_t WS_WPOOL = 7 * MiB + 512 * 1024;
constexpr size_t WS_WOUT = 8 * MiB;
constexpr size_t WS_WGU = 16 * MiB;
constexpr size_t WS_WD = 144 * MiB;
constexpr size_t WS_XN = 208 * MiB;
constexpr size_t WS_X1 = WS_XN;
constexpr size_t WS_U = 240 * MiB;
constexpr size_t WS_QN = 256 * MiB;
constexpr size_t WS_KVN = 264 * MiB;
constexpr size_t WS_KR = 268 * MiB;
constexpr size_t WS_Q = 272 * MiB;
constexpr size_t WS_K = 296 * MiB;
constexpr size_t WS_V = 320 * MiB;
constexpr size_t WS_MIX = 336 * MiB;
constexpr size_t WS_SSQ = 368 * MiB;
constexpr size_t WS_H = 370 * MiB;
constexpr size_t WS_SLOT = 402 * MiB;
constexpr size_t WS_LIST = 403 * MiB;
constexpr size_t WS_GLIST = 405 * MiB;
constexpr size_t WS_ACT = 408 * MiB;
constexpr size_t WS_Y = 552 * MiB;
constexpr size_t WS_TMP = 700 * MiB;
constexpr size_t WS_END = 828 * MiB;
constexpr int CW_CNT = 64;

__device__ __forceinline__ unsigned f2bf(float f) { unsigned u = __builtin_bit_cast(unsigned, f); return (u + 0x7fffu + ((u >> 16) & 1u)) >> 16; }
__device__ __forceinline__ unsigned pk2(float lo, float hi) { return f2bf(lo) | (f2bf(hi) << 16); }
__device__ __forceinline__ float bf2f(bf16_t b) { return __builtin_bit_cast(float, (unsigned)b << 16); }
__device__ __forceinline__ float wave_sum(float v) {
#pragma unroll
    for (int o = 1; o < 64; o <<= 1) v += __shfl_xor(v, o);
    return v;
}
__device__ __forceinline__ float wave_max(float v) {
#pragma unroll
    for (int o = 1; o < 64; o <<= 1) v = fmaxf(v, __shfl_xor(v, o));
    return v;
}

typedef int v8i_t __attribute__((ext_vector_type(8)));
constexpr float W8_SCALE = 64.f, W8_INV = 1.f / 64.f;
__device__ __forceinline__ float clamp8(float x) { return __builtin_amdgcn_fmed3f(x, -448.f, 448.f); }
__device__ __forceinline__ unsigned pk4_fp8(float a, float b, float c, float d) {
    int p = 0; p = __builtin_amdgcn_cvt_pk_fp8_f32(clamp8(a), clamp8(b), p, false); p = __builtin_amdgcn_cvt_pk_fp8_f32(clamp8(c), clamp8(d), p, true); return (unsigned)p; }
__device__ __forceinline__ unsigned pk4_fp8_nc(float a, float b, float c, float d) {
    int p = 0; p = __builtin_amdgcn_cvt_pk_fp8_f32(a, b, p, false); p = __builtin_amdgcn_cvt_pk_fp8_f32(c, d, p, true); return (unsigned)p; }
__device__ __forceinline__ int tid_opaque() { int t = threadIdx.x; asm volatile("" : "+v"(t)); return t; }

__device__ __forceinline__ void transpose_item(const float* W, int ldw, int k0, int n0, bf16_t* WT, int ldt, int dn0, int dk0,
                                               const float* ksc, float* scr, int lane) {
    { const int kq = lane >> 3, n4 = (lane & 7) * 4; f32x4 v[8];
#pragma unroll
      for (int i = 0; i < 8; ++i) v[i] = *(const f32x4*)(W + (size_t)(k0 + 8 * i + kq) * ldw + n0 + n4);
#pragma unroll
      for (int i = 0; i < 8; ++i) { const int kk = 8 * i + kq; f32x4 x = v[i]; if (ksc) x = x * ksc[kk];
          scr[kk * 33 + n4 + 0] = x[0]; scr[kk * 33 + n4 + 1] = x[1]; scr[kk * 33 + n4 + 2] = x[2]; scr[kk * 33 + n4 + 3] = x[3]; } }
    asm volatile("s_waitcnt lgkmcnt(0)" ::: "memory");
    const int c = lane & 7;
#pragma unroll
    for (int j = 0; j < 4; ++j) { const int n = (lane >> 3) + 8 * j; const float* s = scr + (8 * c) * 33 + n;
        u32x4 o; o.x = pk2(s[0 * 33], s[1 * 33]); o.y = pk2(s[2 * 33], s[3 * 33]); o.z = pk2(s[4 * 33], s[5 * 33]); o.w = pk2(s[6 * 33], s[7 * 33]);
        *(u32x4*)(WT + (size_t)(dn0 + n) * ldt + dk0 + 8 * c) = o; }
    asm volatile("s_waitcnt lgkmcnt(0)" ::: "memory");
}

__device__ __forceinline__ void transpose_item8(const float* W, int ldw, int k0, int n0, unsigned char* WT, int ldt, int dn0, int dk0, float* scr, int lane) {
    { const int kq = lane >> 3, n4 = (lane & 7) * 4; f32x4 v[8];
#pragma unroll
      for (int i = 0; i < 8; ++i) v[i] = *(const f32x4*)(W + (size_t)(k0 + 8 * i + kq) * ldw + n0 + n4);
#pragma unroll
      for (int i = 0; i < 8; ++i) { const int kk = 8 * i + kq; const f32x4 x = v[i] * W8_SCALE;
          scr[kk * 33 + n4 + 0] = x[0]; scr[kk * 33 + n4 + 1] = x[1]; scr[kk * 33 + n4 + 2] = x[2]; scr[kk * 33 + n4 + 3] = x[3]; } }
    asm volatile("s_waitcnt lgkmcnt(0)" ::: "memory");
    const int c = lane & 7;
#pragma unroll
    for (int j = 0; j < 4; ++j) { const int n = (lane >> 3) + 8 * j; const float* q = scr + (8 * c) * 33 + n;
        u32x2 o; o.x = pk4_fp8(q[0 * 33], q[1 * 33], q[2 * 33], q[3 * 33]); o.y = pk4_fp8(q[4 * 33], q[5 * 33], q[6 * 33], q[7 * 33]);
        *(u32x2*)(WT + (size_t)(dn0 + n) * ldt + dk0 + 8 * c) = o; }
    asm volatile("s_waitcnt lgkmcnt(0)" ::: "memory");
}

struct Ptrs {
    const float* x; const int* pos; const float* g_attn; const float* w_in; const float* w_pool; const float* b_pool; const float* pool_scale;
    const float* g_q_a; const float* w_q_b; const float* g_kv_a; const float* w_kv_b; const float* g_out_pool; const float* g_out_attn; const float* w_out;
    const float* g_ffn; const float* w_router; const float* b_router; const float* w_gu; const float* b_gu; const float* w_down; const float* b_down; const float* g_final;
    float* out; unsigned char* ws;
};

constexpr int IT_IN = 16 * 29, IT_QB = 4 * 24, IT_KVB = 2 * 32, IT_POOL = 4 * 2 * 4, IT_OUT = 16 * 32, IT_GU = 32 * 16 * 64, IT_DN = 32 * 16 * 32;
constexpr int IT_TOTAL = IT_IN + IT_QB + IT_KVB + IT_POOL + IT_OUT + IT_GU + IT_DN;

__device__ __forceinline__ void prologue_item(const Ptrs& P, int it, float* scr, int lane) {
    unsigned char* ws = P.ws;
    int r = it;
    if (r < IT_IN) { const int kb = r / 29, nb = r % 29; transpose_item(P.w_in, DINP, 64 * kb, 32 * nb, (bf16_t*)(ws + WS_WIN), 1024, 32 * nb, 64 * kb, nullptr, scr, lane); return; } r -= IT_IN;
    if (r < IT_QB) { const int kb = r / 24, nb = r % 24; transpose_item(P.w_q_b, 768, 64 * kb, 32 * nb, (bf16_t*)(ws + WS_WQB), 256, 32 * nb, 64 * kb, nullptr, scr, lane); return; } r -= IT_QB;
    if (r < IT_KVB) { const int kb = r / 32, nb = r % 32; transpose_item(P.w_kv_b, 1024, 64 * kb, 32 * nb, (bf16_t*)(ws + WS_WKVB), 128, 32 * nb, 64 * kb, nullptr, scr, lane); return; } r -= IT_KVB;
    if (r < IT_POOL) { const int g = r / 8, kb = (r % 8) / 4, nb = r % 4; transpose_item(P.w_pool + (size_t)g * 128 * 128, 128, 64 * kb, 32 * nb, (bf16_t*)(ws + WS_WPOOL) + (size_t)g * 128 * 128, 128, 32 * nb, 64 * kb, nullptr, scr, lane); return; } r -= IT_POOL;
    if (r < IT_OUT) { const int kb = r / 32, nb = r % 32, k0 = 64 * kb; const float* ksc = k0 < 512 ? P.g_out_pool + k0 : P.g_out_attn + (k0 - 512);
        transpose_item(P.w_out, 1024, k0, 32 * nb, (bf16_t*)(ws + WS_WOUT), 1024, 32 * nb, (k0 + 512) & 1023, ksc, scr, lane); return; } r -= IT_OUT;
    if (r < IT_GU) { const int e = r / 1024, q = r % 1024, kb = q / 64, nb = q % 64, n0 = 32 * nb; const int nn = n0 & 1023, p = nn >> 7, dn0 = 256 * p + (n0 >= 1024 ? 128 : 0) + (nn & 127);
#if FP8_MOE
        transpose_item8(P.w_gu + (size_t)e * 1024 * 2048, 2048, 64 * kb, n0, ws + WS_WGU + (size_t)e * 2048 * 1024, 1024, dn0, 64 * kb, scr, lane); return; } r -= IT_GU;
#else
        transpose_item(P.w_gu + (size_t)e * 1024 * 2048, 2048, 64 * kb, n0, (bf16_t*)(ws + WS_WGU) + (size_t)e * 2048 * 1024, 1024, dn0, 64 * kb, nullptr, scr, lane); return; } r -= IT_GU;
#endif
    { const int e = r / 512, q = r % 512, kb = q / 32, nb = q % 32;
#if FP8_MOE
        transpose_item8(P.w_down + (size_t)e * 1024 * 1024, 1024, 64 * kb, 32 * nb, ws + WS_WD + (size_t)e * 1024 * 1024, 1024, 32 * nb, 64 * kb, scr, lane); }
#else
        transpose_item(P.w_down + (size_t)e * 1024 * 1024, 1024, 64 * kb, 32 * nb, (bf16_t*)(ws + WS_WD) + (size_t)e * 1024 * 1024, 1024, 32 * nb, 64 * kb, nullptr, scr, lane); }
#endif
}

__device__ __forceinline__ void rms_row_to_bf16(const float* xrow, const float* g, bf16_t* orow, int lane) {
    const f32x4* xr = (const f32x4*)xrow + lane; const f32x4* gr = (const f32x4*)g + lane;
    f32x4 v[4]; float s = 0.f;
#pragma unroll
    for (int j = 0; j < 4; ++j) { v[j] = xr[64 * j]; s += (v[j].x * v[j].x + v[j].y * v[j].y) + (v[j].z * v[j].z + v[j].w * v[j].w); }
    const float rstd = 1.f / sqrtf(wave_sum(s) * (1.f / 1024.f) + RMS_EPS);
    u32x2* o8 = (u32x2*)orow + lane;
#pragma unroll
    for (int j = 0; j < 4; ++j) { const f32x4 gg = gr[64 * j]; u32x2 w; w.x = pk2(v[j].x * rstd * gg.x, v[j].y * rstd * gg.y); w.y = pk2(v[j].z * rstd * gg.z, v[j].w * rstd * gg.w); o8[64 * j] = w; }
}

#define LAS __attribute__((address_space(3)))
#define XB_TMO      128
#define XB_XCNT(j)  (256  + 64 * (j))
#define XB_XSUB(j)  (1280 + 64 * (j))
#define XB_XGEN(j)  (2304 + 64 * (j))
#define XB_TOP      3328
#define XB_TOPGEN   3392
#define XCD_BAR_WORDS 3456
#define XB_SPIN_CAP (1u << 18)
__device__ __forceinline__ unsigned xb_ld(unsigned* p)              { return __hip_atomic_load(p, __ATOMIC_RELAXED, __HIP_MEMORY_SCOPE_AGENT); }
__device__ __forceinline__ unsigned xb_add(unsigned* p, unsigned v) { return __hip_atomic_fetch_add(p, v, __ATOMIC_RELAXED, __HIP_MEMORY_SCOPE_AGENT); }
__device__ __forceinline__ unsigned xb_xcc_id() { return (unsigned)__builtin_amdgcn_s_getreg((3 << 11) | 20) & 0xFu; }
#define XB_SPIN(cond, bar) do { unsigned _sp = 0; while (cond) { __builtin_amdgcn_s_sleep(1); \
    if ((++_sp & 255u) == 0u) { if (xb_ld(&(bar)[XB_TMO])) break; if (_sp > XB_SPIN_CAP) { atomicAdd(&(bar)[XB_TMO], 1u); break; } } } } while (0)
struct XcdBarrier { unsigned* bar; unsigned x; volatile LAS unsigned* st; };
__device__ __forceinline__ XcdBarrier xcd_barrier_post(unsigned* bar, volatile LAS unsigned* st) {
    XcdBarrier b; b.bar = bar; b.x = xb_xcc_id(); b.st = st;
    if (threadIdx.x == 0) (void)xb_add(&bar[XB_XCNT(b.x)], 1u);
    return b;
}
__device__ __forceinline__ void xcd_barrier_complete(unsigned* bar, unsigned x, unsigned& nloc, unsigned& nx) {
    const unsigned G = gridDim.x * gridDim.y * gridDim.z;
    unsigned sum, cnt, mine, sp = 0u;
    for (;;) {
        sum = 0u; cnt = 0u; mine = 0u;
#pragma unroll
        for (unsigned j = 0; j < 16; ++j) { const unsigned c = xb_ld(&bar[XB_XCNT(j)]); sum += c; cnt += (c > 0u) ? 1u : 0u; mine = (j == x) ? c : mine; }
        if (sum == G) break;
        __builtin_amdgcn_s_sleep(1);
        if ((++sp & 255u) == 0u) { if (xb_ld(&bar[XB_TMO])) break; if (sp > XB_SPIN_CAP) { atomicAdd(&bar[XB_TMO], 1u); break; } }
    }
    nloc = mine > 0u ? mine : 1u; nx = cnt > 0u ? cnt : 1u;
}
__device__ __forceinline__ void xcd_barrier(const XcdBarrier& b) {
    asm volatile("s_waitcnt vmcnt(0)" ::: "memory");
    __syncthreads();
    if (threadIdx.x == 0) {
        unsigned* bar = b.bar;
        __builtin_amdgcn_s_waitcnt(0);
        unsigned nloc = b.st[0], nx = b.st[1];
        if (nloc == 0u) { xcd_barrier_complete(bar, b.x, nloc, nx); b.st[0] = nloc; b.st[1] = nx; }
        const unsigned old = xb_add(&bar[XB_XSUB(b.x)], 1u);
        const unsigned gen = old / nloc;
        if (old + 1u == (gen + 1u) * nloc) {
            __builtin_amdgcn_fence(__ATOMIC_RELEASE, "agent");
            asm volatile("s_waitcnt vmcnt(0)" ::: "memory");
            const unsigned og = xb_add(&bar[XB_TOP], 1u);
            const unsigned tg = og / nx;
            if (og + 1u == (tg + 1u) * nx) xb_add(&bar[XB_TOPGEN], 1u);
            else XB_SPIN(xb_ld(&bar[XB_TOPGEN]) == tg, bar);
            __builtin_amdgcn_fence(__ATOMIC_ACQUIRE, "agent");
            xb_add(&bar[XB_XGEN(b.x)], 1u);
            asm volatile("s_waitcnt vmcnt(0)" ::: "memory");
        } else {
            XB_SPIN(xb_ld(&bar[XB_XGEN(b.x)]) == gen, bar);
            __builtin_amdgcn_fence(__ATOMIC_ACQUIRE, "agent");
            asm volatile("s_waitcnt vmcnt(0)" ::: "memory");
        }
    }
    __syncthreads();
}

constexpr int NWAVES = 8;
constexpr int RING_BYTES = 131072;
constexpr int LDSCTL_OFF = RING_BYTES, MISC_OFF = LDSCTL_OFF + 320;
constexpr int LDS_BYTES = 147456;
constexpr int CW_BAR = 4096;
constexpr int TS_OFF = 131584;
constexpr int SA_OFF = 131840;
constexpr int GT_OFF = 132864;
static_assert(GT_OFF + 9 * 1024 <= LDS_BYTES, "LDS map");
#ifndef FAST_INPROJ
#define FAST_INPROJ 1
#endif
#ifndef FAST_QKV
#define FAST_QKV 1
#endif
#ifndef FAST_WOUT
#define FAST_WOUT 1
#endif
#ifndef FAST_MOE
#define FAST_MOE 1
#endif
#ifndef FAST_ATTN
#define FAST_ATTN 1
#endif
#ifndef FAST_ROUTER
#define FAST_ROUTER 1
#endif
#ifndef FAST_POOL
#define FAST_POOL 1
#endif


namespace pg8 {
typedef int v4i_t __attribute__((ext_vector_type(4)));
#define PG8_LAS __attribute__((address_space(3)))
constexpr int BM = 256, BK = 64, HALF = 128, HTB = HALF * BK * 2, STAGE_BYTES = 8 * HTB, NXCD = 8, WGM = 8;
__host__ __device__ __forceinline__ int lds_byte(int r, int c) { const int st = (r >> 4) * 2 + (c >> 5), rr = r & 15, cc = c & 31, ob = rr * 64 + cc * 2; return st * 1024 + (ob ^ (((ob >> 9) & 1) << 5)); }
__host__ __device__ __forceinline__ void stage_rc(int b, int& R, int& C) { const int st = b / 1024, sb = b % 1024, swz = sb ^ (((sb >> 9) & 1) << 5); R = (st >> 1) * 16 + swz / 64; C = (st & 1) * 32 + (swz % 64) / 2; }
__host__ __device__ __forceinline__ int perm32(int rho) { const int n = rho >> 4, i = rho & 15; return 8 * (i >> 2) + 4 * n + (i & 3); }
__device__ __forceinline__ unsigned cvt_pk_bf16(float lo, float hi) { unsigned r; asm volatile("v_cvt_pk_bf16_f32 %0, %1, %2" : "=v"(r) : "v"(lo), "v"(hi)); return r; }

struct Unit { const char* a; const char* b; int pm, pn, e, rt; };

struct DenseOrder {
    const char* A; const char* Bt; int nM, nN, nwg, G, c, K;
    __device__ void init(const void* A_, const void* Bt_, int M, int N, int K_, int G_, int c_) { A = (const char*)A_; Bt = (const char*)Bt_; nM = M / BM; nN = N / BM; nwg = nM * nN; G = G_; c = c_; K = K_; }
    __device__ bool next(int i, Unit& u) const {
        const long L = (long)i * G + c; if (L >= nwg) return false;
        int wgid = (int)L; { const int q = nwg / NXCD, r = nwg % NXCD, xcd = wgid % NXCD, off = wgid / NXCD; wgid = (xcd < r ? xcd * (q + 1) : r * (q + 1) + (xcd - r) * q) + off; }
        const int nig = WGM * nN, gid = wgid / nig, fm = gid * WGM, gsz = (nM - fm) < WGM ? (nM - fm) : WGM;
        u.pm = fm + ((wgid % nig) % gsz); u.pn = (wgid % nig) / gsz; u.e = 0; u.rt = 0;
        u.a = A + (size_t)u.pm * BM * K * 2; u.b = Bt + (size_t)u.pn * BM * K * 2; return true;
    }
};

template <class Epi, class Sched, bool ALIGN_EPI, bool GATHER, bool FP8 = false>
__device__ __forceinline__ void gemm_phase(PG8_LAS unsigned char* lds, const int K_, const Sched& S, const Epi& E) {
    int K = K_; asm volatile("" : "+s"(K));
    const int tid = tid_opaque(), wid = __builtin_amdgcn_readfirstlane(tid >> 6), lane = tid & 63, wr = wid >> 2, wc = wid & 3, fr = lane & 15, fq = lane >> 4;
    const int nt = K / BK;
    unsigned voffA0, voffB0; int rowA0;
    { int R, C; stage_rc(tid * 16, R, C); const int Rb = Epi::PERM ? ((R & ~31) + perm32(R & 31)) : R;
      voffA0 = GATHER ? (unsigned)(C * 2) : (unsigned)(R * K + C) * 2u; voffB0 = (unsigned)(Rb * K + C) * 2u; rowA0 = R; }
    const unsigned r64 = (unsigned)(64 * K * 2);
    const size_t kstep = (size_t)(BK * 2);
    const size_t hstep = (size_t)HALF * K * 2;
    const unsigned ldsw = (unsigned)wid * 1024u;
    const int aoff = lds_byte(wr * 64 + fr, fq * 8), boff = lds_byte(wc * 32 + fr, fq * 8);
#define PG8_SA(b, h) (((b) * 2 + (h)) * HTB)
#define PG8_SB(b, h) ((4 + (b) * 2 + (h)) * HTB)
#define PG8_STAGE(bufoff, gbase, voff) do { _Pragma("unroll") for (int _i = 0; _i < 2; ++_i) \
        __builtin_amdgcn_global_load_lds((const unsigned*)((const char*)(gbase) + (size_t)(_i * r64) + (voff)), (PG8_LAS unsigned*)(lds + (bufoff) + ldsw + _i * 8192), 16, 0, 0); } while (0)
#define PG8_STAGE_A(bufoff, abase, rtab, h, koff) do { if constexpr (GATHER) { _Pragma("unroll") for (int _i = 0; _i < 2; ++_i) { \
            const unsigned _ro = *(const PG8_LAS unsigned*)(lds + (rtab) + ((h) * HALF + _i * 64 + rowA0) * 4); \
            __builtin_amdgcn_global_load_lds((const unsigned*)((const char*)(abase) + (koff) + (size_t)(_ro + voffA0)), (PG8_LAS unsigned*)(lds + (bufoff) + ldsw + _i * 8192), 16, 0, 0); } } \
        else { PG8_STAGE(bufoff, (const char*)(abase) + (h) * hstep + (koff), voffA0); } } while (0)
#define PG8_LDA(dst, b, h) do { _Pragma("unroll") for (int m = 0; m < 4; ++m) _Pragma("unroll") for (int k = 0; k < 2; ++k) dst[m][k] = *(const PG8_LAS bf16x8*)(lds + PG8_SA(b, h) + aoff + m * 2048 + k * 1024); } while (0)
#define PG8_LDB(dst, b, h) do { _Pragma("unroll") for (int n = 0; n < 2; ++n) _Pragma("unroll") for (int k = 0; k < 2; ++k) dst[n][k] = *(const PG8_LAS bf16x8*)(lds + PG8_SB(b, h) + boff + n * 2048 + k * 1024); } while (0)
#define PG8_CAT(x) __builtin_shufflevector(__builtin_bit_cast(v4i_t, (x)[0]), __builtin_bit_cast(v4i_t, (x)[1]), 0, 1, 2, 3, 4, 5, 6, 7)
#define PG8_MMA(ai, bj, At, Bt) do { __builtin_amdgcn_s_setprio(1); \
        if constexpr (FP8) { _Pragma("unroll") for (int m = 0; m < 4; ++m) _Pragma("unroll") for (int n = 0; n < 2; ++n) \
            asm volatile("v_mfma_scale_f32_16x16x128_f8f6f4 %0, %1, %2, %0, %3, %3 op_sel_hi:[0,0,0]" : "+v"(acc[ai][bj][m][n]) : "v"(PG8_CAT(Bt[n])), "v"(PG8_CAT(At[m])), "v"(sc1)); } \
        else { _Pragma("unroll") for (int m = 0; m < 4; ++m) _Pragma("unroll") for (int n = 0; n < 2; ++n) _Pragma("unroll") for (int k = 0; k < 2; ++k) \
            acc[ai][bj][m][n] = __builtin_amdgcn_mfma_f32_16x16x32_bf16(Bt[n][k], At[m][k], acc[ai][bj][m][n], 0, 0, 0); } \
        __builtin_amdgcn_s_setprio(0); } while (0)
#define PG8_WAIT_V(n) asm volatile("s_waitcnt vmcnt(" #n ")" ::: "memory")
#define PG8_WAIT_L(n) asm volatile("s_waitcnt lgkmcnt(" #n ")" ::: "memory")
#define PG8_BAR __builtin_amdgcn_s_barrier()
#define PG8_SCHED __builtin_amdgcn_sched_barrier(0)
    Unit cur, nxt; int ui = 0;
    if (!S.next(0, cur)) return;
    f32x4 acc[2][2][4][2];
#pragma unroll
    for (int a = 0; a < 2; ++a)
#pragma unroll
        for (int b = 0; b < 2; ++b)
#pragma unroll
            for (int m = 0; m < 4; ++m)
#pragma unroll
                for (int n = 0; n < 2; ++n) acc[a][b][m][n] = (f32x4){0.f, 0.f, 0.f, 0.f};
    bf16x8 At[4][2], B0[2][2], B1[2][2];
    int sc1 = 0x7f7f7f7f; asm volatile("" : "+v"(sc1));
    const char* cA = cur.a; const char* cB = cur.b; int cR = cur.rt;
    if constexpr (Epi::MID) E.pre(cur, lds, tid);
    PG8_STAGE(PG8_SB(0, 0), cB, voffB0); PG8_STAGE(PG8_SB(0, 1), cB + hstep, voffB0); PG8_STAGE_A(PG8_SA(0, 0), cA, cR, 0, 0); PG8_STAGE_A(PG8_SA(0, 1), cA, cR, 1, 0);
    if (wr == 1) PG8_BAR;
    PG8_WAIT_V(2); PG8_BAR;
    PG8_STAGE(PG8_SB(1, 0), cB + kstep, voffB0); PG8_STAGE_A(PG8_SA(1, 0), cA, cR, 0, kstep); PG8_STAGE(PG8_SB(1, 1), cB + hstep + kstep, voffB0);
    PG8_WAIT_V(6); PG8_BAR;
    for (;;) {
        const bool has_next = S.next(ui + 1, nxt);
        const char* nA = has_next ? nxt.a : cA; const char* nB = has_next ? nxt.b : cB; const int nR = has_next ? nxt.rt : cR;
        for (int t = 0; t < nt; t += 2) {
            const bool last = (t == nt - 2);
            if constexpr (Epi::MID) { if (t == nt / 2) E.mid(acc, wr, fr, lds); }
            const size_t k1 = (size_t)(t + 1) * kstep;
            const char* a2 = last ? nA : cA; const char* b2 = last ? nB : cB + (size_t)(t + 2) * kstep; const int r2 = last ? nR : cR;
            const size_t k2 = last ? 0 : (size_t)(t + 2) * kstep, k3 = k2 + kstep; const char* b3 = b2 + kstep;
            PG8_LDB(B0, 0, 0); PG8_LDB(B1, 0, 1); PG8_SCHED; PG8_LDA(At, 0, 0); PG8_STAGE_A(PG8_SA(1, 1), cA, cR, 1, k1);
            PG8_WAIT_V(8); PG8_WAIT_L(0); PG8_BAR; PG8_MMA(0, 0, At, B0); PG8_MMA(0, 1, At, B1); PG8_BAR; PG8_SCHED;
            PG8_LDA(At, 0, 1); PG8_STAGE(PG8_SB(0, 0), b2, voffB0); PG8_STAGE(PG8_SB(0, 1), b2 + hstep, voffB0); PG8_STAGE_A(PG8_SA(0, 0), a2, r2, 0, k2);
            PG8_WAIT_V(8); PG8_WAIT_L(0); PG8_BAR; PG8_MMA(1, 0, At, B0); PG8_MMA(1, 1, At, B1); PG8_BAR; PG8_SCHED;
            PG8_LDB(B0, 1, 0); PG8_LDB(B1, 1, 1); PG8_SCHED; PG8_LDA(At, 1, 0); PG8_STAGE_A(PG8_SA(0, 1), a2, r2, 1, k2);
            PG8_WAIT_V(8); PG8_WAIT_L(0); PG8_BAR; PG8_MMA(0, 0, At, B0); PG8_MMA(0, 1, At, B1); PG8_BAR; PG8_SCHED;
            PG8_LDA(At, 1, 1); PG8_STAGE(PG8_SB(1, 0), b3, voffB0); PG8_STAGE(PG8_SB(1, 1), b3 + hstep, voffB0); PG8_STAGE_A(PG8_SA(1, 0), a2, r2, 0, k3);
            PG8_WAIT_V(8); PG8_WAIT_L(0); PG8_BAR; PG8_MMA(1, 0, At, B0); PG8_MMA(1, 1, At, B1); PG8_BAR; PG8_SCHED;
        }
        if constexpr (ALIGN_EPI) { if (wr == 0) PG8_BAR; }
        if constexpr (FP8) {
            asm volatile("s_nop 15\n\ts_nop 15\n\ts_nop 7" ::: "memory");
            _Pragma("unroll") for (int a = 0; a < 2; ++a) _Pragma("unroll") for (int b = 0; b < 2; ++b) _Pragma("unroll") for (int m = 0; m < 4; ++m) _Pragma("unroll") for (int n = 0; n < 2; ++n)
                asm volatile("" : "+v"(acc[a][b][m][n]));
        }
        if constexpr (!Epi::AFTER_DRAIN) { E(acc, cur, wr, wc, fr, fq); }
        if (!has_next) break;
#pragma unroll
        for (int a = 0; a < 2; ++a)
#pragma unroll
            for (int b = 0; b < 2; ++b)
#pragma unroll
                for (int m = 0; m < 4; ++m)
#pragma unroll
                    for (int n = 0; n < 2; ++n) acc[a][b][m][n] = (f32x4){0.f, 0.f, 0.f, 0.f};
        cur = nxt; cA = nA; cB = nB; cR = nR; ++ui;
        if constexpr (ALIGN_EPI) { if (wr == 1) PG8_BAR; }
    }
    PG8_WAIT_V(0);
    if constexpr (!ALIGN_EPI) { if (wr == 0) PG8_BAR; }
    PG8_BAR;
    if constexpr (Epi::AFTER_DRAIN) { E.fused(acc, cur, wr, wc, fr, fq, lds, wid, lane); }
#undef PG8_SA
#undef PG8_SB
#undef PG8_STAGE
#undef PG8_STAGE_A
#undef PG8_LDA
#undef PG8_LDB
#undef PG8_MMA
#undef PG8_CAT
#undef PG8_WAIT_V
#undef PG8_WAIT_L
#undef PG8_BAR
#undef PG8_SCHED
}

struct EpiInProj {
    static constexpr bool PERM = false, AFTER_DRAIN = true, MID = false;
    bf16_t* U; bf16_t* QN; bf16_t* KVN; bf16_t* KR; const float* g_q_a; const float* g_kv_a; const float* COS; const float* SIN;
    __device__ __forceinline__ void fused(f32x4 (&acc)[2][2][4][2], const Unit& u, int wr, int wc, int fr, int fq, PG8_LAS unsigned char* lds, int wid, int lane) const {
        const int row0 = u.pm * BM + wr * 64 + fr;
        if (u.pn < 2) {
#pragma unroll
            for (int ai = 0; ai < 2; ++ai)
#pragma unroll
                for (int m = 0; m < 4; ++m) { bf16_t* rowp = U + (size_t)(row0 + ai * HALF + m * 16) * 512 + u.pn * 256 + wc * 32 + 4 * fq;
#pragma unroll
                    for (int bj = 0; bj < 2; ++bj)
#pragma unroll
                        for (int n = 0; n < 2; ++n) { const f32x4 v = acc[ai][bj][m][n]; u32x2 w; w.x = cvt_pk_bf16(v[0], v[1]); w.y = cvt_pk_bf16(v[2], v[3]); *(u32x2*)(rowp + bj * HALF + n * 16) = w; } }
            return;
        }
        const bool isq = (u.pn == 2);
        PG8_LAS float* Pp = (PG8_LAS float*)lds;
#pragma unroll
        for (int ai = 0; ai < 2; ++ai)
#pragma unroll
            for (int m = 0; m < 4; ++m) { float s = 0.f;
#pragma unroll
                for (int bj = 0; bj < 2; ++bj) { if (bj == 1 && !isq) continue;
#pragma unroll
                    for (int n = 0; n < 2; ++n) { const f32x4 x = acc[ai][bj][m][n]; s += (x[0] * x[0] + x[1] * x[1]) + (x[2] * x[2] + x[3] * x[3]); } }
                s += __shfl_xor(s, 16); s += __shfl_xor(s, 32);
                if (fq == 0) Pp[(ai * HALF + wr * 64 + m * 16 + fr) * 4 + wc] = s; }
        asm volatile("s_waitcnt lgkmcnt(0)" ::: "memory"); __builtin_amdgcn_s_barrier(); asm volatile("" ::: "memory");
        const float invn = isq ? (1.f / 256.f) : (1.f / 128.f);
#pragma unroll
        for (int ai = 0; ai < 2; ++ai)
#pragma unroll
            for (int m = 0; m < 4; ++m) { const int rl = ai * HALF + wr * 64 + m * 16 + fr; const f32x4 p4 = *(const PG8_LAS f32x4*)(Pp + rl * 4);
                const float rstd = 1.f / sqrtf(((p4[0] + p4[1]) + (p4[2] + p4[3])) * invn + RMS_EPS); const size_t row = (size_t)(u.pm * BM + rl);
                if (isq) {
#pragma unroll
                    for (int bj = 0; bj < 2; ++bj)
#pragma unroll
                        for (int n = 0; n < 2; ++n) { const int c = bj * HALF + wc * 32 + n * 16 + 4 * fq; const f32x4 g = *(const f32x4*)(g_q_a + c); const f32x4 v = acc[ai][bj][m][n] * rstd * g;
                            u32x2 w; w.x = cvt_pk_bf16(v[0], v[1]); w.y = cvt_pk_bf16(v[2], v[3]); *(u32x2*)(QN + row * 256 + c) = w; }
                } else {
#pragma unroll
                    for (int n = 0; n < 2; ++n) { const int c = wc * 32 + n * 16 + 4 * fq; const f32x4 g = *(const f32x4*)(g_kv_a + c); const f32x4 v = acc[ai][0][m][n] * rstd * g;
                        u32x2 w; w.x = cvt_pk_bf16(v[0], v[1]); w.y = cvt_pk_bf16(v[2], v[3]); *(u32x2*)(KVN + row * 128 + c) = w; }
                    if (wc == 0) { const f32x4 x1 = acc[ai][1][m][0], x2 = acc[ai][1][m][1]; const f32x4 cs = *(const f32x4*)(COS + row * 16 + 4 * fq), sn = *(const f32x4*)(SIN + row * 16 + 4 * fq);
                        const f32x4 o1 = x1 * cs - x2 * sn, o2 = x2 * cs + x1 * sn; u32x2 w1, w2; w1.x = cvt_pk_bf16(o1[0], o1[1]); w1.y = cvt_pk_bf16(o1[2], o1[3]); w2.x = cvt_pk_bf16(o2[0], o2[1]); w2.y = cvt_pk_bf16(o2[2], o2[3]);
                        *(u32x2*)(KR + row * 32 + 4 * fq) = w1; *(u32x2*)(KR + row * 32 + 16 + 4 * fq) = w2; }
                } }
    }
};
}
namespace pg8 {
constexpr float QN8_SCALE = 8.f;
struct EpiQ {
    static constexpr bool PERM = false, AFTER_DRAIN = false, MID = false;
    unsigned char* QF; const float* COS; const float* SIN;
    __device__ __forceinline__ void operator()(const f32x4 (&acc)[2][2][4][2], const Unit& u, int wr, int wc, int fr, int fq) const {
        const int row0 = u.pm * BM + wr * 64 + fr; const int G0 = 8 * u.pn + wc, G1 = G0 + 4; const bool r0 = (G0 % 3) == 2, r1 = (G1 % 3) == 2;
#pragma unroll
        for (int ai = 0; ai < 2; ++ai)
#pragma unroll
            for (int m = 0; m < 4; ++m) { const size_t row = (size_t)(row0 + ai * HALF + m * 16);
                f32x4 cs = {1.f, 1.f, 1.f, 1.f}, sn = {0.f, 0.f, 0.f, 0.f};
                if (r0 || r1) { cs = *(const f32x4*)(COS + row * 16 + 4 * fq); sn = *(const f32x4*)(SIN + row * 16 + 4 * fq); }
#pragma unroll
                for (int bj = 0; bj < 2; ++bj) { const bool rope = bj ? r1 : r0; const int G = bj ? G1 : G0; f32x4 o1 = acc[ai][bj][m][0], o2 = acc[ai][bj][m][1];
                    unsigned char* hp = QF + row * 1024 + (G / 3) * 128;
                    if (rope) { const f32x4 x1 = o1, x2 = o2; o1 = (x1 * cs - x2 * sn) * QSCALE; o2 = (x2 * cs + x1 * sn) * QSCALE;
                        u32x2 w1, w2; w1.x = cvt_pk_bf16(o1[0], o1[1]); w1.y = cvt_pk_bf16(o1[2], o1[3]); w2.x = cvt_pk_bf16(o2[0], o2[1]); w2.y = cvt_pk_bf16(o2[2], o2[3]);
                        *(u32x2*)(hp + 64 + 8 * fq) = w1; *(u32x2*)(hp + 64 + 32 + 8 * fq) = w2; }
                    else { o1 = o1 * (QSCALE * QN8_SCALE); o2 = o2 * (QSCALE * QN8_SCALE); const int cb = 32 * (G % 3) + 4 * fq;
                        *(unsigned*)(hp + cb) = pk4_fp8(o1[0], o1[1], o1[2], o1[3]); *(unsigned*)(hp + cb + 16) = pk4_fp8(o2[0], o2[1], o2[2], o2[3]); } }
                asm volatile("" ::: "memory"); }
    }
};
struct EpiKV {
    static constexpr bool PERM = true, AFTER_DRAIN = false, MID = false;
    unsigned char* Kn8; bf16_t* V;
    __device__ __forceinline__ void operator()(const f32x4 (&acc)[2][2][4][2], const Unit& u, int wr, int wc, int fr, int fq) const {
        const int row0 = u.pm * BM + wr * 64 + fr;
#pragma unroll
        for (int bj = 0; bj < 2; ++bj) { const int head = 2 * u.pn + bj;
#pragma unroll
            for (int ai = 0; ai < 2; ++ai)
#pragma unroll
                for (int m = 0; m < 4; ++m) { const size_t row = (size_t)(row0 + ai * HALF + m * 16); const f32x4 v0 = acc[ai][bj][m][0], v1 = acc[ai][bj][m][1];
                    if (wc < 2) { u32x2 w; w.x = pk4_fp8(v0[0], v0[1], v0[2], v0[3]); w.y = pk4_fp8(v1[0], v1[1], v1[2], v1[3]); *(u32x2*)(Kn8 + row * 512 + head * 64 + wc * 32 + 8 * fq) = w; }
                    else { u32x4 w; w.x = cvt_pk_bf16(v0[0], v0[1]); w.y = cvt_pk_bf16(v0[2], v0[3]); w.z = cvt_pk_bf16(v1[0], v1[1]); w.w = cvt_pk_bf16(v1[2], v1[3]); *(u32x4*)(V + row * 512 + head * 64 + (wc - 2) * 32 + 8 * fq) = w; } } }
    }
};
struct EpiOut {
    static constexpr bool PERM = true, AFTER_DRAIN = false, MID = true;
    const float* x; bf16_t* out; const float* SSQ; int aux_off;
    __device__ __forceinline__ void pre(const Unit& u, PG8_LAS unsigned char* lds, int tid) const {
        if (tid < 256) { const f32x4 a = *(const f32x4*)(SSQ + (size_t)(u.pm * BM + tid) * 8), b = *(const f32x4*)(SSQ + (size_t)(u.pm * BM + tid) * 8 + 4);
            const float s = ((a[0] + a[1]) + (a[2] + a[3])) + ((b[0] + b[1]) + (b[2] + b[3])); ((PG8_LAS float*)(lds + aux_off))[tid] = 1.f / sqrtf(s * (1.f / 512.f) + RMS_EPS); }
    }
    __device__ __forceinline__ void mid(f32x4 (&acc)[2][2][4][2], int wr, int fr, PG8_LAS unsigned char* lds) const {
#pragma unroll
        for (int ai = 0; ai < 2; ++ai)
#pragma unroll
            for (int m = 0; m < 4; ++m) { const float sa = ((const PG8_LAS float*)(lds + aux_off))[ai * HALF + wr * 64 + m * 16 + fr];
#pragma unroll
                for (int bj = 0; bj < 2; ++bj)
#pragma unroll
                    for (int n = 0; n < 2; ++n) acc[ai][bj][m][n] = acc[ai][bj][m][n] * sa; }
    }
    __device__ __forceinline__ void operator()(const f32x4 (&acc)[2][2][4][2], const Unit& u, int wr, int wc, int fr, int fq) const {
        const int row0 = u.pm * BM + wr * 64 + fr, col0 = u.pn * BM + wc * 32 + 8 * fq;
#pragma unroll
        for (int ai = 0; ai < 2; ++ai)
#pragma unroll
            for (int m = 0; m < 4; ++m) { const size_t off = (size_t)(row0 + ai * HALF + m * 16) * 1024 + col0;
#pragma unroll
                for (int bj = 0; bj < 2; ++bj) { const f32x4 v0 = *(const f32x4*)(x + off + bj * HALF) + acc[ai][bj][m][0], v1 = *(const f32x4*)(x + off + bj * HALF + 4) + acc[ai][bj][m][1];
                    u32x4 w; w.x = cvt_pk_bf16(v0[0], v0[1]); w.y = cvt_pk_bf16(v0[2], v0[3]); w.z = cvt_pk_bf16(v1[0], v1[1]); w.w = cvt_pk_bf16(v1[2], v1[3]); *(u32x4*)(out + off + bj * HALF) = w; } }
    }
};
struct EpiSwiglu {
    static constexpr bool PERM = true, AFTER_DRAIN = false, MID = false;
    const float* bgu; bf16_t* ACT;
    __device__ __forceinline__ void operator()(const f32x4 (&acc)[2][2][4][2], const Unit& u, int wr, int wc, int fr, int fq) const {
        const int row0 = u.pm * BM + wr * 64 + fr, col8 = u.pn * HALF + wc * 32 + 8 * fq;
        f32x4 bg[2], bu[2];
#pragma unroll
        for (int n = 0; n < 2; ++n) { bg[n] = *(const f32x4*)(bgu + (size_t)u.e * 2048 + col8 + 4 * n); bu[n] = *(const f32x4*)(bgu + (size_t)u.e * 2048 + 1024 + col8 + 4 * n); }
#pragma unroll
        for (int ai = 0; ai < 2; ++ai)
#pragma unroll
            for (int m = 0; m < 4; ++m) { f32x4 a[2];
#pragma unroll
                for (int n = 0; n < 2; ++n) { const f32x4 g4 = acc[ai][0][m][n] + bg[n], u4 = acc[ai][1][m][n] + bu[n];
#pragma unroll
                    for (int j = 0; j < 4; ++j) { const float g = fminf(g4[j], 7.f), uu = fminf(fmaxf(u4[j], -7.f), 7.f);
                        const float sg = __builtin_amdgcn_rcpf(1.f + __builtin_amdgcn_exp2f(-1.702f * 1.4426950408889634f * g)); a[n][j] = g * sg * (uu + 1.f); } }
                u32x4 w; w.x = cvt_pk_bf16(a[0][0], a[0][1]); w.y = cvt_pk_bf16(a[0][2], a[0][3]); w.z = cvt_pk_bf16(a[1][0], a[1][1]); w.w = cvt_pk_bf16(a[1][2], a[1][3]);
                *(u32x4*)(ACT + (size_t)(row0 + ai * HALF + m * 16) * 1024 + col8) = w; }
    }
};
struct EpiDown {
    static constexpr bool PERM = true, AFTER_DRAIN = false, MID = false;
    const float* bd; const float* GL; bf16_t* Y;
    __device__ __forceinline__ void operator()(const f32x4 (&acc)[2][2][4][2], const Unit& u, int wr, int wc, int fr, int fq) const {
        const int col0 = u.pn * BM + wc * 32 + 8 * fq;
        f32x4 bv[2][2];
#pragma unroll
        for (int bj = 0; bj < 2; ++bj)
#pragma unroll
            for (int n = 0; n < 2; ++n) bv[bj][n] = *(const f32x4*)(bd + (size_t)u.e * 1024 + col0 + bj * HALF + 4 * n);
#pragma unroll
        for (int ai = 0; ai < 2; ++ai)
#pragma unroll
            for (int m = 0; m < 4; ++m) { const int rl = ai * HALF + wr * 64 + m * 16 + fr; const float gt = GL[(size_t)u.e * T + u.rt + rl]; bf16_t* rowp = Y + (size_t)(u.pm * BM + rl) * 1024 + col0;
#pragma unroll
                for (int bj = 0; bj < 2; ++bj) { const f32x4 v0 = (acc[ai][bj][m][0] + bv[bj][0]) * gt, v1 = (acc[ai][bj][m][1] + bv[bj][1]) * gt;
                    u32x4 w; w.x = cvt_pk_bf16(v0[0], v0[1]); w.y = cvt_pk_bf16(v0[2], v0[3]); w.z = cvt_pk_bf16(v1[0], v1[1]); w.w = cvt_pk_bf16(v1[2], v1[3]); *(u32x4*)(rowp + bj * HALF) = w; } }
    }
};
struct EpiSwiglu8 {
    static constexpr bool PERM = true, AFTER_DRAIN = false, MID = false;
    const float* bgu; unsigned char* ACT;
    __device__ __forceinline__ void operator()(const f32x4 (&acc)[2][2][4][2], const Unit& u, int wr, int wc, int fr, int fq) const {
        const int row0 = u.pm * BM + wr * 64 + fr, col8 = u.pn * HALF + wc * 32 + 8 * fq;
        f32x4 bg[2], bu[2];
#pragma unroll
        for (int n = 0; n < 2; ++n) { bg[n] = *(const f32x4*)(bgu + (size_t)u.e * 2048 + col8 + 4 * n); bu[n] = *(const f32x4*)(bgu + (size_t)u.e * 2048 + 1024 + col8 + 4 * n); }
#pragma unroll
        for (int ai = 0; ai < 2; ++ai)
#pragma unroll
            for (int m = 0; m < 4; ++m) { f32x4 a[2];
#pragma unroll
                for (int n = 0; n < 2; ++n) { const f32x4 g4 = acc[ai][0][m][n] * W8_INV + bg[n], u4 = acc[ai][1][m][n] * W8_INV + bu[n];
#pragma unroll
                    for (int j = 0; j < 4; ++j) { const float g = fminf(g4[j], 7.f), uu = fminf(fmaxf(u4[j], -7.f), 7.f);
                        const float sg = __builtin_amdgcn_rcpf(1.f + __builtin_amdgcn_exp2f(-1.702f * 1.4426950408889634f * g)); a[n][j] = g * sg * (uu + 1.f); } }
                u32x2 w; w.x = pk4_fp8_nc(a[0][0], a[0][1], a[0][2], a[0][3]); w.y = pk4_fp8_nc(a[1][0], a[1][1], a[1][2], a[1][3]);
                *(u32x2*)(ACT + (size_t)(row0 + ai * HALF + m * 16) * 1024 + col8) = w; }
    }
};
constexpr float Y8_SCALE = 16.f, Y8_INV = 1.f / 16.f;
struct EpiDown8 {
    static constexpr bool PERM = true, AFTER_DRAIN = false, MID = false;
    const float* bd; const float* GL; unsigned char* Y;
    __device__ __forceinline__ void operator()(const f32x4 (&acc)[2][2][4][2], const Unit& u, int wr, int wc, int fr, int fq) const {
        const int col0 = u.pn * BM + wc * 32 + 8 * fq;
        f32x4 bv[2][2];
#pragma unroll
        for (int bj = 0; bj < 2; ++bj)
#pragma unroll
            for (int n = 0; n < 2; ++n) bv[bj][n] = *(const f32x4*)(bd + (size_t)u.e * 1024 + col0 + bj * HALF + 4 * n);
#pragma unroll
        for (int ai = 0; ai < 2; ++ai)
#pragma unroll
            for (int m = 0; m < 4; ++m) { const int rl = ai * HALF + wr * 64 + m * 16 + fr; const float gt = GL[(size_t)u.e * T + u.rt + rl] * Y8_SCALE; unsigned char* rowp = Y + (size_t)(u.pm * BM + rl) * 1024 + col0;
#pragma unroll
                for (int bj = 0; bj < 2; ++bj) { const f32x4 v0 = (acc[ai][bj][m][0] * W8_INV + bv[bj][0]) * gt, v1 = (acc[ai][bj][m][1] * W8_INV + bv[bj][1]) * gt;
                    u32x2 w; w.x = pk4_fp8(v0[0], v0[1], v0[2], v0[3]); w.y = pk4_fp8(v1[0], v1[1], v1[2], v1[3]); *(u32x2*)(rowp + bj * HALF) = w; } }
    }
};
template <bool GATHER>
struct MoeOrder {
    const char* A; const char* W; size_t wstride; int NN, G, c, rt0; const PG8_LAS int* tstart; int rowbytes;
    __device__ bool next(int i, Unit& u) const {
        const int nwg = tstart[32] * NN; const long L = (long)i * G + c; if (L >= nwg) return false;
        int wgid = (int)L; { const int q = nwg / NXCD, r = nwg % NXCD, xcd = wgid % NXCD, off = wgid / NXCD; wgid = (xcd < r ? xcd * (q + 1) : r * (q + 1) + (xcd - r) * q) + off; }
        const int mt = wgid / NN, pn = wgid % NN; int e = 0;
        for (int k = 1; k < 32; ++k) e += (tstart[k] <= mt) ? 1 : 0;
        u.pm = mt; u.pn = pn; u.e = e; const int jt = mt - tstart[e];
        u.a = GATHER ? A : A + (size_t)mt * BM * rowbytes; u.b = W + (size_t)e * wstride + (size_t)pn * BM * rowbytes;
        u.rt = GATHER ? rt0 + i * 1024 : jt * 256;
        return true;
    }
};
}

template <bool GATHER>
__device__ __forceinline__ void moe_setup(const Ptrs& P, LAS unsigned char* lds, const pg8::MoeOrder<GATHER>& S) {
    const int tid = threadIdx.x; const int* cnt = (const int*)(P.ws + WS_CTL) + CW_CNT;
    if (tid < 33) { int s = 0; for (int e = 0; e < tid; ++e) s += (cnt[e] + 255) >> 8; ((LAS int*)(lds + TS_OFF))[tid] = s; }
    __syncthreads();
    if constexpr (GATHER) {
        const int* LIST = (const int*)(P.ws + WS_LIST); pg8::Unit u;
        for (int i = 0; i < 9 && S.next(i, u); ++i) {
            if (tid < 256) { const int jt = u.pm - S.tstart[u.e]; int pos = jt * 256 + tid; const int n = cnt[u.e]; if (pos >= n) pos = n - 1;
                ((LAS unsigned*)(lds + GT_OFF + i * 1024))[tid] = (unsigned)LIST[(size_t)u.e * T + pos] * (unsigned)S.rowbytes; }
        }
        __syncthreads();
    }
}
namespace att {
typedef short s16x4 __attribute__((ext_vector_type(4)));
typedef float f32x16 __attribute__((ext_vector_type(16)));
constexpr int NW = 8, QBLK = 32, KVBLK = 64, QB = NW * QBLK;
constexpr int SHM_V = KVBLK * 64 * 2, SHM_K = KVBLK * 128;
constexpr int NVS = 3;
constexpr int OFF_V = 0, OFF_K = NVS * SHM_V, OFF_WS = OFF_K + 2 * SHM_K, OFF_OST = OFF_WS + NW * 64 * 4, ATT_LDS = OFF_OST + NW * 4096;
constexpr float THR2 = 11.5f;
#define KSWZ(row, ch) ((row) * 128 + ((((ch) ^ (((row) >> 1) & 7))) << 4))
#define SBAR() __builtin_amdgcn_sched_barrier(0)
__device__ __forceinline__ int v_st(int k, int c) { return ((k >> 3) * 2 + (c >> 5)) * 512 + ((k & 7) * 32 + (c & 31)) * 2; }
__device__ __forceinline__ int v_rd_base(int lane) { return ((lane & 3) << 3) | (((lane >> 2) & 3) << 6) | (((lane >> 4) & 1) << 5) | (((lane >> 5) & 1) << 8); }
__device__ __forceinline__ int crow(int r, int hi) { return (r & 3) + 8 * (r >> 2) + 4 * hi; }
__device__ __forceinline__ unsigned cvtpk(float lo, float hi) { unsigned r; asm volatile("v_cvt_pk_bf16_f32 %0, %1, %2" : "=v"(r) : "v"(lo), "v"(hi)); return r; }
__device__ __forceinline__ void mask_tile(f32x16& p0, f32x16& p1, int dq) {
    const float NEG = -__builtin_inff();
#pragma unroll
    for (int r = 0; r < 16; ++r) { const int c = (r & 3) + 8 * (r >> 2); if (dq - c < 0) p0[r] = NEG; if (dq - c - 32 < 0) p1[r] = NEG; }
}
template <bool FIRST, int VAR = 0>
__device__ __forceinline__ void partialSM(f32x16& p0, f32x16& p1, float& m_reg, f32x16& negm, float& alpha) {
    if constexpr (VAR == 1) { alpha = 1.f; return; }
    float pmax = p0[0];
#pragma unroll
    for (int r = 1; r < 16; ++r) pmax = fmaxf(pmax, p0[r]);
#pragma unroll
    for (int r = 0; r < 16; ++r) pmax = fmaxf(pmax, p1[r]);
    { auto rr = __builtin_amdgcn_permlane32_swap(__float_as_uint(pmax), __float_as_uint(pmax), false, false); pmax = fmaxf(__uint_as_float(rr[0]), __uint_as_float(rr[1])); }
    if (!FIRST && __builtin_expect(__all(pmax <= THR2), 1)) { alpha = 1.f; }
    else { const float dl = FIRST ? pmax : fmaxf(pmax, 0.f); m_reg += dl; alpha = FIRST ? 1.f : __builtin_amdgcn_exp2f(-dl);
#pragma unroll
        for (int r = 0; r < 16; ++r) { p0[r] -= dl; p1[r] -= dl; }
#pragma unroll
        for (int r = 0; r < 16; ++r) negm[r] = -m_reg;
        asm volatile("" : "+v"(negm)); }
#pragma unroll
    for (int r = 0; r < 16; ++r) p0[r] = __builtin_amdgcn_exp2f(p0[r]);
}
template <int VAR = 0>
__device__ __forceinline__ void finishSM(f32x16& p0, f32x16& p1, float alpha, float& l_reg, bf16x8& pa0, bf16x8& pa1, bf16x8& pa2, bf16x8& pa3) {
    if constexpr (VAR != 1) {
#pragma unroll
    for (int r = 0; r < 16; ++r) p1[r] = __builtin_amdgcn_exp2f(p1[r]); }
    float ps = 0;
#pragma unroll
    for (int r = 0; r < 16; ++r) ps += p0[r];
#pragma unroll
    for (int r = 0; r < 16; ++r) ps += p1[r];
    { auto rr = __builtin_amdgcn_permlane32_swap(__float_as_uint(ps), __float_as_uint(ps), false, false); ps = __uint_as_float(rr[0]) + __uint_as_float(rr[1]); }
    l_reg = l_reg * alpha + ps;
#define PK4(P, B_, OUT) do { u32x4 w = {cvtpk(P[B_+0], P[B_+1]), cvtpk(P[B_+2], P[B_+3]), cvtpk(P[B_+4], P[B_+5]), cvtpk(P[B_+6], P[B_+7])}; OUT = *reinterpret_cast<bf16x8*>(&w); } while (0)
    PK4(p0, 0, pa0); PK4(p0, 8, pa1); PK4(p1, 0, pa2); PK4(p1, 8, pa3);
#undef PK4
}
typedef int v8i_a __attribute__((ext_vector_type(8)));
typedef int v4i_a __attribute__((ext_vector_type(4)));
template <int KB, int VAR = 0>
__device__ __forceinline__ void qkt(f32x16& p0, f32x16& p1, const char* K_lds, int r32, int hi, const v8i_a& qn, const bf16x8* qro, const f32x16& negm) {
    if constexpr (VAR == 2) { p0 = negm; p1 = negm; asm volatile("" : "+v"(p0), "+v"(p1)); return; }
    const char* kb = K_lds + KB * SHM_K;
    const v4i_a a0 = *reinterpret_cast<const v4i_a*>(kb + KSWZ(r32, 2 * hi)), a1 = *reinterpret_cast<const v4i_a*>(kb + KSWZ(r32, 2 * hi + 1));
    const v4i_a b0 = *reinterpret_cast<const v4i_a*>(kb + KSWZ(32 + r32, 2 * hi)), b1 = *reinterpret_cast<const v4i_a*>(kb + KSWZ(32 + r32, 2 * hi + 1));
    const bf16x8 c0 = *reinterpret_cast<const bf16x8*>(kb + KSWZ(r32, 4 + hi)), c1 = *reinterpret_cast<const bf16x8*>(kb + KSWZ(r32, 6 + hi));
    const bf16x8 d0 = *reinterpret_cast<const bf16x8*>(kb + KSWZ(32 + r32, 4 + hi)), d1 = *reinterpret_cast<const bf16x8*>(kb + KSWZ(32 + r32, 6 + hi));
    __builtin_amdgcn_s_setprio(1);
    p0 = __builtin_amdgcn_mfma_scale_f32_32x32x64_f8f6f4(__builtin_shufflevector(a0, a1, 0, 1, 2, 3, 4, 5, 6, 7), qn, negm, 0, 0, 0, 0x7f7f7f7f, 0, 0x7c7c7c7c);
    p1 = __builtin_amdgcn_mfma_scale_f32_32x32x64_f8f6f4(__builtin_shufflevector(b0, b1, 0, 1, 2, 3, 4, 5, 6, 7), qn, negm, 0, 0, 0, 0x7f7f7f7f, 0, 0x7c7c7c7c);
    p0 = __builtin_amdgcn_mfma_f32_32x32x16_bf16(c0, qro[0], p0, 0, 0, 0);
    p1 = __builtin_amdgcn_mfma_f32_32x32x16_bf16(d0, qro[0], p1, 0, 0, 0);
    p0 = __builtin_amdgcn_mfma_f32_32x32x16_bf16(c1, qro[1], p0, 0, 0, 0);
    p1 = __builtin_amdgcn_mfma_f32_32x32x16_bf16(d1, qro[1], p1, 0, 0, 0);
    __builtin_amdgcn_s_setprio(0);
}
typedef short v4i16_t __attribute__((ext_vector_type(4)));
__device__ __forceinline__ s16x4 vtr(const char* p) { return __builtin_bit_cast(s16x4, __builtin_amdgcn_ds_read_tr16_b64_v4i16((__attribute__((address_space(3))) v4i16_t*)(p))); }
template <int VAR = 0>
__device__ __forceinline__ void pv_tile(f32x16* o, const char* vb, bf16x8 pa0, bf16x8 pa1, bf16x8 pa2, bf16x8 pa3) {
    if constexpr (VAR == 2) { asm volatile("" :: "v"(pa0), "v"(pa1), "v"(pa2), "v"(pa3)); return; }
#pragma unroll
    for (int d0 = 0; d0 < 2; ++d0) { const char* b_ = vb + d0 * 512;
        const s16x4 l0 = vtr(b_), h0 = vtr(b_ + 1024), l1 = vtr(b_ + 2048), h1 = vtr(b_ + 3072), l2 = vtr(b_ + 4096), h2 = vtr(b_ + 5120), l3 = vtr(b_ + 6144), h3 = vtr(b_ + 7168);
        __builtin_amdgcn_s_setprio(1);
        o[d0] = __builtin_amdgcn_mfma_f32_32x32x16_bf16(pa0, (bf16x8){l0[0], l0[1], l0[2], l0[3], h0[0], h0[1], h0[2], h0[3]}, o[d0], 0, 0, 0);
        o[d0] = __builtin_amdgcn_mfma_f32_32x32x16_bf16(pa1, (bf16x8){l1[0], l1[1], l1[2], l1[3], h1[0], h1[1], h1[2], h1[3]}, o[d0], 0, 0, 0);
        o[d0] = __builtin_amdgcn_mfma_f32_32x32x16_bf16(pa2, (bf16x8){l2[0], l2[1], l2[2], l2[3], h2[0], h2[1], h2[2], h2[3]}, o[d0], 0, 0, 0);
        o[d0] = __builtin_amdgcn_mfma_f32_32x32x16_bf16(pa3, (bf16x8){l3[0], l3[1], l3[2], l3[3], h3[0], h3[1], h3[2], h3[3]}, o[d0], 0, 0, 0);
        __builtin_amdgcn_s_setprio(0); }
}
constexpr int CV_UNITS = 32 * 768, CV_BUF = 64 * 68 * 4, OFF_CV = ATT_LDS, OFF_CVT = OFF_CV + 2 * CV_BUF, CV_MAXJ = 128;
static_assert(OFF_CV % 16 == 0 && OFF_CVT + CV_MAXJ * 16 <= 131072, "conversion images + unit table fit beside the attention scratch");
struct Cv { f32x4 a0, a1, b0, b1; int next, nj, pa, pb, emit, sb; };
typedef unsigned u32x4_cv __attribute__((ext_vector_type(4)));
__device__ __forceinline__ void cv_build_table(const Ptrs& P, char* lds, int nj, int tid) {
    if (tid < nj) { const int u = (int)blockIdx.x + tid * (int)gridDim.x; const int e = u / 768, q = u % 768; u32x4_cv t;
        if (q < 512) { const int kb = q >> 5, nb = q & 31, n0 = 64 * nb; const int nn = n0 & 1023, p = nn >> 7, dn0 = 256 * p + (n0 >= 1024 ? 128 : 0) + (nn & 127);
            t.x = (unsigned)(((size_t)e * 1024 * 2048 + (size_t)(64 * kb) * 2048 + n0) * 4); t.y = (unsigned)(WS_WGU + (size_t)e * 2048 * 1024 + (size_t)dn0 * 1024 + 64 * kb); t.z = 2048u * 4u; t.w = 0u; }
        else { const int qq = q - 512, kb = qq >> 4, nb = qq & 15;
            t.x = (unsigned)(((size_t)e * 1024 * 1024 + (size_t)(64 * kb) * 1024 + 64 * nb) * 4); t.y = (unsigned)(WS_WD + (size_t)e * 1024 * 1024 + (size_t)(64 * nb) * 1024 + 64 * kb); t.z = 1024u * 4u; t.w = 1u; }
        *(u32x4_cv*)(lds + OFF_CVT + tid * 16) = t; }
}
__device__ __forceinline__ void cv_load(const Ptrs& P, const char* lds, int j, f32x4& r0, f32x4& r1, int tid) {
    const u32x4_cv t = *(const u32x4_cv*)(lds + OFF_CVT + j * 16);
    const char* p = (t.w ? (const char*)P.w_down : (const char*)P.w_gu) + t.x + (unsigned)(tid >> 4) * t.z + (tid & 15) * 16;
    r0 = __builtin_nontemporal_load((const f32x4*)p); r1 = __builtin_nontemporal_load((const f32x4*)(p + 32u * t.z));
}
__device__ __forceinline__ void cv_stage(const f32x4& r0, const f32x4& r1, char* buf, int tid) {
    const int k = tid >> 4, c4 = (tid & 15) * 4;
    *(f32x4*)(buf + (k * 68 + ((c4 + 4 * (k >> 3)) & 63)) * 4) = r0 * W8_SCALE;
    *(f32x4*)(buf + ((k + 32) * 68 + ((c4 + 4 * ((k + 32) >> 3)) & 63)) * 4) = r1 * W8_SCALE;
}
__device__ __forceinline__ void cv_begin(const Ptrs& P, Cv& cv, char* lds, int tid) {
    const bool on = cv.emit >= 0; const int n = tid >> 3, g = tid & 7;
    const float* q = (const float*)(lds + OFF_CV + (cv.sb ^ 1) * CV_BUF) + (8 * g) * 68 + ((n + 4 * g) & 63);
    u32x2 o; o.x = pk4_fp8(q[0 * 68], q[1 * 68], q[2 * 68], q[3 * 68]); o.y = pk4_fp8(q[4 * 68], q[5 * 68], q[6 * 68], q[7 * 68]);
    const unsigned doff = on ? *(const unsigned*)(lds + OFF_CVT + cv.emit * 16 + 4) + (unsigned)(n * 1024 + 8 * g) : (unsigned)(WS_TMP + (size_t)blockIdx.x * 4096 + tid * 8);
    *(u32x2*)(P.ws + doff) = o;
}
__device__ __forceinline__ void cv_mid(const Ptrs& P, Cv& cv, f32x4& r0, f32x4& r1, int& pend, char* lds, int tid) {
    int staged = -1;
    if (pend >= 0) { cv_stage(r0, r1, lds + OFF_CV + cv.sb * CV_BUF, tid); staged = pend; }
    const bool more = cv.next < cv.nj;
    cv_load(P, lds, more ? cv.next : 0, r0, r1, tid); pend = more ? cv.next : -1; if (more) cv.next += 1;
    cv.emit = staged; if (staged >= 0) cv.sb ^= 1;
}
struct BlockRef { const unsigned char* Q; const unsigned char* Kn; const unsigned char* KR; const bf16_t* V; bf16_t* O; float* SSQ; int P0; };
struct Seam { v8i_a qn; bf16x8 qro[2]; bf16x8 st_v0, st_k0; };
#define VMW() asm volatile("s_waitcnt vmcnt(0)" ::: "memory")
#define VMWN(n) asm volatile("s_waitcnt vmcnt(%0)" :: "i"(n) : "memory")
#define KSRC(B, k0) (ch < 4 ? (B).Kn + (size_t)((k0) + sr) * 512 + ch * 16 : (B).KR + (size_t)((k0) + sr) * 64 + (ch - 4) * 16)
#define SLOAD_H(B, k0) do { S.st_v0 = *(const bf16x8*)((B).V + (size_t)((k0) + vk) * 512 + vc); S.st_k0 = *(const bf16x8*)KSRC(B, k0); } while (0)
#define SWRITE_HK(bf) do { *(bf16x8*)(K_lds + (bf) * SHM_K + kws) = S.st_k0; } while (0)
#define QLOAD(B) do { const unsigned char* qp_ = (B).Q + (size_t)(wid * QBLK + r32) * 1024; \
        const v4i_a q0_ = *(const v4i_a*)(qp_ + 32 * hi), q1_ = *(const v4i_a*)(qp_ + 32 * hi + 16); S.qn = __builtin_shufflevector(q0_, q1_, 0, 1, 2, 3, 4, 5, 6, 7); \
        S.qro[0] = *(const bf16x8*)(qp_ + 64 + 16 * hi); S.qro[1] = *(const bf16x8*)(qp_ + 96 + 16 * hi); } while (0)
#define SWRITE_HV(vs) do { *(bf16x8*)(V_lds + (vs) * SHM_V + vst0) = S.st_v0; } while (0)
#define SWRITE_H(bf, vs) do { SWRITE_HV(vs); SWRITE_HK(bf); } while (0)
__device__ __forceinline__ void attn_prime(const BlockRef& cur, char* lds, Seam& S) {
    const int tid = tid_opaque(), wid = __builtin_amdgcn_readfirstlane(tid >> 6), lane = tid & 63, r32 = lane & 31, hi = lane >> 5;
    const int sr = tid >> 3, ch = tid & 7, kws = KSWZ(sr, ch), vk = tid >> 3, vc = (tid & 7) * 8; char* K_lds = lds + OFF_K;
    QLOAD(cur);
    SLOAD_H(cur, 0); VMW(); SWRITE_HK(0);
    __syncthreads();
}
template <int VAR = 0>
__device__ __forceinline__ void attn_block(const Ptrs& P, Cv& cv, const BlockRef& cur, const BlockRef& nxt, char* lds, Seam& S) {
    const int tid = tid_opaque(), wid = __builtin_amdgcn_readfirstlane(tid >> 6), lane = tid & 63, r32 = lane & 31, hi = lane >> 5;
    const int NT = (cur.P0 + QB) / KVBLK;
    const int qlo = cur.P0 + wid * QBLK, qm = qlo + r32 - 4 * hi;
    char* V_lds = lds + OFF_V; char* K_lds = lds + OFF_K;
    float* ws = (float*)(lds + OFF_WS) + wid * 64; float* li_l = ws, * al_l = ws + 32;
    float m_reg = 0.f, l_reg = 0; f32x16 o[2] = {}; f32x16 negm = {}; asm volatile("" : "+v"(negm));
    const int sr = tid >> 3, ch = tid & 7, kws = KSWZ(sr, ch), vk = tid >> 3, vc = (tid & 7) * 8, vst0 = v_st(vk, vc);
    const char* vrd = lds + OFF_V + v_rd_base(lane);
#define RESC(a) do { if (__any((a) < 1.f)) { if (hi == 0) al_l[r32] = (a); asm volatile("s_waitcnt lgkmcnt(0)" ::: "memory"); \
                     _Pragma("unroll") for (int d_ = 0; d_ < 2; ++d_) _Pragma("unroll") for (int r = 0; r < 16; ++r) o[d_][r] *= al_l[crow(r, hi)]; } } while (0)
#define KBASE(t) ((t) * KVBLK)
#define MASKT(P0_, P1_, t) do { const int kb_ = KBASE(t); if (VAR != 1 && kb_ + KVBLK - 1 > qlo) mask_tile(P0_, P1_, qm - kb_); } while (0)
    constexpr int NQL = 4;
#define SEAM_K0() do { VMWN(NQL); SWRITE_HK(0); SBAR(); } while (0)
#define VROT(x) ((x) == (NVS - 1) * SHM_V ? 0 : (x) + SHM_V)
    f32x16 pA0, pA1, pB0, pB1; float alA, alB; bf16x8 pa0, pa1, pa2, pa3;
    int vrs = 0, vws = SHM_V;
    SWRITE_HV(0); SBAR();
    if (NT > 1) SLOAD_H(cur, KBASE(1));
    SBAR(); qkt<0, VAR>(pA0, pA1, K_lds, r32, hi, S.qn, S.qro, negm);
    MASKT(pA0, pA1, 0); partialSM<true, VAR>(pA0, pA1, m_reg, negm, alA);
    if (NT > 1) { VMW(); *(bf16x8*)(V_lds + vws + vst0) = S.st_v0; SWRITE_HK(1); }
    if (CONV_IN_ATTN) { SBAR(); if (VAR == 0) { cv_begin(P, cv, lds, tid); SBAR(); } SLOAD_H(cur, KBASE(2)); SBAR(); if (VAR == 0) { cv_mid(P, cv, cv.b0, cv.b1, cv.pb, lds, tid); SBAR(); } }
    __syncthreads();
#if CONV_IN_ATTN
#define HALF_STEP(PX0, PX1, alX, PY0, PY1, alY, t, KB, KBN, CR0, CR1, CPEND) do { \
        SBAR(); if (VAR == 0) { cv_begin(P, cv, lds, tid); SBAR(); } \
        qkt<KB, VAR>(PX0, PX1, K_lds, r32, hi, S.qn, S.qro, negm); \
        finishSM<VAR>(PY0, PY1, alY, l_reg, pa0, pa1, pa2, pa3); SBAR(); \
        pv_tile<VAR>(o, vrd + vrs, pa0, pa1, pa2, pa3); MASKT(PX0, PX1, (t)); partialSM<false, VAR>(PX0, PX1, m_reg, negm, alX); \
        vrs = VROT(vrs); vws = VROT(vws); SBAR(); \
        if ((t) + 1 < NT) { *(bf16x8*)(V_lds + vws + vst0) = S.st_v0; SWRITE_HK(KBN); } SBAR(); \
        { const int tn_ = (t) + 2 < NT ? (t) + 2 : NT - 1; SLOAD_H(cur, KBASE(tn_)); } SBAR(); \
        if (VAR == 0) { cv_mid(P, cv, CR0, CR1, CPEND, lds, tid); SBAR(); } \
        RESC(alX); __syncthreads(); } while (0)
#else
#define HALF_STEP(PX0, PX1, alX, PY0, PY1, alY, t, KB, KBN, CR0, CR1, CPEND) do { \
        SBAR(); qkt<KB, VAR>(PX0, PX1, K_lds, r32, hi, S.qn, S.qro, negm); \
        finishSM<VAR>(PY0, PY1, alY, l_reg, pa0, pa1, pa2, pa3); SBAR(); \
        if ((t) + 1 < NT) { SLOAD_H(cur, KBASE((t) + 1)); SBAR(); } \
        pv_tile<VAR>(o, vrd + vrs, pa0, pa1, pa2, pa3); MASKT(PX0, PX1, (t)); partialSM<false, VAR>(PX0, PX1, m_reg, negm, alX); \
        vrs = VROT(vrs); vws = VROT(vws); \
        if ((t) + 1 < NT) { VMW(); *(bf16x8*)(V_lds + vws + vst0) = S.st_v0; SWRITE_HK(KBN); } \
        RESC(alX); __syncthreads(); } while (0)
#endif
    for (int t = 1; t + 1 < NT; t += 2) {
        HALF_STEP(pB0, pB1, alB, pA0, pA1, alA, t, 1, 0, cv.a0, cv.a1, cv.pa);
        HALF_STEP(pA0, pA1, alA, pB0, pB1, alB, t + 1, 0, 1, cv.b0, cv.b1, cv.pb);
    }
    SBAR(); qkt<1, VAR>(pB0, pB1, K_lds, r32, hi, S.qn, S.qro, negm); SBAR();
    SLOAD_H(nxt, 0); SBAR();
    QLOAD(nxt);
    SBAR();
    finishSM<VAR>(pA0, pA1, alA, l_reg, pa0, pa1, pa2, pa3); SBAR();
    pv_tile<VAR>(o, vrd + vrs, pa0, pa1, pa2, pa3);
    MASKT(pB0, pB1, NT - 1); partialSM<false, VAR>(pB0, pB1, m_reg, negm, alB); RESC(alB);
    vrs = VROT(vrs);
    finishSM<VAR>(pB0, pB1, alB, l_reg, pa0, pa1, pa2, pa3); SBAR(); pv_tile<VAR>(o, vrd + vrs, pa0, pa1, pa2, pa3);
    SBAR(); SEAM_K0();
    if (hi == 0) li_l[r32] = l_reg; asm volatile("s_waitcnt lgkmcnt(0)" ::: "memory");
    float rli[16];
#pragma unroll
    for (int r = 0; r < 16; ++r) rli[r] = __builtin_amdgcn_rcpf(li_l[crow(r, hi)]);
    { bf16_t* stg = (bf16_t*)(lds + OFF_OST) + wid * 2048;
#pragma unroll
      for (int r = 0; r < 16; ++r) { const int orow = crow(r, hi);
#pragma unroll
          for (int d0 = 0; d0 < 2; ++d0) stg[orow * 64 + d0 * 32 + r32] = (bf16_t)f2bf(o[d0][r] * rli[r]); }
      asm volatile("s_waitcnt lgkmcnt(0)" ::: "memory");
#pragma unroll
      for (int i = 0; i < 4; ++i) { const int row = i * 8 + (lane >> 3), c8 = lane & 7; const u32x4 v = *(const u32x4*)(stg + row * 64 + c8 * 8);
          *(u32x4*)(cur.O + (size_t)(wid * QBLK + row) * 1024 + c8 * 8) = v;
          float s = 0.f;
#pragma unroll
          for (int j = 0; j < 4; ++j) { const float a = __builtin_bit_cast(float, v[j] << 16), b = __builtin_bit_cast(float, v[j] & 0xffff0000u); s += a * a + b * b; }
          s += __shfl_xor(s, 1); s += __shfl_xor(s, 2); s += __shfl_xor(s, 4);
          if (c8 == 0) cur.SSQ[(size_t)(wid * QBLK + row) * 8] = s; } }
    __syncthreads();
#undef RESC
#undef KBASE
#undef MASKT
#undef SEAM_K0
#undef HALF_STEP
#undef VROT
}
#undef VMW
#undef VMWN
#undef KSRC
#undef SLOAD_H
#undef QLOAD
#undef SWRITE_HK
#undef SWRITE_HV
#undef SWRITE_H
#undef KSWZ
#undef SBAR
__device__ __forceinline__ BlockRef block_ref(const Ptrs& P, int bh, int qb) {
    const int b = bh >> 3, h = bh & 7; const size_t r0 = (size_t)b * SEQ + (size_t)qb * QB; BlockRef r;
    r.Q = P.ws + WS_Q + r0 * 1024 + h * 128; r.Kn = P.ws + WS_K + (size_t)b * SEQ * 512 + h * 64; r.KR = P.ws + WS_KR + (size_t)b * SEQ * 64;
    r.V = (const bf16_t*)(P.ws + WS_V) + (size_t)b * SEQ * 512 + h * 64; r.O = (bf16_t*)(P.ws + WS_MIX) + r0 * 1024 + h * 64; r.SSQ = (float*)(P.ws + WS_SSQ) + r0 * 8 + h; r.P0 = qb * QB; return r;
}
template <int VAR = 0>
__device__ __forceinline__ void attn_phase(const Ptrs& P, char* lds) {
    const int G = gridDim.x, c = blockIdx.x; const int vcu = (G % 8 == 0) ? (c % 8) * (G / 8) + c / 8 : c;
    Seam S; Cv cv; cv.a0 = (f32x4){0.f, 0.f, 0.f, 0.f}; cv.a1 = cv.a0; cv.b0 = cv.a0; cv.b1 = cv.a0; cv.next = 0; cv.pa = -1; cv.pb = -1; cv.emit = -1; cv.sb = 0;
    cv.nj = (CONV_IN_ATTN && VAR == 0 && c < CV_UNITS) ? (CV_UNITS - c + G - 1) / G : 0; if (cv.nj > CV_MAXJ) cv.nj = CV_MAXJ;
    if (CONV_IN_ATTN && VAR == 0) { cv_build_table(P, lds, cv.nj > 0 ? cv.nj : 1, tid_opaque()); __syncthreads(); }
    for (int it = vcu; it < 256; it += G) {
        const int bh = it >> 4, x = it & 15;
        BlockRef b0 = block_ref(P, bh, x), b1 = block_ref(P, bh, 31 - x);
        if (VAR != 0) { b0.O = (bf16_t*)(P.ws + WS_TMP) + (b0.O - (bf16_t*)(P.ws + WS_MIX)); b1.O = (bf16_t*)(P.ws + WS_TMP) + (b1.O - (bf16_t*)(P.ws + WS_MIX));
                        b0.SSQ = (float*)(P.ws + WS_TMP + 64 * MiB) + (b0.SSQ - (float*)(P.ws + WS_SSQ)); b1.SSQ = (float*)(P.ws + WS_TMP + 64 * MiB) + (b1.SSQ - (float*)(P.ws + WS_SSQ)); }
        attn_prime(b0, lds, S);
        attn_block<VAR>(P, cv, b0, b1, lds, S);
        attn_block<VAR>(P, cv, b1, b1, lds, S);
    }
    if (CONV_IN_ATTN && VAR == 0) {
        const int tid = tid_opaque();
        while (cv.emit >= 0 || cv.pa >= 0 || cv.pb >= 0 || cv.next < cv.nj) {
            cv_begin(P, cv, lds, tid); cv_mid(P, cv, cv.a0, cv.a1, cv.pa, lds, tid); __syncthreads();
            cv_begin(P, cv, lds, tid); cv_mid(P, cv, cv.b0, cv.b1, cv.pb, lds, tid); __syncthreads();
        }
    }
}
}
typedef float f32x16r __attribute__((ext_vector_type(16)));
__device__ __forceinline__ void router_phase(const Ptrs& P, LAS unsigned char* lds) {
    const int tid = tid_opaque(), lane = tid & 63, w = __builtin_amdgcn_readfirstlane(tid >> 6), i32 = lane & 31, kk = lane >> 5;
    LAS float* RED = (LAS float*)lds;
    LAS float* SSQ = (LAS float*)(lds + 8 * 32 * 33 * 4);
    LAS float* LOG = SSQ + 8 * 32;
    LAS float* RSTD = LOG + 32 * 33;
    LAS int* HIST = (LAS int*)(RSTD + 32);
    LAS int* SELE = HIST + 32;
    LAS int* SELR = SELE + 128;
    LAS float* SELG = (LAS float*)(SELR + 128);
    int* cnt = (int*)(P.ws + WS_CTL) + CW_CNT; int* SLOT = (int*)(P.ws + WS_SLOT); int* LIST = (int*)(P.ws + WS_LIST); float* GLIST = (float*)(P.ws + WS_GLIST);
    float wrv[64];
    { const float* wr = P.w_router + (size_t)(128 * w + 64 * kk) * 32 + i32;
#pragma unroll
      for (int q = 0; q < 64; ++q) wrv[q] = wr[q * 32]; }
    for (int rb = blockIdx.x; rb < T / 32; rb += gridDim.x) {
        const int t0 = rb * 32;
        { u32x4 t[8];
#pragma unroll
          for (int i = 0; i < 4; ++i)
#pragma unroll
              for (int j = 0; j < 2; ++j) t[2 * i + j] = *(const u32x4*)((const bf16_t*)(P.ws + WS_X1) + (size_t)(t0 + 4 * w + i) * 1024 + 8 * (lane + 64 * j));
#pragma unroll
          for (int i = 0; i < 4; ++i)
#pragma unroll
              for (int j = 0; j < 2; ++j) { const int r = 4 * w + i, cb = 2 * (lane + 64 * j); const u32x4 v = t[2 * i + j];
                  const f32x4 lo = {__builtin_bit_cast(float, v.x << 16), __builtin_bit_cast(float, v.x & 0xffff0000u), __builtin_bit_cast(float, v.y << 16), __builtin_bit_cast(float, v.y & 0xffff0000u)};
                  const f32x4 hi = {__builtin_bit_cast(float, v.z << 16), __builtin_bit_cast(float, v.z & 0xffff0000u), __builtin_bit_cast(float, v.w << 16), __builtin_bit_cast(float, v.w & 0xffff0000u)};
                  *(LAS f32x4*)(lds + r * 4096 + ((cb + r) & 255) * 16) = lo; *(LAS f32x4*)(lds + r * 4096 + ((cb + 1 + r) & 255) * 16) = hi; } }
        __syncthreads();
        f32x4 av[16]; float ssq = 0.f;
#pragma unroll
        for (int m = 0; m < 16; ++m) { const int c = 32 * w + 16 * kk + m;
            const f32x4 a = *(const LAS f32x4*)(lds + i32 * 4096 + ((c + i32) & 255) * 16); const f32x4 g = *(const f32x4*)(P.g_ffn + 128 * w + 64 * kk + 4 * m);
            ssq += (a[0] * a[0] + a[1] * a[1]) + (a[2] * a[2] + a[3] * a[3]); av[m] = a * g; }
        __syncthreads();
        f32x16r acc = {};
#pragma unroll
        for (int m = 0; m < 16; ++m) {
#pragma unroll
            for (int j = 0; j < 4; ++j) acc = __builtin_amdgcn_mfma_f32_32x32x2f32(av[m][j], wrv[4 * m + j], acc, 0, 0, 0); }
        ssq += __shfl_xor(ssq, 32);
        if (kk == 0) SSQ[w * 32 + i32] = ssq;
#pragma unroll
        for (int r = 0; r < 16; ++r) RED[(w * 32 + (r & 3) + 8 * (r >> 2) + 4 * kk) * 33 + i32] = acc[r];
        if (tid < 32) HIST[tid] = 0;
        __syncthreads();
        if (tid < 32) { float s = 0.f;
#pragma unroll
            for (int q = 0; q < 8; ++q) s += SSQ[q * 32 + tid];
            RSTD[tid] = 1.f / sqrtf(s * (1.f / 1024.f) + RMS_EPS); }
        __syncthreads();
#pragma unroll
        for (int q = 0; q < 2; ++q) { const int idx = tid + 512 * q, row = idx >> 5, e = idx & 31; float s = 0.f;
#pragma unroll
            for (int p = 0; p < 8; ++p) s += RED[(p * 32 + row) * 33 + e];
            LOG[row * 33 + e] = s * RSTD[row] + P.b_router[e]; }
#if FP8_MOE
        { const float rs = RSTD[i32]; unsigned char* hp = P.ws + WS_H + (size_t)(t0 + i32) * 1024 + 128 * w + 64 * kk;
#pragma unroll
          for (int q = 0; q < 4; ++q) { u32x4 o;
              { const f32x4 v = av[4 * q + 0] * rs; o.x = pk4_fp8(v[0], v[1], v[2], v[3]); } { const f32x4 v = av[4 * q + 1] * rs; o.y = pk4_fp8(v[0], v[1], v[2], v[3]); }
              { const f32x4 v = av[4 * q + 2] * rs; o.z = pk4_fp8(v[0], v[1], v[2], v[3]); } { const f32x4 v = av[4 * q + 3] * rs; o.w = pk4_fp8(v[0], v[1], v[2], v[3]); }
              *(u32x4*)(hp + 16 * q) = o; } }
#else
        { const float rs = RSTD[i32]; bf16_t* hp = (bf16_t*)(P.ws + WS_H) + (size_t)(t0 + i32) * 1024 + 128 * w + 64 * kk;
#pragma unroll
          for (int q = 0; q < 8; ++q) { const f32x4 v0 = av[2 * q] * rs, v1 = av[2 * q + 1] * rs; u32x4 o; o.x = pk2(v0[0], v0[1]); o.y = pk2(v0[2], v0[3]); o.z = pk2(v1[0], v1[1]); o.w = pk2(v1[2], v1[3]); *(u32x4*)(hp + 8 * q) = o; } }
#endif
        __syncthreads();
        if (tid < 32) { const int row = tid; float lv[4]; int li[4]; unsigned used = 0u; float lg[32];
#pragma unroll
            for (int e = 0; e < 32; ++e) lg[e] = LOG[row * 33 + e];
#pragma unroll
            for (int k = 0; k < 4; ++k) { float best = -__builtin_inff(); int bi = 0;
#pragma unroll
                for (int e = 0; e < 32; ++e) { const bool take = !((used >> e) & 1u) && lg[e] > best; best = take ? lg[e] : best; bi = take ? e : bi; }
                lv[k] = best; li[k] = bi; used |= 1u << bi; }
            const float e1 = expf(lv[1] - lv[0]), e2 = expf(lv[2] - lv[0]), e3 = expf(lv[3] - lv[0]); const float inv = 1.f / (1.f + e1 + e2 + e3);
            const float gt[4] = {inv, e1 * inv, e2 * inv, e3 * inv};
            for (int k = 0; k < 4; ++k) { SELE[row * 4 + k] = li[k]; SELG[row * 4 + k] = gt[k]; SELR[row * 4 + k] = atomicAdd((int*)&HIST[li[k]], 1); } }
        __syncthreads();
        if (tid < 32) { const int n = HIST[tid]; HIST[tid] = n > 0 ? atomicAdd(&cnt[tid], n) : 0; }
        __syncthreads();
        if (tid < 128) { const int row = tid >> 2, k = tid & 3, e = SELE[tid], pos = HIST[e] + SELR[tid]; const int t = t0 + row;
            SLOT[t * 4 + k] = e * T + pos; LIST[e * T + pos] = t; GLIST[e * T + pos] = SELG[tid]; }
        __syncthreads();
    }
}
__device__ __forceinline__ void pool_phase(const Ptrs& P, LAS unsigned char* lds) {
    const int tid = tid_opaque(), lane = tid & 63, w = __builtin_amdgcn_readfirstlane(tid >> 6), fr = lane & 15, fq = lane >> 4;
    constexpr int RS = 1040;
    LAS float* PS = (LAS float*)(lds + 64 * RS);
    const bf16_t* U = (const bf16_t*)(P.ws + WS_U);
    const int g = w >> 1, dh = (w & 1) * 64;
    bf16x8 bfr[4][4];
    { const bf16_t* Wt = (const bf16_t*)(P.ws + WS_WPOOL) + (size_t)g * 128 * 128;
#pragma unroll
      for (int ni = 0; ni < 4; ++ni)
#pragma unroll
          for (int ks = 0; ks < 4; ++ks) bfr[ni][ks] = *(const bf16x8*)(Wt + (size_t)(dh + ni * 16 + fr) * 128 + ks * 32 + 8 * fq); }
    f32x4 bias[4], scl[4];
#pragma unroll
    for (int ni = 0; ni < 4; ++ni) { const int c = g * 128 + dh + ni * 16 + 4 * fq; bias[ni] = *(const f32x4*)(P.b_pool + c); scl[ni] = *(const f32x4*)(P.pool_scale + c); }
    for (int tile = blockIdx.x; tile < T / 64; tile += gridDim.x) {
        const int t0 = tile * 64;
        { const int gg = w >> 1, win = 2 << gg, cc = gg * 16 + (lane & 15), r0 = 8 * ((lane >> 4) + 4 * (w & 1)); const int tb = t0 + r0, sb = tb & (SEQ - 1);
          const bf16_t* up = U + (size_t)tb * 512 + cc * 8;
          float sum[8];
#pragma unroll
          for (int j = 0; j < 8; ++j) sum[j] = 0.f;
          for (int k = 1; k < win; ++k) { if (sb - k >= 0) { const bf16x8 u = *(const bf16x8*)(up - (size_t)k * 512);
#pragma unroll
                  for (int j = 0; j < 8; ++j) sum[j] += bf2f((bf16_t)u[j]); } }
#pragma unroll
          for (int i = 0; i < 8; ++i) { const bf16x8 u = *(const bf16x8*)(up + (size_t)i * 512); const int s_ = sb + i; const int n = s_ + 1 < win ? s_ + 1 : win; const float inv = 1.f / (float)n;
              float d[8];
#pragma unroll
              for (int j = 0; j < 8; ++j) { const float uj = bf2f((bf16_t)u[j]); sum[j] += uj; d[j] = sum[j] * inv - uj; }
              u32x4 o; o.x = pk2(d[0], d[1]); o.y = pk2(d[2], d[3]); o.z = pk2(d[4], d[5]); o.w = pk2(d[6], d[7]);
              *(LAS u32x4*)(lds + (r0 + i) * RS + cc * 16) = o;
              if (s_ - win + 1 >= 0) { const bf16x8 ul = *(const bf16x8*)(up + ((long)i - (long)(win - 1)) * 512);
#pragma unroll
                  for (int j = 0; j < 8; ++j) sum[j] -= bf2f((bf16_t)ul[j]); } } }
        __syncthreads();
        f32x4 acc[4][4];
#pragma unroll
        for (int mi = 0; mi < 4; ++mi)
#pragma unroll
            for (int ni = 0; ni < 4; ++ni) acc[mi][ni] = (f32x4){0.f, 0.f, 0.f, 0.f};
#pragma unroll
        for (int ks = 0; ks < 4; ++ks) { bf16x8 a[4];
#pragma unroll
            for (int mi = 0; mi < 4; ++mi) a[mi] = *(const LAS bf16x8*)(lds + (mi * 16 + fr) * RS + (g * 128 + ks * 32 + 8 * fq) * 2);
#pragma unroll
            for (int mi = 0; mi < 4; ++mi)
#pragma unroll
                for (int ni = 0; ni < 4; ++ni) acc[mi][ni] = __builtin_amdgcn_mfma_f32_16x16x32_bf16(bfr[ni][ks], a[mi], acc[mi][ni], 0, 0, 0); }
#pragma unroll
        for (int mi = 0; mi < 4; ++mi) { float s = 0.f;
#pragma unroll
            for (int ni = 0; ni < 4; ++ni) { acc[mi][ni] = (acc[mi][ni] + bias[ni]) * scl[ni]; const f32x4 v = acc[mi][ni]; s += (v[0] * v[0] + v[1] * v[1]) + (v[2] * v[2] + v[3] * v[3]); }
            s += __shfl_xor(s, 16); s += __shfl_xor(s, 32);
            if (fq == 0) PS[(mi * 16 + fr) * 8 + w] = s; }
        __syncthreads();
#pragma unroll
        for (int mi = 0; mi < 4; ++mi) { const int r = mi * 16 + fr; const f32x4 p0 = *(const LAS f32x4*)(PS + r * 8), p1 = *(const LAS f32x4*)(PS + r * 8 + 4);
            const float rstd = 1.f / sqrtf((((p0[0] + p0[1]) + (p0[2] + p0[3])) + ((p1[0] + p1[1]) + (p1[2] + p1[3]))) * (1.f / 512.f) + RMS_EPS);
            bf16_t* mp = (bf16_t*)(P.ws + WS_MIX) + (size_t)(t0 + r) * 1024 + 512 + g * 128 + dh + 4 * fq;
#pragma unroll
            for (int ni = 0; ni < 4; ++ni) { const f32x4 v = acc[mi][ni] * rstd; u32x2 o; o.x = pk2(v[0], v[1]); o.y = pk2(v[2], v[3]); *(u32x2*)(mp + ni * 16) = o; } }
        __syncthreads();
    }
}

#define VB_FOR(vb, NVB) for (int vb = blockIdx.x * 2 + (int)(threadIdx.x >> 8); vb < (NVB); vb += gridDim.x * 2)

__device__ __forceinline__ void nv_gemm_f32(const bf16_t* A, int lda, const bf16_t* Bt, int ldb, float* C, int ldc, int K, int nbx, int nby) {
    const int tid = threadIdx.x & 255, lane = tid & 63, w = tid >> 6, wr = w >> 1, wc = w & 1, fr = lane & 15, fq = lane >> 4;
    VB_FOR(vb, nbx * nby) {
        const int bx = vb % nbx, by = vb / nbx;
        const int row0 = by * 64 + wr * 32, col0 = bx * 128 + wc * 64;
        f32x4 acc[2][4];
#pragma unroll
        for (int i = 0; i < 2; ++i)
#pragma unroll
            for (int j = 0; j < 4; ++j) acc[i][j] = (f32x4){0.f, 0.f, 0.f, 0.f};
        for (int k0 = 0; k0 < K; k0 += 32) {
            bf16x8 a[2], b[4];
#pragma unroll
            for (int i = 0; i < 2; ++i) a[i] = *(const bf16x8*)(A + (size_t)(row0 + i * 16 + fr) * lda + k0 + 8 * fq);
#pragma unroll
            for (int j = 0; j < 4; ++j) b[j] = *(const bf16x8*)(Bt + (size_t)(col0 + j * 16 + fr) * ldb + k0 + 8 * fq);
#pragma unroll
            for (int i = 0; i < 2; ++i)
#pragma unroll
                for (int j = 0; j < 4; ++j) acc[i][j] = __builtin_amdgcn_mfma_f32_16x16x32_bf16(a[i], b[j], acc[i][j], 0, 0, 0);
        }
#pragma unroll
        for (int i = 0; i < 2; ++i)
#pragma unroll
            for (int j = 0; j < 4; ++j)
#pragma unroll
                for (int r = 0; r < 4; ++r) C[(size_t)(row0 + i * 16 + fq * 4 + r) * ldc + col0 + j * 16 + fr] = acc[i][j][r];
    }
}

struct W8Tile { const float* src; unsigned char* dst; int ldw; };
__device__ __forceinline__ W8Tile w8_tile(const Ptrs& P, int r) {
    W8Tile d; const int e = r / 192, q = r % 192;
    if (q < 128) { const int kb = q >> 4, nb = q & 15, n0 = 128 * nb; const int p = nb & 7, dn0 = 256 * p + (nb >= 8 ? 128 : 0);
        d.src = P.w_gu + (size_t)e * 1024 * 2048 + (size_t)(128 * kb) * 2048 + n0; d.ldw = 2048; d.dst = P.ws + WS_WGU + (size_t)e * 2048 * 1024 + (size_t)dn0 * 1024 + 128 * kb; }
    else { const int qq = q - 128, kb = qq >> 3, nb = qq & 7;
        d.src = P.w_down + (size_t)e * 1024 * 1024 + (size_t)(128 * kb) * 1024 + 128 * nb; d.ldw = 1024; d.dst = P.ws + WS_WD + (size_t)e * 1024 * 1024 + (size_t)(128 * nb) * 1024 + 128 * kb; }
    return d;
}
__device__ __forceinline__ void w8_tile_load(const W8Tile& d, f32x4 (&v)[8], int tid) {
    const int kr = tid >> 5, n4 = (tid & 31) * 4;
#pragma unroll
    for (int i = 0; i < 8; ++i) v[i] = __builtin_nontemporal_load((const f32x4*)(d.src + (size_t)(kr + 16 * i) * d.ldw + n4));
}
__device__ __forceinline__ void w8_tile_emit(const W8Tile& d, float* scr, int tid) {
    const int n = tid >> 2, kq = (tid & 3) * 32; const float* q = scr + kq * 132 + ((n + 8 * (tid & 3)) & 127);
    u32x4 o0, o1;
    o0.x = pk4_fp8(q[0 * 132], q[1 * 132], q[2 * 132], q[3 * 132]); o0.y = pk4_fp8(q[4 * 132], q[5 * 132], q[6 * 132], q[7 * 132]);
    o0.z = pk4_fp8(q[8 * 132], q[9 * 132], q[10 * 132], q[11 * 132]); o0.w = pk4_fp8(q[12 * 132], q[13 * 132], q[14 * 132], q[15 * 132]);
    o1.x = pk4_fp8(q[16 * 132], q[17 * 132], q[18 * 132], q[19 * 132]); o1.y = pk4_fp8(q[20 * 132], q[21 * 132], q[22 * 132], q[23 * 132]);
    o1.z = pk4_fp8(q[24 * 132], q[25 * 132], q[26 * 132], q[27 * 132]); o1.w = pk4_fp8(q[28 * 132], q[29 * 132], q[30 * 132], q[31 * 132]);
    unsigned char* dp = d.dst + (size_t)n * 1024 + kq; *(u32x4*)dp = o0; *(u32x4*)(dp + 16) = o1;
}
__device__ __forceinline__ void w8_tile_stage(const f32x4 (&v)[8], float* scr, int tid) {
    const int kr = tid >> 5, n4 = (tid & 31) * 4;
#pragma unroll
    for (int i = 0; i < 8; ++i) { const int k = kr + 16 * i; *(f32x4*)(scr + k * 132 + ((n4 + 8 * (k >> 5)) & 127)) = v[i] * W8_SCALE; }
}
__device__ __forceinline__ void w8_convert_tiles(const Ptrs& P, float* scr) {
    const int tid = tid_opaque(); constexpr int N = 32 * 192; const int G = gridDim.x;
    int it = blockIdx.x; if (it >= N) return;
    W8Tile ta = w8_tile(P, it), tb = ta; f32x4 va[8], vb[8];
    w8_tile_load(ta, va, tid);
    if (it + G < N) { tb = w8_tile(P, it + G); w8_tile_load(tb, vb, tid); }
    for (;;) {
        { w8_tile_stage(va, scr, tid); const W8Tile cur = ta; const int n2 = it + 2 * G;
          if (n2 < N) { ta = w8_tile(P, n2); w8_tile_load(ta, va, tid); }
          __syncthreads(); w8_tile_emit(cur, scr, tid); __syncthreads(); }
        it += G; if (it >= N) break;
        { w8_tile_stage(vb, scr, tid); const W8Tile cur = tb; const int n2 = it + 2 * G;
          if (n2 < N) { tb = w8_tile(P, n2); w8_tile_load(tb, vb, tid); }
          __syncthreads(); w8_tile_emit(cur, scr, tid); __syncthreads(); }
        it += G; if (it >= N) break;
    }
}

#define GW_SETUP const int tid = tid_opaque(), lane = tid & 63, wave = tid >> 6; const int gw = blockIdx.x * NWAVES + wave, NGW = gridDim.x * NWAVES; (void)lane; (void)gw; (void)NGW;
#define GT_FOR(i, N) for (size_t i = (size_t)blockIdx.x * 512 + threadIdx.x; i < (size_t)(N); i += (size_t)gridDim.x * 512)

#ifndef PROBE_PHASE
#define PROBE_PHASE (-1)
#endif
#define TPP(k, var) do { if ((PROBE_PHASE) == (k)) { __syncthreads(); var = __builtin_amdgcn_s_memrealtime(); } } while (0)
__device__ __forceinline__ void ph_prologue(const Ptrs& P, float* ldsf, unsigned long long& tq0, unsigned long long& tq1) {
    GW_SETUP
    TPP(10, tq0);
    float* scr = ldsf + wave * (64 * 33);
#if FP8_MOE
    for (int it = gw; it < IT_TOTAL - IT_GU - IT_DN; it += NGW) prologue_item(P, it, scr, lane);
    TPP(10, tq1); TPP(11, tq0);
#if !CONV_IN_ATTN
    __syncthreads();
    w8_convert_tiles(P, ldsf);
#endif
    TPP(11, tq1); TPP(12, tq0);
#else
    for (int it = gw; it < IT_TOTAL; it += NGW) prologue_item(P, it, scr, lane);
#endif
    { bf16_t* w = (bf16_t*)(P.ws + WS_WIN) + (size_t)DINP * 1024; const int n8 = (1024 - DINP) * 1024 / 8;
      GT_FOR(i, n8) ((u32x4*)w)[i] = (u32x4){0u, 0u, 0u, 0u}; }
    for (int m = gw; m < T; m += 2 * NGW) {
        const int m2 = m + NGW; const bool two = m2 < T;
        const f32x4* xa = (const f32x4*)(P.x + (size_t)m * D) + lane; const f32x4* xb = (const f32x4*)(P.x + (size_t)(two ? m2 : m) * D) + lane; const f32x4* gr = (const f32x4*)P.g_attn + lane;
        f32x4 a[4], b[4]; float sa = 0.f, sb = 0.f;
#pragma unroll
        for (int j = 0; j < 4; ++j) { a[j] = __builtin_nontemporal_load(xa + 64 * j); b[j] = __builtin_nontemporal_load(xb + 64 * j); }
#pragma unroll
        for (int j = 0; j < 4; ++j) { sa += (a[j].x * a[j].x + a[j].y * a[j].y) + (a[j].z * a[j].z + a[j].w * a[j].w); sb += (b[j].x * b[j].x + b[j].y * b[j].y) + (b[j].z * b[j].z + b[j].w * b[j].w); }
        const float ra = 1.f / sqrtf(wave_sum(sa) * (1.f / 1024.f) + RMS_EPS), rb = 1.f / sqrtf(wave_sum(sb) * (1.f / 1024.f) + RMS_EPS);
        u32x2* oa = (u32x2*)((bf16_t*)(P.ws + WS_XN) + (size_t)m * D) + lane; u32x2* ob = (u32x2*)((bf16_t*)(P.ws + WS_XN) + (size_t)m2 * D) + lane;
#pragma unroll
        for (int j = 0; j < 4; ++j) { const f32x4 gg = gr[64 * j]; u32x2 w; w.x = pk2(a[j].x * ra * gg.x, a[j].y * ra * gg.y); w.y = pk2(a[j].z * ra * gg.z, a[j].w * ra * gg.w); oa[64 * j] = w;
            if (two) { u32x2 w2; w2.x = pk2(b[j].x * rb * gg.x, b[j].y * rb * gg.y); w2.y = pk2(b[j].z * rb * gg.z, b[j].w * rb * gg.w); ob[64 * j] = w2; } }
    }
    TPP(12, tq1); TPP(13, tq0);
    { float* C = (float*)(P.ws + WS_COS); float* S = (float*)(P.ws + WS_SIN);
      GT_FOR(i, T * 16) { const int t = (int)(i >> 4), j = (int)(i & 15);
          const float inv = (float)pow(10000.0, -(double)j / 16.0); const float ang = (float)P.pos[t] * inv;
          C[i] = (float)cos((double)ang); S[i] = (float)sin((double)ang); } }
    TPP(13, tq1);
}
__device__ __forceinline__ void ph_e1(const Ptrs& P) {
    GW_SETUP
    const float* PROJ = (const float*)(P.ws + WS_TMP);
    const float* COS = (const float*)(P.ws + WS_COS); const float* SIN = (const float*)(P.ws + WS_SIN);
    for (int t = gw; t < T; t += NGW) {
        const float* pr = PROJ + (size_t)t * 1024;
        bf16_t* u = (bf16_t*)(P.ws + WS_U) + (size_t)t * 512;
        for (int c = lane; c < 512; c += 64) u[c] = (bf16_t)f2bf(pr[c]);
        { float v[4]; float s = 0.f; for (int j = 0; j < 4; ++j) { v[j] = pr[512 + lane + 64 * j]; s += v[j] * v[j]; }
          const float rstd = 1.f / sqrtf(wave_sum(s) * (1.f / 256.f) + RMS_EPS);
          bf16_t* q = (bf16_t*)(P.ws + WS_QN) + (size_t)t * 256;
          for (int j = 0; j < 4; ++j) q[lane + 64 * j] = (bf16_t)f2bf(v[j] * rstd * P.g_q_a[lane + 64 * j]); }
        { float v[2]; float s = 0.f; for (int j = 0; j < 2; ++j) { v[j] = pr[768 + lane + 64 * j]; s += v[j] * v[j]; }
          const float rstd = 1.f / sqrtf(wave_sum(s) * (1.f / 128.f) + RMS_EPS);
          bf16_t* q = (bf16_t*)(P.ws + WS_KVN) + (size_t)t * 128;
          for (int j = 0; j < 2; ++j) q[lane + 64 * j] = (bf16_t)f2bf(v[j] * rstd * P.g_kv_a[lane + 64 * j]); }
        if (lane < 16) { const float x1 = pr[896 + lane], x2 = pr[896 + 16 + lane]; const float c = COS[t * 16 + lane], s = SIN[t * 16 + lane];
          bf16_t* kr = (bf16_t*)(P.ws + WS_KR) + (size_t)t * 32; kr[lane] = (bf16_t)f2bf(x1 * c - x2 * s); kr[16 + lane] = (bf16_t)f2bf(x2 * c + x1 * s); }
    }
}
__device__ __forceinline__ void ph_e2q(const Ptrs& P) {
    const float* TMP = (const float*)(P.ws + WS_TMP); const float* COS = (const float*)(P.ws + WS_COS); const float* SIN = (const float*)(P.ws + WS_SIN);
    bf16_t* Q = (bf16_t*)(P.ws + WS_Q);
    GT_FOR(i, (size_t)T * 768) {
        const int t = (int)(i / 768), c = (int)(i % 768), h = c / 96, d = c % 96; float v;
        if (d < 64) v = TMP[i];
        else { const int j = (d - 64) & 15; const float x1 = TMP[(size_t)t * 768 + h * 96 + 64 + j], x2 = TMP[(size_t)t * 768 + h * 96 + 80 + j]; const float cc = COS[t * 16 + j], ss = SIN[t * 16 + j];
               v = (d < 80) ? (x1 * cc - x2 * ss) : (x2 * cc + x1 * ss); }
        Q[i] = (bf16_t)f2bf(v * QSCALE);
    }
}
__device__ __forceinline__ void ph_e2kv(const Ptrs& P) {
    const float* TMP = (const float*)(P.ws + WS_TMP) + (size_t)T * 1024;
    bf16_t* K = (bf16_t*)(P.ws + WS_K); bf16_t* V = (bf16_t*)(P.ws + WS_V);
    GT_FOR(i, (size_t)T * 512) {
        const int t = (int)(i / 512), c = (int)(i % 512), h = c / 64, d = c % 64;
        K[i] = (bf16_t)f2bf(TMP[(size_t)t * 1024 + h * 128 + d]);
        V[i] = (bf16_t)f2bf(TMP[(size_t)t * 1024 + h * 128 + 64 + d]);
    }
}
__device__ __forceinline__ void ph_pooldiff(const Ptrs& P) {
    const bf16_t* U = (const bf16_t*)(P.ws + WS_U); bf16_t* DIFF = (bf16_t*)(P.ws + WS_H);
    GT_FOR(i, (size_t)T * 512) {
        const int t = (int)(i / 512), c = (int)(i % 512), g = c / 128, s = t % SEQ, w = 2 << g; const int n = s + 1 < w ? s + 1 : w;
        float sum = 0.f; for (int j = 0; j < n; ++j) sum += bf2f(U[(size_t)(t - j) * 512 + c]);
        DIFF[i] = (bf16_t)f2bf(sum / (float)n - bf2f(U[i]));
    }
}
__device__ __forceinline__ void ph_epool(const Ptrs& P, const float* TP) {
    GW_SETUP
    for (int t = gw; t < T; t += NGW) {
        float v[8]; float s = 0.f;
        for (int j = 0; j < 8; ++j) { const int c = lane + 64 * j; v[j] = (TP[(size_t)t * 512 + c] + P.b_pool[c]) * P.pool_scale[c]; s += v[j] * v[j]; }
        const float rstd = 1.f / sqrtf(wave_sum(s) * (1.f / 512.f) + RMS_EPS);
        bf16_t* m = (bf16_t*)(P.ws + WS_MIX) + (size_t)t * 1024 + 512;
        for (int j = 0; j < 8; ++j) m[lane + 64 * j] = (bf16_t)f2bf(v[j] * rstd);
    }
}
__device__ __forceinline__ void ph_attn_naive(const Ptrs& P, float* ldsf) {
    GW_SETUP
    float* qs = ldsf + wave * 96;
    const bf16_t* Q = (const bf16_t*)(P.ws + WS_Q); const bf16_t* K = (const bf16_t*)(P.ws + WS_K); const bf16_t* V = (const bf16_t*)(P.ws + WS_V); const bf16_t* KRp = (const bf16_t*)(P.ws + WS_KR);
    bf16_t* MIX = (bf16_t*)(P.ws + WS_MIX); float* SSQ = (float*)(P.ws + WS_SSQ);
    for (int item = gw; item < T * 8; item += NGW) {
        const int t = item >> 3, h = item & 7, b = t / SEQ, s = t % SEQ;
        for (int d = lane; d < 96; d += 64) qs[d] = bf2f(Q[(size_t)t * 768 + h * 96 + d]);
        asm volatile("s_waitcnt lgkmcnt(0)" ::: "memory");
        float m = -1e30f, l = 0.f, o = 0.f;
        const int ntile = s / 64 + 1;
        for (int kt = 0; kt < ntile; ++kt) {
            const int key = kt * 64 + lane; const size_t krow = (size_t)(b * SEQ + key);
            float sc = -__builtin_inff();
            if (key <= s) { float a = 0.f;
                for (int d8 = 0; d8 < 12; ++d8) { const bf16x8 kv = d8 < 8 ? *(const bf16x8*)(K + krow * 512 + h * 64 + d8 * 8) : *(const bf16x8*)(KRp + krow * 32 + (d8 - 8) * 8);
#pragma unroll
                    for (int j = 0; j < 8; ++j) a += qs[d8 * 8 + j] * bf2f((bf16_t)kv[j]); }
                sc = a; }
            const float mn = fmaxf(m, wave_max(sc)); const float alpha = exp2f(m - mn); const float p = exp2f(sc - mn);
            const float pb = bf2f((bf16_t)f2bf(p));
            l = l * alpha + wave_sum(pb); o *= alpha; m = mn;
            const int nk = (kt == ntile - 1) ? (s - kt * 64 + 1) : 64;
            for (int j = 0; j < nk; ++j) { const float pj = __shfl(pb, j); o += pj * bf2f(V[(size_t)(b * SEQ + kt * 64 + j) * 512 + h * 64 + lane]); }
        }
        const float ov = o / l;
        MIX[(size_t)t * 1024 + h * 64 + lane] = (bf16_t)f2bf(ov);
        const float ss = wave_sum(ov * ov);
        if (lane == 0) SSQ[t * 8 + h] = ss;
        asm volatile("s_waitcnt lgkmcnt(0)" ::: "memory");
    }
}
__device__ __forceinline__ void ph_e4(const Ptrs& P) {
    const float* T1 = (const float*)(P.ws + WS_TMP); const float* T2 = T1 + (size_t)T * 1024; const float* SSQ = (const float*)(P.ws + WS_SSQ);
    GT_FOR(i, (size_t)T * 1024) {
        const int t = (int)(i >> 10); float s = 0.f; for (int h = 0; h < 8; ++h) s += SSQ[t * 8 + h];
        const float sa = 1.f / sqrtf(s * (1.f / 512.f) + RMS_EPS);
        P.out[i] = P.x[i] + sa * T1[i] + T2[i];
    }
}
__device__ __forceinline__ void ph_router(const Ptrs& P, float* ldsf) {
    GW_SETUP
    float* hs = ldsf + wave * 1024;
    int* cnt = (int*)(P.ws + WS_CTL) + CW_CNT; int* SLOT = (int*)(P.ws + WS_SLOT); int* LIST = (int*)(P.ws + WS_LIST); float* GLIST = (float*)(P.ws + WS_GLIST);
    for (int t = gw; t < T; t += NGW) {
        const f32x4* xr = (const f32x4*)(P.out + (size_t)t * 1024) + lane; const f32x4* gr = (const f32x4*)P.g_ffn + lane;
        f32x4 v[4]; float s = 0.f;
        for (int j = 0; j < 4; ++j) { v[j] = xr[64 * j]; s += (v[j].x * v[j].x + v[j].y * v[j].y) + (v[j].z * v[j].z + v[j].w * v[j].w); }
        const float rstd = 1.f / sqrtf(wave_sum(s) * (1.f / 1024.f) + RMS_EPS);
        u32x2* ho = (u32x2*)((bf16_t*)(P.ws + WS_H) + (size_t)t * 1024) + lane;
        for (int j = 0; j < 4; ++j) { const f32x4 gg = gr[64 * j]; f32x4 hv = {v[j].x * rstd * gg.x, v[j].y * rstd * gg.y, v[j].z * rstd * gg.z, v[j].w * rstd * gg.w};
            ((f32x4*)hs)[lane + 64 * j] = hv; u32x2 w; w.x = pk2(hv.x, hv.y); w.y = pk2(hv.z, hv.w); ho[64 * j] = w; }
        asm volatile("s_waitcnt lgkmcnt(0)" ::: "memory");
        const int e = lane & 31, half = lane >> 5; float a = 0.f;
        for (int c = half * 512; c < half * 512 + 512; ++c) a += hs[c] * P.w_router[c * 32 + e];
        a += __shfl_xor(a, 32); a += P.b_router[e];
        float lv[4]; int li[4]; unsigned used = 0u;
        for (int k = 0; k < 4; ++k) { float best = -__builtin_inff(); int bi = 0;
            for (int j = 0; j < 32; ++j) { const float x = __shfl(a, j); if (!((used >> j) & 1u) && x > best) { best = x; bi = j; } }
            lv[k] = best; li[k] = bi; used |= 1u << bi; }
        const float e1 = expf(lv[1] - lv[0]), e2 = expf(lv[2] - lv[0]), e3 = expf(lv[3] - lv[0]); const float inv = 1.f / (1.f + e1 + e2 + e3);
        if (lane < 4) { const int ex = lane == 0 ? li[0] : lane == 1 ? li[1] : lane == 2 ? li[2] : li[3]; const float gt = (lane == 0 ? 1.f : lane == 1 ? e1 : lane == 2 ? e2 : e3) * inv;
            const int pos = atomicAdd(&cnt[ex], 1); SLOT[t * 4 + lane] = ex * T + pos; LIST[ex * T + pos] = t; GLIST[ex * T + pos] = gt; }
        asm volatile("s_waitcnt lgkmcnt(0)" ::: "memory");
    }
}
__device__ __forceinline__ int slot_base(const int* cnt, int e) { int s = 0; for (int i = 0; i < e; ++i) s += (cnt[i] + 255) & ~255; return s; }
__device__ __forceinline__ void ph_moe1_naive(const Ptrs& P) {
    const int* cnt = (const int*)(P.ws + WS_CTL) + CW_CNT;
    const int tid = threadIdx.x & 255, lane = tid & 63, w = tid >> 6, wr = w >> 1, wc = w & 1, fr = lane & 15, fq = lane >> 4;
    const bf16_t* H = (const bf16_t*)(P.ws + WS_H); bf16_t* ACT = (bf16_t*)(P.ws + WS_ACT);
    VB_FOR(vb, 16 * 256 * 32) {
        const int bx = vb & 15, by = (vb >> 4) & 255, e = vb >> 12; const int n = cnt[e], m0 = by * 64; if (m0 >= n) continue;
        const int* LIST = (const int*)(P.ws + WS_LIST) + (size_t)e * T;
        const bf16_t* W = (const bf16_t*)(P.ws + WS_WGU) + (size_t)e * 2048 * 1024;
        const int ca0 = bx * 64 + wc * 32; const int p = ca0 >> 7, r0 = ca0 & 127;
        int tok[2]; for (int i = 0; i < 2; ++i) { int m = m0 + wr * 32 + i * 16 + fr; if (m >= n) m = 0; tok[i] = LIST[m]; }
        f32x4 ag[2][2], au[2][2];
        for (int i = 0; i < 2; ++i) for (int j = 0; j < 2; ++j) { ag[i][j] = (f32x4){0.f, 0.f, 0.f, 0.f}; au[i][j] = (f32x4){0.f, 0.f, 0.f, 0.f}; }
        for (int k0 = 0; k0 < 1024; k0 += 32) {
            bf16x8 a[2], bg[2], bu[2];
            for (int i = 0; i < 2; ++i) a[i] = *(const bf16x8*)(H + (size_t)tok[i] * 1024 + k0 + 8 * fq);
            for (int j = 0; j < 2; ++j) { bg[j] = *(const bf16x8*)(W + (size_t)(256 * p + r0 + j * 16 + fr) * 1024 + k0 + 8 * fq); bu[j] = *(const bf16x8*)(W + (size_t)(256 * p + 128 + r0 + j * 16 + fr) * 1024 + k0 + 8 * fq); }
            for (int i = 0; i < 2; ++i) for (int j = 0; j < 2; ++j) { ag[i][j] = __builtin_amdgcn_mfma_f32_16x16x32_bf16(a[i], bg[j], ag[i][j], 0, 0, 0); au[i][j] = __builtin_amdgcn_mfma_f32_16x16x32_bf16(a[i], bu[j], au[i][j], 0, 0, 0); }
        }
        const int sb = slot_base(cnt, e);
        for (int i = 0; i < 2; ++i) for (int j = 0; j < 2; ++j) for (int r = 0; r < 4; ++r) {
            const int m = m0 + wr * 32 + i * 16 + fq * 4 + r, c = ca0 + j * 16 + fr; if (m >= n) continue;
            float g = ag[i][j][r] + P.b_gu[e * 2048 + c], u = au[i][j][r] + P.b_gu[e * 2048 + 1024 + c];
            g = fminf(g, 7.f); u = fminf(fmaxf(u, -7.f), 7.f);
            const float act = g * (1.f / (1.f + expf(-1.702f * g))) * (u + 1.f);
            ACT[(size_t)(sb + m) * 1024 + c] = (bf16_t)f2bf(act);
        }
    }
}
__device__ __forceinline__ void ph_moe2_naive(const Ptrs& P) {
    const int* cnt = (const int*)(P.ws + WS_CTL) + CW_CNT;
    const int tid = threadIdx.x & 255, lane = tid & 63, w = tid >> 6, wr = w >> 1, wc = w & 1, fr = lane & 15, fq = lane >> 4;
    VB_FOR(vb, 8 * 256 * 32) {
        const int bx = vb & 7, by = (vb >> 3) & 255, e = vb >> 11; const int n = cnt[e], m0 = by * 64; if (m0 >= n) continue;
        const int sb = slot_base(cnt, e); const bf16_t* ACT = (const bf16_t*)(P.ws + WS_ACT) + (size_t)sb * 1024; bf16_t* Y = (bf16_t*)(P.ws + WS_Y) + (size_t)sb * 1024;
        const bf16_t* W = (const bf16_t*)(P.ws + WS_WD) + (size_t)e * 1024 * 1024; const float* GL = (const float*)(P.ws + WS_GLIST) + (size_t)e * T;
        const int col0 = bx * 128 + wc * 64, row0 = m0 + wr * 32;
        f32x4 acc[2][4]; for (int i = 0; i < 2; ++i) for (int j = 0; j < 4; ++j) acc[i][j] = (f32x4){0.f, 0.f, 0.f, 0.f};
        for (int k0 = 0; k0 < 1024; k0 += 32) {
            bf16x8 a[2], b[4];
            for (int i = 0; i < 2; ++i) { int m = row0 + i * 16 + fr; if (m >= n) m = 0; a[i] = *(const bf16x8*)(ACT + (size_t)m * 1024 + k0 + 8 * fq); }
            for (int j = 0; j < 4; ++j) b[j] = *(const bf16x8*)(W + (size_t)(col0 + j * 16 + fr) * 1024 + k0 + 8 * fq);
            for (int i = 0; i < 2; ++i) for (int j = 0; j < 4; ++j) acc[i][j] = __builtin_amdgcn_mfma_f32_16x16x32_bf16(a[i], b[j], acc[i][j], 0, 0, 0);
        }
        for (int i = 0; i < 2; ++i) for (int j = 0; j < 4; ++j) for (int r = 0; r < 4; ++r) {
            const int m = row0 + i * 16 + fq * 4 + r, c = col0 + j * 16 + fr; if (m >= n) continue;
            Y[(size_t)m * 1024 + c] = (bf16_t)f2bf((acc[i][j][r] + P.b_down[e * 1024 + c]) * GL[m]);
        }
    }
}
__device__ __forceinline__ void ph_final(const Ptrs& P, int* sbase) {
    GW_SETUP
    const int* cnt = (const int*)(P.ws + WS_CTL) + CW_CNT; const int* SLOT = (const int*)(P.ws + WS_SLOT); const bf16_t* Y = (const bf16_t*)(P.ws + WS_Y);
    if (tid < 32) sbase[tid] = slot_base(cnt, tid);
    __syncthreads();
#if FP8_MOE
    const unsigned char* Y8 = (const unsigned char*)Y;
    f32x4 gg[4]; { const f32x4* gr = (const f32x4*)P.g_final + lane; for (int j = 0; j < 4; ++j) gg[j] = gr[64 * j]; }
    for (int c0 = 0; (long)gw + (long)c0 * NGW < T; c0 += 8) {
        int ro = 0;
        { long t = (long)gw + (long)(c0 + ((lane & 31) >> 2)) * NGW; if (t > T - 1) t = T - 1; const int sl = SLOT[t * 4 + (lane & 3)]; const int e = sl / T, pos = sl % T; ro = sbase[e] + pos; }
        u32x2 xb[2][4]; unsigned yb[2][16];
#define FIN_ISSUE(i) do { long t_ = (long)gw + (long)(c0 + (i)) * NGW; if (t_ > T - 1) t_ = T - 1; \
            const u32x2* x1r = (const u32x2*)((const bf16_t*)(P.ws + WS_X1) + (size_t)t_ * 1024) + lane; \
            _Pragma("unroll") for (int j = 0; j < 4; ++j) xb[(i) & 1][j] = __builtin_nontemporal_load(x1r + 64 * j); \
            _Pragma("unroll") for (int k = 0; k < 4; ++k) { const int row_ = __builtin_amdgcn_readlane(ro, 4 * (i) + k); const unsigned* yr = (const unsigned*)(Y8 + (size_t)row_ * 1024) + lane; \
                _Pragma("unroll") for (int j = 0; j < 4; ++j) yb[(i) & 1][4 * k + j] = __builtin_nontemporal_load(yr + 64 * j); } } while (0)
        FIN_ISSUE(0);
#pragma unroll
        for (int i = 0; i < 8; ++i) {
            if (i + 1 < 8) FIN_ISSUE(i + 1);
            const long t = (long)gw + (long)(c0 + i) * NGW;
            f32x4 v[4];
#pragma unroll
            for (int j = 0; j < 4; ++j) { const u32x2 w = xb[i & 1][j]; f32x4 ya = {0.f, 0.f, 0.f, 0.f};
#pragma unroll
                for (int k = 0; k < 4; ++k) { const unsigned y = yb[i & 1][4 * k + j]; const auto lo = __builtin_amdgcn_cvt_pk_f32_fp8((int)y, false), hi2 = __builtin_amdgcn_cvt_pk_f32_fp8((int)y, true);
                    ya.x += lo[0]; ya.y += lo[1]; ya.z += hi2[0]; ya.w += hi2[1]; }
                v[j] = (f32x4){__builtin_bit_cast(float, w.x << 16), __builtin_bit_cast(float, w.x & 0xffff0000u), __builtin_bit_cast(float, w.y << 16), __builtin_bit_cast(float, w.y & 0xffff0000u)} + ya * (1.f / 16.f); }
            float s = 0.f;
#pragma unroll
            for (int j = 0; j < 4; ++j) s += (v[j].x * v[j].x + v[j].y * v[j].y) + (v[j].z * v[j].z + v[j].w * v[j].w);
            const float rstd = 1.f / sqrtf(wave_sum(s) * (1.f / 1024.f) + RMS_EPS);
            if (t < T) { f32x4* xr = (f32x4*)(P.out + (size_t)t * 1024) + lane;
#pragma unroll
                for (int j = 0; j < 4; ++j) __builtin_nontemporal_store((f32x4){v[j].x * rstd * gg[j].x, v[j].y * rstd * gg[j].y, v[j].z * rstd * gg[j].z, v[j].w * rstd * gg[j].w}, xr + 64 * j); }
        }
#undef FIN_ISSUE
    }
#else
    for (int t = gw; t < T; t += NGW) {
        f32x4* xr = (f32x4*)(P.out + (size_t)t * 1024) + lane; const f32x4* gr = (const f32x4*)P.g_final + lane;
        f32x4 v[4]; { const u32x2* x1r = (const u32x2*)((const bf16_t*)(P.ws + WS_X1) + (size_t)t * 1024) + lane;
          for (int j = 0; j < 4; ++j) { const u32x2 w = __builtin_nontemporal_load(x1r + 64 * j); v[j] = (f32x4){__builtin_bit_cast(float, w.x << 16), __builtin_bit_cast(float, w.x & 0xffff0000u), __builtin_bit_cast(float, w.y << 16), __builtin_bit_cast(float, w.y & 0xffff0000u)}; } }
        for (int k = 0; k < 4; ++k) { const int sl = SLOT[t * 4 + k]; const int e = sl / T, pos = sl % T; const u32x2* yr = (const u32x2*)(Y + (size_t)(sbase[e] + pos) * 1024) + lane;
            for (int j = 0; j < 4; ++j) { const u32x2 w = yr[64 * j]; v[j].x += __builtin_bit_cast(float, w.x << 16); v[j].y += __builtin_bit_cast(float, w.x & 0xffff0000u); v[j].z += __builtin_bit_cast(float, w.y << 16); v[j].w += __builtin_bit_cast(float, w.y & 0xffff0000u); } }
        float s = 0.f; for (int j = 0; j < 4; ++j) s += (v[j].x * v[j].x + v[j].y * v[j].y) + (v[j].z * v[j].z + v[j].w * v[j].w);
        const float rstd = 1.f / sqrtf(wave_sum(s) * (1.f / 1024.f) + RMS_EPS);
        for (int j = 0; j < 4; ++j) { const f32x4 gg = gr[64 * j]; __builtin_nontemporal_store((f32x4){v[j].x * rstd * gg.x, v[j].y * rstd * gg.y, v[j].z * rstd * gg.z, v[j].w * rstd * gg.w}, xr + 64 * j); }
    }
#endif
}

__global__ void __launch_bounds__(NWAVES * 64, 2) mega_fwd(Ptrs P) {
    extern __shared__ __attribute__((aligned(16))) unsigned char lds[];
    const int tid = threadIdx.x;
    for (int u = tid; u < (LDS_BYTES - LDSCTL_OFF) / 4; u += NWAVES * 64) ((LAS unsigned*)((LAS unsigned char*)lds + LDSCTL_OFF))[u] = 0u;
    __syncthreads();
    unsigned* ctl = (unsigned*)(P.ws + WS_CTL);
    XcdBarrier bar = xcd_barrier_post(ctl + CW_BAR, (volatile LAS unsigned*)((LAS unsigned char*)lds + MISC_OFF) + 8);
    float* ldsf = (float*)lds;
    float* TMP = (float*)(P.ws + WS_TMP);
    unsigned char* ws = P.ws;
#define GRID_BAR() xcd_barrier(bar)
#ifndef PROBE_PHASE
#define PROBE_PHASE (-1)
#endif
    unsigned long long tp0 = 0ull, tp1 = 0ull; (void)tp0; (void)tp1;
#define TP_BEGIN(k) do { if ((PROBE_PHASE) == (k)) tp0 = __builtin_amdgcn_s_memrealtime(); } while (0)
#define TP_END(k) do { if ((PROBE_PHASE) == (k)) tp1 = __builtin_amdgcn_s_memrealtime(); } while (0)
#ifndef PROBE_REP
#define PROBE_REP (-1)
#endif
#if PROBE_REP >= 0
#define REPS(k) int _reps##k = 1 + ((PROBE_REP) == (k) ? 1 : 0); asm volatile("" : "+s"(_reps##k)); for (int _r = 0; _r < _reps##k; ++_r)
#else
#define REPS(k)
#endif
    TP_BEGIN(9); TP_BEGIN(0); { REPS(0) { ph_prologue(P, ldsf, tp0, tp1); GRID_BAR(); } } TP_END(0);
    LAS unsigned char* L = (LAS unsigned char*)lds; const int G = gridDim.x, c = blockIdx.x;
    TP_BEGIN(1);
#if FAST_INPROJ
    { REPS(1) {
    { pg8::DenseOrder S; S.init(ws + WS_XN, ws + WS_WIN, T, 1024, 1024, G, c);
      pg8::EpiInProj E{(bf16_t*)(ws + WS_U), (bf16_t*)(ws + WS_QN), (bf16_t*)(ws + WS_KVN), (bf16_t*)(ws + WS_KR), P.g_q_a, P.g_kv_a, (const float*)(ws + WS_COS), (const float*)(ws + WS_SIN)};
      pg8::gemm_phase<pg8::EpiInProj, pg8::DenseOrder, false, false>(L, 1024, S, E); }
    GRID_BAR(); } }
#else
    nv_gemm_f32((const bf16_t*)(ws + WS_XN), 1024, (const bf16_t*)(ws + WS_WIN), 1024, TMP, 1024, 1024, 8, T / 64); GRID_BAR();
    ph_e1(P); GRID_BAR();
#endif
    TP_END(1); TP_BEGIN(2);
#if FAST_QKV
    { REPS(2) {
#ifndef NO_QB
    TP_BEGIN(20);
    { pg8::DenseOrder S; S.init(ws + WS_QN, ws + WS_WQB, T, 768, 256, G, c);
      pg8::EpiQ E{ws + WS_Q, (const float*)(ws + WS_COS), (const float*)(ws + WS_SIN)};
      pg8::gemm_phase<pg8::EpiQ, pg8::DenseOrder, true, false>(L, 256, S, E); }
    TP_END(20); TP_BEGIN(21);
#endif
#ifndef NO_KVB
    { pg8::DenseOrder S; S.init(ws + WS_KVN, ws + WS_WKVB, T, 1024, 128, G, c);
      pg8::EpiKV E{ws + WS_K, (bf16_t*)(ws + WS_V)};
      pg8::gemm_phase<pg8::EpiKV, pg8::DenseOrder, true, false>(L, 128, S, E); }
    TP_END(21); TP_BEGIN(22);
#endif
#if FAST_POOL
    pool_phase(P, L);
    TP_END(22);
#else
    ph_pooldiff(P);
#endif
    GRID_BAR(); } }
#else
    nv_gemm_f32((const bf16_t*)(ws + WS_QN), 256, (const bf16_t*)(ws + WS_WQB), 256, TMP, 768, 256, 6, T / 64);
    nv_gemm_f32((const bf16_t*)(ws + WS_KVN), 128, (const bf16_t*)(ws + WS_WKVB), 128, TMP + (size_t)T * 1024, 1024, 128, 8, T / 64);
    ph_pooldiff(P); GRID_BAR();
    ph_e2q(P); ph_e2kv(P);
#endif
#if !(FAST_POOL && FAST_QKV)
    for (int g = 0; g < 4; ++g)
        nv_gemm_f32((const bf16_t*)(ws + WS_H) + g * 128, 512, (const bf16_t*)(ws + WS_WPOOL) + (size_t)g * 128 * 128, 128, (float*)(ws + WS_ACT) + g * 128, 512, 128, 1, T / 64);
    GRID_BAR();
    ph_epool(P, (const float*)(ws + WS_ACT));
#endif
    TP_END(2); TP_BEGIN(3);
#if FAST_ATTN
    { REPS(3) { att::attn_phase<0>(P, (char*)lds); GRID_BAR(); } }
#if PROBE_PHASE == 30
    TP_BEGIN(30); att::attn_phase<0>(P, (char*)lds); GRID_BAR(); TP_END(30);
#elif PROBE_PHASE == 31
    TP_BEGIN(31); att::attn_phase<1>(P, (char*)lds); GRID_BAR(); TP_END(31);
#elif PROBE_PHASE == 32
    TP_BEGIN(32); att::attn_phase<2>(P, (char*)lds); GRID_BAR(); TP_END(32);
#endif
#else
    ph_attn_naive(P, ldsf); GRID_BAR();
#endif
    TP_END(3); TP_BEGIN(4);
#if FAST_WOUT
    { REPS(4) {
    { pg8::DenseOrder S; S.init(ws + WS_MIX, ws + WS_WOUT, T, 1024, 1024, G, c);
      pg8::EpiOut E{P.x, (bf16_t*)(ws + WS_X1), (const float*)(ws + WS_SSQ), SA_OFF};
      pg8::gemm_phase<pg8::EpiOut, pg8::DenseOrder, false, false>(L, 1024, S, E); }
    GRID_BAR(); } }
#else
    nv_gemm_f32((const bf16_t*)(ws + WS_MIX), 1024, (const bf16_t*)(ws + WS_WOUT), 1024, TMP, 1024, 512, 8, T / 64);
    nv_gemm_f32((const bf16_t*)(ws + WS_MIX) + 512, 1024, (const bf16_t*)(ws + WS_WOUT) + 512, 1024, TMP + (size_t)T * 1024, 1024, 512, 8, T / 64);
    GRID_BAR();
    ph_e4(P); GRID_BAR();
#endif
    TP_END(4); TP_BEGIN(5);
#if FAST_ROUTER
    router_phase(P, L); GRID_BAR();
#else
    ph_router(P, ldsf); GRID_BAR();
#endif
    TP_END(5); TP_BEGIN(6);
#if FAST_MOE
    { REPS(6) {
#if FP8_MOE
    { pg8::MoeOrder<true> S{(const char*)(ws + WS_H), (const char*)(ws + WS_WGU), (size_t)2048 * 1024, 8, G, c, GT_OFF, (const LAS int*)(L + TS_OFF), 1024};
      moe_setup<true>(P, L, S);
      pg8::EpiSwiglu8 E{P.b_gu, ws + WS_ACT};
      pg8::gemm_phase<pg8::EpiSwiglu8, pg8::MoeOrder<true>, true, true, true>(L, 512, S, E); }
    GRID_BAR(); } }
    TP_END(6); TP_BEGIN(7);
    { REPS(7) {
    { pg8::MoeOrder<false> S{(const char*)(ws + WS_ACT), (const char*)(ws + WS_WD), (size_t)1024 * 1024, 4, G, c, 0, (const LAS int*)(L + TS_OFF), 1024};
      moe_setup<false>(P, L, S);
      pg8::EpiDown8 E{P.b_down, (const float*)(ws + WS_GLIST), ws + WS_Y};
      pg8::gemm_phase<pg8::EpiDown8, pg8::MoeOrder<false>, true, false, true>(L, 512, S, E); }
    GRID_BAR(); } }
#else
    { pg8::MoeOrder<true> S{(const char*)(ws + WS_H), (const char*)(ws + WS_WGU), (size_t)2048 * 1024 * 2, 8, G, c, GT_OFF, (const LAS int*)(L + TS_OFF), 2048};
      moe_setup<true>(P, L, S);
      pg8::EpiSwiglu E{P.b_gu, (bf16_t*)(ws + WS_ACT)};
      pg8::gemm_phase<pg8::EpiSwiglu, pg8::MoeOrder<true>, true, true>(L, 1024, S, E); }
    GRID_BAR(); } }
    { REPS(7) {
    { pg8::MoeOrder<false> S{(const char*)(ws + WS_ACT), (const char*)(ws + WS_WD), (size_t)1024 * 1024 * 2, 4, G, c, 0, (const LAS int*)(L + TS_OFF), 2048};
      moe_setup<false>(P, L, S);
      pg8::EpiDown E{P.b_down, (const float*)(ws + WS_GLIST), (bf16_t*)(ws + WS_Y)};
      pg8::gemm_phase<pg8::EpiDown, pg8::MoeOrder<false>, true, false>(L, 1024, S, E); }
    GRID_BAR(); } }
#endif
#else
    ph_moe1_naive(P); GRID_BAR();
    ph_moe2_naive(P); GRID_BAR();
#endif
    TP_END(7); TP_BEGIN(8);
    ph_final(P, (int*)lds);
    if ((PROBE_PHASE) >= 0) GRID_BAR();
    TP_END(8); TP_END(9);
    if ((PROBE_PHASE) == 40) { TP_BEGIN(40); for (int i = 0; i < 20; ++i) GRID_BAR(); TP_END(40); }
    if ((PROBE_PHASE) >= 0 && blockIdx.x == 0 && threadIdx.x == 0) { const unsigned long long t0 = __builtin_amdgcn_s_memrealtime(); while (__builtin_amdgcn_s_memrealtime() - t0 < (tp1 - tp0)) __builtin_amdgcn_s_sleep(8); }
}

extern "C" void kernel_launch(void* const* d_in, const int* in_sizes, int n_in, void* d_out, int out_size, void* d_ws, size_t ws_size, hipStream_t stream) {
    static int grid = 0;
    if (grid == 0) {
        if (n_in != 22 || out_size != T * D || ws_size < WS_END) { fprintf(stderr, "kernel_launch: unexpected shapes (n_in %d out %d ws %zu)\n", n_in, out_size, ws_size); grid = -1; return; }
        int dev = 0, cus = 0, per_cu = 0;
        if (hipGetDevice(&dev) != hipSuccess || hipDeviceGetAttribute(&cus, hipDeviceAttributeMultiprocessorCount, dev) != hipSuccess) { grid = -1; return; }
        if (hipFuncSetAttribute((const void*)mega_fwd, hipFuncAttributeMaxDynamicSharedMemorySize, LDS_BYTES) != hipSuccess) { fprintf(stderr, "kernel_launch: hipFuncSetAttribute failed\n"); grid = -1; return; }
        if (hipOccupancyMaxActiveBlocksPerMultiprocessor(&per_cu, (const void*)mega_fwd, NWAVES * 64, LDS_BYTES) != hipSuccess || per_cu < 1) fprintf(stderr, "kernel_launch: occupancy query reports %d\n", per_cu);
        (void)hipGetLastError();
        grid = cus;
    }
    if (grid < 0) return;
    Ptrs P{};
    P.x = (const float*)d_in[0]; P.pos = (const int*)d_in[1]; P.g_attn = (const float*)d_in[2]; P.w_in = (const float*)d_in[3]; P.w_pool = (const float*)d_in[4];
    P.b_pool = (const float*)d_in[5]; P.pool_scale = (const float*)d_in[6]; P.g_q_a = (const float*)d_in[7]; P.w_q_b = (const float*)d_in[8]; P.g_kv_a = (const float*)d_in[9];
    P.w_kv_b = (const float*)d_in[10]; P.g_out_pool = (const float*)d_in[11]; P.g_out_attn = (const float*)d_in[12]; P.w_out = (const float*)d_in[13]; P.g_ffn = (const float*)d_in[14];
    P.w_router = (const float*)d_in[15]; P.b_router = (const float*)d_in[16]; P.w_gu = (const float*)d_in[17]; P.b_gu = (const float*)d_in[18]; P.w_down = (const float*)d_in[19];
    P.b_down = (const float*)d_in[20]; P.g_final = (const float*)d_in[21]; P.out = (float*)d_out; P.ws = (unsigned char*)d_ws;
    if (hipMemsetAsync((unsigned char*)d_ws + WS_CTL, 0, CTL_BYTES, stream) != hipSuccess) { fprintf(stderr, "kernel_launch: memset failed\n"); return; }
    hipLaunchKernelGGL(mega_fwd, dim3(grid), dim3(NWAVES * 64), LDS_BYTES, stream, P);
}
```
